# Optimizing an MI355X kernel written in HIP

```python
import jax, jax.numpy as jnp
from jax import lax
import numpy as np

D_MODEL = 1024
BATCH = 2
SEQ = 8192
DEPTH = 2
DEC_BATCH = 128
DEC_SEQ = 8
PAST_LEN = 8192
PAGE_SIZE = 128

RWKV_HEAD = 64
RWKV_HEADS = D_MODEL // RWKV_HEAD
DECAY_LORA = 64
ICL_LORA = 64
GN_EPS = 64e-5
ATT_HEAD_DIM = 64
ATT_HEADS = D_MODEL // ATT_HEAD_DIM
ATT_KV_HEADS = 4
ATT_GROUP = ATT_HEADS // ATT_KV_HEADS
WINDOW = 128
BLOCK = WINDOW
ATT_SCALE = ATT_HEAD_DIM ** -0.5
NEG = -1e30
N_A = (DEPTH + 1) // 2
N_B = DEPTH // 2
ALPHA = (2 * DEPTH) ** 0.25
BETA = (8 * DEPTH) ** -0.25
LN_EPS = 1e-5

kernel_name = 'rwkv7_swa_sink_alibi_deepnorm_step'


def layer_norm(x, g, b):
    xf = x.astype(jnp.float32)
    mu = jnp.mean(xf, -1, keepdims=True)
    var = jnp.mean(jnp.square(xf - mu), -1, keepdims=True)
    return ((xf - mu) * lax.rsqrt(var + LN_EPS) * g.astype(jnp.float32) + b.astype(jnp.float32)).astype(x.dtype)


def rwkv7_mixer(x, shift_prev, wkv0, mu, w_in, w0, w1, w2, a0, a1, a2, k_k, k_a, r_k, gn_g, gn_b, w_out):
    B, T, D = x.shape
    H, N = RWKV_HEADS, RWKV_HEAD
    f32 = jnp.float32
    x_prev = jnp.concatenate([shift_prev[:, None, :].astype(x.dtype), x[:, :-1]], axis=1)
    xx = x_prev - x
    xs = x[None] + xx[None] * mu[:, None, None, :]
    rkvg = jnp.einsum('pbtd,pde->pbte', xs[:4], w_in)
    r, k, v, g = rkvg[0], rkvg[1], rkvg[2], rkvg[3]
    wl = (w0 + jnp.tanh(xs[4] @ w1) @ w2).astype(f32)
    decay = jnp.exp(-jnp.exp(-jax.nn.softplus(-wl) - 0.5))
    a = jax.nn.sigmoid((a0 + (xs[5] @ a1) @ a2).astype(f32))
    heads = lambda t: t.reshape(B, T, H, N)
    kk = heads(k.astype(f32) * k_k.astype(f32))
    kk = kk / jnp.maximum(jnp.sqrt(jnp.sum(kk * kk, -1, keepdims=True)), 1e-12)
    kf = k.astype(f32) * (1.0 + (a - 1.0) * k_a.astype(f32))
    rh, kh, vh, ah, wh = heads(r.astype(f32)), heads(kf), heads(v.astype(f32)), heads(a), heads(decay)
    seq = (jnp.moveaxis(rh, 1, 0), jnp.moveaxis(wh, 1, 0), jnp.moveaxis(kh, 1, 0),
           jnp.moveaxis(vh, 1, 0), jnp.moveaxis(kk, 1, 0), jnp.moveaxis(kk * ah, 1, 0))

    def step(S, inp):
        r_t, w_t, k_t, v_t, kk_t, b_t = inp
        sa = jnp.einsum('bhvk,bhk->bhv', S, kk_t)
        S = S * w_t[:, :, None, :] - sa[..., None] * b_t[:, :, None, :] + v_t[..., None] * k_t[:, :, None, :]
        return S, jnp.einsum('bhvk,bhk->bhv', S, r_t)

    S_fin, ys = lax.scan(step, wkv0.astype(f32), seq)
    y = jnp.moveaxis(ys, 0, 1)
    m = jnp.mean(y, -1, keepdims=True)
    var = jnp.mean(jnp.square(y - m), -1, keepdims=True)
    y = (y - m) * lax.rsqrt(var + GN_EPS) * gn_g.astype(f32).reshape(H, N) + gn_b.astype(f32).reshape(H, N)
    y = y + jnp.sum(rh * kh * r_k.astype(f32), -1, keepdims=True) * vh
    out = (y.reshape(B, T, D).astype(x.dtype) * jax.nn.silu(g)) @ w_out
    return out, x[:, -1], S_fin.astype(x.dtype)


def swa_project(x, w_in):
    B, T, _ = x.shape
    HQ, HKV = ATT_HEADS * ATT_HEAD_DIM, ATT_KV_HEADS * ATT_HEAD_DIM
    z = x @ w_in
    q = z[..., :HQ].reshape(B, T, ATT_KV_HEADS, ATT_GROUP, ATT_HEAD_DIM)
    k = z[..., HQ:HQ + HKV].reshape(B, T, ATT_KV_HEADS, ATT_HEAD_DIM)
    v = z[..., HQ + HKV:HQ + 2 * HKV].reshape(B, T, ATT_KV_HEADS, ATT_HEAD_DIM)
    gate = z[..., HQ + 2 * HKV:]
    return q, k, v, gate


def alibi_slopes():
    h = jnp.arange(1, ATT_HEADS + 1, dtype=jnp.float32)
    return jnp.exp2(-8.0 * h / ATT_HEADS).reshape(ATT_KV_HEADS, ATT_GROUP)


def window_attend(q, k, v, q_pos, k_pos, sinks):
    s = jnp.einsum('bnqhgd,bnshd->bnhgqs', q, k, preferred_element_type=jnp.float32) * ATT_SCALE
    dist = q_pos[:, :, None] - k_pos[:, None, :]
    live = (dist >= 0) & (dist < WINDOW) & (k_pos[:, None, :] >= 0)
    s = s - alibi_slopes()[None, None, :, :, None, None] * dist.astype(jnp.float32)[None, :, None, None]
    s = jnp.where(live[None, :, None, None], s, NEG)
    sink = jnp.broadcast_to(sinks.astype(jnp.float32).reshape(ATT_KV_HEADS, ATT_GROUP)[None, None, :, :, None, None],
                            s.shape[:-1] + (1,))
    p = jax.nn.softmax(jnp.concatenate([s, sink], -1), axis=-1)[..., :-1]
    return jnp.einsum('bnhgqs,bnshd->bnqhgd', p.astype(v.dtype), v)


def swa_prompt(x, w_in, sinks, w_out):
    B, T, _ = x.shape
    nb = T // BLOCK
    q, k, v, gate = swa_project(x, w_in)
    qb = q.reshape(B, nb, BLOCK, ATT_KV_HEADS, ATT_GROUP, ATT_HEAD_DIM)
    kb = k.reshape(B, nb, BLOCK, ATT_KV_HEADS, ATT_HEAD_DIM)
    vb = v.reshape(B, nb, BLOCK, ATT_KV_HEADS, ATT_HEAD_DIM)
    band = lambda t: jnp.concatenate([jnp.concatenate([jnp.zeros_like(t[:, :1]), t[:, :-1]], 1), t], 2)
    pos = jnp.arange(T, dtype=jnp.int32).reshape(nb, BLOCK)
    k_pos = jnp.concatenate([pos - BLOCK, pos], 1)
    o = window_attend(qb, band(kb), band(vb), pos, k_pos, sinks).reshape(B, T, -1)
    out = (o * jax.nn.silu(gate)) @ w_out
    keep = min(WINDOW, T)
    return out, k[:, T - keep:], v[:, T - keep:]


def swa_sample(x, buf_k, buf_v, w_in, sinks, w_out):
    B, T, _ = x.shape
    wb = buf_k.shape[1]
    q, k, v, gate = swa_project(x, w_in)
    keys = jnp.concatenate([buf_k.astype(k.dtype), k], 1)
    vals = jnp.concatenate([buf_v.astype(v.dtype), v], 1)
    q_pos = PAST_LEN + jnp.arange(T, dtype=jnp.int32)
    k_pos = jnp.concatenate([PAST_LEN - wb + jnp.arange(wb, dtype=jnp.int32), q_pos])
    o = window_attend(q[:, None], keys[:, None], vals[:, None], q_pos[None], k_pos[None], sinks)[:, 0]
    out = (o.reshape(B, T, -1) * jax.nn.silu(gate)) @ w_out
    return out, keys[:, T:], vals[:, T:]


def setup_inputs(seed: int = 0) -> dict:
    key = jax.random.key(seed)
    ks = jax.random.split(key, 26)
    f32 = jnp.float32
    D, H, N = D_MODEL, RWKV_HEADS, RWKV_HEAD
    HQ, HKV = ATT_HEADS * ATT_HEAD_DIM, ATT_KV_HEADS * ATT_HEAD_DIM
    wb = min(WINDOW, PAST_LEN)
    nrm = lambda k, shape, s: s * jax.random.normal(k, shape, f32)
    att_cols = jnp.concatenate([jnp.ones((HQ + HKV,), f32), jnp.full((HKV,), BETA, f32), jnp.ones((HQ,), f32)])
    return {
        'x_prompt': nrm(ks[0], (BATCH, SEQ, D), 1.0),
        'x_sample': nrm(ks[1], (DEC_BATCH, DEC_SEQ, D), 1.0),
        'state_wkv': nrm(ks[2], (N_A, DEC_BATCH, H, N, N), 0.3),
        'state_shift': nrm(ks[3], (N_A, DEC_BATCH, D), 1.0),
        'cache_win_k': nrm(ks[4], (N_B, DEC_BATCH, wb, ATT_KV_HEADS, ATT_HEAD_DIM), 1.0),
        'cache_win_v': nrm(ks[5], (N_B, DEC_BATCH, wb, ATT_KV_HEADS, ATT_HEAD_DIM), 1.0),
        'ln_g': 1.0 + nrm(ks[6], (DEPTH, D), 0.05),
        'ln_b': nrm(ks[7], (DEPTH, D), 0.02),
        'rwkv_mu': jax.random.uniform(ks[8], (N_A, 6, D), f32),
        'rwkv_w_in': nrm(ks[9], (N_A, 4, D, D), D ** -0.5) * jnp.array([1.0, 1.0, BETA, 1.0], f32)[None, :, None, None],
        'rwkv_w0': jax.random.uniform(ks[10], (N_A, D), f32, -6.0, 1.0),
        'rwkv_w1': nrm(ks[11], (N_A, D, DECAY_LORA), D ** -0.5),
        'rwkv_w2': nrm(ks[12], (N_A, DECAY_LORA, D), 0.5 * DECAY_LORA ** -0.5),
        'rwkv_a0': nrm(ks[13], (N_A, D), 0.3),
        'rwkv_a1': nrm(ks[14], (N_A, D, ICL_LORA), D ** -0.5),
        'rwkv_a2': nrm(ks[15], (N_A, ICL_LORA, D), 0.5 * ICL_LORA ** -0.5),
        'rwkv_k_k': 0.85 + nrm(ks[16], (N_A, D), 0.05),
        'rwkv_k_a': 1.0 + nrm(ks[17], (N_A, D), 0.05),
        'rwkv_r_k': nrm(ks[18], (N_A, H, N), 0.1),
        'rwkv_gn_g': 1.0 + nrm(ks[19], (N_A, D), 0.05),
        'rwkv_gn_b': nrm(ks[20], (N_A, D), 0.02),
        'rwkv_w_out': nrm(ks[21], (N_A, D, D), BETA * D ** -0.5),
        'att_w_in': nrm(ks[22], (N_B, D, 2 * HQ + 2 * HKV), D ** -0.5) * att_cols,
        'att_sinks': nrm(ks[23], (N_B, ATT_HEADS), 1.0),
        'att_w_out': nrm(ks[24], (N_B, HQ, D), BETA * HQ ** -0.5),
    }


def reference(x_prompt, x_sample, state_wkv, state_shift, cache_win_k, cache_win_v, ln_g, ln_b,
              rwkv_mu, rwkv_w_in, rwkv_w0, rwkv_w1, rwkv_w2, rwkv_a0, rwkv_a1, rwkv_a2, rwkv_k_k,
              rwkv_k_a, rwkv_r_k, rwkv_gn_g, rwkv_gn_b, rwkv_w_out, att_w_in, att_sinks, att_w_out):
    xp, xs = x_prompt, x_sample
    bp = xp.shape[0]
    wkv_p, sh_p, wk_p, wv_p = [], [], [], []
    wkv_s, sh_s, wk_s, wv_s = [], [], [], []
    for i in range(DEPTH):
        j = i // 2
        if i % 2 == 0:
            prm = (rwkv_mu[j], rwkv_w_in[j], rwkv_w0[j], rwkv_w1[j], rwkv_w2[j], rwkv_a0[j], rwkv_a1[j],
                   rwkv_a2[j], rwkv_k_k[j], rwkv_k_a[j], rwkv_r_k[j], rwkv_gn_g[j], rwkv_gn_b[j], rwkv_w_out[j])
            zero_shift = jnp.zeros((bp, D_MODEL), xp.dtype)
            zero_wkv = jnp.zeros((bp, RWKV_HEADS, RWKV_HEAD, RWKV_HEAD), xp.dtype)
            dp, shp, Sp = rwkv7_mixer(xp, zero_shift, zero_wkv, *prm)
            ds, shs, Ss = rwkv7_mixer(xs, state_shift[j], state_wkv[j], *prm)
            wkv_p.append(Sp); sh_p.append(shp); wkv_s.append(Ss); sh_s.append(shs)
        else:
            dp, kp, vp = swa_prompt(xp, att_w_in[j], att_sinks[j], att_w_out[j])
            ds, ksn, vsn = swa_sample(xs, cache_win_k[j], cache_win_v[j], att_w_in[j], att_sinks[j], att_w_out[j])
            wk_p.append(kp); wv_p.append(vp); wk_s.append(ksn); wv_s.append(vsn)
        xp = layer_norm(ALPHA * xp + dp, ln_g[i], ln_b[i])
        xs = layer_norm(ALPHA * xs + ds, ln_g[i], ln_b[i])
    new_wkv_prompt = jnp.stack(wkv_p)
    new_shift_prompt = jnp.stack(sh_p)
    new_win_k_prompt = jnp.stack(wk_p)
    new_win_v_prompt = jnp.stack(wv_p)
    new_wkv_sample = jnp.stack(wkv_s)
    new_shift_sample = jnp.stack(sh_s)
    new_win_k_sample = jnp.stack(wk_s)
    new_win_v_sample = jnp.stack(wv_s)
    return (xp, xs, new_wkv_prompt, new_shift_prompt, new_win_k_prompt, new_win_v_prompt,
            new_wkv_sample, new_shift_sample, new_win_k_sample, new_win_v_sample)
```

```cpp
#include <hip/hip_runtime.h>
#include <hip/hip_cooperative_groups.h>
#include <stdint.h>
#include <cstdio>
namespace cg = cooperative_groups;

#ifndef PHMASK
#define PHMASK 0xFFF
#endif
#ifndef MULTI_LAUNCH
#define MULTI_LAUNCH 0
#endif

typedef unsigned short bf16_t;
typedef _Float16 f16_t;
typedef __attribute__((ext_vector_type(8))) short bf16x8;
typedef __attribute__((ext_vector_type(4))) float f32x4;
typedef __attribute__((ext_vector_type(4))) unsigned u32x4;

#define DM 1024
#define NTOK 17408
#define NPR 16384
#define TP 8192
#define NC 32
#define CL 256
#define NBH 32
#define ALPHA_F 1.41421356237f
#define SMEM_BYTES (56 * 1024)
#define NPHASE 12

#define OUT_Y 0
#define OUT_WKV_P 17825792
#define OUT_SH_P 17956864
#define OUT_WK_P 17958912
#define OUT_WV_P 18024448
#define OUT_WKV_S 18089984
#define OUT_SH_S 26478592
#define OUT_WK_S 26609664
#define OUT_WV_S 30803968

struct Params {
  const float *x_prompt, *x_sample, *state_wkv, *state_shift, *cache_k, *cache_v, *ln_g, *ln_b;
  const float *mu, *w_in, *w0, *w1, *w2, *a0, *a1, *a2, *k_k, *k_a, *r_k, *gn_g, *gn_b, *w_out;
  const float *att_w_in, *att_sinks, *att_w_out;
  float* out;
  unsigned* bar;
  bf16_t *WtIn0, *W2t, *A2t, *WtOut0, *WtIn1, *WtOut1;
  bf16_t *XB, *XXB;
  bf16_t *Rb, *Kb, *Vb, *Gb;
  bf16_t *H1, *H2;
  int phase_begin, phase_end;
};

__device__ __forceinline__ bf16_t f2bf(float f) {
  unsigned u = __float_as_uint(f);
  u += 0x7fffu + ((u >> 16) & 1u);
  return (bf16_t)(u >> 16);
}
__device__ __forceinline__ float bf2f(bf16_t h) { return __uint_as_float(((unsigned)h) << 16); }
__device__ __forceinline__ unsigned pack2(float a, float b) { return (unsigned)f2bf(a) | ((unsigned)f2bf(b) << 16); }
__device__ __forceinline__ float wave_sum(float x) {
#pragma unroll
  for (int o = 32; o >= 1; o >>= 1) x += __shfl_xor(x, o);
  return x;
}
__device__ __forceinline__ float wave_max(float x) {
#pragma unroll
  for (int o = 32; o >= 1; o >>= 1) x = fmaxf(x, __shfl_xor(x, o));
  return x;
}
__device__ __forceinline__ float quad_sum(float x) {
  x += __builtin_bit_cast(float, __builtin_amdgcn_update_dpp(0, __builtin_bit_cast(int, x), 0xB1, 0xF, 0xF, true));
  x += __builtin_bit_cast(float, __builtin_amdgcn_update_dpp(0, __builtin_bit_cast(int, x), 0x4E, 0xF, 0xF, true));
  return x;
}
__device__ __forceinline__ float sigmoidf_(float x) { return 1.f / (1.f + __expf(-x)); }
__device__ __forceinline__ const float* xin_row(const Params& P, int m) {
  return (m < NPR) ? (P.x_prompt + (size_t)m * DM) : (P.x_sample + (size_t)(m - NPR) * DM);
}

#define XB_TMO      128
#define XB_XCNT(j)  (256  + 64 * (j))
#define XB_XSUB(j)  (1280 + 64 * (j))
#define XB_XGEN(j)  (2304 + 64 * (j))
#define XB_TOP      3328
#define XB_TOPGEN   3392
#define XCD_BAR_WORDS 3456
#define XB_SPIN_CAP (1u << 22)
#define LAS __attribute__((address_space(3)))
__device__ __forceinline__ unsigned xb_ld(unsigned* p) { return __hip_atomic_load(p, __ATOMIC_RELAXED, __HIP_MEMORY_SCOPE_AGENT); }
__device__ __forceinline__ unsigned xb_add(unsigned* p, unsigned v) { return __hip_atomic_fetch_add(p, v, __ATOMIC_RELAXED, __HIP_MEMORY_SCOPE_AGENT); }
__device__ __forceinline__ unsigned xb_xcc_id() { return (unsigned)__builtin_amdgcn_s_getreg((3 << 11) | 20) & 0xFu; }
#define XB_SPIN(cond, bar) do { unsigned _sp = 0; while (cond) { __builtin_amdgcn_s_sleep(1); \
    if ((++_sp & 255u) == 0u) { if (xb_ld(&(bar)[XB_TMO])) break; if (_sp > XB_SPIN_CAP) { atomicAdd(&(bar)[XB_TMO], 1u); break; } } } } while (0)
struct XcdBarrier { unsigned* bar; unsigned x; volatile LAS unsigned* st; };
__device__ __forceinline__ XcdBarrier xcd_barrier_post(unsigned* bar, volatile LAS unsigned* st) {
  XcdBarrier b; b.bar = bar; b.x = xb_xcc_id(); b.st = st;
  if (threadIdx.x == 0) (void)xb_add(&bar[XB_XCNT(b.x)], 1u);
  return b;
}
__device__ __forceinline__ void xcd_barrier_complete(unsigned* bar, unsigned x, unsigned& nloc, unsigned& nx) {
  const unsigned G = gridDim.x * gridDim.y * gridDim.z;
  unsigned sum, cnt, mine, sp = 0u;
  for (;;) {
    sum = 0u; cnt = 0u; mine = 0u;
#pragma unroll
    for (unsigned j = 0; j < 16; ++j) { const unsigned c = xb_ld(&bar[XB_XCNT(j)]); sum += c; cnt += (c > 0u) ? 1u : 0u; mine = (j == x) ? c : mine; }
    if (sum == G) break;
    __builtin_amdgcn_s_sleep(1);
    if ((++sp & 255u) == 0u) { if (xb_ld(&bar[XB_TMO])) break; if (sp > XB_SPIN_CAP) { atomicAdd(&bar[XB_TMO], 1u); break; } }
  }
  nloc = mine > 0u ? mine : 1u; nx = cnt > 0u ? cnt : 1u;
}
__device__ __forceinline__ void xcd_barrier(const XcdBarrier& b) {
  asm volatile("s_waitcnt vmcnt(0)" ::: "memory");
  __syncthreads();
  if (threadIdx.x == 0) {
    unsigned* bar = b.bar;
    __builtin_amdgcn_s_waitcnt(0);
    unsigned nloc = b.st[0], nx = b.st[1];
    if (nloc == 0u) { xcd_barrier_complete(bar, b.x, nloc, nx); b.st[0] = nloc; b.st[1] = nx; }
    const unsigned old = xb_add(&bar[XB_XSUB(b.x)], 1u);
    const unsigned gen = old / nloc;
    if (old + 1u == (gen + 1u) * nloc) {
      __builtin_amdgcn_fence(__ATOMIC_RELEASE, "agent");
      asm volatile("s_waitcnt vmcnt(0)" ::: "memory");
      const unsigned og = xb_add(&bar[XB_TOP], 1u);
      const unsigned tg = og / nx;
      if (og + 1u == (tg + 1u) * nx) xb_add(&bar[XB_TOPGEN], 1u);
      else XB_SPIN(xb_ld(&bar[XB_TOPGEN]) == tg, bar);
      __builtin_amdgcn_fence(__ATOMIC_ACQUIRE, "agent");
      xb_add(&bar[XB_XGEN(b.x)], 1u);
      asm volatile("s_waitcnt vmcnt(0)" ::: "memory");
    } else {
      XB_SPIN(xb_ld(&bar[XB_XGEN(b.x)]) == gen, bar);
      __builtin_amdgcn_fence(__ATOMIC_ACQUIRE, "agent");
      asm volatile("s_waitcnt vmcnt(0)" ::: "memory");
    }
  }
  __syncthreads();
}

__device__ __forceinline__ void transpose_tile(const float* __restrict__ src, int ld, int k0, int n0, bf16_t* __restrict__ dst, int ldd, float* tile) {
  const int t = threadIdx.x;
  {
    const int n = t & 63, kq = t >> 6;
#pragma unroll 4
    for (int i = 0; i < 16; i++) { const int k = i * 4 + kq; tile[k * 65 + n] = src[(size_t)(k0 + k) * ld + n0 + n]; }
  }
  __syncthreads();
  {
    const int k = t & 63, nq = t >> 6;
#pragma unroll 4
    for (int i = 0; i < 16; i++) { const int n2 = i * 4 + nq; dst[(size_t)(n0 + n2) * ldd + k0 + k] = f2bf(tile[k * 65 + n2]); }
  }
  __syncthreads();
}

__device__ __forceinline__ void phase_prep(const Params& P, unsigned char* smem, int bid, int nb) {
  float* tile = (float*)smem;
  const int t = threadIdx.x;
  const int NITEMS = 2242 + 4352 + 130;
  for (int id = bid; id < NITEMS; id += nb) {
    if (id < 1024) { const int p = id >> 8, r = id & 255; transpose_tile(P.w_in + (size_t)p * DM * DM, DM, (r >> 4) * 64, (r & 15) * 64, P.WtIn0 + (size_t)p * DM * DM, DM, tile); }
    else if (id < 1040) transpose_tile(P.w1, 64, (id - 1024) * 64, 0, P.WtIn0 + (size_t)4096 * DM, DM, tile);
    else if (id < 1056) transpose_tile(P.a1, 64, (id - 1040) * 64, 0, P.WtIn0 + (size_t)4224 * DM, DM, tile);
    else if (id < 1072) transpose_tile(P.w2, DM, 0, (id - 1056) * 64, P.W2t, 64, tile);
    else if (id < 1088) transpose_tile(P.a2, DM, 0, (id - 1072) * 64, P.A2t, 64, tile);
    else if (id < 1344) { const int r = id - 1088; transpose_tile(P.w_out, DM, (r >> 4) * 64, (r & 15) * 64, P.WtOut0, DM, tile); }
    else if (id < 1984) { const int r = id - 1344; transpose_tile(P.att_w_in, 2560, (r / 40) * 64, (r % 40) * 64, P.WtIn1, DM, tile); }
    else if (id < 2240) { const int r = id - 1984; transpose_tile(P.att_w_out, DM, (r >> 4) * 64, (r & 15) * 64, P.WtOut1, DM, tile); }
    else if (id < 2242) {
      uint4* z = (uint4*)(P.WtIn0 + (size_t)(id == 2240 ? 4160 : 4288) * DM);
      for (int i = t; i < 8192; i += 256) z[i] = make_uint4(0, 0, 0, 0);
    } else if (id < 2242 + 4352) {
      const int it = id - 2242;
#pragma unroll
      for (int q = 0; q < 4; q++) {
        const int m = it * 4 + q;
        const float4 x = ((const float4*)xin_row(P, m))[t];
        float4 pv = make_float4(0.f, 0.f, 0.f, 0.f);
        if (m < NPR) { if ((m & (TP - 1)) != 0) pv = ((const float4*)xin_row(P, m - 1))[t]; }
        else { const int ms = m - NPR; if ((ms & 7) != 0) pv = ((const float4*)xin_row(P, m - 1))[t]; else pv = ((const float4*)(P.state_shift + (size_t)(ms >> 3) * DM))[t]; }
        uint2 xb, xxb;
        xb.x = pack2(x.x, x.y); xb.y = pack2(x.z, x.w);
        xxb.x = pack2(pv.x - x.x, pv.y - x.y); xxb.y = pack2(pv.z - x.z, pv.w - x.w);
        ((uint2*)(P.XB + (size_t)m * DM))[t] = xb;
        ((uint2*)(P.XXB + (size_t)m * DM))[t] = xxb;
      }
    } else {
      const int r = id - (2242 + 4352);
      if (r < 2) ((float4*)(P.out + OUT_SH_P + (size_t)r * DM))[t] = ((const float4*)(P.x_prompt + ((size_t)r * TP + TP - 1) * DM))[t];
      else { const int b = r - 2; ((float4*)(P.out + OUT_SH_S + (size_t)b * DM))[t] = ((const float4*)(P.x_sample + ((size_t)b * 8 + 7) * DM))[t]; }
    }
  }
}

#define LDS_LD 72
template <int MODE>
__device__ __forceinline__ void gemm_tile(const Params& P, unsigned char* smem, int mt, int nt) {
  constexpr int KT = (MODE == 2) ? 1 : 16;
  bf16_t* As = (bf16_t*)smem;
  bf16_t* Bs = As + 128 * LDS_LD;
  const int t = threadIdx.x, lane = t & 63, w = t >> 6;
  const int wm = w >> 1, wn = w & 1;
  const int g = lane >> 4, lc = lane & 15;
  const int lrow = t >> 3, lch = t & 7;
  const int m0 = mt * 128, n0 = nt * 128;

  const bf16_t* Ap; const bf16_t* A2p = nullptr; const float* mup = nullptr; const bf16_t* Bp; int lda, ldb;
  if (MODE == 1) {
    const int p = (nt < 32) ? (nt >> 3) : (4 + (nt - 32));
    Ap = P.XB; A2p = P.XXB; lda = DM; mup = P.mu + (size_t)p * DM;
    Bp = P.WtIn0 + (size_t)((nt < 32) ? n0 : (4096 + (nt - 32) * 128)) * DM; ldb = DM;
  } else if (MODE == 2) {
    Ap = (nt < 8) ? P.H1 : P.H2; lda = 64;
    Bp = ((nt < 8) ? P.W2t : P.A2t) + (size_t)((nt & 7) * 128) * 64; ldb = 64;
  } else if (MODE == 3) { Ap = P.Gb; lda = DM; Bp = P.WtOut0 + (size_t)n0 * DM; ldb = DM; }
  else if (MODE == 4) { Ap = P.Rb; lda = DM; Bp = P.WtIn1 + (size_t)n0 * DM; ldb = DM; }
  else { Ap = P.Gb; lda = DM; Bp = P.WtOut1 + (size_t)n0 * DM; ldb = DM; }

  f32x4 acc[4][4];
#pragma unroll
  for (int i = 0; i < 4; i++)
#pragma unroll
    for (int j = 0; j < 4; j++) acc[i][j] = (f32x4){0.f, 0.f, 0.f, 0.f};

  u32x4 ra[4], rb[4], ra2[4];
  float4 mu0 = make_float4(0, 0, 0, 0), mu1 = make_float4(0, 0, 0, 0);
#define LOAD_TILE(kt_) do { \
    const int k0_ = (kt_) * 64 + lch * 8; \
    _Pragma("unroll") for (int i_ = 0; i_ < 4; i_++) { \
      const int row_ = lrow + 32 * i_; \
      ra[i_] = *(const u32x4*)(Ap + (size_t)(m0 + row_) * lda + k0_); \
      if (MODE == 1) ra2[i_] = *(const u32x4*)(A2p + (size_t)(m0 + row_) * lda + k0_); \
      rb[i_] = *(const u32x4*)(Bp + (size_t)row_ * ldb + k0_); \
    } \
    if (MODE == 1) { mu0 = *(const float4*)(mup + k0_); mu1 = *(const float4*)(mup + k0_ + 4); } \
  } while (0)
  LOAD_TILE(0);
  for (int kt = 0; kt < KT; kt++) {
    __syncthreads();
#pragma unroll
    for (int i = 0; i < 4; i++) {
      const int row = lrow + 32 * i;
      u32x4 av = ra[i];
      if (MODE == 1) {
        const u32x4 xv = ra[i], dv = ra2[i];
#define XS2(xw, dw, ma, mb) pack2(fmaf(__uint_as_float((dw) << 16), (ma), __uint_as_float((xw) << 16)), fmaf(__uint_as_float((dw) & 0xffff0000u), (mb), __uint_as_float((xw) & 0xffff0000u)))
        av = (u32x4){XS2(xv.x, dv.x, mu0.x, mu0.y), XS2(xv.y, dv.y, mu0.z, mu0.w), XS2(xv.z, dv.z, mu1.x, mu1.y), XS2(xv.w, dv.w, mu1.z, mu1.w)};
      }
      *(u32x4*)(As + row * LDS_LD + lch * 8) = av;
      *(u32x4*)(Bs + row * LDS_LD + lch * 8) = rb[i];
    }
    __syncthreads();
    if (kt + 1 < KT) LOAD_TILE(kt + 1);
#pragma unroll
    for (int ks = 0; ks < 2; ks++) {
      bf16x8 af[4], bfr[4];
#pragma unroll
      for (int i = 0; i < 4; i++) af[i] = *(const bf16x8*)(Bs + (wn * 64 + i * 16 + lc) * LDS_LD + ks * 32 + g * 8);
#pragma unroll
      for (int j = 0; j < 4; j++) bfr[j] = *(const bf16x8*)(As + (wm * 64 + j * 16 + lc) * LDS_LD + ks * 32 + g * 8);
#pragma unroll
      for (int i = 0; i < 4; i++)
#pragma unroll
        for (int j = 0; j < 4; j++) acc[i][j] = __builtin_amdgcn_mfma_f32_16x16x32_bf16(af[i], bfr[j], acc[i][j], 0, 0, 0);
    }
  }
#pragma unroll
  for (int i = 0; i < 4; i++) {
    const int nl = wn * 64 + i * 16 + 4 * g;
#pragma unroll
    for (int j = 0; j < 4; j++) {
      const int m = m0 + wm * 64 + j * 16 + lc;
      const f32x4 v = acc[i][j];
      if (MODE == 1) {
        if (nt < 32) {
          const int p = nt >> 3, c = (nt & 7) * 128 + nl;
          bf16_t* dst = (p == 0) ? P.Rb : (p == 1) ? P.Kb : (p == 2) ? P.Vb : P.Gb;
          uint2 o; o.x = pack2(v[0], v[1]); o.y = pack2(v[2], v[3]);
          *(uint2*)(dst + (size_t)m * DM + c) = o;
        } else if (nl < 64) {
          uint2 o;
          if (nt == 32) { o.x = pack2(tanhf(v[0]), tanhf(v[1])); o.y = pack2(tanhf(v[2]), tanhf(v[3])); *(uint2*)(P.H1 + (size_t)m * 64 + nl) = o; }
          else { o.x = pack2(v[0], v[1]); o.y = pack2(v[2], v[3]); *(uint2*)(P.H2 + (size_t)m * 64 + nl) = o; }
        }
      } else if (MODE == 2) {
        const int c = (nt & 7) * 128 + nl;
        f16_t o[4];
        if (nt < 8) {
          const float4 w0v = *(const float4*)(P.w0 + c);
          const float ws[4] = {w0v.x, w0v.y, w0v.z, w0v.w};
#pragma unroll
          for (int r = 0; r < 4; r++) o[r] = (f16_t)(sigmoidf_(ws[r] + v[r]) * 0.60653065971f);
          *(uint2*)((f16_t*)P.XB + (size_t)m * DM + c) = *(uint2*)o;
        } else {
          const float4 a0v = *(const float4*)(P.a0 + c);
          const float as_[4] = {a0v.x, a0v.y, a0v.z, a0v.w};
#pragma unroll
          for (int r = 0; r < 4; r++) o[r] = (f16_t)sigmoidf_(as_[r] + v[r]);
          *(uint2*)((f16_t*)P.XXB + (size_t)m * DM + c) = *(uint2*)o;
        }
      } else if (MODE == 3 || MODE == 5) {
        const int c = n0 + nl;
        float4 res;
        if (MODE == 3) res = *(const float4*)(xin_row(P, m) + c);
        else res = *(const float4*)(P.out + OUT_Y + (size_t)m * DM + c);
        float4 o = make_float4(v[0] + ALPHA_F * res.x, v[1] + ALPHA_F * res.y, v[2] + ALPHA_F * res.z, v[3] + ALPHA_F * res.w);
        *(float4*)(P.out + OUT_Y + (size_t)m * DM + c) = o;
      } else if (MODE == 4) {
        uint2 o; o.x = pack2(v[0], v[1]); o.y = pack2(v[2], v[3]);
        if (nt < 8) { *(uint2*)(P.Kb + (size_t)m * DM + n0 + nl) = o; }
        else if (nt >= 12) { *(uint2*)(P.Vb + (size_t)m * DM + (nt - 12) * 128 + nl) = o; }
        else {
          const bool isk = nt < 10;
          const int ck = (nt & 1) * 128 + nl;
          bf16_t* K1 = P.XB; bf16_t* V1 = P.XB + (size_t)NTOK * 256; bf16_t* VT1 = P.XB + (size_t)NTOK * 512;
          *(uint2*)((isk ? K1 : V1) + (size_t)m * 256 + ck) = o;
          const float4 fo = make_float4(v[0], v[1], v[2], v[3]);
          if (m < NPR) {
            const int b = m >> 13, tt = m & (TP - 1);
            if (!isk) {
              const int hk = ck >> 6, d = ck & 63;
              bf16_t* vt = VT1 + ((size_t)((b * 4 + hk) * 64 + d)) * TP + tt;
              vt[0] = f2bf(v[0]); vt[TP] = f2bf(v[1]); vt[2 * TP] = f2bf(v[2]); vt[3 * TP] = f2bf(v[3]);
            }
            if (tt >= TP - 128) *(float4*)(P.out + (isk ? OUT_WK_P : OUT_WV_P) + ((size_t)(b * 128 + tt - (TP - 128))) * 256 + ck) = fo;
          } else {
            const int ms = m - NPR, b = ms >> 3, tt = ms & 7;
            *(float4*)(P.out + (isk ? OUT_WK_S : OUT_WV_S) + ((size_t)(b * 128 + 120 + tt)) * 256 + ck) = fo;
          }
        }
      }
    }
  }
}
template <int MODE>
__device__ __forceinline__ void gemm_phase(const Params& P, unsigned char* smem, int bid, int nb) {
  constexpr int NT = (MODE == 1) ? 34 : (MODE == 2) ? 16 : (MODE == 4) ? 20 : 8;
  const int ntiles = 136 * NT;
  for (int tile = bid; tile < ntiles; tile += nb) gemm_tile<MODE>(P, smem, tile % 136, tile / 136);
}

#define TS 8
#define REC 392
__device__ __forceinline__ void scan_unit(const Params& P, float* ws, int lane, int tok0, int nsteps, int h,
                          int init_mode  , const float* init_ptr, bool use_v, bool write_y, float* fin) {
  const int rq = lane >> 2, q = lane & 3;
  float s[4][16];
#pragma unroll
  for (int i = 0; i < 4; i++)
#pragma unroll
    for (int j = 0; j < 16; j++) s[i][j] = 0.f;
  if (init_mode == 1) {
#pragma unroll
    for (int i = 0; i < 4; i++)
#pragma unroll
      for (int j = 0; j < 16; j++) s[i][j] = ((rq + 16 * i) == (16 * q + j)) ? 1.f : 0.f;
  } else if (init_mode == 2) {
#pragma unroll
    for (int i = 0; i < 4; i++)
#pragma unroll
      for (int j4 = 0; j4 < 4; j4++) {
        const float4 v = *(const float4*)(init_ptr + (size_t)(rq + 16 * i) * 64 + 16 * q + 4 * j4);
        s[i][4 * j4] = v.x; s[i][4 * j4 + 1] = v.y; s[i][4 * j4 + 2] = v.z; s[i][4 * j4 + 3] = v.w;
      }
  }
  const int c = h * 64 + lane;
  const float kkc = P.k_k[c], kac = P.k_a[c], rkc = P.r_k[c];
  const int crow = h * 64 + rq + 16 * q;
  const float gng = P.gn_g[crow], gnb = P.gn_b[crow];
  const f16_t* EW = (const f16_t*)P.XB;
  const f16_t* AA = (const f16_t*)P.XXB;

  for (int t0 = 0; t0 < nsteps; t0 += TS) {
#pragma unroll 2
    for (int tt = 0; tt < TS; tt++) {
      const size_t off = (size_t)(tok0 + t0 + tt) * DM + c;
      const float kraw = bf2f(P.Kb[off]);
      const float a = (float)AA[off];
      const float wd = __expf(-(float)EW[off]);
      float kkv = kraw * kkc;
      const float ss = wave_sum(kkv * kkv);
      kkv = kkv / fmaxf(sqrtf(ss), 1e-12f);
      const float kf = kraw * (1.f + (a - 1.f) * kac);
      float* rec = ws + tt * REC;
      rec[lane] = kkv; rec[64 + lane] = wd; rec[128 + lane] = kf; rec[192 + lane] = kkv * a;
      if (write_y) {
        const float r = bf2f(P.Rb[off]);
        rec[256 + lane] = r;
        const float bonus = wave_sum(r * kf * rkc);
        if (lane == 0) rec[384] = bonus;
      }
      rec[320 + lane] = use_v ? bf2f(P.Vb[off]) : 0.f;
    }
    __builtin_amdgcn_wave_barrier();
    asm volatile("s_waitcnt lgkmcnt(0)" ::: "memory");
    for (int tt = 0; tt < TS; tt++) {
      const float* rec = ws + tt * REC;
      float op[16];
      float sa[4];
#pragma unroll
      for (int j4 = 0; j4 < 4; j4++) { const float4 v = *(const float4*)(rec + 16 * q + 4 * j4); op[4 * j4] = v.x; op[4 * j4 + 1] = v.y; op[4 * j4 + 2] = v.z; op[4 * j4 + 3] = v.w; }
#pragma unroll
      for (int i = 0; i < 4; i++) {
        float a0 = 0.f, a1 = 0.f;
#pragma unroll
        for (int j = 0; j < 16; j += 2) { a0 = fmaf(s[i][j], op[j], a0); a1 = fmaf(s[i][j + 1], op[j + 1], a1); }
        sa[i] = -quad_sum(a0 + a1);
      }
      float vv[4];
#pragma unroll
      for (int i = 0; i < 4; i++) vv[i] = rec[320 + rq + 16 * i];
      float wv[16], kfv[16];
#pragma unroll
      for (int j4 = 0; j4 < 4; j4++) { const float4 v = *(const float4*)(rec + 64 + 16 * q + 4 * j4); wv[4 * j4] = v.x; wv[4 * j4 + 1] = v.y; wv[4 * j4 + 2] = v.z; wv[4 * j4 + 3] = v.w; }
#pragma unroll
      for (int j4 = 0; j4 < 4; j4++) { const float4 v = *(const float4*)(rec + 128 + 16 * q + 4 * j4); kfv[4 * j4] = v.x; kfv[4 * j4 + 1] = v.y; kfv[4 * j4 + 2] = v.z; kfv[4 * j4 + 3] = v.w; }
#pragma unroll
      for (int j4 = 0; j4 < 4; j4++) { const float4 v = *(const float4*)(rec + 192 + 16 * q + 4 * j4); op[4 * j4] = v.x; op[4 * j4 + 1] = v.y; op[4 * j4 + 2] = v.z; op[4 * j4 + 3] = v.w; }
#pragma unroll
      for (int i = 0; i < 4; i++)
#pragma unroll
        for (int j = 0; j < 16; j++) s[i][j] = fmaf(s[i][j], wv[j], fmaf(vv[i], kfv[j], sa[i] * op[j]));
      if (write_y) {
#pragma unroll
        for (int j4 = 0; j4 < 4; j4++) { const float4 v = *(const float4*)(rec + 256 + 16 * q + 4 * j4); op[4 * j4] = v.x; op[4 * j4 + 1] = v.y; op[4 * j4 + 2] = v.z; op[4 * j4 + 3] = v.w; }
        float y[4];
#pragma unroll
        for (int i = 0; i < 4; i++) {
          float a0 = 0.f, a1 = 0.f;
#pragma unroll
          for (int j = 0; j < 16; j += 2) { a0 = fmaf(s[i][j], op[j], a0); a1 = fmaf(s[i][j + 1], op[j + 1], a1); }
          y[i] = quad_sum(a0 + a1);
        }
        const float ysel = (q == 0) ? y[0] : (q == 1) ? y[1] : (q == 2) ? y[2] : y[3];
        const float vsel = (q == 0) ? vv[0] : (q == 1) ? vv[1] : (q == 2) ? vv[2] : vv[3];
        const float mean = wave_sum(ysel) * (1.f / 64.f);
        const float dlt = ysel - mean;
        const float var = wave_sum(dlt * dlt) * (1.f / 64.f);
        float yo = dlt * rsqrtf(var + 64e-5f) * gng + gnb + rec[384] * vsel;
        const size_t off = (size_t)(tok0 + t0 + tt) * DM + crow;
        const float gt = bf2f(P.Gb[off]);
        yo *= gt * sigmoidf_(gt);
        P.Gb[off] = f2bf(yo);
      }
    }
    __builtin_amdgcn_wave_barrier();
    asm volatile("s_waitcnt lgkmcnt(0)" ::: "memory");
  }
  if (fin) {
#pragma unroll
    for (int i = 0; i < 4; i++)
#pragma unroll
      for (int j4 = 0; j4 < 4; j4++)
        *(float4*)(fin + (size_t)(rq + 16 * i) * 64 + 16 * q + 4 * j4) = make_float4(s[i][4 * j4], s[i][4 * j4 + 1], s[i][4 * j4 + 2], s[i][4 * j4 + 3]);
  }
}

__device__ __forceinline__ void phase_scan1(const Params& P, unsigned char* smem, int bid, int nb) {
  const int lane = threadIdx.x & 63, w = threadIdx.x >> 6;
  float* ws = (float*)smem + w * (TS * REC);
  float* Ploc = P.out + OUT_WK_S;
  float* Sloc = P.out + OUT_WV_S;
  const int total = NBH * (NC - 1) * 2;
  for (int u = w * nb + bid; u < total; u += 4 * nb) {
    const int kind = u & 1, rest = u >> 1;
    const int c = rest % (NC - 1), bh = rest / (NC - 1);
    const int tok0 = (bh >> 4) * TP + c * CL, h = bh & 15;
    float* fin = (kind ? Ploc : Sloc) + (size_t)(bh * (NC - 1) + c) * 4096;
    scan_unit(P, ws, lane, tok0, CL, h, kind ? 1 : 0, nullptr, kind == 0, false, fin);
  }
}
__device__ __forceinline__ void phase_scan2(const Params& P, unsigned char* smem, int bid, int nb) {
  const int lane = threadIdx.x & 63, w = threadIdx.x >> 6;
  float* ws = (float*)smem + w * 256;
  float* Ploc = P.out + OUT_WK_S;
  float* Sloc = P.out + OUT_WV_S;
  for (int item = bid; item < NBH * 4; item += nb) {
    const int bh = item >> 2, row0 = (item & 3) * 16 + w * 4;
    float s[4];
    {
      const float* S0 = Sloc + (size_t)(bh * (NC - 1)) * 4096;
#pragma unroll
      for (int r = 0; r < 4; r++) s[r] = S0[(row0 + r) * 64 + lane];
    }
    for (int c = 1; c < NC - 1; c++) {
      const float* Pc = Ploc + (size_t)(bh * (NC - 1) + c) * 4096;
      float* Sc = Sloc + (size_t)(bh * (NC - 1) + c) * 4096;
      float acc[4];
#pragma unroll
      for (int r = 0; r < 4; r++) { acc[r] = Sc[(row0 + r) * 64 + lane]; ws[r * 64 + lane] = s[r]; }
      __builtin_amdgcn_wave_barrier();
      asm volatile("s_waitcnt lgkmcnt(0)" ::: "memory");
#pragma unroll 1
      for (int hf = 0; hf < 2; hf++) {
        float p[32];
#pragma unroll
        for (int i = 0; i < 32; i++) p[i] = Pc[(hf * 32 + i) * 64 + lane];
#pragma unroll
        for (int r = 0; r < 4; r++) {
#pragma unroll
          for (int i4 = 0; i4 < 8; i4++) {
            const float4 sv = *(const float4*)(ws + r * 64 + hf * 32 + 4 * i4);
            acc[r] = fmaf(sv.x, p[4 * i4], acc[r]); acc[r] = fmaf(sv.y, p[4 * i4 + 1], acc[r]);
            acc[r] = fmaf(sv.z, p[4 * i4 + 2], acc[r]); acc[r] = fmaf(sv.w, p[4 * i4 + 3], acc[r]);
          }
        }
      }
      __builtin_amdgcn_wave_barrier();
      asm volatile("s_waitcnt lgkmcnt(0)" ::: "memory");
#pragma unroll
      for (int r = 0; r < 4; r++) { s[r] = acc[r]; Sc[(row0 + r) * 64 + lane] = acc[r]; }
    }
  }
}
__device__ __forceinline__ void phase_scan3(const Params& P, unsigned char* smem, int bid, int nb) {
  const int lane = threadIdx.x & 63, w = threadIdx.x >> 6;
  float* ws = (float*)smem + w * (TS * REC);
  float* Sloc = P.out + OUT_WV_S;
  const int total = NBH * NC + 2048;
  for (int u = w * nb + bid; u < total; u += 4 * nb) {
    if (u < NBH * NC) {
      const int bh = u >> 5, c = u & 31;
      const int tok0 = (bh >> 4) * TP + c * CL, h = bh & 15;
      const float* ip = (c > 0) ? (Sloc + (size_t)(bh * (NC - 1) + c - 1) * 4096) : nullptr;
      float* fin = (c == NC - 1) ? (P.out + OUT_WKV_P + (size_t)bh * 4096) : nullptr;
      scan_unit(P, ws, lane, tok0, CL, h, (c > 0) ? 2 : 0, ip, true, true, fin);
    } else {
      const int sb = u - NBH * NC;
      scan_unit(P, ws, lane, NPR + (sb >> 4) * 8, 8, sb & 15, 2, P.state_wkv + (size_t)sb * 4096, true, true, P.out + OUT_WKV_S + (size_t)sb * 4096);
    }
  }
}

__device__ __forceinline__ void phase_ln(const Params& P, int layer, int bid, int nb) {
  const int lane = threadIdx.x & 63, w = threadIdx.x >> 6;
  const float* gg = P.ln_g + layer * DM; const float* bb = P.ln_b + layer * DM;
  for (int tok = bid * 4 + w; tok < NTOK; tok += nb * 4) {
    f32x4* row = (f32x4*)(P.out + OUT_Y + (size_t)tok * DM);
    f32x4 v[4];
    float sum = 0.f;
#pragma unroll
    for (int i = 0; i < 4; i++) { v[i] = row[lane + 64 * i]; sum += v[i][0] + v[i][1] + v[i][2] + v[i][3]; }
    const float mean = wave_sum(sum) * (1.f / 1024.f);
    float sq = 0.f;
#pragma unroll
    for (int i = 0; i < 4; i++) { v[i] -= mean; sq += v[i][0] * v[i][0] + v[i][1] * v[i][1] + v[i][2] * v[i][2] + v[i][3] * v[i][3]; }
    const float rs = rsqrtf(wave_sum(sq) * (1.f / 1024.f) + 1e-5f);
#pragma unroll
    for (int i = 0; i < 4; i++) {
      const f32x4 g4 = ((const f32x4*)gg)[lane + 64 * i], b4 = ((const f32x4*)bb)[lane + 64 * i];
      const f32x4 o = v[i] * rs * g4 + b4;
      row[lane + 64 * i] = o;
      if (layer == 0) { uint2 ob; ob.x = pack2(o[0], o[1]); ob.y = pack2(o[2], o[3]); ((uint2*)(P.Rb + (size_t)tok * DM))[lane + 64 * i] = ob; }
    }
  }
}

__device__ __forceinline__ void attn_prompt_item(const Params& P, unsigned char* smem, int item) {
  const int qh = item & 1, hk = (item >> 1) & 3, n = (item >> 3) & 63, b = item >> 9;
  bf16_t* Ks = (bf16_t*)smem;
  bf16_t* Vs = Ks + 192 * 72;
  const bf16_t* K1 = P.XB; const bf16_t* VT1 = P.XB + (size_t)NTOK * 512;
  const bf16_t* Q1 = P.Kb; const bf16_t* G1 = P.Vb; bf16_t* AO = P.Gb;
  const int t = threadIdx.x, lane = t & 63, w = t >> 6;
  const int g = lane >> 4, lc = lane & 15;
  const int pos0 = (n - 1) * 128 + 64 * qh;
  __syncthreads();
#pragma unroll
  for (int i = 0; i < 6; i++) {
    const int idx = t + 256 * i; const int row = idx >> 3, ch = idx & 7; const int pos = pos0 + row;
    uint4 v = make_uint4(0, 0, 0, 0);
    if (pos >= 0) v = *(const uint4*)(K1 + ((size_t)(b * TP + pos)) * 256 + hk * 64 + ch * 8);
    *(uint4*)(Ks + row * 72 + ch * 8) = v;
  }
#pragma unroll
  for (int i = 0; i < 6; i++) {
    const int idx = t + 256 * i; const int d = idx / 24, ch = idx % 24; const int pos = pos0 + ch * 8;
    uint4 v = make_uint4(0, 0, 0, 0);
    if (pos >= 0) v = *(const uint4*)(VT1 + ((size_t)((b * 4 + hk) * 64 + d)) * TP + pos);
    *(uint4*)(Vs + d * 200 + ch * 8) = v;
  }
  __syncthreads();
  const int h = hk * 4 + w;
  const float slope = exp2f(-0.5f * (float)(h + 1));
  const float sink = P.att_sinks[h];
  for (int sb = 0; sb < 2; sb++) {
    const int i0 = 64 * qh + 32 * sb;
    const int tokb = b * TP + n * 128 + i0;
    bf16x8 qf[2][2];
#pragma unroll
    for (int nn = 0; nn < 2; nn++)
#pragma unroll
      for (int ks = 0; ks < 2; ks++) qf[nn][ks] = *(const bf16x8*)(Q1 + (size_t)(tokb + 16 * nn + lc) * DM + h * 64 + ks * 32 + g * 8);
    float mrun[2] = {sink, sink}, lrun[2] = {1.f, 1.f};
    f32x4 O[4][2];
#pragma unroll
    for (int dm = 0; dm < 4; dm++) { O[dm][0] = (f32x4){0.f, 0.f, 0.f, 0.f}; O[dm][1] = (f32x4){0.f, 0.f, 0.f, 0.f}; }
    for (int kt = 0; kt < 3; kt++) {
      if (n == 0 && (qh + kt) < 2) continue;
      f32x4 S[4][2];
#pragma unroll
      for (int mm = 0; mm < 4; mm++) { S[mm][0] = (f32x4){0.f, 0.f, 0.f, 0.f}; S[mm][1] = (f32x4){0.f, 0.f, 0.f, 0.f}; }
#pragma unroll
      for (int ks = 0; ks < 2; ks++)
#pragma unroll
        for (int mm = 0; mm < 4; mm++) {
          const bf16x8 kf = *(const bf16x8*)(Ks + (kt * 64 + mm * 16 + lc) * 72 + ks * 32 + g * 8);
          S[mm][0] = __builtin_amdgcn_mfma_f32_16x16x32_bf16(kf, qf[0][ks], S[mm][0], 0, 0, 0);
          S[mm][1] = __builtin_amdgcn_mfma_f32_16x16x32_bf16(kf, qf[1][ks], S[mm][1], 0, 0, 0);
        }
#pragma unroll
      for (int nn = 0; nn < 2; nn++) {
        const int qi = i0 + 16 * nn + lc;
        float mx = mrun[nn];
#pragma unroll
        for (int mm = 0; mm < 4; mm++)
#pragma unroll
          for (int r = 0; r < 4; r++) {
            const int j = 64 * (qh + kt) + 16 * mm + 4 * g + r;
            const int dist = 128 + qi - j;
            const bool live = (dist >= 0) && (dist < 128);
            const float sv = live ? (S[mm][nn][r] * 0.125f - slope * (float)dist) : -1e30f;
            S[mm][nn][r] = sv; mx = fmaxf(mx, sv);
          }
        mx = fmaxf(mx, __shfl_xor(mx, 16)); mx = fmaxf(mx, __shfl_xor(mx, 32));
        const float corr = __expf(mrun[nn] - mx); mrun[nn] = mx;
        float sum = 0.f;
#pragma unroll
        for (int mm = 0; mm < 4; mm++)
#pragma unroll
          for (int r = 0; r < 4; r++) { const float pp = __expf(S[mm][nn][r] - mx); S[mm][nn][r] = pp; sum += pp; }
        sum += __shfl_xor(sum, 16); sum += __shfl_xor(sum, 32);
        lrun[nn] = lrun[nn] * corr + sum;
#pragma unroll
        for (int dm = 0; dm < 4; dm++) { O[dm][nn][0] *= corr; O[dm][nn][1] *= corr; O[dm][nn][2] *= corr; O[dm][nn][3] *= corr; }
      }
#pragma unroll
      for (int k2 = 0; k2 < 2; k2++) {
        bf16x8 pf[2];
#pragma unroll
        for (int nn = 0; nn < 2; nn++) {
          const unsigned u0 = pack2(S[2 * k2][nn][0], S[2 * k2][nn][1]), u1 = pack2(S[2 * k2][nn][2], S[2 * k2][nn][3]);
          const unsigned u2 = pack2(S[2 * k2 + 1][nn][0], S[2 * k2 + 1][nn][1]), u3 = pack2(S[2 * k2 + 1][nn][2], S[2 * k2 + 1][nn][3]);
          const uint4 uu = make_uint4(u0, u1, u2, u3);
          pf[nn] = *(const bf16x8*)&uu;
        }
#pragma unroll
        for (int dm = 0; dm < 4; dm++) {
          const bf16_t* vb = Vs + (dm * 16 + lc) * 200 + kt * 64 + k2 * 32 + 4 * g;
          const uint2 lo = *(const uint2*)vb, hi = *(const uint2*)(vb + 16);
          const uint4 uu = make_uint4(lo.x, lo.y, hi.x, hi.y);
          const bf16x8 vf = *(const bf16x8*)&uu;
          O[dm][0] = __builtin_amdgcn_mfma_f32_16x16x32_bf16(vf, pf[0], O[dm][0], 0, 0, 0);
          O[dm][1] = __builtin_amdgcn_mfma_f32_16x16x32_bf16(vf, pf[1], O[dm][1], 0, 0, 0);
        }
      }
    }
#pragma unroll
    for (int nn = 0; nn < 2; nn++) {
      const float inv = 1.f / lrun[nn];
      const size_t tok = (size_t)(tokb + 16 * nn + lc);
#pragma unroll
      for (int dm = 0; dm < 4; dm++) {
        const int d = dm * 16 + 4 * g;
        const uint2 gv = *(const uint2*)(G1 + tok * DM + h * 64 + d);
        const float g0 = __uint_as_float(gv.x << 16), g1 = __uint_as_float(gv.x & 0xffff0000u);
        const float g2 = __uint_as_float(gv.y << 16), g3 = __uint_as_float(gv.y & 0xffff0000u);
        uint2 o;
        o.x = pack2(O[dm][nn][0] * inv * g0 * sigmoidf_(g0), O[dm][nn][1] * inv * g1 * sigmoidf_(g1));
        o.y = pack2(O[dm][nn][2] * inv * g2 * sigmoidf_(g2), O[dm][nn][3] * inv * g3 * sigmoidf_(g3));
        *(uint2*)(AO + tok * DM + h * 64 + d) = o;
      }
    }
  }
}

__device__ __forceinline__ void attn_sample_item(const Params& P, unsigned char* smem, int item) {
  const int b = item >> 2, hk = item & 3;
  const int t = threadIdx.x, lane = t & 63, w = t >> 6;
  float* qs = (float*)smem + w * 512;
  float* ps = (float*)smem + 2048 + w * (8 * 136);
  const bf16_t* K1 = P.XB; const bf16_t* V1 = P.XB + (size_t)NTOK * 256;
  const bf16_t* Q1 = P.Kb; const bf16_t* G1 = P.Vb; bf16_t* AO = P.Gb;
  const int h = hk * 4 + w;
  const float slope = exp2f(-0.5f * (float)(h + 1));
  const float sink = P.att_sinks[h];
  const int tok0 = NPR + b * 8;
  __syncthreads();
  for (int idx = t; idx < 120 * 16; idx += 256) {
    const int row = idx >> 4, c4 = idx & 15;
    const size_t so = ((size_t)(b * 128 + row + 8)) * 256 + hk * 64 + c4 * 4;
    const size_t dofs = ((size_t)(b * 128 + row)) * 256 + hk * 64 + c4 * 4;
    *(float4*)(P.out + OUT_WK_S + dofs) = *(const float4*)(P.cache_k + so);
    *(float4*)(P.out + OUT_WV_S + dofs) = *(const float4*)(P.cache_v + so);
  }
#pragma unroll
  for (int i = 0; i < 8; i++) qs[i * 64 + lane] = bf2f(Q1[(size_t)(tok0 + i) * DM + h * 64 + lane]);
  __builtin_amdgcn_wave_barrier();
  asm volatile("s_waitcnt lgkmcnt(0)" ::: "memory");
  float sc[3][8];
#pragma unroll
  for (int ksel = 0; ksel < 3; ksel++) {
    float acc[8];
#pragma unroll
    for (int i = 0; i < 8; i++) acc[i] = 0.f;
    const float* kp = P.cache_k + ((size_t)(b * 128 + lane + 64 * (ksel & 1))) * 256 + hk * 64;
    const bf16_t* kpb = K1 + (size_t)(tok0 + (lane & 7)) * 256 + hk * 64;
#pragma unroll 2
    for (int d4 = 0; d4 < 16; d4++) {
      float4 kv;
      if (ksel < 2) kv = ((const float4*)kp)[d4];
      else { const uint2 u = ((const uint2*)kpb)[d4]; kv = make_float4(__uint_as_float(u.x << 16), __uint_as_float(u.x & 0xffff0000u), __uint_as_float(u.y << 16), __uint_as_float(u.y & 0xffff0000u)); }
#pragma unroll
      for (int i = 0; i < 8; i++) {
        const float4 qv = *(const float4*)(qs + i * 64 + 4 * d4);
        acc[i] = fmaf(qv.x, kv.x, acc[i]); acc[i] = fmaf(qv.y, kv.y, acc[i]); acc[i] = fmaf(qv.z, kv.z, acc[i]); acc[i] = fmaf(qv.w, kv.w, acc[i]);
      }
    }
#pragma unroll
    for (int i = 0; i < 8; i++) {
      int dist; bool live;
      if (ksel < 2) { const int j = lane + 64 * ksel; dist = 128 + i - j; live = (j > i); }
      else { dist = i - lane; live = (lane <= i); }
      sc[ksel][i] = live ? (acc[i] * 0.125f - slope * (float)dist) : -1e30f;
    }
  }
#pragma unroll
  for (int i = 0; i < 8; i++) {
    float mx = fmaxf(fmaxf(sc[0][i], sc[1][i]), sc[2][i]);
    mx = fmaxf(wave_max(mx), sink);
    const float p0 = __expf(sc[0][i] - mx), p1 = __expf(sc[1][i] - mx), p2 = __expf(sc[2][i] - mx);
    const float den = wave_sum(p0 + p1 + p2) + __expf(sink - mx);
    const float inv = 1.f / den;
    ps[i * 136 + lane] = p0 * inv; ps[i * 136 + 64 + lane] = p1 * inv;
    if (lane < 8) ps[i * 136 + 128 + lane] = p2 * inv;
  }
  __builtin_amdgcn_wave_barrier();
  asm volatile("s_waitcnt lgkmcnt(0)" ::: "memory");
  float o[8];
#pragma unroll
  for (int i = 0; i < 8; i++) o[i] = 0.f;
  for (int j = 0; j < 136; j++) {
    float v;
    if (j < 128) v = P.cache_v[((size_t)(b * 128 + j)) * 256 + hk * 64 + lane];
    else v = bf2f(V1[(size_t)(tok0 + j - 128) * 256 + hk * 64 + lane]);
#pragma unroll
    for (int i = 0; i < 8; i++) o[i] = fmaf(ps[i * 136 + j], v, o[i]);
  }
#pragma unroll
  for (int i = 0; i < 8; i++) {
    const size_t off = (size_t)(tok0 + i) * DM + h * 64 + lane;
    const float gt = bf2f(G1[off]);
    AO[off] = f2bf(o[i] * gt * sigmoidf_(gt));
  }
}
__device__ __forceinline__ void phase_attn(const Params& P, unsigned char* smem, int bid, int nb) {
  for (int item = bid; item < 1024 + 512; item += nb) {
    if (item < 1024) attn_prompt_item(P, smem, item);
    else attn_sample_item(P, smem, item - 1024);
  }
}

#if MULTI_LAUNCH
#define PH_BARRIER(ph)
#else
#define PH_BARRIER(ph) do { if ((ph) + 1 < P.phase_end) { if ((ph) == 0) cg::this_grid().sync(); else xcd_barrier(xb); } } while (0)
#endif
#define RUN_PH(ph, call) do { if (P.phase_begin <= (ph) && (ph) < P.phase_end) { call; PH_BARRIER(ph); } } while (0)

__global__ void __launch_bounds__(256, 2) fwd_kernel(Params P) {
  __shared__ __attribute__((aligned(16))) unsigned char smem[SMEM_BYTES];
  const int bid = blockIdx.x, nb = gridDim.x;
#if !MULTI_LAUNCH
  __shared__ uint4 xb_words;
  if (threadIdx.x == 0) xb_words = make_uint4(0u, 0u, 0u, 0u);
  __syncthreads();
  XcdBarrier xb = xcd_barrier_post(P.bar, (volatile LAS unsigned*)&xb_words);
#endif
#if (PHMASK >> 0) & 1
  RUN_PH(0, phase_prep(P, smem, bid, nb));
#endif
#if (PHMASK >> 1) & 1
  RUN_PH(1, gemm_phase<1>(P, smem, bid, nb));
#endif
#if (PHMASK >> 2) & 1
  RUN_PH(2, gemm_phase<2>(P, smem, bid, nb));
#endif
#if (PHMASK >> 3) & 1
  RUN_PH(3, phase_scan1(P, smem, bid, nb));
#endif
#if (PHMASK >> 4) & 1
  RUN_PH(4, phase_scan2(P, smem, bid, nb));
#endif
#if (PHMASK >> 5) & 1
  RUN_PH(5, phase_scan3(P, smem, bid, nb));
#endif
#if (PHMASK >> 6) & 1
  RUN_PH(6, gemm_phase<3>(P, smem, bid, nb));
#endif
#if (PHMASK >> 7) & 1
  RUN_PH(7, phase_ln(P, 0, bid, nb));
#endif
#if (PHMASK >> 8) & 1
  RUN_PH(8, gemm_phase<4>(P, smem, bid, nb));
#endif
#if (PHMASK >> 9) & 1
  RUN_PH(9, phase_attn(P, smem, bid, nb));
#endif
#if (PHMASK >> 10) & 1
  RUN_PH(10, gemm_phase<5>(P, smem, bid, nb));
#endif
#if (PHMASK >> 11) & 1
  RUN_PH(11, phase_ln(P, 1, bid, nb));
#endif
}

extern "C" void kernel_launch(void* const* d_in, const int* in_sizes, int n_in, void* d_out, int out_size, void* d_ws, size_t ws_size, hipStream_t stream) {
  Params P{};
  P.x_prompt = (const float*)d_in[0]; P.x_sample = (const float*)d_in[1]; P.state_wkv = (const float*)d_in[2]; P.state_shift = (const float*)d_in[3];
  P.cache_k = (const float*)d_in[4]; P.cache_v = (const float*)d_in[5]; P.ln_g = (const float*)d_in[6]; P.ln_b = (const float*)d_in[7];
  P.mu = (const float*)d_in[8]; P.w_in = (const float*)d_in[9]; P.w0 = (const float*)d_in[10]; P.w1 = (const float*)d_in[11]; P.w2 = (const float*)d_in[12];
  P.a0 = (const float*)d_in[13]; P.a1 = (const float*)d_in[14]; P.a2 = (const float*)d_in[15]; P.k_k = (const float*)d_in[16]; P.k_a = (const float*)d_in[17];
  P.r_k = (const float*)d_in[18]; P.gn_g = (const float*)d_in[19]; P.gn_b = (const float*)d_in[20]; P.w_out = (const float*)d_in[21];
  P.att_w_in = (const float*)d_in[22]; P.att_sinks = (const float*)d_in[23]; P.att_w_out = (const float*)d_in[24];
  P.out = (float*)d_out;
  unsigned char* ws = (unsigned char*)d_ws;
  size_t off = 0;
  auto take = [&](size_t bytes) { unsigned char* p = ws + off; off += (bytes + 255) & ~(size_t)255; return p; };
  P.bar = (unsigned*)take(16384);
  P.WtIn0 = (bf16_t*)take((size_t)4352 * DM * 2);
  P.W2t = (bf16_t*)take((size_t)DM * 64 * 2);
  P.A2t = (bf16_t*)take((size_t)DM * 64 * 2);
  P.WtOut0 = (bf16_t*)take((size_t)DM * DM * 2);
  P.WtIn1 = (bf16_t*)take((size_t)2560 * DM * 2);
  P.WtOut1 = (bf16_t*)take((size_t)DM * DM * 2);
  P.XB = (bf16_t*)take((size_t)NTOK * DM * 2);
  P.XXB = (bf16_t*)take((size_t)NTOK * DM * 2);
  P.Rb = (bf16_t*)take((size_t)NTOK * DM * 2);
  P.Kb = (bf16_t*)take((size_t)NTOK * DM * 2);
  P.Vb = (bf16_t*)take((size_t)NTOK * DM * 2);
  P.Gb = (bf16_t*)take((size_t)NTOK * DM * 2);
  P.H1 = (bf16_t*)take((size_t)NTOK * 64 * 2);
  P.H2 = (bf16_t*)take((size_t)NTOK * 64 * 2);
  if (off > ws_size) { fprintf(stderr, "workspace too small: need %zu have %zu\n", off, ws_size); return; }
#if MULTI_LAUNCH
  for (int ph = 0; ph < NPHASE; ph++) {
    P.phase_begin = ph; P.phase_end = ph + 1;
    hipLaunchKernelGGL(fwd_kernel, dim3(512), dim3(256), 0, stream, P);
  }
#else
  static int grid_blocks = 0;
  if (!grid_blocks) {
    int dev = 0, cus = 0, per_cu = 0;
    hipGetDevice(&dev);
    hipDeviceGetAttribute(&cus, hipDeviceAttributeMultiprocessorCount, dev);
    hipOccupancyMaxActiveBlocksPerMultiprocessor(&per_cu, fwd_kernel, 256, 0);
    if (per_cu > 2) per_cu = 2;
    if (per_cu < 1) per_cu = 1;
    grid_blocks = cus * per_cu;
  }
  hipMemsetAsync(P.bar, 0, 16384, stream);
  P.phase_begin = 0; P.phase_end = NPHASE;
  void* args[] = {&P};
  hipError_t e = hipLaunchCooperativeKernel((void*)fwd_kernel, dim3(grid_blocks), dim3(256), args, 0, stream);
  if (e != hipSuccess) fprintf(stderr, "cooperative launch failed: %s (grid %d)\n", hipGetErrorString(e), grid_blocks);
#endif
}
```

```cpp
#include <hip/hip_runtime.h>
#include <hip/hip_cooperative_groups.h>
#include <stdint.h>
#include <cstdio>
namespace cg = cooperative_groups;

#ifndef PHMASK
#define PHMASK 0xFFF
#endif
#ifndef REPMASK
#define REPMASK 0
#endif
#ifndef MULTI_LAUNCH
#define MULTI_LAUNCH 0
#endif

typedef unsigned short bf16_t;
typedef _Float16 f16_t;
typedef __attribute__((ext_vector_type(8))) short bf16x8;
typedef __attribute__((ext_vector_type(4))) float f32x4;
typedef __attribute__((ext_vector_type(4))) unsigned u32x4;

#define DM 1024
#define NTOK 17408
#define NPR 16384
#define TP 8192
#define NC 32
#define CL 256
#define NBH 32
#define ALPHA_F 1.41421356237f
#define SMEM_BYTES (56 * 1024)
#define NPHASE 12

#define OUT_Y 0
#define OUT_WKV_P 17825792
#define OUT_SH_P 17956864
#define OUT_WK_P 17958912
#define OUT_WV_P 18024448
#define OUT_WKV_S 18089984
#define OUT_SH_S 26478592
#define OUT_WK_S 26609664
#define OUT_WV_S 30803968

struct Params {
  const float *x_prompt, *x_sample, *state_wkv, *state_shift, *cache_k, *cache_v, *ln_g, *ln_b;
  const float *mu, *w_in, *w0, *w1, *w2, *a0, *a1, *a2, *k_k, *k_a, *r_k, *gn_g, *gn_b, *w_out;
  const float *att_w_in, *att_sinks, *att_w_out;
  float* out;
  unsigned* bar;
  bf16_t *WtIn0, *W2t, *A2t, *WtOut0, *WtIn1, *WtOut1;
  bf16_t *XB, *XXB;
  bf16_t *Rb, *Kb, *Vb, *Gb;
  bf16_t *H1, *H2;
  int phase_begin, phase_end;
};

__device__ __forceinline__ bf16_t f2bf(float f) {
  unsigned u = __float_as_uint(f);
  u += 0x7fffu + ((u >> 16) & 1u);
  return (bf16_t)(u >> 16);
}
__device__ __forceinline__ float bf2f(bf16_t h) { return __uint_as_float(((unsigned)h) << 16); }
__device__ __forceinline__ unsigned pack2(float a, float b) { return (unsigned)f2bf(a) | ((unsigned)f2bf(b) << 16); }
__device__ __forceinline__ float wave_sum(float x) {
#pragma unroll
  for (int o = 32; o >= 1; o >>= 1) x += __shfl_xor(x, o);
  return x;
}
__device__ __forceinline__ float wave_max(float x) {
#pragma unroll
  for (int o = 32; o >= 1; o >>= 1) x = fmaxf(x, __shfl_xor(x, o));
  return x;
}
__device__ __forceinline__ float quad_sum(float x) {
  x += __builtin_bit_cast(float, __builtin_amdgcn_update_dpp(0, __builtin_bit_cast(int, x), 0xB1, 0xF, 0xF, true));
  x += __builtin_bit_cast(float, __builtin_amdgcn_update_dpp(0, __builtin_bit_cast(int, x), 0x4E, 0xF, 0xF, true));
  return x;
}
__device__ __forceinline__ float sigmoidf_(float x) { return 1.f / (1.f + __expf(-x)); }
__device__ __forceinline__ const float* xin_row(const Params& P, int m) {
  return (m < NPR) ? (P.x_prompt + (size_t)m * DM) : (P.x_sample + (size_t)(m - NPR) * DM);
}

#define XB_TMO      128
#define XB_XCNT(j)  (256  + 64 * (j))
#define XB_XSUB(j)  (1280 + 64 * (j))
#define XB_XGEN(j)  (2304 + 64 * (j))
#define XB_TOP      3328
#define XB_TOPGEN   3392
#define XCD_BAR_WORDS 3456
#define XB_SPIN_CAP (1u << 22)
#define LAS __attribute__((address_space(3)))
__device__ __forceinline__ unsigned xb_ld(unsigned* p) { return __hip_atomic_load(p, __ATOMIC_RELAXED, __HIP_MEMORY_SCOPE_AGENT); }
__device__ __forceinline__ unsigned xb_add(unsigned* p, unsigned v) { return __hip_atomic_fetch_add(p, v, __ATOMIC_RELAXED, __HIP_MEMORY_SCOPE_AGENT); }
__device__ __forceinline__ unsigned xb_xcc_id() { return (unsigned)__builtin_amdgcn_s_getreg((3 << 11) | 20) & 0xFu; }
#define XB_SPIN(cond, bar) do { unsigned _sp = 0; while (cond) { __builtin_amdgcn_s_sleep(1); \
    if ((++_sp & 255u) == 0u) { if (xb_ld(&(bar)[XB_TMO])) break; if (_sp > XB_SPIN_CAP) { atomicAdd(&(bar)[XB_TMO], 1u); break; } } } } while (0)
struct XcdBarrier { unsigned* bar; unsigned x; volatile LAS unsigned* st; };
__device__ __forceinline__ XcdBarrier xcd_barrier_post(unsigned* bar, volatile LAS unsigned* st) {
  XcdBarrier b; b.bar = bar; b.x = xb_xcc_id(); b.st = st;
  if (threadIdx.x == 0) (void)xb_add(&bar[XB_XCNT(b.x)], 1u);
  return b;
}
__device__ __forceinline__ void xcd_barrier_complete(unsigned* bar, unsigned x, unsigned& nloc, unsigned& nx) {
  const unsigned G = gridDim.x * gridDim.y * gridDim.z;
  unsigned sum, cnt, mine, sp = 0u;
  for (;;) {
    sum = 0u; cnt = 0u; mine = 0u;
#pragma unroll
    for (unsigned j = 0; j < 16; ++j) { const unsigned c = xb_ld(&bar[XB_XCNT(j)]); sum += c; cnt += (c > 0u) ? 1u : 0u; mine = (j == x) ? c : mine; }
    if (sum == G) break;
    __builtin_amdgcn_s_sleep(1);
    if ((++sp & 255u) == 0u) { if (xb_ld(&bar[XB_TMO])) break; if (sp > XB_SPIN_CAP) { atomicAdd(&bar[XB_TMO], 1u); break; } }
  }
  nloc = mine > 0u ? mine : 1u; nx = cnt > 0u ? cnt : 1u;
}
__device__ __forceinline__ void xcd_barrier(const XcdBarrier& b) {
  asm volatile("s_waitcnt vmcnt(0)" ::: "memory");
  __syncthreads();
  if (threadIdx.x == 0) {
    unsigned* bar = b.bar;
    __builtin_amdgcn_s_waitcnt(0);
    unsigned nloc = b.st[0], nx = b.st[1];
    if (nloc == 0u) { xcd_barrier_complete(bar, b.x, nloc, nx); b.st[0] = nloc; b.st[1] = nx; }
    const unsigned old = xb_add(&bar[XB_XSUB(b.x)], 1u);
    const unsigned gen = old / nloc;
    if (old + 1u == (gen + 1u) * nloc) {
      __builtin_amdgcn_fence(__ATOMIC_RELEASE, "agent");
      asm volatile("s_waitcnt vmcnt(0)" ::: "memory");
      const unsigned og = xb_add(&bar[XB_TOP], 1u);
      const unsigned tg = og / nx;
      if (og + 1u == (tg + 1u) * nx) xb_add(&bar[XB_TOPGEN], 1u);
      else XB_SPIN(xb_ld(&bar[XB_TOPGEN]) == tg, bar);
      __builtin_amdgcn_fence(__ATOMIC_ACQUIRE, "agent");
      xb_add(&bar[XB_XGEN(b.x)], 1u);
      asm volatile("s_waitcnt vmcnt(0)" ::: "memory");
    } else {
      XB_SPIN(xb_ld(&bar[XB_XGEN(b.x)]) == gen, bar);
      __builtin_amdgcn_fence(__ATOMIC_ACQUIRE, "agent");
      asm volatile("s_waitcnt vmcnt(0)" ::: "memory");
    }
  }
  __syncthreads();
}

__device__ __forceinline__ void transpose_tile(const float* __restrict__ src, int ld, int k0, int n0, bf16_t* __restrict__ dst, int ldd, float* tile) {
  const int t = threadIdx.x;
  {
    const int n = t & 63, kq = t >> 6;
#pragma unroll 4
    for (int i = 0; i < 16; i++) { const int k = i * 4 + kq; tile[k * 65 + n] = src[(size_t)(k0 + k) * ld + n0 + n]; }
  }
  __syncthreads();
  {
    const int k = t & 63, nq = t >> 6;
#pragma unroll 4
    for (int i = 0; i < 16; i++) { const int n2 = i * 4 + nq; dst[(size_t)(n0 + n2) * ldd + k0 + k] = f2bf(tile[k * 65 + n2]); }
  }
  __syncthreads();
}

__device__ __forceinline__ void phase_prep(const Params& P, unsigned char* smem, int bid, int nb) {
  float* tile = (float*)smem;
  const int t = threadIdx.x;
  const int NITEMS = 2242 + 4352 + 130;
  for (int id = bid; id < NITEMS; id += nb) {
    if (id < 1024) { const int p = id >> 8, r = id & 255; transpose_tile(P.w_in + (size_t)p * DM * DM, DM, (r >> 4) * 64, (r & 15) * 64, P.WtIn0 + (size_t)p * DM * DM, DM, tile); }
    else if (id < 1040) transpose_tile(P.w1, 64, (id - 1024) * 64, 0, P.WtIn0 + (size_t)4096 * DM, DM, tile);
    else if (id < 1056) transpose_tile(P.a1, 64, (id - 1040) * 64, 0, P.WtIn0 + (size_t)4224 * DM, DM, tile);
    else if (id < 1072) transpose_tile(P.w2, DM, 0, (id - 1056) * 64, P.W2t, 64, tile);
    else if (id < 1088) transpose_tile(P.a2, DM, 0, (id - 1072) * 64, P.A2t, 64, tile);
    else if (id < 1344) { const int r = id - 1088; transpose_tile(P.w_out, DM, (r >> 4) * 64, (r & 15) * 64, P.WtOut0, DM, tile); }
    else if (id < 1984) { const int r = id - 1344; transpose_tile(P.att_w_in, 2560, (r / 40) * 64, (r % 40) * 64, P.WtIn1, DM, tile); }
    else if (id < 2240) { const int r = id - 1984; transpose_tile(P.att_w_out, DM, (r >> 4) * 64, (r & 15) * 64, P.WtOut1, DM, tile); }
    else if (id < 2242) {
      uint4* z = (uint4*)(P.WtIn0 + (size_t)(id == 2240 ? 4160 : 4288) * DM);
      for (int i = t; i < 8192; i += 256) z[i] = make_uint4(0, 0, 0, 0);
    } else if (id < 2242 + 4352) {
      const int it = id - 2242;
#pragma unroll
      for (int q = 0; q < 4; q++) {
        const int m = it * 4 + q;
        const float4 x = ((const float4*)xin_row(P, m))[t];
        float4 pv = make_float4(0.f, 0.f, 0.f, 0.f);
        if (m < NPR) { if ((m & (TP - 1)) != 0) pv = ((const float4*)xin_row(P, m - 1))[t]; }
        else { const int ms = m - NPR; if ((ms & 7) != 0) pv = ((const float4*)xin_row(P, m - 1))[t]; else pv = ((const float4*)(P.state_shift + (size_t)(ms >> 3) * DM))[t]; }
        uint2 xb, xxb;
        xb.x = pack2(x.x, x.y); xb.y = pack2(x.z, x.w);
        xxb.x = pack2(pv.x - x.x, pv.y - x.y); xxb.y = pack2(pv.z - x.z, pv.w - x.w);
        ((uint2*)(P.XB + (size_t)m * DM))[t] = xb;
        ((uint2*)(P.XXB + (size_t)m * DM))[t] = xxb;
      }
    } else {
      const int r = id - (2242 + 4352);
      if (r < 2) ((float4*)(P.out + OUT_SH_P + (size_t)r * DM))[t] = ((const float4*)(P.x_prompt + ((size_t)r * TP + TP - 1) * DM))[t];
      else { const int b = r - 2; ((float4*)(P.out + OUT_SH_S + (size_t)b * DM))[t] = ((const float4*)(P.x_sample + ((size_t)b * 8 + 7) * DM))[t]; }
    }
  }
}

#define LDS_LD 72
template <int MODE>
__device__ __forceinline__ void gemm_tile(const Params& P, unsigned char* smem, int mt, int nt) {
  constexpr int KT = (MODE == 2) ? 1 : 16;
  bf16_t* As = (bf16_t*)smem;
  bf16_t* Bs = As + 128 * LDS_LD;
  const int t = threadIdx.x, lane = t & 63, w = t >> 6;
  const int wm = w >> 1, wn = w & 1;
  const int g = lane >> 4, lc = lane & 15;
  const int lrow = t >> 3, lch = t & 7;
  const int m0 = mt * 128, n0 = nt * 128;

  const bf16_t* Ap; const bf16_t* A2p = nullptr; const float* mup = nullptr; const bf16_t* Bp; int lda, ldb;
  if (MODE == 1) {
    const int p = (nt < 32) ? (nt >> 3) : (4 + (nt - 32));
    Ap = P.XB; A2p = P.XXB; lda = DM; mup = P.mu + (size_t)p * DM;
    Bp = P.WtIn0 + (size_t)((nt < 32) ? n0 : (4096 + (nt - 32) * 128)) * DM; ldb = DM;
  } else if (MODE == 2) {
    Ap = (nt < 8) ? P.H1 : P.H2; lda = 64;
    Bp = ((nt < 8) ? P.W2t : P.A2t) + (size_t)((nt & 7) * 128) * 64; ldb = 64;
  } else if (MODE == 3) { Ap = P.Gb; lda = DM; Bp = P.WtOut0 + (size_t)n0 * DM; ldb = DM; }
  else if (MODE == 4) { Ap = P.Rb; lda = DM; Bp = P.WtIn1 + (size_t)n0 * DM; ldb = DM; }
  else { Ap = P.Gb; lda = DM; Bp = P.WtOut1 + (size_t)n0 * DM; ldb = DM; }

  f32x4 acc[4][4];
#pragma unroll
  for (int i = 0; i < 4; i++)
#pragma unroll
    for (int j = 0; j < 4; j++) acc[i][j] = (f32x4){0.f, 0.f, 0.f, 0.f};

  u32x4 ra[4], rb[4], ra2[4];
  float4 mu0 = make_float4(0, 0, 0, 0), mu1 = make_float4(0, 0, 0, 0);
#define LOAD_TILE(kt_) do { \
    const int k0_ = (kt_) * 64 + lch * 8; \
    _Pragma("unroll") for (int i_ = 0; i_ < 4; i_++) { \
      const int row_ = lrow + 32 * i_; \
      ra[i_] = *(const u32x4*)(Ap + (size_t)(m0 + row_) * lda + k0_); \
      if (MODE == 1) ra2[i_] = *(const u32x4*)(A2p + (size_t)(m0 + row_) * lda + k0_); \
      rb[i_] = *(const u32x4*)(Bp + (size_t)row_ * ldb + k0_); \
    } \
    if (MODE == 1) { mu0 = *(const float4*)(mup + k0_); mu1 = *(const float4*)(mup + k0_ + 4); } \
  } while (0)
  LOAD_TILE(0);
  for (int kt = 0; kt < KT; kt++) {
    __syncthreads();
#pragma unroll
    for (int i = 0; i < 4; i++) {
      const int row = lrow + 32 * i;
      u32x4 av = ra[i];
      if (MODE == 1) {
        const u32x4 xv = ra[i], dv = ra2[i];
#define XS2(xw, dw, ma, mb) pack2(fmaf(__uint_as_float((dw) << 16), (ma), __uint_as_float((xw) << 16)), fmaf(__uint_as_float((dw) & 0xffff0000u), (mb), __uint_as_float((xw) & 0xffff0000u)))
        av = (u32x4){XS2(xv.x, dv.x, mu0.x, mu0.y), XS2(xv.y, dv.y, mu0.z, mu0.w), XS2(xv.z, dv.z, mu1.x, mu1.y), XS2(xv.w, dv.w, mu1.z, mu1.w)};
      }
      *(u32x4*)(As + row * LDS_LD + lch * 8) = av;
      *(u32x4*)(Bs + row * LDS_LD + lch * 8) = rb[i];
    }
    __syncthreads();
    if (kt + 1 < KT) LOAD_TILE(kt + 1);
#pragma unroll
    for (int ks = 0; ks < 2; ks++) {
      bf16x8 af[4], bfr[4];
#pragma unroll
      for (int i = 0; i < 4; i++) af[i] = *(const bf16x8*)(Bs + (wn * 64 + i * 16 + lc) * LDS_LD + ks * 32 + g * 8);
#pragma unroll
      for (int j = 0; j < 4; j++) bfr[j] = *(const bf16x8*)(As + (wm * 64 + j * 16 + lc) * LDS_LD + ks * 32 + g * 8);
#pragma unroll
      for (int i = 0; i < 4; i++)
#pragma unroll
        for (int j = 0; j < 4; j++) acc[i][j] = __builtin_amdgcn_mfma_f32_16x16x32_bf16(af[i], bfr[j], acc[i][j], 0, 0, 0);
    }
  }
#pragma unroll
  for (int i = 0; i < 4; i++) {
    const int nl = wn * 64 + i * 16 + 4 * g;
#pragma unroll
    for (int j = 0; j < 4; j++) {
      const int m = m0 + wm * 64 + j * 16 + lc;
      const f32x4 v = acc[i][j];
      if (MODE == 1) {
        if (nt < 32) {
          const int p = nt >> 3, c = (nt & 7) * 128 + nl;
          bf16_t* dst = (p == 0) ? P.Rb : (p == 1) ? P.Kb : (p == 2) ? P.Vb : P.Gb;
          uint2 o; o.x = pack2(v[0], v[1]); o.y = pack2(v[2], v[3]);
          *(uint2*)(dst + (size_t)m * DM + c) = o;
        } else if (nl < 64) {
          uint2 o;
          if (nt == 32) { o.x = pack2(tanhf(v[0]), tanhf(v[1])); o.y = pack2(tanhf(v[2]), tanhf(v[3])); *(uint2*)(P.H1 + (size_t)m * 64 + nl) = o; }
          else { o.x = pack2(v[0], v[1]); o.y = pack2(v[2], v[3]); *(uint2*)(P.H2 + (size_t)m * 64 + nl) = o; }
        }
      } else if (MODE == 2) {
        const int c = (nt & 7) * 128 + nl;
        f16_t o[4];
        if (nt < 8) {
          const float4 w0v = *(const float4*)(P.w0 + c);
          const float ws[4] = {w0v.x, w0v.y, w0v.z, w0v.w};
#pragma unroll
          for (int r = 0; r < 4; r++) o[r] = (f16_t)(sigmoidf_(ws[r] + v[r]) * 0.60653065971f);
          *(uint2*)((f16_t*)P.XB + (size_t)m * DM + c) = *(uint2*)o;
        } else {
          const float4 a0v = *(const float4*)(P.a0 + c);
          const float as_[4] = {a0v.x, a0v.y, a0v.z, a0v.w};
#pragma unroll
          for (int r = 0; r < 4; r++) o[r] = (f16_t)sigmoidf_(as_[r] + v[r]);
          *(uint2*)((f16_t*)P.XXB + (size_t)m * DM + c) = *(uint2*)o;
        }
      } else if (MODE == 3 || MODE == 5) {
        const int c = n0 + nl;
        float4 res;
        if (MODE == 3) res = *(const float4*)(xin_row(P, m) + c);
        else res = *(const float4*)(P.out + OUT_Y + (size_t)m * DM + c);
        float4 o = make_float4(v[0] + ALPHA_F * res.x, v[1] + ALPHA_F * res.y, v[2] + ALPHA_F * res.z, v[3] + ALPHA_F * res.w);
        *(float4*)(P.out + OUT_Y + (size_t)m * DM + c) = o;
      } else if (MODE == 4) {
        uint2 o; o.x = pack2(v[0], v[1]); o.y = pack2(v[2], v[3]);
        if (nt < 8) { *(uint2*)(P.Kb + (size_t)m * DM + n0 + nl) = o; }
        else if (nt >= 12) { *(uint2*)(P.Vb + (size_t)m * DM + (nt - 12) * 128 + nl) = o; }
        else {
          const bool isk = nt < 10;
          const int ck = (nt & 1) * 128 + nl;
          bf16_t* K1 = P.XB; bf16_t* V1 = P.XB + (size_t)NTOK * 256; bf16_t* VT1 = P.XB + (size_t)NTOK * 512;
          *(uint2*)((isk ? K1 : V1) + (size_t)m * 256 + ck) = o;
          const float4 fo = make_float4(v[0], v[1], v[2], v[3]);
          if (m < NPR) {
            const int b = m >> 13, tt = m & (TP - 1);
            if (!isk) {
              const int hk = ck >> 6, d = ck & 63;
              bf16_t* vt = VT1 + ((size_t)((b * 4 + hk) * 64 + d)) * TP + tt;
              vt[0] = f2bf(v[0]); vt[TP] = f2bf(v[1]); vt[2 * TP] = f2bf(v[2]); vt[3 * TP] = f2bf(v[3]);
            }
            if (tt >= TP - 128) *(float4*)(P.out + (isk ? OUT_WK_P : OUT_WV_P) + ((size_t)(b * 128 + tt - (TP - 128))) * 256 + ck) = fo;
          } else {
            const int ms = m - NPR, b = ms >> 3, tt = ms & 7;
            *(float4*)(P.out + (isk ? OUT_WK_S : OUT_WV_S) + ((size_t)(b * 128 + 120 + tt)) * 256 + ck) = fo;
          }
        }
      }
    }
  }
}
template <int MODE>
__device__ __forceinline__ void gemm_phase(const Params& P, unsigned char* smem, int bid, int nb) {
  constexpr int NT = (MODE == 1) ? 34 : (MODE == 2) ? 16 : (MODE == 4) ? 20 : 8;
  const int ntiles = 136 * NT;
  for (int tile = bid; tile < ntiles; tile += nb) gemm_tile<MODE>(P, smem, tile % 136, tile / 136);
}

#define TS 8
#define REC 392
typedef float f32x2 __attribute__((ext_vector_type(2)));
__device__ __forceinline__ f32x2 pkfma(f32x2 a, f32x2 b, f32x2 c) { return __builtin_elementwise_fma(a, b, c); }
#define DPP_ADD(x, ctrl) ((x) + __builtin_bit_cast(float, __builtin_amdgcn_update_dpp(0, __builtin_bit_cast(int, (x)), (ctrl), 0xF, 0xF, true)))
__device__ __forceinline__ float wave_sum_fast(float x) {
  x = DPP_ADD(x, 0xB1); x = DPP_ADD(x, 0x4E); x = DPP_ADD(x, 0x141); x = DPP_ADD(x, 0x140);
  const int xi = __builtin_bit_cast(int, x);
  const float t0 = __builtin_bit_cast(float, __builtin_amdgcn_readlane(xi, 0)), t1 = __builtin_bit_cast(float, __builtin_amdgcn_readlane(xi, 16));
  const float t2 = __builtin_bit_cast(float, __builtin_amdgcn_readlane(xi, 32)), t3 = __builtin_bit_cast(float, __builtin_amdgcn_readlane(xi, 48));
  return (t0 + t1) + (t2 + t3);
}
#define LD8(dst, ptr) do { _Pragma("unroll") for (int j4_ = 0; j4_ < 4; j4_++) { const f32x4 v_ = *(const f32x4*)((ptr) + 4 * j4_); \
    dst[2 * j4_] = (f32x2){v_[0], v_[1]}; dst[2 * j4_ + 1] = (f32x2){v_[2], v_[3]}; } } while (0)

template <int INIT  , bool USEV, bool WRITEY>
__device__ __forceinline__ void scan_unit(const Params& P, float* ws, int lane, int tok0, int nsteps, int h, const float* init_ptr, float* fin) {
  const int rq = lane >> 2, q = lane & 3;
  f32x2 s[4][8];
#pragma unroll
  for (int i = 0; i < 4; i++)
#pragma unroll
    for (int j = 0; j < 8; j++) {
      if (INIT == 1) s[i][j] = (f32x2){((rq + 16 * i) == (16 * q + 2 * j)) ? 1.f : 0.f, ((rq + 16 * i) == (16 * q + 2 * j + 1)) ? 1.f : 0.f};
      else s[i][j] = (f32x2){0.f, 0.f};
    }
  if (INIT == 2) {
#pragma unroll
    for (int i = 0; i < 4; i++) LD8(s[i], init_ptr + (size_t)(rq + 16 * i) * 64 + 16 * q);
  }
  const int c = h * 64 + lane;
  const float kkc = P.k_k[c], kac = P.k_a[c], rkc = P.r_k[c];
  const int crow = h * 64 + rq + 16 * q;
  const float gng = P.gn_g[crow], gnb = P.gn_b[crow];
  const f16_t* EW = (const f16_t*)P.XB;
  const f16_t* AA = (const f16_t*)P.XXB;

  bf16_t rk[TS], rv[TS], rr[TS]; f16_t ra_[TS], re_[TS];
#define LOAD_RAW(tb) do { _Pragma("unroll") for (int tt_ = 0; tt_ < TS; tt_++) { const size_t off_ = (size_t)(tok0 + (tb) + tt_) * DM + c; \
    rk[tt_] = P.Kb[off_]; ra_[tt_] = AA[off_]; re_[tt_] = EW[off_]; if (USEV) rv[tt_] = P.Vb[off_]; if (WRITEY) rr[tt_] = P.Rb[off_]; } } while (0)
  LOAD_RAW(0);
  for (int t0 = 0; t0 < nsteps; t0 += TS) {
#pragma unroll
    for (int tt = 0; tt < TS; tt++) {
      const float kraw = bf2f(rk[tt]);
      const float a = (float)ra_[tt];
      const float wd = __expf(-(float)re_[tt]);
      float kkv = kraw * kkc;
      const float ss = wave_sum_fast(kkv * kkv);
      kkv = kkv / fmaxf(sqrtf(ss), 1e-12f);
      const float kf = kraw * (1.f + (a - 1.f) * kac);
      float* rec = ws + tt * REC;
      rec[lane] = kkv; rec[64 + lane] = wd; rec[128 + lane] = kf; rec[192 + lane] = kkv * a;
      if (WRITEY) {
        const float r = bf2f(rr[tt]);
        rec[256 + lane] = r;
        const float bonus = wave_sum_fast(r * kf * rkc);
        if (lane == 0) rec[384] = bonus;
      }
      if (USEV) rec[320 + lane] = bf2f(rv[tt]);
    }
    __builtin_amdgcn_wave_barrier();
    asm volatile("s_waitcnt lgkmcnt(0)" ::: "memory");
    if (t0 + TS < nsteps) LOAD_RAW(t0 + TS);
#pragma unroll 2
    for (int tt = 0; tt < TS; tt++) {
      const float* rec = ws + tt * REC;
      f32x2 o2[8];
      LD8(o2, rec + 16 * q);
      f32x2 nsa2[4];
      {
        f32x2 acc[4];
#pragma unroll
        for (int i = 0; i < 4; i++) acc[i] = s[i][0] * o2[0];
#pragma unroll
        for (int j = 1; j < 8; j++)
#pragma unroll
          for (int i = 0; i < 4; i++) acc[i] = pkfma(s[i][j], o2[j], acc[i]);
#pragma unroll
        for (int i = 0; i < 4; i++) { const float t = -quad_sum(acc[i][0] + acc[i][1]); nsa2[i] = (f32x2){t, t}; }
      }
      float vv[4];
      if (USEV) {
#pragma unroll
        for (int i = 0; i < 4; i++) vv[i] = rec[320 + rq + 16 * i];
      }
      f32x2 w2[8], b2[8];
      LD8(w2, rec + 64 + 16 * q);
      LD8(b2, rec + 192 + 16 * q);
      if (USEV) {
        LD8(o2, rec + 128 + 16 * q);
#pragma unroll
        for (int i = 0; i < 4; i++) {
          const f32x2 vv2 = (f32x2){vv[i], vv[i]};
#pragma unroll
          for (int j = 0; j < 8; j++) s[i][j] = pkfma(s[i][j], w2[j], pkfma(vv2, o2[j], nsa2[i] * b2[j]));
        }
      } else {
#pragma unroll
        for (int i = 0; i < 4; i++)
#pragma unroll
          for (int j = 0; j < 8; j++) s[i][j] = pkfma(s[i][j], w2[j], nsa2[i] * b2[j]);
      }
      if (WRITEY) {
        LD8(o2, rec + 256 + 16 * q);
        float y[4];
        {
          f32x2 acc[4];
#pragma unroll
          for (int i = 0; i < 4; i++) acc[i] = s[i][0] * o2[0];
#pragma unroll
          for (int j = 1; j < 8; j++)
#pragma unroll
            for (int i = 0; i < 4; i++) acc[i] = pkfma(s[i][j], o2[j], acc[i]);
#pragma unroll
          for (int i = 0; i < 4; i++) y[i] = quad_sum(acc[i][0] + acc[i][1]);
        }
        const float ysel = (q == 0) ? y[0] : (q == 1) ? y[1] : (q == 2) ? y[2] : y[3];
        const float vsel = (q == 0) ? vv[0] : (q == 1) ? vv[1] : (q == 2) ? vv[2] : vv[3];
        const float mean = wave_sum_fast(ysel) * (1.f / 64.f);
        const float ex2 = wave_sum_fast(ysel * ysel) * (1.f / 64.f);
        const float var = fmaxf(ex2 - mean * mean, 0.f);
        float yo = (ysel - mean) * rsqrtf(var + 64e-5f) * gng + gnb + rec[384] * vsel;
        const size_t off = (size_t)(tok0 + t0 + tt) * DM + crow;
        const float gt = bf2f(P.Gb[off]);
        yo *= gt * sigmoidf_(gt);
        P.Gb[off] = f2bf(yo);
      }
    }
    __builtin_amdgcn_wave_barrier();
    asm volatile("s_waitcnt lgkmcnt(0)" ::: "memory");
  }
  if (fin) {
#pragma unroll
    for (int i = 0; i < 4; i++)
#pragma unroll
      for (int j4 = 0; j4 < 4; j4++)
        *(f32x4*)(fin + (size_t)(rq + 16 * i) * 64 + 16 * q + 4 * j4) = (f32x4){s[i][2 * j4][0], s[i][2 * j4][1], s[i][2 * j4 + 1][0], s[i][2 * j4 + 1][1]};
  }
}

__device__ __forceinline__ void phase_scan1(const Params& P, unsigned char* smem, int bid, int nb) {
  const int lane = threadIdx.x & 63, w = threadIdx.x >> 6;
  float* ws = (float*)smem + w * (TS * REC);
  float* Ploc = P.out + OUT_WK_S;
  float* Sloc = P.out + OUT_WV_S;
  const int total = NBH * (NC - 1) * 2;
  for (int u = w * nb + bid; u < total; u += 4 * nb) {
    const int kind = u & 1, rest = u >> 1;
    const int c = rest % (NC - 1), bh = rest / (NC - 1);
    const int tok0 = (bh >> 4) * TP + c * CL, h = bh & 15;
    float* fin = (kind ? Ploc : Sloc) + (size_t)(bh * (NC - 1) + c) * 4096;
    if (kind) scan_unit<1, false, false>(P, ws, lane, tok0, CL, h, nullptr, fin);
    else scan_unit<0, true, false>(P, ws, lane, tok0, CL, h, nullptr, fin);
  }
}
__device__ __forceinline__ void phase_scan2(const Params& P, unsigned char* smem, int bid, int nb) {
  const int lane = threadIdx.x & 63, w = threadIdx.x >> 6;
  float* ws = (float*)smem + w * 256;
  float* Ploc = P.out + OUT_WK_S;
  float* Sloc = P.out + OUT_WV_S;
  for (int item = bid; item < NBH * 4; item += nb) {
    const int bh = item >> 2, row0 = (item & 3) * 16 + w * 4;
    float s[4];
    {
      const float* S0 = Sloc + (size_t)(bh * (NC - 1)) * 4096;
#pragma unroll
      for (int r = 0; r < 4; r++) s[r] = S0[(row0 + r) * 64 + lane];
    }
    for (int c = 1; c < NC - 1; c++) {
      const float* Pc = Ploc + (size_t)(bh * (NC - 1) + c) * 4096;
      float* Sc = Sloc + (size_t)(bh * (NC - 1) + c) * 4096;
      float acc[4];
#pragma unroll
      for (int r = 0; r < 4; r++) { acc[r] = Sc[(row0 + r) * 64 + lane]; ws[r * 64 + lane] = s[r]; }
      __builtin_amdgcn_wave_barrier();
      asm volatile("s_waitcnt lgkmcnt(0)" ::: "memory");
#pragma unroll 1
      for (int hf = 0; hf < 2; hf++) {
        float p[32];
#pragma unroll
        for (int i = 0; i < 32; i++) p[i] = Pc[(hf * 32 + i) * 64 + lane];
#pragma unroll
        for (int r = 0; r < 4; r++) {
#pragma unroll
          for (int i4 = 0; i4 < 8; i4++) {
            const float4 sv = *(const float4*)(ws + r * 64 + hf * 32 + 4 * i4);
            acc[r] = fmaf(sv.x, p[4 * i4], acc[r]); acc[r] = fmaf(sv.y, p[4 * i4 + 1], acc[r]);
            acc[r] = fmaf(sv.z, p[4 * i4 + 2], acc[r]); acc[r] = fmaf(sv.w, p[4 * i4 + 3], acc[r]);
          }
        }
      }
      __builtin_amdgcn_wave_barrier();
      asm volatile("s_waitcnt lgkmcnt(0)" ::: "memory");
#pragma unroll
      for (int r = 0; r < 4; r++) { s[r] = acc[r]; Sc[(row0 + r) * 64 + lane] = acc[r]; }
    }
  }
}
__device__ __forceinline__ void phase_scan3(const Params& P, unsigned char* smem, int bid, int nb) {
  const int lane = threadIdx.x & 63, w = threadIdx.x >> 6;
  float* ws = (float*)smem + w * (TS * REC);
  float* Sloc = P.out + OUT_WV_S;
  const int total = NBH * NC + 2048;
  for (int u = w * nb + bid; u < total; u += 4 * nb) {
    if (u < NBH * NC) {
      const int bh = u >> 5, c = u & 31;
      const int tok0 = (bh >> 4) * TP + c * CL, h = bh & 15;
      const float* ip = (c > 0) ? (Sloc + (size_t)(bh * (NC - 1) + c - 1) * 4096) : nullptr;
      float* fin = (c == NC - 1) ? (P.out + OUT_WKV_P + (size_t)bh * 4096) : nullptr;
      if (c > 0) scan_unit<2, true, true>(P, ws, lane, tok0, CL, h, ip, fin);
      else scan_unit<0, true, true>(P, ws, lane, tok0, CL, h, ip, fin);
    } else {
      const int sb = u - NBH * NC;
      scan_unit<2, true, true>(P, ws, lane, NPR + (sb >> 4) * 8, 8, sb & 15, P.state_wkv + (size_t)sb * 4096, P.out + OUT_WKV_S + (size_t)sb * 4096);
    }
  }
}

__device__ __forceinline__ void phase_ln(const Params& P, int layer, int bid, int nb) {
  const int lane = threadIdx.x & 63, w = threadIdx.x >> 6;
  const float* gg = P.ln_g + layer * DM; const float* bb = P.ln_b + layer * DM;
  for (int tok = bid * 4 + w; tok < NTOK; tok += nb * 4) {
    f32x4* row = (f32x4*)(P.out + OUT_Y + (size_t)tok * DM);
    f32x4 v[4];
    float sum = 0.f;
#pragma unroll
    for (int i = 0; i < 4; i++) { v[i] = row[lane + 64 * i]; sum += v[i][0] + v[i][1] + v[i][2] + v[i][3]; }
    const float mean = wave_sum(sum) * (1.f / 1024.f);
    float sq = 0.f;
#pragma unroll
    for (int i = 0; i < 4; i++) { v[i] -= mean; sq += v[i][0] * v[i][0] + v[i][1] * v[i][1] + v[i][2] * v[i][2] + v[i][3] * v[i][3]; }
    const float rs = rsqrtf(wave_sum(sq) * (1.f / 1024.f) + 1e-5f);
#pragma unroll
    for (int i = 0; i < 4; i++) {
      const f32x4 g4 = ((const f32x4*)gg)[lane + 64 * i], b4 = ((const f32x4*)bb)[lane + 64 * i];
      const f32x4 o = v[i] * rs * g4 + b4;
      row[lane + 64 * i] = o;
      if (layer == 0) { uint2 ob; ob.x = pack2(o[0], o[1]); ob.y = pack2(o[2], o[3]); ((uint2*)(P.Rb + (size_t)tok * DM))[lane + 64 * i] = ob; }
    }
  }
}

__device__ __forceinline__ void attn_prompt_item(const Params& P, unsigned char* smem, int item) {
  const int qh = item & 1, hk = (item >> 1) & 3, n = (item >> 3) & 63, b = item >> 9;
  bf16_t* Ks = (bf16_t*)smem;
  bf16_t* Vs = Ks + 192 * 72;
  const bf16_t* K1 = P.XB; const bf16_t* VT1 = P.XB + (size_t)NTOK * 512;
  const bf16_t* Q1 = P.Kb; const bf16_t* G1 = P.Vb; bf16_t* AO = P.Gb;
  const int t = threadIdx.x, lane = t & 63, w = t >> 6;
  const int g = lane >> 4, lc = lane & 15;
  const int pos0 = (n - 1) * 128 + 64 * qh;
  __syncthreads();
#pragma unroll
  for (int i = 0; i < 6; i++) {
    const int idx = t + 256 * i; const int row = idx >> 3, ch = idx & 7; const int pos = pos0 + row;
    uint4 v = make_uint4(0, 0, 0, 0);
    if (pos >= 0) v = *(const uint4*)(K1 + ((size_t)(b * TP + pos)) * 256 + hk * 64 + ch * 8);
    *(uint4*)(Ks + row * 72 + ch * 8) = v;
  }
#pragma unroll
  for (int i = 0; i < 6; i++) {
    const int idx = t + 256 * i; const int d = idx / 24, ch = idx % 24; const int pos = pos0 + ch * 8;
    uint4 v = make_uint4(0, 0, 0, 0);
    if (pos >= 0) v = *(const uint4*)(VT1 + ((size_t)((b * 4 + hk) * 64 + d)) * TP + pos);
    *(uint4*)(Vs + d * 200 + ch * 8) = v;
  }
  __syncthreads();
  const int h = hk * 4 + w;
  const float slope = exp2f(-0.5f * (float)(h + 1));
  const float sink = P.att_sinks[h];
  for (int sb = 0; sb < 2; sb++) {
    const int i0 = 64 * qh + 32 * sb;
    const int tokb = b * TP + n * 128 + i0;
    bf16x8 qf[2][2];
#pragma unroll
    for (int nn = 0; nn < 2; nn++)
#pragma unroll
      for (int ks = 0; ks < 2; ks++) qf[nn][ks] = *(const bf16x8*)(Q1 + (size_t)(tokb + 16 * nn + lc) * DM + h * 64 + ks * 32 + g * 8);
    float mrun[2] = {sink, sink}, lrun[2] = {1.f, 1.f};
    f32x4 O[4][2];
#pragma unroll
    for (int dm = 0; dm < 4; dm++) { O[dm][0] = (f32x4){0.f, 0.f, 0.f, 0.f}; O[dm][1] = (f32x4){0.f, 0.f, 0.f, 0.f}; }
    for (int kt = 0; kt < 3; kt++) {
      if (n == 0 && (qh + kt) < 2) continue;
      f32x4 S[4][2];
#pragma unroll
      for (int mm = 0; mm < 4; mm++) { S[mm][0] = (f32x4){0.f, 0.f, 0.f, 0.f}; S[mm][1] = (f32x4){0.f, 0.f, 0.f, 0.f}; }
#pragma unroll
      for (int ks = 0; ks < 2; ks++)
#pragma unroll
        for (int mm = 0; mm < 4; mm++) {
          const bf16x8 kf = *(const bf16x8*)(Ks + (kt * 64 + mm * 16 + lc) * 72 + ks * 32 + g * 8);
          S[mm][0] = __builtin_amdgcn_mfma_f32_16x16x32_bf16(kf, qf[0][ks], S[mm][0], 0, 0, 0);
          S[mm][1] = __builtin_amdgcn_mfma_f32_16x16x32_bf16(kf, qf[1][ks], S[mm][1], 0, 0, 0);
        }
#pragma unroll
      for (int nn = 0; nn < 2; nn++) {
        const int qi = i0 + 16 * nn + lc;
        float mx = mrun[nn];
#pragma unroll
        for (int mm = 0; mm < 4; mm++)
#pragma unroll
          for (int r = 0; r < 4; r++) {
            const int j = 64 * (qh + kt) + 16 * mm + 4 * g + r;
            const int dist = 128 + qi - j;
            const bool live = (dist >= 0) && (dist < 128);
            const float sv = live ? (S[mm][nn][r] * 0.125f - slope * (float)dist) : -1e30f;
            S[mm][nn][r] = sv; mx = fmaxf(mx, sv);
          }
        mx = fmaxf(mx, __shfl_xor(mx, 16)); mx = fmaxf(mx, __shfl_xor(mx, 32));
        const float corr = __expf(mrun[nn] - mx); mrun[nn] = mx;
        float sum = 0.f;
#pragma unroll
        for (int mm = 0; mm < 4; mm++)
#pragma unroll
          for (int r = 0; r < 4; r++) { const float pp = __expf(S[mm][nn][r] - mx); S[mm][nn][r] = pp; sum += pp; }
        sum += __shfl_xor(sum, 16); sum += __shfl_xor(sum, 32);
        lrun[nn] = lrun[nn] * corr + sum;
#pragma unroll
        for (int dm = 0; dm < 4; dm++) { O[dm][nn][0] *= corr; O[dm][nn][1] *= corr; O[dm][nn][2] *= corr; O[dm][nn][3] *= corr; }
      }
#pragma unroll
      for (int k2 = 0; k2 < 2; k2++) {
        bf16x8 pf[2];
#pragma unroll
        for (int nn = 0; nn < 2; nn++) {
          const unsigned u0 = pack2(S[2 * k2][nn][0], S[2 * k2][nn][1]), u1 = pack2(S[2 * k2][nn][2], S[2 * k2][nn][3]);
          const unsigned u2 = pack2(S[2 * k2 + 1][nn][0], S[2 * k2 + 1][nn][1]), u3 = pack2(S[2 * k2 + 1][nn][2], S[2 * k2 + 1][nn][3]);
          const uint4 uu = make_uint4(u0, u1, u2, u3);
          pf[nn] = *(const bf16x8*)&uu;
        }
#pragma unroll
        for (int dm = 0; dm < 4; dm++) {
          const bf16_t* vb = Vs + (dm * 16 + lc) * 200 + kt * 64 + k2 * 32 + 4 * g;
          const uint2 lo = *(const uint2*)vb, hi = *(const uint2*)(vb + 16);
          const uint4 uu = make_uint4(lo.x, lo.y, hi.x, hi.y);
          const bf16x8 vf = *(const bf16x8*)&uu;
          O[dm][0] = __builtin_amdgcn_mfma_f32_16x16x32_bf16(vf, pf[0], O[dm][0], 0, 0, 0);
          O[dm][1] = __builtin_amdgcn_mfma_f32_16x16x32_bf16(vf, pf[1], O[dm][1], 0, 0, 0);
        }
      }
    }
#pragma unroll
    for (int nn = 0; nn < 2; nn++) {
      const float inv = 1.f / lrun[nn];
      const size_t tok = (size_t)(tokb + 16 * nn + lc);
#pragma unroll
      for (int dm = 0; dm < 4; dm++) {
        const int d = dm * 16 + 4 * g;
        const uint2 gv = *(const uint2*)(G1 + tok * DM + h * 64 + d);
        const float g0 = __uint_as_float(gv.x << 16), g1 = __uint_as_float(gv.x & 0xffff0000u);
        const float g2 = __uint_as_float(gv.y << 16), g3 = __uint_as_float(gv.y & 0xffff0000u);
        uint2 o;
        o.x = pack2(O[dm][nn][0] * inv * g0 * sigmoidf_(g0), O[dm][nn][1] * inv * g1 * sigmoidf_(g1));
        o.y = pack2(O[dm][nn][2] * inv * g2 * sigmoidf_(g2), O[dm][nn][3] * inv * g3 * sigmoidf_(g3));
        *(uint2*)(AO + tok * DM + h * 64 + d) = o;
      }
    }
  }
}

__device__ __forceinline__ void attn_sample_item(const Params& P, unsigned char* smem, int item) {
  const int b = item >> 2, hk = item & 3;
  const int t = threadIdx.x, lane = t & 63, w = t >> 6;
  float* qs = (float*)smem + w * 512;
  float* ps = (float*)smem + 2048 + w * (8 * 136);
  const bf16_t* K1 = P.XB; const bf16_t* V1 = P.XB + (size_t)NTOK * 256;
  const bf16_t* Q1 = P.Kb; const bf16_t* G1 = P.Vb; bf16_t* AO = P.Gb;
  const int h = hk * 4 + w;
  const float slope = exp2f(-0.5f * (float)(h + 1));
  const float sink = P.att_sinks[h];
  const int tok0 = NPR + b * 8;
  __syncthreads();
  for (int idx = t; idx < 120 * 16; idx += 256) {
    const int row = idx >> 4, c4 = idx & 15;
    const size_t so = ((size_t)(b * 128 + row + 8)) * 256 + hk * 64 + c4 * 4;
    const size_t dofs = ((size_t)(b * 128 + row)) * 256 + hk * 64 + c4 * 4;
    *(float4*)(P.out + OUT_WK_S + dofs) = *(const float4*)(P.cache_k + so);
    *(float4*)(P.out + OUT_WV_S + dofs) = *(const float4*)(P.cache_v + so);
  }
#pragma unroll
  for (int i = 0; i < 8; i++) qs[i * 64 + lane] = bf2f(Q1[(size_t)(tok0 + i) * DM + h * 64 + lane]);
  __builtin_amdgcn_wave_barrier();
  asm volatile("s_waitcnt lgkmcnt(0)" ::: "memory");
  float sc[3][8];
#pragma unroll
  for (int ksel = 0; ksel < 3; ksel++) {
    float acc[8];
#pragma unroll
    for (int i = 0; i < 8; i++) acc[i] = 0.f;
    const float* kp = P.cache_k + ((size_t)(b * 128 + lane + 64 * (ksel & 1))) * 256 + hk * 64;
    const bf16_t* kpb = K1 + (size_t)(tok0 + (lane & 7)) * 256 + hk * 64;
#pragma unroll 2
    for (int d4 = 0; d4 < 16; d4++) {
      float4 kv;
      if (ksel < 2) kv = ((const float4*)kp)[d4];
      else { const uint2 u = ((const uint2*)kpb)[d4]; kv = make_float4(__uint_as_float(u.x << 16), __uint_as_float(u.x & 0xffff0000u), __uint_as_float(u.y << 16), __uint_as_float(u.y & 0xffff0000u)); }
#pragma unroll
      for (int i = 0; i < 8; i++) {
        const float4 qv = *(const float4*)(qs + i * 64 + 4 * d4);
        acc[i] = fmaf(qv.x, kv.x, acc[i]); acc[i] = fmaf(qv.y, kv.y, acc[i]); acc[i] = fmaf(qv.z, kv.z, acc[i]); acc[i] = fmaf(qv.w, kv.w, acc[i]);
      }
    }
#pragma unroll
    for (int i = 0; i < 8; i++) {
      int dist; bool live;
      if (ksel < 2) { const int j = lane + 64 * ksel; dist = 128 + i - j; live = (j > i); }
      else { dist = i - lane; live = (lane <= i); }
      sc[ksel][i] = live ? (acc[i] * 0.125f - slope * (float)dist) : -1e30f;
    }
  }
#pragma unroll
  for (int i = 0; i < 8; i++) {
    float mx = fmaxf(fmaxf(sc[0][i], sc[1][i]), sc[2][i]);
    mx = fmaxf(wave_max(mx), sink);
    const float p0 = __expf(sc[0][i] - mx), p1 = __expf(sc[1][i] - mx), p2 = __expf(sc[2][i] - mx);
    const float den = wave_sum(p0 + p1 + p2) + __expf(sink - mx);
    const float inv = 1.f / den;
    ps[i * 136 + lane] = p0 * inv; ps[i * 136 + 64 + lane] = p1 * inv;
    if (lane < 8) ps[i * 136 + 128 + lane] = p2 * inv;
  }
  __builtin_amdgcn_wave_barrier();
  asm volatile("s_waitcnt lgkmcnt(0)" ::: "memory");
  float o[8];
#pragma unroll
  for (int i = 0; i < 8; i++) o[i] = 0.f;
  for (int j = 0; j < 136; j++) {
    float v;
    if (j < 128) v = P.cache_v[((size_t)(b * 128 + j)) * 256 + hk * 64 + lane];
    else v = bf2f(V1[(size_t)(tok0 + j - 128) * 256 + hk * 64 + lane]);
#pragma unroll
    for (int i = 0; i < 8; i++) o[i] = fmaf(ps[i * 136 + j], v, o[i]);
  }
#pragma unroll
  for (int i = 0; i < 8; i++) {
    const size_t off = (size_t)(tok0 + i) * DM + h * 64 + lane;
    const float gt = bf2f(G1[off]);
    AO[off] = f2bf(o[i] * gt * sigmoidf_(gt));
  }
}
__device__ __forceinline__ void phase_attn(const Params& P, unsigned char* smem, int bid, int nb) {
  for (int item = bid; item < 1024 + 512; item += nb) {
    if (item < 1024) attn_prompt_item(P, smem, item);
    else attn_sample_item(P, smem, item - 1024);
  }
}

#if MULTI_LAUNCH
#define PH_BARRIER(ph)
#else
#define PH_BARRIER(ph) do { if ((ph) + 1 < P.phase_end) { if ((ph) == 0) cg::this_grid().sync(); else xcd_barrier(xb); } } while (0)
#endif
#define RUN_PH(ph, call) do { if (P.phase_begin <= (ph) && (ph) < P.phase_end) { if ((REPMASK >> (ph)) & 1) { call; PH_BARRIER(ph); } call; PH_BARRIER(ph); } } while (0)

__global__ void __launch_bounds__(256, 2) fwd_kernel(Params P) {
  __shared__ __attribute__((aligned(16))) unsigned char smem[SMEM_BYTES];
  const int bid = blockIdx.x, nb = gridDim.x;
#if !MULTI_LAUNCH
  __shared__ uint4 xb_words;
  if (threadIdx.x == 0) xb_words = make_uint4(0u, 0u, 0u, 0u);
  __syncthreads();
  XcdBarrier xb = xcd_barrier_post(P.bar, (volatile LAS unsigned*)&xb_words);
#endif
#if (PHMASK >> 0) & 1
  RUN_PH(0, phase_prep(P, smem, bid, nb));
#endif
#if (PHMASK >> 1) & 1
  RUN_PH(1, gemm_phase<1>(P, smem, bid, nb));
#endif
#if (PHMASK >> 2) & 1
  RUN_PH(2, gemm_phase<2>(P, smem, bid, nb));
#endif
#if (PHMASK >> 3) & 1
  RUN_PH(3, phase_scan1(P, smem, bid, nb));
#endif
#if (PHMASK >> 4) & 1
  RUN_PH(4, phase_scan2(P, smem, bid, nb));
#endif
#if (PHMASK >> 5) & 1
  RUN_PH(5, phase_scan3(P, smem, bid, nb));
#endif
#if (PHMASK >> 6) & 1
  RUN_PH(6, gemm_phase<3>(P, smem, bid, nb));
#endif
#if (PHMASK >> 7) & 1
  RUN_PH(7, phase_ln(P, 0, bid, nb));
#endif
#if (PHMASK >> 8) & 1
  RUN_PH(8, gemm_phase<4>(P, smem, bid, nb));
#endif
#if (PHMASK >> 9) & 1
  RUN_PH(9, phase_attn(P, smem, bid, nb));
#endif
#if (PHMASK >> 10) & 1
  RUN_PH(10, gemm_phase<5>(P, smem, bid, nb));
#endif
#if (PHMASK >> 11) & 1
  RUN_PH(11, phase_ln(P, 1, bid, nb));
#endif
}

extern "C" void kernel_launch(void* const* d_in, const int* in_sizes, int n_in, void* d_out, int out_size, void* d_ws, size_t ws_size, hipStream_t stream) {
  Params P{};
  P.x_prompt = (const float*)d_in[0]; P.x_sample = (const float*)d_in[1]; P.state_wkv = (const float*)d_in[2]; P.state_shift = (const float*)d_in[3];
  P.cache_k = (const float*)d_in[4]; P.cache_v = (const float*)d_in[5]; P.ln_g = (const float*)d_in[6]; P.ln_b = (const float*)d_in[7];
  P.mu = (const float*)d_in[8]; P.w_in = (const float*)d_in[9]; P.w0 = (const float*)d_in[10]; P.w1 = (const float*)d_in[11]; P.w2 = (const float*)d_in[12];
  P.a0 = (const float*)d_in[13]; P.a1 = (const float*)d_in[14]; P.a2 = (const float*)d_in[15]; P.k_k = (const float*)d_in[16]; P.k_a = (const float*)d_in[17];
  P.r_k = (const float*)d_in[18]; P.gn_g = (const float*)d_in[19]; P.gn_b = (const float*)d_in[20]; P.w_out = (const float*)d_in[21];
  P.att_w_in = (const float*)d_in[22]; P.att_sinks = (const float*)d_in[23]; P.att_w_out = (const float*)d_in[24];
  P.out = (float*)d_out;
  unsigned char* ws = (unsigned char*)d_ws;
  size_t off = 0;
  auto take = [&](size_t bytes) { unsigned char* p = ws + off; off += (bytes + 255) & ~(size_t)255; return p; };
  P.bar = (unsigned*)take(16384);
  P.WtIn0 = (bf16_t*)take((size_t)4352 * DM * 2);
  P.W2t = (bf16_t*)take((size_t)DM * 64 * 2);
  P.A2t = (bf16_t*)take((size_t)DM * 64 * 2);
  P.WtOut0 = (bf16_t*)take((size_t)DM * DM * 2);
  P.WtIn1 = (bf16_t*)take((size_t)2560 * DM * 2);
  P.WtOut1 = (bf16_t*)take((size_t)DM * DM * 2);
  P.XB = (bf16_t*)take((size_t)NTOK * DM * 2);
  P.XXB = (bf16_t*)take((size_t)NTOK * DM * 2);
  P.Rb = (bf16_t*)take((size_t)NTOK * DM * 2);
  P.Kb = (bf16_t*)take((size_t)NTOK * DM * 2);
  P.Vb = (bf16_t*)take((size_t)NTOK * DM * 2);
  P.Gb = (bf16_t*)take((size_t)NTOK * DM * 2);
  P.H1 = (bf16_t*)take((size_t)NTOK * 64 * 2);
  P.H2 = (bf16_t*)take((size_t)NTOK * 64 * 2);
  if (off > ws_size) { fprintf(stderr, "workspace too small: need %zu have %zu\n", off, ws_size); return; }
#if MULTI_LAUNCH
  for (int ph = 0; ph < NPHASE; ph++) {
    P.phase_begin = ph; P.phase_end = ph + 1;
    hipLaunchKernelGGL(fwd_kernel, dim3(512), dim3(256), 0, stream, P);
  }
#else
  static int grid_blocks = 0;
  if (!grid_blocks) {
    int dev = 0, cus = 0, per_cu = 0;
    hipGetDevice(&dev);
    hipDeviceGetAttribute(&cus, hipDeviceAttributeMultiprocessorCount, dev);
    hipOccupancyMaxActiveBlocksPerMultiprocessor(&per_cu, fwd_kernel, 256, 0);
    if (per_cu > 2) per_cu = 2;
    if (per_cu < 1) per_cu = 1;
    grid_blocks = cus * per_cu;
  }
  hipMemsetAsync(P.bar, 0, 16384, stream);
  P.phase_begin = 0; P.phase_end = NPHASE;
  void* args[] = {&P};
  hipError_t e = hipLaunchCooperativeKernel((void*)fwd_kernel, dim3(grid_blocks), dim3(256), args, 0, stream);
  if (e != hipSuccess) fprintf(stderr, "cooperative launch failed: %s (grid %d)\n", hipGetErrorString(e), grid_blocks);
#endif
}
```

```cpp
#include <hip/hip_runtime.h>
#include <hip/hip_cooperative_groups.h>
#include <stdint.h>
#include <cstdio>
namespace cg = cooperative_groups;

#ifndef PHMASK
#define PHMASK 0xFFF
#endif
#ifndef REPMASK
#define REPMASK 0
#endif
#ifndef MULTI_LAUNCH
#define MULTI_LAUNCH 0
#endif

typedef unsigned short bf16_t;
typedef _Float16 f16_t;
typedef __attribute__((ext_vector_type(8))) short bf16x8;
typedef __attribute__((ext_vector_type(4))) float f32x4;
typedef __attribute__((ext_vector_type(4))) unsigned u32x4;

#define DM 1024
#define NTOK 17408
#define NPR 16384
#define TP 8192
#define NC 32
#define CL 256
#define NBH 32
#define ALPHA_F 1.41421356237f
#define SMEM_BYTES (56 * 1024)
#define NPHASE 12

#define OUT_Y 0
#define OUT_WKV_P 17825792
#define OUT_SH_P 17956864
#define OUT_WK_P 17958912
#define OUT_WV_P 18024448
#define OUT_WKV_S 18089984
#define OUT_SH_S 26478592
#define OUT_WK_S 26609664
#define OUT_WV_S 30803968

struct Params {
  const float *x_prompt, *x_sample, *state_wkv, *state_shift, *cache_k, *cache_v, *ln_g, *ln_b;
  const float *mu, *w_in, *w0, *w1, *w2, *a0, *a1, *a2, *k_k, *k_a, *r_k, *gn_g, *gn_b, *w_out;
  const float *att_w_in, *att_sinks, *att_w_out;
  float* out;
  unsigned* bar;
  bf16_t *WtIn0, *W2t, *A2t, *WtOut0, *WtIn1, *WtOut1;
  bf16_t *XB, *XXB;
  bf16_t *Rb, *Kb, *Vb, *Gb;
  bf16_t *H1, *H2;
  int phase_begin, phase_end;
};

__device__ __forceinline__ bf16_t f2bf(float f) {
  unsigned u = __float_as_uint(f);
  u += 0x7fffu + ((u >> 16) & 1u);
  return (bf16_t)(u >> 16);
}
__device__ __forceinline__ float bf2f(bf16_t h) { return __uint_as_float(((unsigned)h) << 16); }
__device__ __forceinline__ unsigned pack2(float a, float b) { return (unsigned)f2bf(a) | ((unsigned)f2bf(b) << 16); }
__device__ __forceinline__ float wave_sum(float x) {
#pragma unroll
  for (int o = 32; o >= 1; o >>= 1) x += __shfl_xor(x, o);
  return x;
}
__device__ __forceinline__ float wave_max(float x) {
#pragma unroll
  for (int o = 32; o >= 1; o >>= 1) x = fmaxf(x, __shfl_xor(x, o));
  return x;
}
__device__ __forceinline__ float quad_sum(float x) {
  x += __builtin_bit_cast(float, __builtin_amdgcn_update_dpp(0, __builtin_bit_cast(int, x), 0xB1, 0xF, 0xF, true));
  x += __builtin_bit_cast(float, __builtin_amdgcn_update_dpp(0, __builtin_bit_cast(int, x), 0x4E, 0xF, 0xF, true));
  return x;
}
__device__ __forceinline__ float sigmoidf_(float x) { return 1.f / (1.f + __expf(-x)); }
__device__ __forceinline__ const float* xin_row(const Params& P, int m) {
  return (m < NPR) ? (P.x_prompt + (size_t)m * DM) : (P.x_sample + (size_t)(m - NPR) * DM);
}

#define XB_TMO      128
#define XB_XCNT(j)  (256  + 64 * (j))
#define XB_XSUB(j)  (1280 + 64 * (j))
#define XB_XGEN(j)  (2304 + 64 * (j))
#define XB_TOP      3328
#define XB_TOPGEN   3392
#define XCD_BAR_WORDS 3456
#define XB_SPIN_CAP (1u << 22)
#define LAS __attribute__((address_space(3)))
__device__ __forceinline__ unsigned xb_ld(unsigned* p) { return __hip_atomic_load(p, __ATOMIC_RELAXED, __HIP_MEMORY_SCOPE_AGENT); }
__device__ __forceinline__ unsigned xb_add(unsigned* p, unsigned v) { return __hip_atomic_fetch_add(p, v, __ATOMIC_RELAXED, __HIP_MEMORY_SCOPE_AGENT); }
__device__ __forceinline__ unsigned xb_xcc_id() { return (unsigned)__builtin_amdgcn_s_getreg((3 << 11) | 20) & 0xFu; }
#define XB_SPIN(cond, bar) do { unsigned _sp = 0; while (cond) { __builtin_amdgcn_s_sleep(1); \
    if ((++_sp & 255u) == 0u) { if (xb_ld(&(bar)[XB_TMO])) break; if (_sp > XB_SPIN_CAP) { atomicAdd(&(bar)[XB_TMO], 1u); break; } } } } while (0)
struct XcdBarrier { unsigned* bar; unsigned x; volatile LAS unsigned* st; };
__device__ __forceinline__ XcdBarrier xcd_barrier_post(unsigned* bar, volatile LAS unsigned* st) {
  XcdBarrier b; b.bar = bar; b.x = xb_xcc_id(); b.st = st;
  if (threadIdx.x == 0) (void)xb_add(&bar[XB_XCNT(b.x)], 1u);
  return b;
}
__device__ __forceinline__ void xcd_barrier_complete(unsigned* bar, unsigned x, unsigned& nloc, unsigned& nx) {
  const unsigned G = gridDim.x * gridDim.y * gridDim.z;
  unsigned sum, cnt, mine, sp = 0u;
  for (;;) {
    sum = 0u; cnt = 0u; mine = 0u;
#pragma unroll
    for (unsigned j = 0; j < 16; ++j) { const unsigned c = xb_ld(&bar[XB_XCNT(j)]); sum += c; cnt += (c > 0u) ? 1u : 0u; mine = (j == x) ? c : mine; }
    if (sum == G) break;
    __builtin_amdgcn_s_sleep(1);
    if ((++sp & 255u) == 0u) { if (xb_ld(&bar[XB_TMO])) break; if (sp > XB_SPIN_CAP) { atomicAdd(&bar[XB_TMO], 1u); break; } }
  }
  nloc = mine > 0u ? mine : 1u; nx = cnt > 0u ? cnt : 1u;
}
__device__ __forceinline__ void xcd_barrier(const XcdBarrier& b) {
  asm volatile("s_waitcnt vmcnt(0)" ::: "memory");
  __syncthreads();
  if (threadIdx.x == 0) {
    unsigned* bar = b.bar;
    __builtin_amdgcn_s_waitcnt(0);
    unsigned nloc = b.st[0], nx = b.st[1];
    if (nloc == 0u) { xcd_barrier_complete(bar, b.x, nloc, nx); b.st[0] = nloc; b.st[1] = nx; }
    const unsigned old = xb_add(&bar[XB_XSUB(b.x)], 1u);
    const unsigned gen = old / nloc;
    if (old + 1u == (gen + 1u) * nloc) {
      __builtin_amdgcn_fence(__ATOMIC_RELEASE, "agent");
      asm volatile("s_waitcnt vmcnt(0)" ::: "memory");
      const unsigned og = xb_add(&bar[XB_TOP], 1u);
      const unsigned tg = og / nx;
      if (og + 1u == (tg + 1u) * nx) xb_add(&bar[XB_TOPGEN], 1u);
      else XB_SPIN(xb_ld(&bar[XB_TOPGEN]) == tg, bar);
      __builtin_amdgcn_fence(__ATOMIC_ACQUIRE, "agent");
      xb_add(&bar[XB_XGEN(b.x)], 1u);
      asm volatile("s_waitcnt vmcnt(0)" ::: "memory");
    } else {
      XB_SPIN(xb_ld(&bar[XB_XGEN(b.x)]) == gen, bar);
      __builtin_amdgcn_fence(__ATOMIC_ACQUIRE, "agent");
      asm volatile("s_waitcnt vmcnt(0)" ::: "memory");
    }
  }
  __syncthreads();
}

__device__ __forceinline__ void transpose_tile(const float* __restrict__ src, int ld, int k0, int n0, bf16_t* __restrict__ dst, int ldd, float* tile) {
  const int t = threadIdx.x;
  {
    const int n = t & 63, kq = t >> 6;
#pragma unroll 4
    for (int i = 0; i < 16; i++) { const int k = i * 4 + kq; tile[k * 65 + n] = src[(size_t)(k0 + k) * ld + n0 + n]; }
  }
  __syncthreads();
  {
    const int k = t & 63, nq = t >> 6;
#pragma unroll 4
    for (int i = 0; i < 16; i++) { const int n2 = i * 4 + nq; dst[(size_t)(n0 + n2) * ldd + k0 + k] = f2bf(tile[k * 65 + n2]); }
  }
  __syncthreads();
}

__device__ __forceinline__ void phase_prep(const Params& P, unsigned char* smem, int bid, int nb) {
  float* tile = (float*)smem;
  const int t = threadIdx.x;
  const int NITEMS = 2242 + 4352 + 130;
  for (int id = bid; id < NITEMS; id += nb) {
    if (id < 1024) { const int p = id >> 8, r = id & 255; transpose_tile(P.w_in + (size_t)p * DM * DM, DM, (r >> 4) * 64, (r & 15) * 64, P.WtIn0 + (size_t)p * DM * DM, DM, tile); }
    else if (id < 1040) transpose_tile(P.w1, 64, (id - 1024) * 64, 0, P.WtIn0 + (size_t)4096 * DM, DM, tile);
    else if (id < 1056) transpose_tile(P.a1, 64, (id - 1040) * 64, 0, P.WtIn0 + (size_t)4224 * DM, DM, tile);
    else if (id < 1072) transpose_tile(P.w2, DM, 0, (id - 1056) * 64, P.W2t, 64, tile);
    else if (id < 1088) transpose_tile(P.a2, DM, 0, (id - 1072) * 64, P.A2t, 64, tile);
    else if (id < 1344) { const int r = id - 1088; transpose_tile(P.w_out, DM, (r >> 4) * 64, (r & 15) * 64, P.WtOut0, DM, tile); }
    else if (id < 1984) { const int r = id - 1344; transpose_tile(P.att_w_in, 2560, (r / 40) * 64, (r % 40) * 64, P.WtIn1, DM, tile); }
    else if (id < 2240) { const int r = id - 1984; transpose_tile(P.att_w_out, DM, (r >> 4) * 64, (r & 15) * 64, P.WtOut1, DM, tile); }
    else if (id < 2242) {
      uint4* z = (uint4*)(P.WtIn0 + (size_t)(id == 2240 ? 4160 : 4288) * DM);
      for (int i = t; i < 8192; i += 256) z[i] = make_uint4(0, 0, 0, 0);
    } else if (id < 2242 + 4352) {
      const int it = id - 2242;
#pragma unroll
      for (int q = 0; q < 4; q++) {
        const int m = it * 4 + q;
        const float4 x = ((const float4*)xin_row(P, m))[t];
        float4 pv = make_float4(0.f, 0.f, 0.f, 0.f);
        if (m < NPR) { if ((m & (TP - 1)) != 0) pv = ((const float4*)xin_row(P, m - 1))[t]; }
        else { const int ms = m - NPR; if ((ms & 7) != 0) pv = ((const float4*)xin_row(P, m - 1))[t]; else pv = ((const float4*)(P.state_shift + (size_t)(ms >> 3) * DM))[t]; }
        uint2 xb, xxb;
        xb.x = pack2(x.x, x.y); xb.y = pack2(x.z, x.w);
        xxb.x = pack2(pv.x - x.x, pv.y - x.y); xxb.y = pack2(pv.z - x.z, pv.w - x.w);
        ((uint2*)(P.XB + (size_t)m * DM))[t] = xb;
        ((uint2*)(P.XXB + (size_t)m * DM))[t] = xxb;
      }
    } else {
      const int r = id - (2242 + 4352);
      if (r < 2) ((float4*)(P.out + OUT_SH_P + (size_t)r * DM))[t] = ((const float4*)(P.x_prompt + ((size_t)r * TP + TP - 1) * DM))[t];
      else { const int b = r - 2; ((float4*)(P.out + OUT_SH_S + (size_t)b * DM))[t] = ((const float4*)(P.x_sample + ((size_t)b * 8 + 7) * DM))[t]; }
    }
  }
}

#define LDS_LD 72
template <int MODE>
__device__ __forceinline__ void gemm_tile(const Params& P, unsigned char* smem, int mt, int nt) {
  constexpr int KT = (MODE == 2) ? 1 : 16;
  bf16_t* As = (bf16_t*)smem;
  bf16_t* Bs = As + 128 * LDS_LD;
  const int t = threadIdx.x, lane = t & 63, w = t >> 6;
  const int wm = w >> 1, wn = w & 1;
  const int g = lane >> 4, lc = lane & 15;
  const int lrow = t >> 3, lch = t & 7;
  const int m0 = mt * 128, n0 = nt * 128;

  const bf16_t* Ap; const bf16_t* A2p = nullptr; const float* mup = nullptr; const bf16_t* Bp; int lda, ldb;
  if (MODE == 1) {
    const int p = (nt < 32) ? (nt >> 3) : (4 + (nt - 32));
    Ap = P.XB; A2p = P.XXB; lda = DM; mup = P.mu + (size_t)p * DM;
    Bp = P.WtIn0 + (size_t)((nt < 32) ? n0 : (4096 + (nt - 32) * 128)) * DM; ldb = DM;
  } else if (MODE == 2) {
    Ap = (nt < 8) ? P.H1 : P.H2; lda = 64;
    Bp = ((nt < 8) ? P.W2t : P.A2t) + (size_t)((nt & 7) * 128) * 64; ldb = 64;
  } else if (MODE == 3) { Ap = P.Gb; lda = DM; Bp = P.WtOut0 + (size_t)n0 * DM; ldb = DM; }
  else if (MODE == 4) { Ap = P.Rb; lda = DM; Bp = P.WtIn1 + (size_t)n0 * DM; ldb = DM; }
  else { Ap = P.Gb; lda = DM; Bp = P.WtOut1 + (size_t)n0 * DM; ldb = DM; }

  f32x4 acc[4][4];
#pragma unroll
  for (int i = 0; i < 4; i++)
#pragma unroll
    for (int j = 0; j < 4; j++) acc[i][j] = (f32x4){0.f, 0.f, 0.f, 0.f};

  u32x4 ra[4], rb[4], ra2[4];
  float4 mu0 = make_float4(0, 0, 0, 0), mu1 = make_float4(0, 0, 0, 0);
#define LOAD_TILE(kt_) do { \
    const int k0_ = (kt_) * 64 + lch * 8; \
    _Pragma("unroll") for (int i_ = 0; i_ < 4; i_++) { \
      const int row_ = lrow + 32 * i_; \
      ra[i_] = *(const u32x4*)(Ap + (size_t)(m0 + row_) * lda + k0_); \
      if (MODE == 1) ra2[i_] = *(const u32x4*)(A2p + (size_t)(m0 + row_) * lda + k0_); \
      rb[i_] = *(const u32x4*)(Bp + (size_t)row_ * ldb + k0_); \
    } \
    if (MODE == 1) { mu0 = *(const float4*)(mup + k0_); mu1 = *(const float4*)(mup + k0_ + 4); } \
  } while (0)
  LOAD_TILE(0);
  for (int kt = 0; kt < KT; kt++) {
    __syncthreads();
#pragma unroll
    for (int i = 0; i < 4; i++) {
      const int row = lrow + 32 * i;
      u32x4 av = ra[i];
      if (MODE == 1) {
        const u32x4 xv = ra[i], dv = ra2[i];
#define XS2(xw, dw, ma, mb) pack2(fmaf(__uint_as_float((dw) << 16), (ma), __uint_as_float((xw) << 16)), fmaf(__uint_as_float((dw) & 0xffff0000u), (mb), __uint_as_float((xw) & 0xffff0000u)))
        av = (u32x4){XS2(xv.x, dv.x, mu0.x, mu0.y), XS2(xv.y, dv.y, mu0.z, mu0.w), XS2(xv.z, dv.z, mu1.x, mu1.y), XS2(xv.w, dv.w, mu1.z, mu1.w)};
      }
      *(u32x4*)(As + row * LDS_LD + lch * 8) = av;
      *(u32x4*)(Bs + row * LDS_LD + lch * 8) = rb[i];
    }
    __syncthreads();
    if (kt + 1 < KT) LOAD_TILE(kt + 1);
#pragma unroll
    for (int ks = 0; ks < 2; ks++) {
      bf16x8 af[4], bfr[4];
#pragma unroll
      for (int i = 0; i < 4; i++) af[i] = *(const bf16x8*)(Bs + (wn * 64 + i * 16 + lc) * LDS_LD + ks * 32 + g * 8);
#pragma unroll
      for (int j = 0; j < 4; j++) bfr[j] = *(const bf16x8*)(As + (wm * 64 + j * 16 + lc) * LDS_LD + ks * 32 + g * 8);
#pragma unroll
      for (int i = 0; i < 4; i++)
#pragma unroll
        for (int j = 0; j < 4; j++) acc[i][j] = __builtin_amdgcn_mfma_f32_16x16x32_bf16(af[i], bfr[j], acc[i][j], 0, 0, 0);
    }
  }
#pragma unroll
  for (int i = 0; i < 4; i++) {
    const int nl = wn * 64 + i * 16 + 4 * g;
#pragma unroll
    for (int j = 0; j < 4; j++) {
      const int m = m0 + wm * 64 + j * 16 + lc;
      const f32x4 v = acc[i][j];
      if (MODE == 1) {
        if (nt < 32) {
          const int p = nt >> 3, c = (nt & 7) * 128 + nl;
          bf16_t* dst = (p == 0) ? P.Rb : (p == 1) ? P.Kb : (p == 2) ? P.Vb : P.Gb;
          uint2 o; o.x = pack2(v[0], v[1]); o.y = pack2(v[2], v[3]);
          *(uint2*)(dst + (size_t)m * DM + c) = o;
        } else if (nl < 64) {
          uint2 o;
          if (nt == 32) { o.x = pack2(tanhf(v[0]), tanhf(v[1])); o.y = pack2(tanhf(v[2]), tanhf(v[3])); *(uint2*)(P.H1 + (size_t)m * 64 + nl) = o; }
          else { o.x = pack2(v[0], v[1]); o.y = pack2(v[2], v[3]); *(uint2*)(P.H2 + (size_t)m * 64 + nl) = o; }
        }
      } else if (MODE == 2) {
        const int c = (nt & 7) * 128 + nl;
        f16_t o[4];
        if (nt < 8) {
          const float4 w0v = *(const float4*)(P.w0 + c);
          const float ws[4] = {w0v.x, w0v.y, w0v.z, w0v.w};
#pragma unroll
          for (int r = 0; r < 4; r++) o[r] = (f16_t)(sigmoidf_(ws[r] + v[r]) * 0.60653065971f);
          *(uint2*)((f16_t*)P.XB + (size_t)m * DM + c) = *(uint2*)o;
        } else {
          const float4 a0v = *(const float4*)(P.a0 + c);
          const float as_[4] = {a0v.x, a0v.y, a0v.z, a0v.w};
#pragma unroll
          for (int r = 0; r < 4; r++) o[r] = (f16_t)sigmoidf_(as_[r] + v[r]);
          *(uint2*)((f16_t*)P.XXB + (size_t)m * DM + c) = *(uint2*)o;
        }
      } else if (MODE == 3 || MODE == 5) {
        const int c = n0 + nl;
        float4 res;
        if (MODE == 3) res = *(const float4*)(xin_row(P, m) + c);
        else res = *(const float4*)(P.out + OUT_Y + (size_t)m * DM + c);
        float4 o = make_float4(v[0] + ALPHA_F * res.x, v[1] + ALPHA_F * res.y, v[2] + ALPHA_F * res.z, v[3] + ALPHA_F * res.w);
        *(float4*)(P.out + OUT_Y + (size_t)m * DM + c) = o;
      } else if (MODE == 4) {
        uint2 o; o.x = pack2(v[0], v[1]); o.y = pack2(v[2], v[3]);
        if (nt < 8) { *(uint2*)(P.Kb + (size_t)m * DM + n0 + nl) = o; }
        else if (nt >= 12) { *(uint2*)(P.Vb + (size_t)m * DM + (nt - 12) * 128 + nl) = o; }
        else {
          const bool isk = nt < 10;
          const int ck = (nt & 1) * 128 + nl;
          bf16_t* K1 = P.XB; bf16_t* V1 = P.XB + (size_t)NTOK * 256; bf16_t* VT1 = P.XB + (size_t)NTOK * 512;
          *(uint2*)((isk ? K1 : V1) + (size_t)m * 256 + ck) = o;
          const float4 fo = make_float4(v[0], v[1], v[2], v[3]);
          if (m < NPR) {
            const int b = m >> 13, tt = m & (TP - 1);
            if (!isk) {
              const int hk = ck >> 6, d = ck & 63;
              bf16_t* vt = VT1 + ((size_t)((b * 4 + hk) * 64 + d)) * TP + tt;
              vt[0] = f2bf(v[0]); vt[TP] = f2bf(v[1]); vt[2 * TP] = f2bf(v[2]); vt[3 * TP] = f2bf(v[3]);
            }
            if (tt >= TP - 128) *(float4*)(P.out + (isk ? OUT_WK_P : OUT_WV_P) + ((size_t)(b * 128 + tt - (TP - 128))) * 256 + ck) = fo;
          } else {
            const int ms = m - NPR, b = ms >> 3, tt = ms & 7;
            *(float4*)(P.out + (isk ? OUT_WK_S : OUT_WV_S) + ((size_t)(b * 128 + 120 + tt)) * 256 + ck) = fo;
          }
        }
      }
    }
  }
}
template <int MODE>
__device__ __forceinline__ void gemm_phase(const Params& P, unsigned char* smem, int bid, int nb) {
  constexpr int NT = (MODE == 1) ? 34 : (MODE == 2) ? 16 : (MODE == 4) ? 20 : 8;
  const int ntiles = 136 * NT;
  for (int tile = bid; tile < ntiles; tile += nb) gemm_tile<MODE>(P, smem, tile % 136, tile / 136);
}

#define TS 8
#define REC 392
typedef float f32x2 __attribute__((ext_vector_type(2)));
__device__ __forceinline__ f32x2 pkfma(f32x2 a, f32x2 b, f32x2 c) { return __builtin_elementwise_fma(a, b, c); }
#define DPP_ADD(x, ctrl) ((x) + __builtin_bit_cast(float, __builtin_amdgcn_update_dpp(0, __builtin_bit_cast(int, (x)), (ctrl), 0xF, 0xF, true)))
__device__ __forceinline__ float wave_sum_fast(float x) {
  x = DPP_ADD(x, 0xB1); x = DPP_ADD(x, 0x4E); x = DPP_ADD(x, 0x141); x = DPP_ADD(x, 0x140);
  const int xi = __builtin_bit_cast(int, x);
  const float t0 = __builtin_bit_cast(float, __builtin_amdgcn_readlane(xi, 0)), t1 = __builtin_bit_cast(float, __builtin_amdgcn_readlane(xi, 16));
  const float t2 = __builtin_bit_cast(float, __builtin_amdgcn_readlane(xi, 32)), t3 = __builtin_bit_cast(float, __builtin_amdgcn_readlane(xi, 48));
  return (t0 + t1) + (t2 + t3);
}
#define LD8(dst, ptr) do { _Pragma("unroll") for (int j4_ = 0; j4_ < 4; j4_++) { const f32x4 v_ = *(const f32x4*)((ptr) + 4 * j4_); \
    dst[2 * j4_] = (f32x2){v_[0], v_[1]}; dst[2 * j4_ + 1] = (f32x2){v_[2], v_[3]}; } } while (0)

template <int INIT  , bool USEV, bool WRITEY>
__device__ __forceinline__ void scan_unit(const Params& P, float* ws, int lane, int tok0, int nsteps, int h, const float* init_ptr, float* fin) {
  const int rq = lane >> 2, q = lane & 3;
  f32x2 s[4][8];
#pragma unroll
  for (int i = 0; i < 4; i++)
#pragma unroll
    for (int j = 0; j < 8; j++) {
      if (INIT == 1) s[i][j] = (f32x2){((rq + 16 * i) == (16 * q + 2 * j)) ? 1.f : 0.f, ((rq + 16 * i) == (16 * q + 2 * j + 1)) ? 1.f : 0.f};
      else s[i][j] = (f32x2){0.f, 0.f};
    }
  if (INIT == 2) {
#pragma unroll
    for (int i = 0; i < 4; i++) LD8(s[i], init_ptr + (size_t)(rq + 16 * i) * 64 + 16 * q);
  }
  const int c = h * 64 + lane;
  const float kkc = P.k_k[c], kac = P.k_a[c], rkc = P.r_k[c];
  const int crow = h * 64 + rq + 16 * q;
  const float gng = P.gn_g[crow], gnb = P.gn_b[crow];
  const f16_t* EW = (const f16_t*)P.XB;
  const f16_t* AA = (const f16_t*)P.XXB;

  bf16_t rk[TS], rv[TS], rr[TS]; f16_t ra_[TS], re_[TS];
#define LOAD_RAW(tb) do { _Pragma("unroll") for (int tt_ = 0; tt_ < TS; tt_++) { const size_t off_ = (size_t)(tok0 + (tb) + tt_) * DM + c; \
    rk[tt_] = P.Kb[off_]; ra_[tt_] = AA[off_]; re_[tt_] = EW[off_]; if (USEV) rv[tt_] = P.Vb[off_]; if (WRITEY) rr[tt_] = P.Rb[off_]; } } while (0)
  LOAD_RAW(0);
  for (int t0 = 0; t0 < nsteps; t0 += TS) {
#pragma unroll
    for (int tt = 0; tt < TS; tt++) {
      const float kraw = bf2f(rk[tt]);
      const float a = (float)ra_[tt];
      const float wd = __expf(-(float)re_[tt]);
      float kkv = kraw * kkc;
      const float ss = wave_sum_fast(kkv * kkv);
      kkv = kkv / fmaxf(sqrtf(ss), 1e-12f);
      const float kf = kraw * (1.f + (a - 1.f) * kac);
      float* rec = ws + tt * REC;
      rec[lane] = kkv; rec[64 + lane] = wd; rec[128 + lane] = kf; rec[192 + lane] = kkv * a;
      if (WRITEY) {
        const float r = bf2f(rr[tt]);
        rec[256 + lane] = r;
        const float bonus = wave_sum_fast(r * kf * rkc);
        if (lane == 0) rec[384] = bonus;
      }
      if (USEV) rec[320 + lane] = bf2f(rv[tt]);
    }
    __builtin_amdgcn_wave_barrier();
    asm volatile("s_waitcnt lgkmcnt(0)" ::: "memory");
    if (t0 + TS < nsteps) LOAD_RAW(t0 + TS);
#pragma unroll 2
    for (int tt = 0; tt < TS; tt++) {
      const float* rec = ws + tt * REC;
      f32x2 o2[8];
      LD8(o2, rec + 16 * q);
      f32x2 nsa2[4];
      {
        f32x2 acc[4];
#pragma unroll
        for (int i = 0; i < 4; i++) acc[i] = s[i][0] * o2[0];
#pragma unroll
        for (int j = 1; j < 8; j++)
#pragma unroll
          for (int i = 0; i < 4; i++) acc[i] = pkfma(s[i][j], o2[j], acc[i]);
#pragma unroll
        for (int i = 0; i < 4; i++) { const float t = -quad_sum(acc[i][0] + acc[i][1]); nsa2[i] = (f32x2){t, t}; }
      }
      float vv[4];
      if (USEV) {
#pragma unroll
        for (int i = 0; i < 4; i++) vv[i] = rec[320 + rq + 16 * i];
      }
      f32x2 w2[8], b2[8];
      LD8(w2, rec + 64 + 16 * q);
      LD8(b2, rec + 192 + 16 * q);
      if (USEV) {
        LD8(o2, rec + 128 + 16 * q);
#pragma unroll
        for (int i = 0; i < 4; i++) {
          const f32x2 vv2 = (f32x2){vv[i], vv[i]};
#pragma unroll
          for (int j = 0; j < 8; j++) s[i][j] = pkfma(s[i][j], w2[j], pkfma(vv2, o2[j], nsa2[i] * b2[j]));
        }
      } else {
#pragma unroll
        for (int i = 0; i < 4; i++)
#pragma unroll
          for (int j = 0; j < 8; j++) s[i][j] = pkfma(s[i][j], w2[j], nsa2[i] * b2[j]);
      }
      if (WRITEY) {
        LD8(o2, rec + 256 + 16 * q);
        float y[4];
        {
          f32x2 acc[4];
#pragma unroll
          for (int i = 0; i < 4; i++) acc[i] = s[i][0] * o2[0];
#pragma unroll
          for (int j = 1; j < 8; j++)
#pragma unroll
            for (int i = 0; i < 4; i++) acc[i] = pkfma(s[i][j], o2[j], acc[i]);
#pragma unroll
          for (int i = 0; i < 4; i++) y[i] = quad_sum(acc[i][0] + acc[i][1]);
        }
        const float ysel = (q == 0) ? y[0] : (q == 1) ? y[1] : (q == 2) ? y[2] : y[3];
        const float vsel = (q == 0) ? vv[0] : (q == 1) ? vv[1] : (q == 2) ? vv[2] : vv[3];
        const float mean = wave_sum_fast(ysel) * (1.f / 64.f);
        const float ex2 = wave_sum_fast(ysel * ysel) * (1.f / 64.f);
        const float var = fmaxf(ex2 - mean * mean, 0.f);
        float yo = (ysel - mean) * rsqrtf(var + 64e-5f) * gng + gnb + rec[384] * vsel;
        const size_t off = (size_t)(tok0 + t0 + tt) * DM + crow;
        const float gt = bf2f(P.Gb[off]);
        yo *= gt * sigmoidf_(gt);
        P.Gb[off] = f2bf(yo);
      }
    }
    __builtin_amdgcn_wave_barrier();
    asm volatile("s_waitcnt lgkmcnt(0)" ::: "memory");
  }
  if (fin) {
#pragma unroll
    for (int i = 0; i < 4; i++)
#pragma unroll
      for (int j4 = 0; j4 < 4; j4++)
        *(f32x4*)(fin + (size_t)(rq + 16 * i) * 64 + 16 * q + 4 * j4) = (f32x4){s[i][2 * j4][0], s[i][2 * j4][1], s[i][2 * j4 + 1][0], s[i][2 * j4 + 1][1]};
  }
}

__device__ __forceinline__ void phase_scan1(const Params& P, unsigned char* smem, int bid, int nb) {
  const int lane = threadIdx.x & 63, w = threadIdx.x >> 6;
  float* ws = (float*)smem + w * (TS * REC);
  float* Ploc = P.out + OUT_WK_S;
  float* Sloc = P.out + OUT_WV_S;
  const int total = NBH * (NC - 1) * 2;
  for (int u = w * nb + bid; u < total; u += 4 * nb) {
    const int kind = u & 1, rest = u >> 1;
    const int c = rest % (NC - 1), bh = rest / (NC - 1);
    const int tok0 = (bh >> 4) * TP + c * CL, h = bh & 15;
    float* fin = (kind ? Ploc : Sloc) + (size_t)(bh * (NC - 1) + c) * 4096;
    if (kind) scan_unit<1, false, false>(P, ws, lane, tok0, CL, h, nullptr, fin);
    else scan_unit<0, true, false>(P, ws, lane, tok0, CL, h, nullptr, fin);
  }
}
__device__ __forceinline__ void phase_scan2(const Params& P, unsigned char* smem, int bid, int nb) {
  const int lane = threadIdx.x & 63, w = threadIdx.x >> 6;
  float* ws = (float*)smem + w * 256;
  float* Ploc = P.out + OUT_WK_S;
  float* Sloc = P.out + OUT_WV_S;
  for (int item = bid; item < NBH * 4; item += nb) {
    const int bh = item >> 2, row0 = (item & 3) * 16 + w * 4;
    float s[4];
    {
      const float* S0 = Sloc + (size_t)(bh * (NC - 1)) * 4096;
#pragma unroll
      for (int r = 0; r < 4; r++) s[r] = S0[(row0 + r) * 64 + lane];
    }
    for (int c = 1; c < NC - 1; c++) {
      const float* Pc = Ploc + (size_t)(bh * (NC - 1) + c) * 4096;
      float* Sc = Sloc + (size_t)(bh * (NC - 1) + c) * 4096;
      float acc[4];
#pragma unroll
      for (int r = 0; r < 4; r++) { acc[r] = Sc[(row0 + r) * 64 + lane]; ws[r * 64 + lane] = s[r]; }
      __builtin_amdgcn_wave_barrier();
      asm volatile("s_waitcnt lgkmcnt(0)" ::: "memory");
#pragma unroll 1
      for (int hf = 0; hf < 2; hf++) {
        float p[32];
#pragma unroll
        for (int i = 0; i < 32; i++) p[i] = Pc[(hf * 32 + i) * 64 + lane];
#pragma unroll
        for (int r = 0; r < 4; r++) {
#pragma unroll
          for (int i4 = 0; i4 < 8; i4++) {
            const float4 sv = *(const float4*)(ws + r * 64 + hf * 32 + 4 * i4);
            acc[r] = fmaf(sv.x, p[4 * i4], acc[r]); acc[r] = fmaf(sv.y, p[4 * i4 + 1], acc[r]);
            acc[r] = fmaf(sv.z, p[4 * i4 + 2], acc[r]); acc[r] = fmaf(sv.w, p[4 * i4 + 3], acc[r]);
          }
        }
      }
      __builtin_amdgcn_wave_barrier();
      asm volatile("s_waitcnt lgkmcnt(0)" ::: "memory");
#pragma unroll
      for (int r = 0; r < 4; r++) { s[r] = acc[r]; Sc[(row0 + r) * 64 + lane] = acc[r]; }
    }
  }
}
__device__ __forceinline__ void phase_scan3(const Params& P, unsigned char* smem, int bid, int nb) {
  const int lane = threadIdx.x & 63, w = threadIdx.x >> 6;
  float* ws = (float*)smem + w * (TS * REC);
  float* Sloc = P.out + OUT_WV_S;
  const int hb = nb >> 1;
  if (bid < hb) {
    for (int u = w * hb + bid; u < NBH * NC; u += 4 * hb) {
      const int bh = u >> 5, c = u & 31;
      const int tok0 = (bh >> 4) * TP + c * CL, h = bh & 15;
      const float* ip = (c > 0) ? (Sloc + (size_t)(bh * (NC - 1) + c - 1) * 4096) : nullptr;
      float* fin = (c == NC - 1) ? (P.out + OUT_WKV_P + (size_t)bh * 4096) : nullptr;
      if (c > 0) scan_unit<2, true, true>(P, ws, lane, tok0, CL, h, ip, fin);
      else scan_unit<0, true, true>(P, ws, lane, tok0, CL, h, ip, fin);
    }
  } else {
    for (int sb = w * (nb - hb) + (bid - hb); sb < 2048; sb += 4 * (nb - hb))
      scan_unit<2, true, true>(P, ws, lane, NPR + (sb >> 4) * 8, 8, sb & 15, P.state_wkv + (size_t)sb * 4096, P.out + OUT_WKV_S + (size_t)sb * 4096);
  }
}

__device__ __forceinline__ void phase_ln(const Params& P, int layer, int bid, int nb) {
  const int lane = threadIdx.x & 63, w = threadIdx.x >> 6;
  const float* gg = P.ln_g + layer * DM; const float* bb = P.ln_b + layer * DM;
  for (int tok = bid * 4 + w; tok < NTOK; tok += nb * 4) {
    f32x4* row = (f32x4*)(P.out + OUT_Y + (size_t)tok * DM);
    f32x4 v[4];
    float sum = 0.f;
#pragma unroll
    for (int i = 0; i < 4; i++) { v[i] = row[lane + 64 * i]; sum += v[i][0] + v[i][1] + v[i][2] + v[i][3]; }
    const float mean = wave_sum(sum) * (1.f / 1024.f);
    float sq = 0.f;
#pragma unroll
    for (int i = 0; i < 4; i++) { v[i] -= mean; sq += v[i][0] * v[i][0] + v[i][1] * v[i][1] + v[i][2] * v[i][2] + v[i][3] * v[i][3]; }
    const float rs = rsqrtf(wave_sum(sq) * (1.f / 1024.f) + 1e-5f);
#pragma unroll
    for (int i = 0; i < 4; i++) {
      const f32x4 g4 = ((const f32x4*)gg)[lane + 64 * i], b4 = ((const f32x4*)bb)[lane + 64 * i];
      const f32x4 o = v[i] * rs * g4 + b4;
      row[lane + 64 * i] = o;
      if (layer == 0) { uint2 ob; ob.x = pack2(o[0], o[1]); ob.y = pack2(o[2], o[3]); ((uint2*)(P.Rb + (size_t)tok * DM))[lane + 64 * i] = ob; }
    }
  }
}

__device__ __forceinline__ void attn_prompt_item(const Params& P, unsigned char* smem, int item) {
  const int qh = item & 1, hk = (item >> 1) & 3, n = (item >> 3) & 63, b = item >> 9;
  bf16_t* Ks = (bf16_t*)smem;
  bf16_t* Vs = Ks + 192 * 72;
  const bf16_t* K1 = P.XB; const bf16_t* VT1 = P.XB + (size_t)NTOK * 512;
  const bf16_t* Q1 = P.Kb; const bf16_t* G1 = P.Vb; bf16_t* AO = P.Gb;
  const int t = threadIdx.x, lane = t & 63, w = t >> 6;
  const int g = lane >> 4, lc = lane & 15;
  const int pos0 = (n - 1) * 128 + 64 * qh;
  __syncthreads();
#pragma unroll
  for (int i = 0; i < 6; i++) {
    const int idx = t + 256 * i; const int row = idx >> 3, ch = idx & 7; const int pos = pos0 + row;
    uint4 v = make_uint4(0, 0, 0, 0);
    if (pos >= 0) v = *(const uint4*)(K1 + ((size_t)(b * TP + pos)) * 256 + hk * 64 + ch * 8);
    *(uint4*)(Ks + row * 72 + ch * 8) = v;
  }
#pragma unroll
  for (int i = 0; i < 6; i++) {
    const int idx = t + 256 * i; const int d = idx / 24, ch = idx % 24; const int pos = pos0 + ch * 8;
    uint4 v = make_uint4(0, 0, 0, 0);
    if (pos >= 0) v = *(const uint4*)(VT1 + ((size_t)((b * 4 + hk) * 64 + d)) * TP + pos);
    *(uint4*)(Vs + d * 200 + ch * 8) = v;
  }
  __syncthreads();
  const int h = hk * 4 + w;
  const float slope = exp2f(-0.5f * (float)(h + 1));
  const float sink = P.att_sinks[h];
  for (int sb = 0; sb < 2; sb++) {
    const int i0 = 64 * qh + 32 * sb;
    const int tokb = b * TP + n * 128 + i0;
    bf16x8 qf[2][2];
#pragma unroll
    for (int nn = 0; nn < 2; nn++)
#pragma unroll
      for (int ks = 0; ks < 2; ks++) qf[nn][ks] = *(const bf16x8*)(Q1 + (size_t)(tokb + 16 * nn + lc) * DM + h * 64 + ks * 32 + g * 8);
    float mrun[2] = {sink, sink}, lrun[2] = {1.f, 1.f};
    f32x4 O[4][2];
#pragma unroll
    for (int dm = 0; dm < 4; dm++) { O[dm][0] = (f32x4){0.f, 0.f, 0.f, 0.f}; O[dm][1] = (f32x4){0.f, 0.f, 0.f, 0.f}; }
    for (int kt = 0; kt < 3; kt++) {
      if (n == 0 && (qh + kt) < 2) continue;
      f32x4 S[4][2];
#pragma unroll
      for (int mm = 0; mm < 4; mm++) { S[mm][0] = (f32x4){0.f, 0.f, 0.f, 0.f}; S[mm][1] = (f32x4){0.f, 0.f, 0.f, 0.f}; }
#pragma unroll
      for (int ks = 0; ks < 2; ks++)
#pragma unroll
        for (int mm = 0; mm < 4; mm++) {
          const bf16x8 kf = *(const bf16x8*)(Ks + (kt * 64 + mm * 16 + lc) * 72 + ks * 32 + g * 8);
          S[mm][0] = __builtin_amdgcn_mfma_f32_16x16x32_bf16(kf, qf[0][ks], S[mm][0], 0, 0, 0);
          S[mm][1] = __builtin_amdgcn_mfma_f32_16x16x32_bf16(kf, qf[1][ks], S[mm][1], 0, 0, 0);
        }
#pragma unroll
      for (int nn = 0; nn < 2; nn++) {
        const int qi = i0 + 16 * nn + lc;
        float mx = mrun[nn];
#pragma unroll
        for (int mm = 0; mm < 4; mm++)
#pragma unroll
          for (int r = 0; r < 4; r++) {
            const int j = 64 * (qh + kt) + 16 * mm + 4 * g + r;
            const int dist = 128 + qi - j;
            const bool live = (dist >= 0) && (dist < 128);
            const float sv = live ? (S[mm][nn][r] * 0.125f - slope * (float)dist) : -1e30f;
            S[mm][nn][r] = sv; mx = fmaxf(mx, sv);
          }
        mx = fmaxf(mx, __shfl_xor(mx, 16)); mx = fmaxf(mx, __shfl_xor(mx, 32));
        const float corr = __expf(mrun[nn] - mx); mrun[nn] = mx;
        float sum = 0.f;
#pragma unroll
        for (int mm = 0; mm < 4; mm++)
#pragma unroll
          for (int r = 0; r < 4; r++) { const float pp = __expf(S[mm][nn][r] - mx); S[mm][nn][r] = pp; sum += pp; }
        sum += __shfl_xor(sum, 16); sum += __shfl_xor(sum, 32);
        lrun[nn] = lrun[nn] * corr + sum;
#pragma unroll
        for (int dm = 0; dm < 4; dm++) { O[dm][nn][0] *= corr; O[dm][nn][1] *= corr; O[dm][nn][2] *= corr; O[dm][nn][3] *= corr; }
      }
#pragma unroll
      for (int k2 = 0; k2 < 2; k2++) {
        bf16x8 pf[2];
#pragma unroll
        for (int nn = 0; nn < 2; nn++) {
          const unsigned u0 = pack2(S[2 * k2][nn][0], S[2 * k2][nn][1]), u1 = pack2(S[2 * k2][nn][2], S[2 * k2][nn][3]);
          const unsigned u2 = pack2(S[2 * k2 + 1][nn][0], S[2 * k2 + 1][nn][1]), u3 = pack2(S[2 * k2 + 1][nn][2], S[2 * k2 + 1][nn][3]);
          const uint4 uu = make_uint4(u0, u1, u2, u3);
          pf[nn] = *(const bf16x8*)&uu;
        }
#pragma unroll
        for (int dm = 0; dm < 4; dm++) {
          const bf16_t* vb = Vs + (dm * 16 + lc) * 200 + kt * 64 + k2 * 32 + 4 * g;
          const uint2 lo = *(const uint2*)vb, hi = *(const uint2*)(vb + 16);
          const uint4 uu = make_uint4(lo.x, lo.y, hi.x, hi.y);
          const bf16x8 vf = *(const bf16x8*)&uu;
          O[dm][0] = __builtin_amdgcn_mfma_f32_16x16x32_bf16(vf, pf[0], O[dm][0], 0, 0, 0);
          O[dm][1] = __builtin_amdgcn_mfma_f32_16x16x32_bf16(vf, pf[1], O[dm][1], 0, 0, 0);
        }
      }
    }
#pragma unroll
    for (int nn = 0; nn < 2; nn++) {
      const float inv = 1.f / lrun[nn];
      const size_t tok = (size_t)(tokb + 16 * nn + lc);
#pragma unroll
      for (int dm = 0; dm < 4; dm++) {
        const int d = dm * 16 + 4 * g;
        const uint2 gv = *(const uint2*)(G1 + tok * DM + h * 64 + d);
        const float g0 = __uint_as_float(gv.x << 16), g1 = __uint_as_float(gv.x & 0xffff0000u);
        const float g2 = __uint_as_float(gv.y << 16), g3 = __uint_as_float(gv.y & 0xffff0000u);
        uint2 o;
        o.x = pack2(O[dm][nn][0] * inv * g0 * sigmoidf_(g0), O[dm][nn][1] * inv * g1 * sigmoidf_(g1));
        o.y = pack2(O[dm][nn][2] * inv * g2 * sigmoidf_(g2), O[dm][nn][3] * inv * g3 * sigmoidf_(g3));
        *(uint2*)(AO + tok * DM + h * 64 + d) = o;
      }
    }
  }
}

__device__ __forceinline__ void attn_sample_item(const Params& P, unsigned char* smem, int item) {
  const int b = item >> 2, hk = item & 3;
  const int t = threadIdx.x, lane = t & 63, w = t >> 6;
  float* qs = (float*)smem + w * 512;
  float* ps = (float*)smem + 2048 + w * (8 * 136);
  const bf16_t* K1 = P.XB; const bf16_t* V1 = P.XB + (size_t)NTOK * 256;
  const bf16_t* Q1 = P.Kb; const bf16_t* G1 = P.Vb; bf16_t* AO = P.Gb;
  const int h = hk * 4 + w;
  const float slope = exp2f(-0.5f * (float)(h + 1));
  const float sink = P.att_sinks[h];
  const int tok0 = NPR + b * 8;
  __syncthreads();
  for (int idx = t; idx < 120 * 16; idx += 256) {
    const int row = idx >> 4, c4 = idx & 15;
    const size_t so = ((size_t)(b * 128 + row + 8)) * 256 + hk * 64 + c4 * 4;
    const size_t dofs = ((size_t)(b * 128 + row)) * 256 + hk * 64 + c4 * 4;
    *(float4*)(P.out + OUT_WK_S + dofs) = *(const float4*)(P.cache_k + so);
    *(float4*)(P.out + OUT_WV_S + dofs) = *(const float4*)(P.cache_v + so);
  }
#pragma unroll
  for (int i = 0; i < 8; i++) qs[i * 64 + lane] = bf2f(Q1[(size_t)(tok0 + i) * DM + h * 64 + lane]);
  __builtin_amdgcn_wave_barrier();
  asm volatile("s_waitcnt lgkmcnt(0)" ::: "memory");
  float sc[3][8];
#pragma unroll
  for (int ksel = 0; ksel < 3; ksel++) {
    float acc[8];
#pragma unroll
    for (int i = 0; i < 8; i++) acc[i] = 0.f;
    const float* kp = P.cache_k + ((size_t)(b * 128 + lane + 64 * (ksel & 1))) * 256 + hk * 64;
    const bf16_t* kpb = K1 + (size_t)(tok0 + (lane & 7)) * 256 + hk * 64;
#pragma unroll 2
    for (int d4 = 0; d4 < 16; d4++) {
      float4 kv;
      if (ksel < 2) kv = ((const float4*)kp)[d4];
      else { const uint2 u = ((const uint2*)kpb)[d4]; kv = make_float4(__uint_as_float(u.x << 16), __uint_as_float(u.x & 0xffff0000u), __uint_as_float(u.y << 16), __uint_as_float(u.y & 0xffff0000u)); }
#pragma unroll
      for (int i = 0; i < 8; i++) {
        const float4 qv = *(const float4*)(qs + i * 64 + 4 * d4);
        acc[i] = fmaf(qv.x, kv.x, acc[i]); acc[i] = fmaf(qv.y, kv.y, acc[i]); acc[i] = fmaf(qv.z, kv.z, acc[i]); acc[i] = fmaf(qv.w, kv.w, acc[i]);
      }
    }
#pragma unroll
    for (int i = 0; i < 8; i++) {
      int dist; bool live;
      if (ksel < 2) { const int j = lane + 64 * ksel; dist = 128 + i - j; live = (j > i); }
      else { dist = i - lane; live = (lane <= i); }
      sc[ksel][i] = live ? (acc[i] * 0.125f - slope * (float)dist) : -1e30f;
    }
  }
#pragma unroll
  for (int i = 0; i < 8; i++) {
    float mx = fmaxf(fmaxf(sc[0][i], sc[1][i]), sc[2][i]);
    mx = fmaxf(wave_max(mx), sink);
    const float p0 = __expf(sc[0][i] - mx), p1 = __expf(sc[1][i] - mx), p2 = __expf(sc[2][i] - mx);
    const float den = wave_sum(p0 + p1 + p2) + __expf(sink - mx);
    const float inv = 1.f / den;
    ps[i * 136 + lane] = p0 * inv; ps[i * 136 + 64 + lane] = p1 * inv;
    if (lane < 8) ps[i * 136 + 128 + lane] = p2 * inv;
  }
  __builtin_amdgcn_wave_barrier();
  asm volatile("s_waitcnt lgkmcnt(0)" ::: "memory");
  float o[8];
#pragma unroll
  for (int i = 0; i < 8; i++) o[i] = 0.f;
  for (int j = 0; j < 136; j++) {
    float v;
    if (j < 128) v = P.cache_v[((size_t)(b * 128 + j)) * 256 + hk * 64 + lane];
    else v = bf2f(V1[(size_t)(tok0 + j - 128) * 256 + hk * 64 + lane]);
#pragma unroll
    for (int i = 0; i < 8; i++) o[i] = fmaf(ps[i * 136 + j], v, o[i]);
  }
#pragma unroll
  for (int i = 0; i < 8; i++) {
    const size_t off = (size_t)(tok0 + i) * DM + h * 64 + lane;
    const float gt = bf2f(G1[off]);
    AO[off] = f2bf(o[i] * gt * sigmoidf_(gt));
  }
}
__device__ __forceinline__ void phase_attn(const Params& P, unsigned char* smem, int bid, int nb) {
  for (int item = bid; item < 1024 + 512; item += nb) {
    if (item < 1024) attn_prompt_item(P, smem, item);
    else attn_sample_item(P, smem, item - 1024);
  }
}

#if MULTI_LAUNCH
#define PH_BARRIER(ph)
#else
#define PH_BARRIER(ph) do { if ((ph) + 1 < P.phase_end) xcd_barrier(xb); } while (0)
#endif
#define RUN_PH(ph, call) do { if (P.phase_begin <= (ph) && (ph) < P.phase_end) { if ((REPMASK >> (ph)) & 1) { call; PH_BARRIER(ph); } call; PH_BARRIER(ph); } } while (0)

__global__ void __launch_bounds__(256, 2) fwd_kernel(Params P) {
  __shared__ __attribute__((aligned(16))) unsigned char smem[SMEM_BYTES];
  const int bid = blockIdx.x, nb = gridDim.x;
#if !MULTI_LAUNCH
  __shared__ uint4 xb_words;
  if (threadIdx.x == 0) xb_words = make_uint4(0u, 0u, 0u, 0u);
  __syncthreads();
  XcdBarrier xb = xcd_barrier_post(P.bar, (volatile LAS unsigned*)&xb_words);
#endif
#if (PHMASK >> 0) & 1
  RUN_PH(0, phase_prep(P, smem, bid, nb));
#endif
#if (PHMASK >> 1) & 1
  RUN_PH(1, gemm_phase<1>(P, smem, bid, nb));
#endif
#if (PHMASK >> 2) & 1
  RUN_PH(2, gemm_phase<2>(P, smem, bid, nb));
#endif
#if (PHMASK >> 3) & 1
  RUN_PH(3, phase_scan1(P, smem, bid, nb));
#endif
#if (PHMASK >> 4) & 1
  RUN_PH(4, phase_scan2(P, smem, bid, nb));
#endif
#if (PHMASK >> 5) & 1
  RUN_PH(5, phase_scan3(P, smem, bid, nb));
#endif
#if (PHMASK >> 6) & 1
  RUN_PH(6, gemm_phase<3>(P, smem, bid, nb));
#endif
#if (PHMASK >> 7) & 1
  RUN_PH(7, phase_ln(P, 0, bid, nb));
#endif
#if (PHMASK >> 8) & 1
  RUN_PH(8, gemm_phase<4>(P, smem, bid, nb));
#endif
#if (PHMASK >> 9) & 1
  RUN_PH(9, phase_attn(P, smem, bid, nb));
#endif
#if (PHMASK >> 10) & 1
  RUN_PH(10, gemm_phase<5>(P, smem, bid, nb));
#endif
#if (PHMASK >> 11) & 1
  RUN_PH(11, phase_ln(P, 1, bid, nb));
#endif
#if !MULTI_LAUNCH
  if (P.phase_end > NPHASE) cg::this_grid().sync();
#endif
}

extern "C" void kernel_launch(void* const* d_in, const int* in_sizes, int n_in, void* d_out, int out_size, void* d_ws, size_t ws_size, hipStream_t stream) {
  Params P{};
  P.x_prompt = (const float*)d_in[0]; P.x_sample = (const float*)d_in[1]; P.state_wkv = (const float*)d_in[2]; P.state_shift = (const float*)d_in[3];
  P.cache_k = (const float*)d_in[4]; P.cache_v = (const float*)d_in[5]; P.ln_g = (const float*)d_in[6]; P.ln_b = (const float*)d_in[7];
  P.mu = (const float*)d_in[8]; P.w_in = (const float*)d_in[9]; P.w0 = (const float*)d_in[10]; P.w1 = (const float*)d_in[11]; P.w2 = (const float*)d_in[12];
  P.a0 = (const float*)d_in[13]; P.a1 = (const float*)d_in[14]; P.a2 = (const float*)d_in[15]; P.k_k = (const float*)d_in[16]; P.k_a = (const float*)d_in[17];
  P.r_k = (const float*)d_in[18]; P.gn_g = (const float*)d_in[19]; P.gn_b = (const float*)d_in[20]; P.w_out = (const float*)d_in[21];
  P.att_w_in = (const float*)d_in[22]; P.att_sinks = (const float*)d_in[23]; P.att_w_out = (const float*)d_in[24];
  P.out = (float*)d_out;
  unsigned char* ws = (unsigned char*)d_ws;
  size_t off = 0;
  auto take = [&](size_t bytes) { unsigned char* p = ws + off; off += (bytes + 255) & ~(size_t)255; return p; };
  P.bar = (unsigned*)take(16384);
  P.WtIn0 = (bf16_t*)take((size_t)4352 * DM * 2);
  P.W2t = (bf16_t*)take((size_t)DM * 64 * 2);
  P.A2t = (bf16_t*)take((size_t)DM * 64 * 2);
  P.WtOut0 = (bf16_t*)take((size_t)DM * DM * 2);
  P.WtIn1 = (bf16_t*)take((size_t)2560 * DM * 2);
  P.WtOut1 = (bf16_t*)take((size_t)DM * DM * 2);
  P.XB = (bf16_t*)take((size_t)NTOK * DM * 2);
  P.XXB = (bf16_t*)take((size_t)NTOK * DM * 2);
  P.Rb = (bf16_t*)take((size_t)NTOK * DM * 2);
  P.Kb = (bf16_t*)take((size_t)NTOK * DM * 2);
  P.Vb = (bf16_t*)take((size_t)NTOK * DM * 2);
  P.Gb = (bf16_t*)take((size_t)NTOK * DM * 2);
  P.H1 = (bf16_t*)take((size_t)NTOK * 64 * 2);
  P.H2 = (bf16_t*)take((size_t)NTOK * 64 * 2);
  if (off > ws_size) { fprintf(stderr, "workspace too small: need %zu have %zu\n", off, ws_size); return; }
#if MULTI_LAUNCH
  for (int ph = 0; ph < NPHASE; ph++) {
    P.phase_begin = ph; P.phase_end = ph + 1;
    hipLaunchKernelGGL(fwd_kernel, dim3(512), dim3(256), 0, stream, P);
  }
#else
  static int grid_blocks = 0;
  if (!grid_blocks) {
    int dev = 0, cus = 0, per_cu = 0;
    hipGetDevice(&dev);
    hipDeviceGetAttribute(&cus, hipDeviceAttributeMultiprocessorCount, dev);
    hipOccupancyMaxActiveBlocksPerMultiprocessor(&per_cu, fwd_kernel, 256, 0);
    if (per_cu > 2) per_cu = 2;
    if (per_cu < 1) per_cu = 1;
    grid_blocks = cus * per_cu;
  }
  hipMemsetAsync(P.bar, 0, 16384, stream);
  P.phase_begin = 0; P.phase_end = NPHASE;
  void* args[] = {&P};
  hipError_t e = hipLaunchCooperativeKernel((void*)fwd_kernel, dim3(grid_blocks), dim3(256), args, 0, stream);
  if (e != hipSuccess) fprintf(stderr, "cooperative launch failed: %s (grid %d)\n", hipGetErrorString(e), grid_blocks);
#endif
}
```

```cpp
#include <hip/hip_runtime.h>
#include <hip/hip_cooperative_groups.h>
#include <stdint.h>
#include <cstdio>
namespace cg = cooperative_groups;

#ifndef PHMASK
#define PHMASK 0xFFF
#endif
#ifndef REPMASK
#define REPMASK 0
#endif
#ifndef MULTI_LAUNCH
#define MULTI_LAUNCH 0
#endif

typedef unsigned short bf16_t;
typedef _Float16 f16_t;
typedef __attribute__((ext_vector_type(8))) short bf16x8;
typedef __attribute__((ext_vector_type(4))) float f32x4;
typedef __attribute__((ext_vector_type(4))) unsigned u32x4;

#define DM 1024
#define NTOK 17408
#define NPR 16384
#define TP 8192
#define NC 32
#define CL 256
#define NBH 32
#define ALPHA_F 1.41421356237f
#define SMEM_BYTES (56 * 1024)
#define NPHASE 12

#define OUT_Y 0
#define OUT_WKV_P 17825792
#define OUT_SH_P 17956864
#define OUT_WK_P 17958912
#define OUT_WV_P 18024448
#define OUT_WKV_S 18089984
#define OUT_SH_S 26478592
#define OUT_WK_S 26609664
#define OUT_WV_S 30803968

struct Params {
  const float *x_prompt, *x_sample, *state_wkv, *state_shift, *cache_k, *cache_v, *ln_g, *ln_b;
  const float *mu, *w_in, *w0, *w1, *w2, *a0, *a1, *a2, *k_k, *k_a, *r_k, *gn_g, *gn_b, *w_out;
  const float *att_w_in, *att_sinks, *att_w_out;
  float* out;
  unsigned* bar;
  bf16_t *WtIn0, *W2t, *A2t, *WtOut0, *WtIn1, *WtOut1;
  bf16_t *XB, *XXB;
  bf16_t *Rb, *Kb, *Vb, *Gb;
  bf16_t *H1, *H2;
  int phase_begin, phase_end;
};

typedef __bf16 hbf2 __attribute__((ext_vector_type(2)));
typedef float f32x2_ __attribute__((ext_vector_type(2)));
__device__ __forceinline__ unsigned pack2(float a, float b) {
  const f32x2_ v = {a, b};
  return __builtin_bit_cast(unsigned, __builtin_convertvector(v, hbf2));
}
__device__ __forceinline__ bf16_t f2bf(float f) { return (bf16_t)(pack2(f, 0.f) & 0xffffu); }
__device__ __forceinline__ float bf2f(bf16_t h) { return __uint_as_float(((unsigned)h) << 16); }
__device__ __forceinline__ float wave_sum(float x) {
#pragma unroll
  for (int o = 32; o >= 1; o >>= 1) x += __shfl_xor(x, o);
  return x;
}
__device__ __forceinline__ float wave_max(float x) {
#pragma unroll
  for (int o = 32; o >= 1; o >>= 1) x = fmaxf(x, __shfl_xor(x, o));
  return x;
}
__device__ __forceinline__ float quad_sum(float x) {
  x += __builtin_bit_cast(float, __builtin_amdgcn_update_dpp(0, __builtin_bit_cast(int, x), 0xB1, 0xF, 0xF, true));
  x += __builtin_bit_cast(float, __builtin_amdgcn_update_dpp(0, __builtin_bit_cast(int, x), 0x4E, 0xF, 0xF, true));
  return x;
}
__device__ __forceinline__ float sigmoidf_(float x) { return 1.f / (1.f + __expf(-x)); }
__device__ __forceinline__ const float* xin_row(const Params& P, int m) {
  return (m < NPR) ? (P.x_prompt + (size_t)m * DM) : (P.x_sample + (size_t)(m - NPR) * DM);
}

#define XB_TMO      128
#define XB_XCNT(j)  (256  + 64 * (j))
#define XB_XSUB(j)  (1280 + 64 * (j))
#define XB_XGEN(j)  (2304 + 64 * (j))
#define XB_TOP      3328
#define XB_TOPGEN   3392
#define XCD_BAR_WORDS 3456
#define XB_SPIN_CAP (1u << 22)
#define LAS __attribute__((address_space(3)))
__device__ __forceinline__ unsigned xb_ld(unsigned* p) { return __hip_atomic_load(p, __ATOMIC_RELAXED, __HIP_MEMORY_SCOPE_AGENT); }
__device__ __forceinline__ unsigned xb_add(unsigned* p, unsigned v) { return __hip_atomic_fetch_add(p, v, __ATOMIC_RELAXED, __HIP_MEMORY_SCOPE_AGENT); }
__device__ __forceinline__ unsigned xb_xcc_id() { return (unsigned)__builtin_amdgcn_s_getreg((3 << 11) | 20) & 0xFu; }
#define XB_SPIN(cond, bar) do { unsigned _sp = 0; while (cond) { __builtin_amdgcn_s_sleep(1); \
    if ((++_sp & 255u) == 0u) { if (xb_ld(&(bar)[XB_TMO])) break; if (_sp > XB_SPIN_CAP) { atomicAdd(&(bar)[XB_TMO], 1u); break; } } } } while (0)
struct XcdBarrier { unsigned* bar; unsigned x; volatile LAS unsigned* st; };
__device__ __forceinline__ XcdBarrier xcd_barrier_post(unsigned* bar, volatile LAS unsigned* st) {
  XcdBarrier b; b.bar = bar; b.x = xb_xcc_id(); b.st = st;
  if (threadIdx.x == 0) (void)xb_add(&bar[XB_XCNT(b.x)], 1u);
  return b;
}
__device__ __forceinline__ void xcd_barrier_complete(unsigned* bar, unsigned x, unsigned& nloc, unsigned& nx) {
  const unsigned G = gridDim.x * gridDim.y * gridDim.z;
  unsigned sum, cnt, mine, sp = 0u;
  for (;;) {
    sum = 0u; cnt = 0u; mine = 0u;
#pragma unroll
    for (unsigned j = 0; j < 16; ++j) { const unsigned c = xb_ld(&bar[XB_XCNT(j)]); sum += c; cnt += (c > 0u) ? 1u : 0u; mine = (j == x) ? c : mine; }
    if (sum == G) break;
    __builtin_amdgcn_s_sleep(1);
    if ((++sp & 255u) == 0u) { if (xb_ld(&bar[XB_TMO])) break; if (sp > XB_SPIN_CAP) { atomicAdd(&bar[XB_TMO], 1u); break; } }
  }
  nloc = mine > 0u ? mine : 1u; nx = cnt > 0u ? cnt : 1u;
}
__device__ __forceinline__ void xcd_barrier(const XcdBarrier& b) {
  asm volatile("s_waitcnt vmcnt(0)" ::: "memory");
  __syncthreads();
  if (threadIdx.x == 0) {
    unsigned* bar = b.bar;
    __builtin_amdgcn_s_waitcnt(0);
    unsigned nloc = b.st[0], nx = b.st[1];
    if (nloc == 0u) { xcd_barrier_complete(bar, b.x, nloc, nx); b.st[0] = nloc; b.st[1] = nx; }
    const unsigned old = xb_add(&bar[XB_XSUB(b.x)], 1u);
    const unsigned gen = old / nloc;
    if (old + 1u == (gen + 1u) * nloc) {
      __builtin_amdgcn_fence(__ATOMIC_RELEASE, "agent");
      asm volatile("s_waitcnt vmcnt(0)" ::: "memory");
      const unsigned og = xb_add(&bar[XB_TOP], 1u);
      const unsigned tg = og / nx;
      if (og + 1u == (tg + 1u) * nx) xb_add(&bar[XB_TOPGEN], 1u);
      else XB_SPIN(xb_ld(&bar[XB_TOPGEN]) == tg, bar);
      __builtin_amdgcn_fence(__ATOMIC_ACQUIRE, "agent");
      xb_add(&bar[XB_XGEN(b.x)], 1u);
      asm volatile("s_waitcnt vmcnt(0)" ::: "memory");
    } else {
      XB_SPIN(xb_ld(&bar[XB_XGEN(b.x)]) == gen, bar);
      __builtin_amdgcn_fence(__ATOMIC_ACQUIRE, "agent");
      asm volatile("s_waitcnt vmcnt(0)" ::: "memory");
    }
  }
  __syncthreads();
}

__device__ __forceinline__ void transpose_tile(const float* __restrict__ src, int ld, int k0, int n0, bf16_t* __restrict__ dst, int ldd, float* tile) {
  const int t = threadIdx.x;
  {
    const int n = t & 63, kq = t >> 6;
#pragma unroll 4
    for (int i = 0; i < 16; i++) { const int k = i * 4 + kq; tile[k * 65 + n] = src[(size_t)(k0 + k) * ld + n0 + n]; }
  }
  __syncthreads();
  {
    const int k = t & 63, nq = t >> 6;
#pragma unroll 4
    for (int i = 0; i < 16; i++) { const int n2 = i * 4 + nq; dst[(size_t)(n0 + n2) * ldd + k0 + k] = f2bf(tile[k * 65 + n2]); }
  }
  __syncthreads();
}

__device__ __forceinline__ void phase_prep(const Params& P, unsigned char* smem, int bid, int nb) {
  float* tile = (float*)smem;
  const int t = threadIdx.x;
  const int NITEMS = 2242 + 4352 + 130;
  for (int id = bid; id < NITEMS; id += nb) {
    if (id < 1024) { const int p = id >> 8, r = id & 255; transpose_tile(P.w_in + (size_t)p * DM * DM, DM, (r >> 4) * 64, (r & 15) * 64, P.WtIn0 + (size_t)p * DM * DM, DM, tile); }
    else if (id < 1040) transpose_tile(P.w1, 64, (id - 1024) * 64, 0, P.WtIn0 + (size_t)4096 * DM, DM, tile);
    else if (id < 1056) transpose_tile(P.a1, 64, (id - 1040) * 64, 0, P.WtIn0 + (size_t)4224 * DM, DM, tile);
    else if (id < 1072) transpose_tile(P.w2, DM, 0, (id - 1056) * 64, P.W2t, 64, tile);
    else if (id < 1088) transpose_tile(P.a2, DM, 0, (id - 1072) * 64, P.A2t, 64, tile);
    else if (id < 1344) { const int r = id - 1088; transpose_tile(P.w_out, DM, (r >> 4) * 64, (r & 15) * 64, P.WtOut0, DM, tile); }
    else if (id < 1984) { const int r = id - 1344; transpose_tile(P.att_w_in, 2560, (r / 40) * 64, (r % 40) * 64, P.WtIn1, DM, tile); }
    else if (id < 2240) { const int r = id - 1984; transpose_tile(P.att_w_out, DM, (r >> 4) * 64, (r & 15) * 64, P.WtOut1, DM, tile); }
    else if (id < 2242) {
      uint4* z = (uint4*)(P.WtIn0 + (size_t)(id == 2240 ? 4160 : 4288) * DM);
      for (int i = t; i < 8192; i += 256) z[i] = make_uint4(0, 0, 0, 0);
    } else if (id < 2242 + 4352) {
      const int it = id - 2242;
#pragma unroll
      for (int q = 0; q < 4; q++) {
        const int m = it * 4 + q;
        const float4 x = ((const float4*)xin_row(P, m))[t];
        float4 pv = make_float4(0.f, 0.f, 0.f, 0.f);
        if (m < NPR) { if ((m & (TP - 1)) != 0) pv = ((const float4*)xin_row(P, m - 1))[t]; }
        else { const int ms = m - NPR; if ((ms & 7) != 0) pv = ((const float4*)xin_row(P, m - 1))[t]; else pv = ((const float4*)(P.state_shift + (size_t)(ms >> 3) * DM))[t]; }
        uint2 xb, xxb;
        xb.x = pack2(x.x, x.y); xb.y = pack2(x.z, x.w);
        xxb.x = pack2(pv.x - x.x, pv.y - x.y); xxb.y = pack2(pv.z - x.z, pv.w - x.w);
        ((uint2*)(P.XB + (size_t)m * DM))[t] = xb;
        ((uint2*)(P.XXB + (size_t)m * DM))[t] = xxb;
      }
    } else {
      const int r = id - (2242 + 4352);
      if (r < 2) ((float4*)(P.out + OUT_SH_P + (size_t)r * DM))[t] = ((const float4*)(P.x_prompt + ((size_t)r * TP + TP - 1) * DM))[t];
      else { const int b = r - 2; ((float4*)(P.out + OUT_SH_S + (size_t)b * DM))[t] = ((const float4*)(P.x_sample + ((size_t)b * 8 + 7) * DM))[t]; }
    }
  }
}

#define LDS_LD 72
template <int MODE>
__device__ __forceinline__ void gemm_tile(const Params& P, unsigned char* smem, int mt, int nt) {
  constexpr int KT = (MODE == 2) ? 1 : 16;
  bf16_t* As = (bf16_t*)smem;
  bf16_t* Bs = As + 128 * LDS_LD;
  const int t = threadIdx.x, lane = t & 63, w = t >> 6;
  const int wm = w >> 1, wn = w & 1;
  const int g = lane >> 4, lc = lane & 15;
  const int lrow = t >> 3, lch = t & 7;
  const int m0 = mt * 128, n0 = nt * 128;

  const bf16_t* Ap; const bf16_t* A2p = nullptr; const float* mup = nullptr; const bf16_t* Bp; int lda, ldb;
  if (MODE == 1) {
    const int p = (nt < 32) ? (nt >> 3) : (4 + (nt - 32));
    Ap = P.XB; A2p = P.XXB; lda = DM; mup = P.mu + (size_t)p * DM;
    Bp = P.WtIn0 + (size_t)((nt < 32) ? n0 : (4096 + (nt - 32) * 128)) * DM; ldb = DM;
  } else if (MODE == 2) {
    Ap = (nt < 8) ? P.H1 : P.H2; lda = 64;
    Bp = ((nt < 8) ? P.W2t : P.A2t) + (size_t)((nt & 7) * 128) * 64; ldb = 64;
  } else if (MODE == 3) { Ap = P.Gb; lda = DM; Bp = P.WtOut0 + (size_t)n0 * DM; ldb = DM; }
  else if (MODE == 4) { Ap = P.Rb; lda = DM; Bp = P.WtIn1 + (size_t)n0 * DM; ldb = DM; }
  else { Ap = P.Gb; lda = DM; Bp = P.WtOut1 + (size_t)n0 * DM; ldb = DM; }

  f32x4 acc[4][4];
#pragma unroll
  for (int i = 0; i < 4; i++)
#pragma unroll
    for (int j = 0; j < 4; j++) acc[i][j] = (f32x4){0.f, 0.f, 0.f, 0.f};

  u32x4 ra[2][4], rb[2][4], ra2[2][4];
  float4 mu0[2], mu1[2];
  mu0[0] = mu0[1] = mu1[0] = mu1[1] = make_float4(0, 0, 0, 0);
  const unsigned voffA = (unsigned)(lrow * lda + lch * 8) * 2u;
  const unsigned voffB = (unsigned)(lrow * ldb + lch * 8) * 2u;
  const char* baseA = (const char*)(Ap + (size_t)m0 * lda);
  const char* baseA2 = (const char*)(A2p + (size_t)m0 * lda);
  const char* baseB = (const char*)Bp;
#define LOAD_TILE(S_, kt_) do { \
    _Pragma("unroll") for (int i_ = 0; i_ < 4; i_++) { \
      const size_t uo_ = ((size_t)(32 * i_) * lda + (size_t)(kt_) * 64) * 2; \
      const size_t uob_ = ((size_t)(32 * i_) * ldb + (size_t)(kt_) * 64) * 2; \
      ra[S_][i_] = *(const u32x4*)(baseA + uo_ + voffA); \
      if (MODE == 1) ra2[S_][i_] = *(const u32x4*)(baseA2 + uo_ + voffA); \
      rb[S_][i_] = *(const u32x4*)(baseB + uob_ + voffB); \
    } \
    if (MODE == 1) { const int k0_ = (kt_) * 64 + lch * 8; mu0[S_] = *(const float4*)(mup + k0_); mu1[S_] = *(const float4*)(mup + k0_ + 4); } \
  } while (0)
#define XS2(xw, dw, ma, mb) pack2(fmaf(__uint_as_float((dw) << 16), (ma), __uint_as_float((xw) << 16)), fmaf(__uint_as_float((dw) & 0xffff0000u), (mb), __uint_as_float((xw) & 0xffff0000u)))
#define STORE_TILE(S_) do { \
    _Pragma("unroll") for (int i_ = 0; i_ < 4; i_++) { \
      const int row_ = lrow + 32 * i_; \
      u32x4 av_ = ra[S_][i_]; \
      if (MODE == 1) { \
        const u32x4 xv_ = ra[S_][i_], dv_ = ra2[S_][i_]; \
        av_ = (u32x4){XS2(xv_.x, dv_.x, mu0[S_].x, mu0[S_].y), XS2(xv_.y, dv_.y, mu0[S_].z, mu0[S_].w), XS2(xv_.z, dv_.z, mu1[S_].x, mu1[S_].y), XS2(xv_.w, dv_.w, mu1[S_].z, mu1[S_].w)}; \
      } \
      *(u32x4*)(As + row_ * LDS_LD + lch * 8) = av_; \
      *(u32x4*)(Bs + row_ * LDS_LD + lch * 8) = rb[S_][i_]; \
    } \
  } while (0)
#define COMPUTE_TILE() do { \
    _Pragma("unroll") for (int ks = 0; ks < 2; ks++) { \
      bf16x8 af[4], bfr[4]; \
      _Pragma("unroll") for (int i = 0; i < 4; i++) af[i] = *(const bf16x8*)(Bs + (wn * 64 + i * 16 + lc) * LDS_LD + ks * 32 + g * 8); \
      _Pragma("unroll") for (int j = 0; j < 4; j++) bfr[j] = *(const bf16x8*)(As + (wm * 64 + j * 16 + lc) * LDS_LD + ks * 32 + g * 8); \
      _Pragma("unroll") for (int i = 0; i < 4; i++) \
        _Pragma("unroll") for (int j = 0; j < 4; j++) acc[i][j] = __builtin_amdgcn_mfma_f32_16x16x32_bf16(af[i], bfr[j], acc[i][j], 0, 0, 0); \
    } \
  } while (0)
  LOAD_TILE(0, 0);
  if (KT > 1) LOAD_TILE(1, 1);
  for (int kt = 0; kt < KT; kt += 2) {
    __syncthreads();
    STORE_TILE(0);
    __syncthreads();
    if (kt + 2 < KT) LOAD_TILE(0, kt + 2);
    COMPUTE_TILE();
    if (KT > 1) {
      __syncthreads();
      STORE_TILE(1);
      __syncthreads();
      if (kt + 3 < KT) LOAD_TILE(1, kt + 3);
      COMPUTE_TILE();
    }
  }
#pragma unroll
  for (int i = 0; i < 4; i++) {
    const int nl = wn * 64 + i * 16 + 4 * g;
#pragma unroll
    for (int j = 0; j < 4; j++) {
      const int m = m0 + wm * 64 + j * 16 + lc;
      const f32x4 v = acc[i][j];
      if (MODE == 1) {
        if (nt < 32) {
          const int p = nt >> 3, c = (nt & 7) * 128 + nl;
          bf16_t* dst = (p == 0) ? P.Rb : (p == 1) ? P.Kb : (p == 2) ? P.Vb : P.Gb;
          uint2 o; o.x = pack2(v[0], v[1]); o.y = pack2(v[2], v[3]);
          *(uint2*)(dst + (size_t)m * DM + c) = o;
        } else if (nl < 64) {
          uint2 o;
          if (nt == 32) { o.x = pack2(tanhf(v[0]), tanhf(v[1])); o.y = pack2(tanhf(v[2]), tanhf(v[3])); *(uint2*)(P.H1 + (size_t)m * 64 + nl) = o; }
          else { o.x = pack2(v[0], v[1]); o.y = pack2(v[2], v[3]); *(uint2*)(P.H2 + (size_t)m * 64 + nl) = o; }
        }
      } else if (MODE == 2) {
        const int c = (nt & 7) * 128 + nl;
        f16_t o[4];
        if (nt < 8) {
          const float4 w0v = *(const float4*)(P.w0 + c);
          const float ws[4] = {w0v.x, w0v.y, w0v.z, w0v.w};
#pragma unroll
          for (int r = 0; r < 4; r++) o[r] = (f16_t)(sigmoidf_(ws[r] + v[r]) * 0.60653065971f);
          *(uint2*)((f16_t*)P.XB + (size_t)m * DM + c) = *(uint2*)o;
        } else {
          const float4 a0v = *(const float4*)(P.a0 + c);
          const float as_[4] = {a0v.x, a0v.y, a0v.z, a0v.w};
#pragma unroll
          for (int r = 0; r < 4; r++) o[r] = (f16_t)sigmoidf_(as_[r] + v[r]);
          *(uint2*)((f16_t*)P.XXB + (size_t)m * DM + c) = *(uint2*)o;
        }
      } else if (MODE == 3 || MODE == 5) {
        const int c = n0 + nl;
        float4 res;
        if (MODE == 3) res = *(const float4*)(xin_row(P, m) + c);
        else res = *(const float4*)(P.out + OUT_Y + (size_t)m * DM + c);
        float4 o = make_float4(v[0] + ALPHA_F * res.x, v[1] + ALPHA_F * res.y, v[2] + ALPHA_F * res.z, v[3] + ALPHA_F * res.w);
        *(float4*)(P.out + OUT_Y + (size_t)m * DM + c) = o;
      } else if (MODE == 4) {
        uint2 o; o.x = pack2(v[0], v[1]); o.y = pack2(v[2], v[3]);
        if (nt < 8) { *(uint2*)(P.Kb + (size_t)m * DM + n0 + nl) = o; }
        else if (nt >= 12) { *(uint2*)(P.Vb + (size_t)m * DM + (nt - 12) * 128 + nl) = o; }
        else {
          const bool isk = nt < 10;
          const int ck = (nt & 1) * 128 + nl;
          bf16_t* K1 = P.XB; bf16_t* V1 = P.XB + (size_t)NTOK * 256; bf16_t* VT1 = P.XB + (size_t)NTOK * 512;
          *(uint2*)((isk ? K1 : V1) + (size_t)m * 256 + ck) = o;
          const float4 fo = make_float4(v[0], v[1], v[2], v[3]);
          if (m < NPR) {
            const int b = m >> 13, tt = m & (TP - 1);
            if (!isk) {
              const int hk = ck >> 6, d = ck & 63;
              bf16_t* vt = VT1 + ((size_t)((b * 4 + hk) * 64 + d)) * TP + tt;
              vt[0] = f2bf(v[0]); vt[TP] = f2bf(v[1]); vt[2 * TP] = f2bf(v[2]); vt[3 * TP] = f2bf(v[3]);
            }
            if (tt >= TP - 128) *(float4*)(P.out + (isk ? OUT_WK_P : OUT_WV_P) + ((size_t)(b * 128 + tt - (TP - 128))) * 256 + ck) = fo;
          } else {
            const int ms = m - NPR, b = ms >> 3, tt = ms & 7;
            *(float4*)(P.out + (isk ? OUT_WK_S : OUT_WV_S) + ((size_t)(b * 128 + 120 + tt)) * 256 + ck) = fo;
          }
        }
      }
    }
  }
}
template <int MODE>
__device__ __forceinline__ void gemm_phase(const Params& P, unsigned char* smem, int bid, int nb) {
  constexpr int NT = (MODE == 1) ? 34 : (MODE == 2) ? 16 : (MODE == 4) ? 20 : 8;
  const int ntiles = 136 * NT;
  for (int tile = bid; tile < ntiles; tile += nb) gemm_tile<MODE>(P, smem, tile % 136, tile / 136);
}

#define TS 8
#define REC 392
typedef float f32x2 __attribute__((ext_vector_type(2)));
__device__ __forceinline__ f32x2 pkfma(f32x2 a, f32x2 b, f32x2 c) { return __builtin_elementwise_fma(a, b, c); }
#define DPP_ADD(x, ctrl) ((x) + __builtin_bit_cast(float, __builtin_amdgcn_update_dpp(0, __builtin_bit_cast(int, (x)), (ctrl), 0xF, 0xF, true)))
__device__ __forceinline__ float wave_sum_fast(float x) {
  x = DPP_ADD(x, 0xB1); x = DPP_ADD(x, 0x4E); x = DPP_ADD(x, 0x141); x = DPP_ADD(x, 0x140);
  const int xi = __builtin_bit_cast(int, x);
  const float t0 = __builtin_bit_cast(float, __builtin_amdgcn_readlane(xi, 0)), t1 = __builtin_bit_cast(float, __builtin_amdgcn_readlane(xi, 16));
  const float t2 = __builtin_bit_cast(float, __builtin_amdgcn_readlane(xi, 32)), t3 = __builtin_bit_cast(float, __builtin_amdgcn_readlane(xi, 48));
  return (t0 + t1) + (t2 + t3);
}
#define LD8(dst, ptr) do { _Pragma("unroll") for (int j4_ = 0; j4_ < 4; j4_++) { const f32x4 v_ = *(const f32x4*)((ptr) + 4 * j4_); \
    dst[2 * j4_] = (f32x2){v_[0], v_[1]}; dst[2 * j4_ + 1] = (f32x2){v_[2], v_[3]}; } } while (0)

template <int INIT  , bool USEV, bool WRITEY>
__device__ __forceinline__ void scan_unit(const Params& P, float* ws, int lane, int tok0, int nsteps, int h, const float* init_ptr, float* fin) {
  const int rq = lane >> 2, q = lane & 3;
  f32x2 s[4][8];
#pragma unroll
  for (int i = 0; i < 4; i++)
#pragma unroll
    for (int j = 0; j < 8; j++) {
      if (INIT == 1) s[i][j] = (f32x2){((rq + 16 * i) == (16 * q + 2 * j)) ? 1.f : 0.f, ((rq + 16 * i) == (16 * q + 2 * j + 1)) ? 1.f : 0.f};
      else s[i][j] = (f32x2){0.f, 0.f};
    }
  if (INIT == 2) {
#pragma unroll
    for (int i = 0; i < 4; i++) LD8(s[i], init_ptr + (size_t)(rq + 16 * i) * 64 + 16 * q);
  }
  const int c = h * 64 + lane;
  const float kkc = P.k_k[c], kac = P.k_a[c], rkc = P.r_k[c];
  const int crow = h * 64 + rq + 16 * q;
  const float gng = P.gn_g[crow], gnb = P.gn_b[crow];
  const f16_t* EW = (const f16_t*)P.XB;
  const f16_t* AA = (const f16_t*)P.XXB;

  bf16_t rk[TS], rv[TS], rr[TS]; f16_t ra_[TS], re_[TS];
#define LOAD_RAW(tb) do { _Pragma("unroll") for (int tt_ = 0; tt_ < TS; tt_++) { const size_t off_ = (size_t)(tok0 + (tb) + tt_) * DM + c; \
    rk[tt_] = P.Kb[off_]; ra_[tt_] = AA[off_]; re_[tt_] = EW[off_]; if (USEV) rv[tt_] = P.Vb[off_]; if (WRITEY) rr[tt_] = P.Rb[off_]; } } while (0)
  LOAD_RAW(0);
  for (int t0 = 0; t0 < nsteps; t0 += TS) {
#pragma unroll
    for (int tt = 0; tt < TS; tt++) {
      const float kraw = bf2f(rk[tt]);
      const float a = (float)ra_[tt];
      const float wd = __expf(-(float)re_[tt]);
      float kkv = kraw * kkc;
      const float ss = wave_sum_fast(kkv * kkv);
      kkv = kkv / fmaxf(sqrtf(ss), 1e-12f);
      const float kf = kraw * (1.f + (a - 1.f) * kac);
      float* rec = ws + tt * REC;
      rec[lane] = kkv; rec[64 + lane] = wd; rec[128 + lane] = kf; rec[192 + lane] = kkv * a;
      if (WRITEY) {
        const float r = bf2f(rr[tt]);
        rec[256 + lane] = r;
        const float bonus = wave_sum_fast(r * kf * rkc);
        if (lane == 0) rec[384] = bonus;
      }
      if (USEV) rec[320 + lane] = bf2f(rv[tt]);
    }
    __builtin_amdgcn_wave_barrier();
    asm volatile("s_waitcnt lgkmcnt(0)" ::: "memory");
    if (t0 + TS < nsteps) LOAD_RAW(t0 + TS);
#pragma unroll 2
    for (int tt = 0; tt < TS; tt++) {
      const float* rec = ws + tt * REC;
      f32x2 o2[8];
      LD8(o2, rec + 16 * q);
      f32x2 nsa2[4];
      {
        f32x2 acc[4];
#pragma unroll
        for (int i = 0; i < 4; i++) acc[i] = s[i][0] * o2[0];
#pragma unroll
        for (int j = 1; j < 8; j++)
#pragma unroll
          for (int i = 0; i < 4; i++) acc[i] = pkfma(s[i][j], o2[j], acc[i]);
#pragma unroll
        for (int i = 0; i < 4; i++) { const float t = -quad_sum(acc[i][0] + acc[i][1]); nsa2[i] = (f32x2){t, t}; }
      }
      float vv[4];
      if (USEV) {
#pragma unroll
        for (int i = 0; i < 4; i++) vv[i] = rec[320 + rq + 16 * i];
      }
      f32x2 w2[8], b2[8];
      LD8(w2, rec + 64 + 16 * q);
      LD8(b2, rec + 192 + 16 * q);
      if (USEV) {
        LD8(o2, rec + 128 + 16 * q);
#pragma unroll
        for (int i = 0; i < 4; i++) {
          const f32x2 vv2 = (f32x2){vv[i], vv[i]};
#pragma unroll
          for (int j = 0; j < 8; j++) s[i][j] = pkfma(s[i][j], w2[j], pkfma(vv2, o2[j], nsa2[i] * b2[j]));
        }
      } else {
#pragma unroll
        for (int i = 0; i < 4; i++)
#pragma unroll
          for (int j = 0; j < 8; j++) s[i][j] = pkfma(s[i][j], w2[j], nsa2[i] * b2[j]);
      }
      if (WRITEY) {
        LD8(o2, rec + 256 + 16 * q);
        float y[4];
        {
          f32x2 acc[4];
#pragma unroll
          for (int i = 0; i < 4; i++) acc[i] = s[i][0] * o2[0];
#pragma unroll
          for (int j = 1; j < 8; j++)
#pragma unroll
            for (int i = 0; i < 4; i++) acc[i] = pkfma(s[i][j], o2[j], acc[i]);
#pragma unroll
          for (int i = 0; i < 4; i++) y[i] = quad_sum(acc[i][0] + acc[i][1]);
        }
        const float ysel = (q == 0) ? y[0] : (q == 1) ? y[1] : (q == 2) ? y[2] : y[3];
        const float vsel = (q == 0) ? vv[0] : (q == 1) ? vv[1] : (q == 2) ? vv[2] : vv[3];
        const float mean = wave_sum_fast(ysel) * (1.f / 64.f);
        const float ex2 = wave_sum_fast(ysel * ysel) * (1.f / 64.f);
        const float var = fmaxf(ex2 - mean * mean, 0.f);
        float yo = (ysel - mean) * rsqrtf(var + 64e-5f) * gng + gnb + rec[384] * vsel;
        const size_t off = (size_t)(tok0 + t0 + tt) * DM + crow;
        const float gt = bf2f(P.Gb[off]);
        yo *= gt * sigmoidf_(gt);
        P.Gb[off] = f2bf(yo);
      }
    }
    __builtin_amdgcn_wave_barrier();
    asm volatile("s_waitcnt lgkmcnt(0)" ::: "memory");
  }
  if (fin) {
#pragma unroll
    for (int i = 0; i < 4; i++)
#pragma unroll
      for (int j4 = 0; j4 < 4; j4++)
        *(f32x4*)(fin + (size_t)(rq + 16 * i) * 64 + 16 * q + 4 * j4) = (f32x4){s[i][2 * j4][0], s[i][2 * j4][1], s[i][2 * j4 + 1][0], s[i][2 * j4 + 1][1]};
  }
}

__device__ __forceinline__ void phase_scan1(const Params& P, unsigned char* smem, int bid, int nb) {
  const int lane = threadIdx.x & 63, w = threadIdx.x >> 6;
  float* ws = (float*)smem + w * (TS * REC);
  float* Ploc = P.out + OUT_WK_S;
  float* Sloc = P.out + OUT_WV_S;
  const int total = NBH * (NC - 1) * 2;
  for (int u = w * nb + bid; u < total; u += 4 * nb) {
    const int kind = u & 1, rest = u >> 1;
    const int c = rest % (NC - 1), bh = rest / (NC - 1);
    const int tok0 = (bh >> 4) * TP + c * CL, h = bh & 15;
    float* fin = (kind ? Ploc : Sloc) + (size_t)(bh * (NC - 1) + c) * 4096;
    if (kind) scan_unit<1, false, false>(P, ws, lane, tok0, CL, h, nullptr, fin);
    else scan_unit<0, true, false>(P, ws, lane, tok0, CL, h, nullptr, fin);
  }
}
__device__ __forceinline__ void phase_scan2(const Params& P, unsigned char* smem, int bid, int nb) {
  const int lane = threadIdx.x & 63, w = threadIdx.x >> 6;
  float* ws = (float*)smem + w * 256;
  float* Ploc = P.out + OUT_WK_S;
  float* Sloc = P.out + OUT_WV_S;
  for (int item = bid; item < NBH * 4; item += nb) {
    const int bh = item >> 2, row0 = (item & 3) * 16 + w * 4;
    float s[4];
    {
      const float* S0 = Sloc + (size_t)(bh * (NC - 1)) * 4096;
#pragma unroll
      for (int r = 0; r < 4; r++) s[r] = S0[(row0 + r) * 64 + lane];
    }
    for (int c = 1; c < NC - 1; c++) {
      const float* Pc = Ploc + (size_t)(bh * (NC - 1) + c) * 4096;
      float* Sc = Sloc + (size_t)(bh * (NC - 1) + c) * 4096;
      float acc[4];
#pragma unroll
      for (int r = 0; r < 4; r++) { acc[r] = Sc[(row0 + r) * 64 + lane]; ws[r * 64 + lane] = s[r]; }
      __builtin_amdgcn_wave_barrier();
      asm volatile("s_waitcnt lgkmcnt(0)" ::: "memory");
#pragma unroll 1
      for (int hf = 0; hf < 2; hf++) {
        float p[32];
#pragma unroll
        for (int i = 0; i < 32; i++) p[i] = Pc[(hf * 32 + i) * 64 + lane];
#pragma unroll
        for (int r = 0; r < 4; r++) {
#pragma unroll
          for (int i4 = 0; i4 < 8; i4++) {
            const float4 sv = *(const float4*)(ws + r * 64 + hf * 32 + 4 * i4);
            acc[r] = fmaf(sv.x, p[4 * i4], acc[r]); acc[r] = fmaf(sv.y, p[4 * i4 + 1], acc[r]);
            acc[r] = fmaf(sv.z, p[4 * i4 + 2], acc[r]); acc[r] = fmaf(sv.w, p[4 * i4 + 3], acc[r]);
          }
        }
      }
      __builtin_amdgcn_wave_barrier();
      asm volatile("s_waitcnt lgkmcnt(0)" ::: "memory");
#pragma unroll
      for (int r = 0; r < 4; r++) { s[r] = acc[r]; Sc[(row0 + r) * 64 + lane] = acc[r]; }
    }
  }
}
__device__ __forceinline__ void phase_scan3(const Params& P, unsigned char* smem, int bid, int nb) {
  const int lane = threadIdx.x & 63, w = threadIdx.x >> 6;
  float* ws = (float*)smem + w * (TS * REC);
  float* Sloc = P.out + OUT_WV_S;
  const int hb = nb >> 1;
  if (bid < hb) {
    for (int u = w * hb + bid; u < NBH * NC; u += 4 * hb) {
      const int bh = u >> 5, c = u & 31;
      const int tok0 = (bh >> 4) * TP + c * CL, h = bh & 15;
      const float* ip = (c > 0) ? (Sloc + (size_t)(bh * (NC - 1) + c - 1) * 4096) : nullptr;
      float* fin = (c == NC - 1) ? (P.out + OUT_WKV_P + (size_t)bh * 4096) : nullptr;
      if (c > 0) scan_unit<2, true, true>(P, ws, lane, tok0, CL, h, ip, fin);
      else scan_unit<0, true, true>(P, ws, lane, tok0, CL, h, ip, fin);
    }
  } else {
    for (int sb = w * (nb - hb) + (bid - hb); sb < 2048; sb += 4 * (nb - hb))
      scan_unit<2, true, true>(P, ws, lane, NPR + (sb >> 4) * 8, 8, sb & 15, P.state_wkv + (size_t)sb * 4096, P.out + OUT_WKV_S + (size_t)sb * 4096);
  }
}

__device__ __forceinline__ void phase_ln(const Params& P, int layer, int bid, int nb) {
  const int lane = threadIdx.x & 63, w = threadIdx.x >> 6;
  const float* gg = P.ln_g + layer * DM; const float* bb = P.ln_b + layer * DM;
  for (int tok = bid * 4 + w; tok < NTOK; tok += nb * 4) {
    f32x4* row = (f32x4*)(P.out + OUT_Y + (size_t)tok * DM);
    f32x4 v[4];
    float sum = 0.f;
#pragma unroll
    for (int i = 0; i < 4; i++) { v[i] = row[lane + 64 * i]; sum += v[i][0] + v[i][1] + v[i][2] + v[i][3]; }
    const float mean = wave_sum(sum) * (1.f / 1024.f);
    float sq = 0.f;
#pragma unroll
    for (int i = 0; i < 4; i++) { v[i] -= mean; sq += v[i][0] * v[i][0] + v[i][1] * v[i][1] + v[i][2] * v[i][2] + v[i][3] * v[i][3]; }
    const float rs = rsqrtf(wave_sum(sq) * (1.f / 1024.f) + 1e-5f);
#pragma unroll
    for (int i = 0; i < 4; i++) {
      const f32x4 g4 = ((const f32x4*)gg)[lane + 64 * i], b4 = ((const f32x4*)bb)[lane + 64 * i];
      const f32x4 o = v[i] * rs * g4 + b4;
      row[lane + 64 * i] = o;
      if (layer == 0) { uint2 ob; ob.x = pack2(o[0], o[1]); ob.y = pack2(o[2], o[3]); ((uint2*)(P.Rb + (size_t)tok * DM))[lane + 64 * i] = ob; }
    }
  }
}

__device__ __forceinline__ void attn_prompt_item(const Params& P, unsigned char* smem, int item) {
  const int qh = item & 1, hk = (item >> 1) & 3, n = (item >> 3) & 63, b = item >> 9;
  bf16_t* Ks = (bf16_t*)smem;
  bf16_t* Vs = Ks + 192 * 72;
  const bf16_t* K1 = P.XB; const bf16_t* VT1 = P.XB + (size_t)NTOK * 512;
  const bf16_t* Q1 = P.Kb; const bf16_t* G1 = P.Vb; bf16_t* AO = P.Gb;
  const int t = threadIdx.x, lane = t & 63, w = t >> 6;
  const int g = lane >> 4, lc = lane & 15;
  const int pos0 = (n - 1) * 128 + 64 * qh;
  __syncthreads();
#pragma unroll
  for (int i = 0; i < 6; i++) {
    const int idx = t + 256 * i; const int row = idx >> 3, ch = idx & 7; const int pos = pos0 + row;
    uint4 v = make_uint4(0, 0, 0, 0);
    if (pos >= 0) v = *(const uint4*)(K1 + ((size_t)(b * TP + pos)) * 256 + hk * 64 + ch * 8);
    *(uint4*)(Ks + row * 72 + ch * 8) = v;
  }
#pragma unroll
  for (int i = 0; i < 6; i++) {
    const int idx = t + 256 * i; const int d = idx / 24, ch = idx % 24; const int pos = pos0 + ch * 8;
    uint4 v = make_uint4(0, 0, 0, 0);
    if (pos >= 0) v = *(const uint4*)(VT1 + ((size_t)((b * 4 + hk) * 64 + d)) * TP + pos);
    *(uint4*)(Vs + d * 200 + ch * 8) = v;
  }
  __syncthreads();
  const int h = hk * 4 + w;
  const float slope = exp2f(-0.5f * (float)(h + 1));
  const float sink = P.att_sinks[h];
  for (int sb = 0; sb < 2; sb++) {
    const int i0 = 64 * qh + 32 * sb;
    const int tokb = b * TP + n * 128 + i0;
    bf16x8 qf[2][2];
#pragma unroll
    for (int nn = 0; nn < 2; nn++)
#pragma unroll
      for (int ks = 0; ks < 2; ks++) qf[nn][ks] = *(const bf16x8*)(Q1 + (size_t)(tokb + 16 * nn + lc) * DM + h * 64 + ks * 32 + g * 8);
    float mrun[2] = {sink, sink}, lrun[2] = {1.f, 1.f};
    f32x4 O[4][2];
#pragma unroll
    for (int dm = 0; dm < 4; dm++) { O[dm][0] = (f32x4){0.f, 0.f, 0.f, 0.f}; O[dm][1] = (f32x4){0.f, 0.f, 0.f, 0.f}; }
    for (int kt = 0; kt < 3; kt++) {
      if (n == 0 && (qh + kt) < 2) continue;
      f32x4 S[4][2];
#pragma unroll
      for (int mm = 0; mm < 4; mm++) { S[mm][0] = (f32x4){0.f, 0.f, 0.f, 0.f}; S[mm][1] = (f32x4){0.f, 0.f, 0.f, 0.f}; }
#pragma unroll
      for (int ks = 0; ks < 2; ks++)
#pragma unroll
        for (int mm = 0; mm < 4; mm++) {
          const bf16x8 kf = *(const bf16x8*)(Ks + (kt * 64 + mm * 16 + lc) * 72 + ks * 32 + g * 8);
          S[mm][0] = __builtin_amdgcn_mfma_f32_16x16x32_bf16(kf, qf[0][ks], S[mm][0], 0, 0, 0);
          S[mm][1] = __builtin_amdgcn_mfma_f32_16x16x32_bf16(kf, qf[1][ks], S[mm][1], 0, 0, 0);
        }
#pragma unroll
      for (int nn = 0; nn < 2; nn++) {
        const int qi = i0 + 16 * nn + lc;
        float mx = mrun[nn];
#pragma unroll
        for (int mm = 0; mm < 4; mm++)
#pragma unroll
          for (int r = 0; r < 4; r++) {
            const int j = 64 * (qh + kt) + 16 * mm + 4 * g + r;
            const int dist = 128 + qi - j;
            const bool live = (dist >= 0) && (dist < 128);
            const float sv = live ? (S[mm][nn][r] * 0.125f - slope * (float)dist) : -1e30f;
            S[mm][nn][r] = sv; mx = fmaxf(mx, sv);
          }
        mx = fmaxf(mx, __shfl_xor(mx, 16)); mx = fmaxf(mx, __shfl_xor(mx, 32));
        const float corr = __expf(mrun[nn] - mx); mrun[nn] = mx;
        float sum = 0.f;
#pragma unroll
        for (int mm = 0; mm < 4; mm++)
#pragma unroll
          for (int r = 0; r < 4; r++) { const float pp = __expf(S[mm][nn][r] - mx); S[mm][nn][r] = pp; sum += pp; }
        sum += __shfl_xor(sum, 16); sum += __shfl_xor(sum, 32);
        lrun[nn] = lrun[nn] * corr + sum;
#pragma unroll
        for (int dm = 0; dm < 4; dm++) { O[dm][nn][0] *= corr; O[dm][nn][1] *= corr; O[dm][nn][2] *= corr; O[dm][nn][3] *= corr; }
      }
#pragma unroll
      for (int k2 = 0; k2 < 2; k2++) {
        bf16x8 pf[2];
#pragma unroll
        for (int nn = 0; nn < 2; nn++) {
          const unsigned u0 = pack2(S[2 * k2][nn][0], S[2 * k2][nn][1]), u1 = pack2(S[2 * k2][nn][2], S[2 * k2][nn][3]);
          const unsigned u2 = pack2(S[2 * k2 + 1][nn][0], S[2 * k2 + 1][nn][1]), u3 = pack2(S[2 * k2 + 1][nn][2], S[2 * k2 + 1][nn][3]);
          const uint4 uu = make_uint4(u0, u1, u2, u3);
          pf[nn] = *(const bf16x8*)&uu;
        }
#pragma unroll
        for (int dm = 0; dm < 4; dm++) {
          const bf16_t* vb = Vs + (dm * 16 + lc) * 200 + kt * 64 + k2 * 32 + 4 * g;
          const uint2 lo = *(const uint2*)vb, hi = *(const uint2*)(vb + 16);
          const uint4 uu = make_uint4(lo.x, lo.y, hi.x, hi.y);
          const bf16x8 vf = *(const bf16x8*)&uu;
          O[dm][0] = __builtin_amdgcn_mfma_f32_16x16x32_bf16(vf, pf[0], O[dm][0], 0, 0, 0);
          O[dm][1] = __builtin_amdgcn_mfma_f32_16x16x32_bf16(vf, pf[1], O[dm][1], 0, 0, 0);
        }
      }
    }
#pragma unroll
    for (int nn = 0; nn < 2; nn++) {
      const float inv = 1.f / lrun[nn];
      const size_t tok = (size_t)(tokb + 16 * nn + lc);
#pragma unroll
      for (int dm = 0; dm < 4; dm++) {
        const int d = dm * 16 + 4 * g;
        const uint2 gv = *(const uint2*)(G1 + tok * DM + h * 64 + d);
        const float g0 = __uint_as_float(gv.x << 16), g1 = __uint_as_float(gv.x & 0xffff0000u);
        const float g2 = __uint_as_float(gv.y << 16), g3 = __uint_as_float(gv.y & 0xffff0000u);
        uint2 o;
        o.x = pack2(O[dm][nn][0] * inv * g0 * sigmoidf_(g0), O[dm][nn][1] * inv * g1 * sigmoidf_(g1));
        o.y = pack2(O[dm][nn][2] * inv * g2 * sigmoidf_(g2), O[dm][nn][3] * inv * g3 * sigmoidf_(g3));
        *(uint2*)(AO + tok * DM + h * 64 + d) = o;
      }
    }
  }
}

__device__ __forceinline__ void attn_sample_item(const Params& P, unsigned char* smem, int item) {
  const int b = item >> 2, hk = item & 3;
  const int t = threadIdx.x, lane = t & 63, w = t >> 6;
  float* qs = (float*)smem + w * 512;
  float* ps = (float*)smem + 2048 + w * (8 * 136);
  const bf16_t* K1 = P.XB; const bf16_t* V1 = P.XB + (size_t)NTOK * 256;
  const bf16_t* Q1 = P.Kb; const bf16_t* G1 = P.Vb; bf16_t* AO = P.Gb;
  const int h = hk * 4 + w;
  const float slope = exp2f(-0.5f * (float)(h + 1));
  const float sink = P.att_sinks[h];
  const int tok0 = NPR + b * 8;
  __syncthreads();
  for (int idx = t; idx < 120 * 16; idx += 256) {
    const int row = idx >> 4, c4 = idx & 15;
    const size_t so = ((size_t)(b * 128 + row + 8)) * 256 + hk * 64 + c4 * 4;
    const size_t dofs = ((size_t)(b * 128 + row)) * 256 + hk * 64 + c4 * 4;
    *(float4*)(P.out + OUT_WK_S + dofs) = *(const float4*)(P.cache_k + so);
    *(float4*)(P.out + OUT_WV_S + dofs) = *(const float4*)(P.cache_v + so);
  }
#pragma unroll
  for (int i = 0; i < 8; i++) qs[i * 64 + lane] = bf2f(Q1[(size_t)(tok0 + i) * DM + h * 64 + lane]);
  __builtin_amdgcn_wave_barrier();
  asm volatile("s_waitcnt lgkmcnt(0)" ::: "memory");
  float sc[3][8];
#pragma unroll
  for (int ksel = 0; ksel < 3; ksel++) {
    float acc[8];
#pragma unroll
    for (int i = 0; i < 8; i++) acc[i] = 0.f;
    const float* kp = P.cache_k + ((size_t)(b * 128 + lane + 64 * (ksel & 1))) * 256 + hk * 64;
    const bf16_t* kpb = K1 + (size_t)(tok0 + (lane & 7)) * 256 + hk * 64;
#pragma unroll 2
    for (int d4 = 0; d4 < 16; d4++) {
      float4 kv;
      if (ksel < 2) kv = ((const float4*)kp)[d4];
      else { const uint2 u = ((const uint2*)kpb)[d4]; kv = make_float4(__uint_as_float(u.x << 16), __uint_as_float(u.x & 0xffff0000u), __uint_as_float(u.y << 16), __uint_as_float(u.y & 0xffff0000u)); }
#pragma unroll
      for (int i = 0; i < 8; i++) {
        const float4 qv = *(const float4*)(qs + i * 64 + 4 * d4);
        acc[i] = fmaf(qv.x, kv.x, acc[i]); acc[i] = fmaf(qv.y, kv.y, acc[i]); acc[i] = fmaf(qv.z, kv.z, acc[i]); acc[i] = fmaf(qv.w, kv.w, acc[i]);
      }
    }
#pragma unroll
    for (int i = 0; i < 8; i++) {
      int dist; bool live;
      if (ksel < 2) { const int j = lane + 64 * ksel; dist = 128 + i - j; live = (j > i); }
      else { dist = i - lane; live = (lane <= i); }
      sc[ksel][i] = live ? (acc[i] * 0.125f - slope * (float)dist) : -1e30f;
    }
  }
#pragma unroll
  for (int i = 0; i < 8; i++) {
    float mx = fmaxf(fmaxf(sc[0][i], sc[1][i]), sc[2][i]);
    mx = fmaxf(wave_max(mx), sink);
    const float p0 = __expf(sc[0][i] - mx), p1 = __expf(sc[1][i] - mx), p2 = __expf(sc[2][i] - mx);
    const float den = wave_sum(p0 + p1 + p2) + __expf(sink - mx);
    const float inv = 1.f / den;
    ps[i * 136 + lane] = p0 * inv; ps[i * 136 + 64 + lane] = p1 * inv;
    if (lane < 8) ps[i * 136 + 128 + lane] = p2 * inv;
  }
  __builtin_amdgcn_wave_barrier();
  asm volatile("s_waitcnt lgkmcnt(0)" ::: "memory");
  float o[8];
#pragma unroll
  for (int i = 0; i < 8; i++) o[i] = 0.f;
  for (int j = 0; j < 136; j++) {
    float v;
    if (j < 128) v = P.cache_v[((size_t)(b * 128 + j)) * 256 + hk * 64 + lane];
    else v = bf2f(V1[(size_t)(tok0 + j - 128) * 256 + hk * 64 + lane]);
#pragma unroll
    for (int i = 0; i < 8; i++) o[i] = fmaf(ps[i * 136 + j], v, o[i]);
  }
#pragma unroll
  for (int i = 0; i < 8; i++) {
    const size_t off = (size_t)(tok0 + i) * DM + h * 64 + lane;
    const float gt = bf2f(G1[off]);
    AO[off] = f2bf(o[i] * gt * sigmoidf_(gt));
  }
}
__device__ __forceinline__ void phase_attn(const Params& P, unsigned char* smem, int bid, int nb) {
  for (int item = bid; item < 1024 + 512; item += nb) {
    if (item < 1024) attn_prompt_item(P, smem, item);
    else attn_sample_item(P, smem, item - 1024);
  }
}

#if MULTI_LAUNCH
#define PH_BARRIER(ph)
#else
#define PH_BARRIER(ph) do { if ((ph) + 1 < P.phase_end) xcd_barrier(xb); } while (0)
#endif
#define RUN_PH(ph, call) do { if (P.phase_begin <= (ph) && (ph) < P.phase_end) { if ((REPMASK >> (ph)) & 1) { call; PH_BARRIER(ph); } call; PH_BARRIER(ph); } } while (0)

__global__ void __launch_bounds__(256, 2) fwd_kernel(Params P) {
  __shared__ __attribute__((aligned(16))) unsigned char smem[SMEM_BYTES];
  const int bid = blockIdx.x, nb = gridDim.x;
#if !MULTI_LAUNCH
  __shared__ uint4 xb_words;
  if (threadIdx.x == 0) xb_words = make_uint4(0u, 0u, 0u, 0u);
  __syncthreads();
  XcdBarrier xb = xcd_barrier_post(P.bar, (volatile LAS unsigned*)&xb_words);
#endif
#if (PHMASK >> 0) & 1
  RUN_PH(0, phase_prep(P, smem, bid, nb));
#endif
#if (PHMASK >> 1) & 1
  RUN_PH(1, gemm_phase<1>(P, smem, bid, nb));
#endif
#if (PHMASK >> 2) & 1
  RUN_PH(2, gemm_phase<2>(P, smem, bid, nb));
#endif
#if (PHMASK >> 3) & 1
  RUN_PH(3, phase_scan1(P, smem, bid, nb));
#endif
#if (PHMASK >> 4) & 1
  RUN_PH(4, phase_scan2(P, smem, bid, nb));
#endif
#if (PHMASK >> 5) & 1
  RUN_PH(5, phase_scan3(P, smem, bid, nb));
#endif
#if (PHMASK >> 6) & 1
  RUN_PH(6, gemm_phase<3>(P, smem, bid, nb));
#endif
#if (PHMASK >> 7) & 1
  RUN_PH(7, phase_ln(P, 0, bid, nb));
#endif
#if (PHMASK >> 8) & 1
  RUN_PH(8, gemm_phase<4>(P, smem, bid, nb));
#endif
#if (PHMASK >> 9) & 1
  RUN_PH(9, phase_attn(P, smem, bid, nb));
#endif
#if (PHMASK >> 10) & 1
  RUN_PH(10, gemm_phase<5>(P, smem, bid, nb));
#endif
#if (PHMASK >> 11) & 1
  RUN_PH(11, phase_ln(P, 1, bid, nb));
#endif
#if !MULTI_LAUNCH
  if (P.phase_end > NPHASE) cg::this_grid().sync();
#endif
}

extern "C" void kernel_launch(void* const* d_in, const int* in_sizes, int n_in, void* d_out, int out_size, void* d_ws, size_t ws_size, hipStream_t stream) {
  Params P{};
  P.x_prompt = (const float*)d_in[0]; P.x_sample = (const float*)d_in[1]; P.state_wkv = (const float*)d_in[2]; P.state_shift = (const float*)d_in[3];
  P.cache_k = (const float*)d_in[4]; P.cache_v = (const float*)d_in[5]; P.ln_g = (const float*)d_in[6]; P.ln_b = (const float*)d_in[7];
  P.mu = (const float*)d_in[8]; P.w_in = (const float*)d_in[9]; P.w0 = (const float*)d_in[10]; P.w1 = (const float*)d_in[11]; P.w2 = (const float*)d_in[12];
  P.a0 = (const float*)d_in[13]; P.a1 = (const float*)d_in[14]; P.a2 = (const float*)d_in[15]; P.k_k = (const float*)d_in[16]; P.k_a = (const float*)d_in[17];
  P.r_k = (const float*)d_in[18]; P.gn_g = (const float*)d_in[19]; P.gn_b = (const float*)d_in[20]; P.w_out = (const float*)d_in[21];
  P.att_w_in = (const float*)d_in[22]; P.att_sinks = (const float*)d_in[23]; P.att_w_out = (const float*)d_in[24];
  P.out = (float*)d_out;
  unsigned char* ws = (unsigned char*)d_ws;
  size_t off = 0;
  auto take = [&](size_t bytes) { unsigned char* p = ws + off; off += (bytes + 255) & ~(size_t)255; return p; };
  P.bar = (unsigned*)take(16384);
  P.WtIn0 = (bf16_t*)take((size_t)4352 * DM * 2);
  P.W2t = (bf16_t*)take((size_t)DM * 64 * 2);
  P.A2t = (bf16_t*)take((size_t)DM * 64 * 2);
  P.WtOut0 = (bf16_t*)take((size_t)DM * DM * 2);
  P.WtIn1 = (bf16_t*)take((size_t)2560 * DM * 2);
  P.WtOut1 = (bf16_t*)take((size_t)DM * DM * 2);
  P.XB = (bf16_t*)take((size_t)NTOK * DM * 2);
  P.XXB = (bf16_t*)take((size_t)NTOK * DM * 2);
  P.Rb = (bf16_t*)take((size_t)NTOK * DM * 2);
  P.Kb = (bf16_t*)take((size_t)NTOK * DM * 2);
  P.Vb = (bf16_t*)take((size_t)NTOK * DM * 2);
  P.Gb = (bf16_t*)take((size_t)NTOK * DM * 2);
  P.H1 = (bf16_t*)take((size_t)NTOK * 64 * 2);
  P.H2 = (bf16_t*)take((size_t)NTOK * 64 * 2);
  if (off > ws_size) { fprintf(stderr, "workspace too small: need %zu have %zu\n", off, ws_size); return; }
#if MULTI_LAUNCH
  for (int ph = 0; ph < NPHASE; ph++) {
    P.phase_begin = ph; P.phase_end = ph + 1;
    hipLaunchKernelGGL(fwd_kernel, dim3(512), dim3(256), 0, stream, P);
  }
#else
  static int grid_blocks = 0;
  if (!grid_blocks) {
    int dev = 0, cus = 0, per_cu = 0;
    hipGetDevice(&dev);
    hipDeviceGetAttribute(&cus, hipDeviceAttributeMultiprocessorCount, dev);
    hipOccupancyMaxActiveBlocksPerMultiprocessor(&per_cu, fwd_kernel, 256, 0);
    if (per_cu > 2) per_cu = 2;
    if (per_cu < 1) per_cu = 1;
    grid_blocks = cus * per_cu;
  }
  hipMemsetAsync(P.bar, 0, 16384, stream);
  P.phase_begin = 0; P.phase_end = NPHASE;
  void* args[] = {&P};
  hipError_t e = hipLaunchCooperativeKernel((void*)fwd_kernel, dim3(grid_blocks), dim3(256), args, 0, stream);
  if (e != hipSuccess) fprintf(stderr, "cooperative launch failed: %s (grid %d)\n", hipGetErrorString(e), grid_blocks);
#endif
}
```

```cpp
#include <hip/hip_runtime.h>
#include <hip/hip_cooperative_groups.h>
#include <stdint.h>
#include <cstdio>
namespace cg = cooperative_groups;

#ifndef PHMASK
#define PHMASK 0xFFF
#endif
#ifndef PROBE
#define PROBE 0
#endif
#ifndef REPMASK
#define REPMASK 0
#endif
#ifndef MULTI_LAUNCH
#define MULTI_LAUNCH 0
#endif

typedef unsigned short bf16_t;
typedef _Float16 f16_t;
typedef __attribute__((ext_vector_type(8))) short bf16x8;
typedef __attribute__((ext_vector_type(4))) float f32x4;
typedef __attribute__((ext_vector_type(4))) unsigned u32x4;

#define DM 1024
#define NTOK 17408
#define NPR 16384
#define TP 8192
#define NC 32
#define CL 256
#define NBH 32
#define ALPHA_F 1.41421356237f
#define SMEM_BYTES (56 * 1024)
#define NPHASE 12

#define OUT_Y 0
#define OUT_WKV_P 17825792
#define OUT_SH_P 17956864
#define OUT_WK_P 17958912
#define OUT_WV_P 18024448
#define OUT_WKV_S 18089984
#define OUT_SH_S 26478592
#define OUT_WK_S 26609664
#define OUT_WV_S 30803968

struct Params {
  const float *x_prompt, *x_sample, *state_wkv, *state_shift, *cache_k, *cache_v, *ln_g, *ln_b;
  const float *mu, *w_in, *w0, *w1, *w2, *a0, *a1, *a2, *k_k, *k_a, *r_k, *gn_g, *gn_b, *w_out;
  const float *att_w_in, *att_sinks, *att_w_out;
  float* out;
  unsigned* bar;
  bf16_t *WtIn0, *W2t, *A2t, *WtOut0, *WtIn1, *WtOut1;
  bf16_t *XB, *XXB;
  bf16_t *Rb, *Kb, *Vb, *Gb;
  bf16_t *H1, *H2, *MU16;
  int phase_begin, phase_end;
};

typedef __bf16 hbf2 __attribute__((ext_vector_type(2)));
typedef float f32x2_ __attribute__((ext_vector_type(2)));
__device__ __forceinline__ unsigned pack2(float a, float b) {
  const f32x2_ v = {a, b};
  return __builtin_bit_cast(unsigned, __builtin_convertvector(v, hbf2));
}
__device__ __forceinline__ bf16_t f2bf(float f) { return (bf16_t)(pack2(f, 0.f) & 0xffffu); }
__device__ __forceinline__ float bf2f(bf16_t h) { return __uint_as_float(((unsigned)h) << 16); }
__device__ __forceinline__ float wave_sum(float x) {
#pragma unroll
  for (int o = 32; o >= 1; o >>= 1) x += __shfl_xor(x, o);
  return x;
}
__device__ __forceinline__ float wave_max(float x) {
#pragma unroll
  for (int o = 32; o >= 1; o >>= 1) x = fmaxf(x, __shfl_xor(x, o));
  return x;
}
__device__ __forceinline__ float quad_sum(float x) {
  x += __builtin_bit_cast(float, __builtin_amdgcn_update_dpp(0, __builtin_bit_cast(int, x), 0xB1, 0xF, 0xF, true));
  x += __builtin_bit_cast(float, __builtin_amdgcn_update_dpp(0, __builtin_bit_cast(int, x), 0x4E, 0xF, 0xF, true));
  return x;
}
__device__ __forceinline__ float sigmoidf_(float x) { return 1.f / (1.f + __expf(-x)); }
__device__ __forceinline__ const float* xin_row(const Params& P, int m) {
  return (m < NPR) ? (P.x_prompt + (size_t)m * DM) : (P.x_sample + (size_t)(m - NPR) * DM);
}

#define XB_TMO      128
#define XB_XCNT(j)  (256  + 64 * (j))
#define XB_XSUB(j)  (1280 + 64 * (j))
#define XB_XGEN(j)  (2304 + 64 * (j))
#define XB_TOP      3328
#define XB_TOPGEN   3392
#define XCD_BAR_WORDS 3456
#define XB_SPIN_CAP (1u << 22)
#define LAS __attribute__((address_space(3)))
__device__ __forceinline__ unsigned xb_ld(unsigned* p) { return __hip_atomic_load(p, __ATOMIC_RELAXED, __HIP_MEMORY_SCOPE_AGENT); }
__device__ __forceinline__ unsigned xb_add(unsigned* p, unsigned v) { return __hip_atomic_fetch_add(p, v, __ATOMIC_RELAXED, __HIP_MEMORY_SCOPE_AGENT); }
__device__ __forceinline__ unsigned xb_xcc_id() { return (unsigned)__builtin_amdgcn_s_getreg((3 << 11) | 20) & 0xFu; }
#define XB_SPIN(cond, bar) do { unsigned _sp = 0; while (cond) { __builtin_amdgcn_s_sleep(1); \
    if ((++_sp & 255u) == 0u) { if (xb_ld(&(bar)[XB_TMO])) break; if (_sp > XB_SPIN_CAP) { atomicAdd(&(bar)[XB_TMO], 1u); break; } } } } while (0)
struct XcdBarrier { unsigned* bar; unsigned x; volatile LAS unsigned* st; };
__device__ __forceinline__ XcdBarrier xcd_barrier_post(unsigned* bar, volatile LAS unsigned* st) {
  XcdBarrier b; b.bar = bar; b.x = xb_xcc_id(); b.st = st;
  if (threadIdx.x == 0) (void)xb_add(&bar[XB_XCNT(b.x)], 1u);
  return b;
}
__device__ __forceinline__ void xcd_barrier_complete(unsigned* bar, unsigned x, unsigned& nloc, unsigned& nx) {
  const unsigned G = gridDim.x * gridDim.y * gridDim.z;
  unsigned sum, cnt, mine, sp = 0u;
  for (;;) {
    sum = 0u; cnt = 0u; mine = 0u;
#pragma unroll
    for (unsigned j = 0; j < 16; ++j) { const unsigned c = xb_ld(&bar[XB_XCNT(j)]); sum += c; cnt += (c > 0u) ? 1u : 0u; mine = (j == x) ? c : mine; }
    if (sum == G) break;
    __builtin_amdgcn_s_sleep(1);
    if ((++sp & 255u) == 0u) { if (xb_ld(&bar[XB_TMO])) break; if (sp > XB_SPIN_CAP) { atomicAdd(&bar[XB_TMO], 1u); break; } }
  }
  nloc = mine > 0u ? mine : 1u; nx = cnt > 0u ? cnt : 1u;
}
__device__ __forceinline__ void xcd_barrier(const XcdBarrier& b) {
  asm volatile("s_waitcnt vmcnt(0)" ::: "memory");
  __syncthreads();
  if (threadIdx.x == 0) {
    unsigned* bar = b.bar;
    __builtin_amdgcn_s_waitcnt(0);
    unsigned nloc = b.st[0], nx = b.st[1];
    if (nloc == 0u) { xcd_barrier_complete(bar, b.x, nloc, nx); b.st[0] = nloc; b.st[1] = nx; }
    const unsigned old = xb_add(&bar[XB_XSUB(b.x)], 1u);
    const unsigned gen = old / nloc;
    if (old + 1u == (gen + 1u) * nloc) {
      __builtin_amdgcn_fence(__ATOMIC_RELEASE, "agent");
      asm volatile("s_waitcnt vmcnt(0)" ::: "memory");
      const unsigned og = xb_add(&bar[XB_TOP], 1u);
      const unsigned tg = og / nx;
      if (og + 1u == (tg + 1u) * nx) xb_add(&bar[XB_TOPGEN], 1u);
      else XB_SPIN(xb_ld(&bar[XB_TOPGEN]) == tg, bar);
      __builtin_amdgcn_fence(__ATOMIC_ACQUIRE, "agent");
      xb_add(&bar[XB_XGEN(b.x)], 1u);
      asm volatile("s_waitcnt vmcnt(0)" ::: "memory");
    } else {
      XB_SPIN(xb_ld(&bar[XB_XGEN(b.x)]) == gen, bar);
      __builtin_amdgcn_fence(__ATOMIC_ACQUIRE, "agent");
      asm volatile("s_waitcnt vmcnt(0)" ::: "memory");
    }
  }
  __syncthreads();
}

__device__ __forceinline__ unsigned short f2h_bits(float f) { const _Float16 h = (_Float16)f; return __builtin_bit_cast(unsigned short, h); }
__device__ __forceinline__ unsigned pack2h(float a, float b) { return (unsigned)f2h_bits(a) | ((unsigned)f2h_bits(b) << 16); }
__device__ __forceinline__ void transpose_tile(const float* __restrict__ src, int ld, int k0, int n0, bf16_t* __restrict__ dst, int ldd, float* tile, bool half = false) {
  const int t = threadIdx.x;
  {
    const int n = t & 63, kq = t >> 6;
#pragma unroll 4
    for (int i = 0; i < 16; i++) { const int k = i * 4 + kq; tile[k * 65 + n] = src[(size_t)(k0 + k) * ld + n0 + n]; }
  }
  __syncthreads();
  {
    const int k = t & 63, nq = t >> 6;
#pragma unroll 4
    for (int i = 0; i < 16; i++) { const int n2 = i * 4 + nq; const float v_ = tile[k * 65 + n2]; dst[(size_t)(n0 + n2) * ldd + k0 + k] = half ? f2h_bits(v_) : f2bf(v_); }
  }
  __syncthreads();
}

__device__ __forceinline__ void phase_prep(const Params& P, unsigned char* smem, int bid, int nb) {
  float* tile = (float*)smem;
  const int t = threadIdx.x;
  const int NITEMS = 2242 + 4352 + 130;
  for (int id = bid; id < NITEMS; id += nb) {
    if (id < 1024) { const int p = id >> 8, r = id & 255; transpose_tile(P.w_in + (size_t)p * DM * DM, DM, (r >> 4) * 64, (r & 15) * 64, P.WtIn0 + (size_t)p * DM * DM, DM, tile, true); }
    else if (id < 1040) transpose_tile(P.w1, 64, (id - 1024) * 64, 0, P.WtIn0 + (size_t)4096 * DM, DM, tile, true);
    else if (id < 1056) transpose_tile(P.a1, 64, (id - 1040) * 64, 0, P.WtIn0 + (size_t)4224 * DM, DM, tile, true);
    else if (id < 1072) transpose_tile(P.w2, DM, 0, (id - 1056) * 64, P.W2t, 64, tile);
    else if (id < 1088) transpose_tile(P.a2, DM, 0, (id - 1072) * 64, P.A2t, 64, tile);
    else if (id < 1344) { const int r = id - 1088; transpose_tile(P.w_out, DM, (r >> 4) * 64, (r & 15) * 64, P.WtOut0, DM, tile); }
    else if (id < 1984) { const int r = id - 1344; transpose_tile(P.att_w_in, 2560, (r / 40) * 64, (r % 40) * 64, P.WtIn1, DM, tile); }
    else if (id < 2240) { const int r = id - 1984; transpose_tile(P.att_w_out, DM, (r >> 4) * 64, (r & 15) * 64, P.WtOut1, DM, tile); }
    else if (id < 2242) {
      uint4* z = (uint4*)(P.WtIn0 + (size_t)(id == 2240 ? 4160 : 4288) * DM);
      for (int i = t; i < 8192; i += 256) z[i] = make_uint4(0, 0, 0, 0);
      if (id == 2240) for (int i = t; i < 6 * DM; i += 256) P.MU16[i] = f2h_bits(P.mu[i]);
    } else if (id < 2242 + 4352) {
      const int it = id - 2242;
#pragma unroll
      for (int q = 0; q < 4; q++) {
        const int m = it * 4 + q;
        const float4 x = ((const float4*)xin_row(P, m))[t];
        float4 pv = make_float4(0.f, 0.f, 0.f, 0.f);
        if (m < NPR) { if ((m & (TP - 1)) != 0) pv = ((const float4*)xin_row(P, m - 1))[t]; }
        else { const int ms = m - NPR; if ((ms & 7) != 0) pv = ((const float4*)xin_row(P, m - 1))[t]; else pv = ((const float4*)(P.state_shift + (size_t)(ms >> 3) * DM))[t]; }
        uint2 xb, xxb;
        xb.x = pack2h(x.x, x.y); xb.y = pack2h(x.z, x.w);
        xxb.x = pack2h(pv.x - x.x, pv.y - x.y); xxb.y = pack2h(pv.z - x.z, pv.w - x.w);
        ((uint2*)(P.XB + (size_t)m * DM))[t] = xb;
        ((uint2*)(P.XXB + (size_t)m * DM))[t] = xxb;
      }
    } else {
      const int r = id - (2242 + 4352);
      if (r < 2) ((float4*)(P.out + OUT_SH_P + (size_t)r * DM))[t] = ((const float4*)(P.x_prompt + ((size_t)r * TP + TP - 1) * DM))[t];
      else { const int b = r - 2; ((float4*)(P.out + OUT_SH_S + (size_t)b * DM))[t] = ((const float4*)(P.x_sample + ((size_t)b * 8 + 7) * DM))[t]; }
    }
  }
}

#define LDB 40
typedef _Float16 f16x8 __attribute__((ext_vector_type(8)));
typedef _Float16 f16x2 __attribute__((ext_vector_type(2)));
__device__ __forceinline__ unsigned xs16(unsigned x, unsigned d, unsigned m) {
  const f16x2 r = __builtin_elementwise_fma(__builtin_bit_cast(f16x2, d), __builtin_bit_cast(f16x2, m), __builtin_bit_cast(f16x2, x));
  return __builtin_bit_cast(unsigned, r);
}
template <int MODE>
__device__ __forceinline__ void gemm_tile(const Params& P, unsigned char* smem, int mt, int nt) {
  constexpr int KT = (MODE == 2) ? 1 : 16;
  bf16_t* Asb[2]; bf16_t* Bsb[2];
  Asb[0] = (bf16_t*)smem; Bsb[0] = Asb[0] + 128 * LDB; Asb[1] = Bsb[0] + 128 * LDB; Bsb[1] = Asb[1] + 128 * LDB;
  const int t = threadIdx.x, lane = t & 63, w = t >> 6;
  const int wm = w >> 1, wn = w & 1;
  const int g = lane >> 4, lc = lane & 15;
  const int lr = t >> 2, lc4 = t & 3;
  const int m0 = mt * 128, n0 = nt * 128;

  const bf16_t* Ap; const bf16_t* A2p = nullptr; const bf16_t* mup = nullptr; const bf16_t* Bp; int lda, ldb;
  if (MODE == 1) {
    const int p = (nt < 32) ? (nt >> 3) : (4 + (nt - 32));
    Ap = P.XB; A2p = P.XXB; lda = DM; mup = P.MU16 + (size_t)p * DM;
    Bp = P.WtIn0 + (size_t)((nt < 32) ? n0 : (4096 + (nt - 32) * 128)) * DM; ldb = DM;
  } else if (MODE == 2) {
    Ap = (nt < 8) ? P.H1 : P.H2; lda = 64;
    Bp = ((nt < 8) ? P.W2t : P.A2t) + (size_t)((nt & 7) * 128) * 64; ldb = 64;
  } else if (MODE == 3) { Ap = P.Gb; lda = DM; Bp = P.WtOut0 + (size_t)n0 * DM; ldb = DM; }
  else if (MODE == 4 || MODE == 6) { Ap = P.Rb; lda = DM; Bp = P.WtIn1 + (size_t)n0 * DM; ldb = DM; }
  else { Ap = P.Gb; lda = DM; Bp = P.WtOut1 + (size_t)n0 * DM; ldb = DM; }

  f32x4 acc[4][4];
#pragma unroll
  for (int i = 0; i < 4; i++)
#pragma unroll
    for (int j = 0; j < 4; j++) acc[i][j] = (f32x4){0.f, 0.f, 0.f, 0.f};

  u32x4 ra[2][2][2], rb[2][2][2], ra2[2][2][2], rmu[2][2];
  const unsigned voffA = (unsigned)(lr * lda + lc4 * 8) * 2u;
  const unsigned voffB = (unsigned)(lr * ldb + lc4 * 8) * 2u;
  const char* baseA = (const char*)(Ap + (size_t)m0 * lda);
  const char* baseA2 = (const char*)(A2p + (size_t)m0 * lda);
  const char* baseB = (const char*)Bp;
#define LOADH(S_, kt_, H_) do { if ((kt_) < KT) { \
    _Pragma("unroll") for (int ii_ = 0; ii_ < 2; ii_++) { \
      const size_t uo_ = ((size_t)(64 * ii_) * lda + (size_t)(kt_) * 64 + 32 * (H_)) * 2; \
      const size_t uob_ = ((size_t)(64 * ii_) * ldb + (size_t)(kt_) * 64 + 32 * (H_)) * 2; \
      ra[S_][H_][ii_] = *(const u32x4*)(baseA + uo_ + voffA); \
      if (MODE == 1) ra2[S_][H_][ii_] = *(const u32x4*)(baseA2 + uo_ + voffA); \
      rb[S_][H_][ii_] = *(const u32x4*)(baseB + uob_ + voffB); \
    } \
    if (MODE == 1) rmu[S_][H_] = *(const u32x4*)(mup + (kt_) * 64 + 32 * (H_) + lc4 * 8); \
  } } while (0)
#define STOREH(S_, H_, B_) do { \
    _Pragma("unroll") for (int ii_ = 0; ii_ < 2; ii_++) { \
      const int row_ = lr + 64 * ii_; \
      u32x4 av_ = ra[S_][H_][ii_]; \
      if (MODE == 1) { \
        const u32x4 xv_ = ra[S_][H_][ii_], dv_ = ra2[S_][H_][ii_], mv_ = rmu[S_][H_]; \
        av_ = (u32x4){xs16(xv_.x, dv_.x, mv_.x), xs16(xv_.y, dv_.y, mv_.y), xs16(xv_.z, dv_.z, mv_.z), xs16(xv_.w, dv_.w, mv_.w)}; \
      } \
      *(u32x4*)(Asb[B_] + row_ * LDB + lc4 * 8) = av_; \
      *(u32x4*)(Bsb[B_] + row_ * LDB + lc4 * 8) = rb[S_][H_][ii_]; \
    } \
  } while (0)
#define COMPUTE_SUB(B_) do { if (!(MODE == 6 && PROBE == 3)) { \
    bf16x8 af[4], bfr[4]; \
    _Pragma("unroll") for (int i = 0; i < 4; i++) af[i] = *(const bf16x8*)(Bsb[B_] + (wn * 64 + i * 16 + lc) * LDB + g * 8); \
    _Pragma("unroll") for (int j = 0; j < 4; j++) bfr[j] = *(const bf16x8*)(Asb[B_] + (wm * 64 + j * 16 + lc) * LDB + g * 8); \
    _Pragma("unroll") for (int i = 0; i < 4; i++) \
      _Pragma("unroll") for (int j = 0; j < 4; j++) { \
        if (MODE == 1) acc[i][j] = __builtin_amdgcn_mfma_f32_16x16x32_f16(__builtin_bit_cast(f16x8, af[i]), __builtin_bit_cast(f16x8, bfr[j]), acc[i][j], 0, 0, 0); \
        else acc[i][j] = __builtin_amdgcn_mfma_f32_16x16x32_bf16(af[i], bfr[j], acc[i][j], 0, 0, 0); \
      } \
  } } while (0)
  __syncthreads();
  LOADH(0, 0, 0); LOADH(0, 0, 1); LOADH(1, 1, 0); LOADH(1, 1, 1);
  STOREH(0, 0, 0);
  LOADH(0, 2, 0);
  __syncthreads();
  for (int kt = 0; kt < KT; kt += 2) {
    STOREH(0, 1, 1); LOADH(0, kt + 2, 1);
    COMPUTE_SUB(0);
    __syncthreads();
    if (kt + 1 < KT) { STOREH(1, 0, 0); LOADH(1, kt + 3, 0); }
    COMPUTE_SUB(1);
    __syncthreads();
    if (kt + 1 < KT) {
      STOREH(1, 1, 1); LOADH(1, kt + 3, 1);
      COMPUTE_SUB(0);
      __syncthreads();
      if (kt + 2 < KT) { STOREH(0, 0, 0); LOADH(0, kt + 4, 0); }
      COMPUTE_SUB(1);
      __syncthreads();
    }
  }
#pragma unroll
  for (int i = 0; i < 4; i++) {
    const int nl = wn * 64 + i * 16 + 4 * g;
#pragma unroll
    for (int j = 0; j < 4; j++) {
      const int m = m0 + wm * 64 + j * 16 + lc;
      const f32x4 v = acc[i][j];
      if (MODE == 1) {
        if (nt < 32) {
          const int p = nt >> 3, c = (nt & 7) * 128 + nl;
          bf16_t* dst = (p == 0) ? P.Rb : (p == 1) ? P.Kb : (p == 2) ? P.Vb : P.Gb;
          uint2 o; o.x = pack2(v[0], v[1]); o.y = pack2(v[2], v[3]);
          *(uint2*)(dst + (size_t)m * DM + c) = o;
        } else if (nl < 64) {
          uint2 o;
          if (nt == 32) { o.x = pack2(tanhf(v[0]), tanhf(v[1])); o.y = pack2(tanhf(v[2]), tanhf(v[3])); *(uint2*)(P.H1 + (size_t)m * 64 + nl) = o; }
          else { o.x = pack2(v[0], v[1]); o.y = pack2(v[2], v[3]); *(uint2*)(P.H2 + (size_t)m * 64 + nl) = o; }
        }
      } else if (MODE == 2) {
        const int c = (nt & 7) * 128 + nl;
        f16_t o[4];
        if (nt < 8) {
          const float4 w0v = *(const float4*)(P.w0 + c);
          const float ws[4] = {w0v.x, w0v.y, w0v.z, w0v.w};
#pragma unroll
          for (int r = 0; r < 4; r++) o[r] = (f16_t)(sigmoidf_(ws[r] + v[r]) * 0.60653065971f);
          *(uint2*)((f16_t*)P.XB + (size_t)m * DM + c) = *(uint2*)o;
        } else {
          const float4 a0v = *(const float4*)(P.a0 + c);
          const float as_[4] = {a0v.x, a0v.y, a0v.z, a0v.w};
#pragma unroll
          for (int r = 0; r < 4; r++) o[r] = (f16_t)sigmoidf_(as_[r] + v[r]);
          *(uint2*)((f16_t*)P.XXB + (size_t)m * DM + c) = *(uint2*)o;
        }
      } else if (MODE == 3 || MODE == 5) {
        const int c = n0 + nl;
        float4 res;
        if (MODE == 3) res = *(const float4*)(xin_row(P, m) + c);
        else res = *(const float4*)(P.out + OUT_Y + (size_t)m * DM + c);
        float4 o = make_float4(v[0] + ALPHA_F * res.x, v[1] + ALPHA_F * res.y, v[2] + ALPHA_F * res.z, v[3] + ALPHA_F * res.w);
        *(float4*)(P.out + OUT_Y + (size_t)m * DM + c) = o;
      } else if (MODE == 6) {
        uint2 o; o.x = pack2(v[0], v[1]); o.y = pack2(v[2], v[3]);
        *(uint2*)(P.XB + (size_t)(m & 4095) * DM + ((n0 + nl) & 1023)) = o;
      } else if (MODE == 4) {
        uint2 o; o.x = pack2(v[0], v[1]); o.y = pack2(v[2], v[3]);
        if (nt < 8) { *(uint2*)(P.Kb + (size_t)m * DM + n0 + nl) = o; }
        else if (nt >= 12) { *(uint2*)(P.Vb + (size_t)m * DM + (nt - 12) * 128 + nl) = o; }
        else {
          const bool isk = nt < 10;
          const int ck = (nt & 1) * 128 + nl;
          bf16_t* K1 = P.XB; bf16_t* V1 = P.XB + (size_t)NTOK * 256; bf16_t* VT1 = P.XB + (size_t)NTOK * 512;
          *(uint2*)((isk ? K1 : V1) + (size_t)m * 256 + ck) = o;
          const float4 fo = make_float4(v[0], v[1], v[2], v[3]);
          if (m < NPR) {
            const int b = m >> 13, tt = m & (TP - 1);
            if (!isk) {
              const int hk = ck >> 6, d = ck & 63;
              bf16_t* vt = VT1 + ((size_t)((b * 4 + hk) * 64 + d)) * TP + tt;
              vt[0] = f2bf(v[0]); vt[TP] = f2bf(v[1]); vt[2 * TP] = f2bf(v[2]); vt[3 * TP] = f2bf(v[3]);
            }
            if (tt >= TP - 128) *(float4*)(P.out + (isk ? OUT_WK_P : OUT_WV_P) + ((size_t)(b * 128 + tt - (TP - 128))) * 256 + ck) = fo;
          } else {
            const int ms = m - NPR, b = ms >> 3, tt = ms & 7;
            *(float4*)(P.out + (isk ? OUT_WK_S : OUT_WV_S) + ((size_t)(b * 128 + 120 + tt)) * 256 + ck) = fo;
          }
        }
      }
    }
  }
}
template <int MODE>
__device__ __forceinline__ void gemm_phase(const Params& P, unsigned char* smem, int bid, int nb) {
  constexpr int NT = (MODE == 1) ? 34 : (MODE == 2) ? 16 : (MODE == 4 || MODE == 6) ? 20 : 8;
  const int ntiles = 136 * NT;
  for (int tile = bid; tile < ntiles; tile += nb) gemm_tile<MODE>(P, smem, tile % 136, tile / 136);
}

#define TS 4
#define REC 392
typedef float f32x2 __attribute__((ext_vector_type(2)));
__device__ __forceinline__ f32x2 pkfma(f32x2 a, f32x2 b, f32x2 c) { return __builtin_elementwise_fma(a, b, c); }
#define DPP_ADD(x, ctrl) ((x) + __builtin_bit_cast(float, __builtin_amdgcn_update_dpp(0, __builtin_bit_cast(int, (x)), (ctrl), 0xF, 0xF, true)))
__device__ __forceinline__ float wave_sum_fast(float x) {
  x = DPP_ADD(x, 0xB1); x = DPP_ADD(x, 0x4E); x = DPP_ADD(x, 0x141); x = DPP_ADD(x, 0x140);
  const int xi = __builtin_bit_cast(int, x);
  const float t0 = __builtin_bit_cast(float, __builtin_amdgcn_readlane(xi, 0)), t1 = __builtin_bit_cast(float, __builtin_amdgcn_readlane(xi, 16));
  const float t2 = __builtin_bit_cast(float, __builtin_amdgcn_readlane(xi, 32)), t3 = __builtin_bit_cast(float, __builtin_amdgcn_readlane(xi, 48));
  return (t0 + t1) + (t2 + t3);
}
#define LD8(dst, ptr) do { _Pragma("unroll") for (int j4_ = 0; j4_ < 4; j4_++) { const f32x4 v_ = *(const f32x4*)((ptr) + 4 * j4_); \
    dst[2 * j4_] = (f32x2){v_[0], v_[1]}; dst[2 * j4_ + 1] = (f32x2){v_[2], v_[3]}; } } while (0)

template <int INIT  , bool USEV, bool WRITEY>
__device__ __forceinline__ void scan_unit(const Params& P, float* ws, int lane, int tok0, int nsteps, int h, const float* init_ptr, float* fin) {
  const int rq = lane >> 2, q = lane & 3;
  f32x2 s[4][8];
#pragma unroll
  for (int i = 0; i < 4; i++)
#pragma unroll
    for (int j = 0; j < 8; j++) {
      if (INIT == 1) s[i][j] = (f32x2){((rq + 16 * i) == (16 * q + 2 * j)) ? 1.f : 0.f, ((rq + 16 * i) == (16 * q + 2 * j + 1)) ? 1.f : 0.f};
      else s[i][j] = (f32x2){0.f, 0.f};
    }
  if (INIT == 2) {
#pragma unroll
    for (int i = 0; i < 4; i++) LD8(s[i], init_ptr + (size_t)(rq + 16 * i) * 64 + 16 * q);
  }
  const int c = h * 64 + lane;
  const float kkc = P.k_k[c], kac = P.k_a[c], rkc = P.r_k[c];
  const int crow = h * 64 + rq + 16 * q;
  const float gng = P.gn_g[crow], gnb = P.gn_b[crow];
  const f16_t* EW = (const f16_t*)P.XB;
  const f16_t* AA = (const f16_t*)P.XXB;

  bf16_t rk[TS], rv[TS], rr[TS]; f16_t ra_[TS], re_[TS];
#define LOAD_RAW(tb) do { _Pragma("unroll") for (int tt_ = 0; tt_ < TS; tt_++) { const size_t off_ = (size_t)(tok0 + (tb) + tt_) * DM + c; \
    rk[tt_] = P.Kb[off_]; ra_[tt_] = AA[off_]; re_[tt_] = EW[off_]; if (USEV) rv[tt_] = P.Vb[off_]; if (WRITEY) rr[tt_] = P.Rb[off_]; } } while (0)
  LOAD_RAW(0);
  for (int t0 = 0; t0 < nsteps; t0 += TS) {
#pragma unroll
    for (int tt = 0; tt < TS; tt++) {
      const float kraw = bf2f(rk[tt]);
      const float a = (float)ra_[tt];
      const float wd = __expf(-(float)re_[tt]);
      float kkv = kraw * kkc;
      const float ss = wave_sum_fast(kkv * kkv);
      kkv = kkv / fmaxf(sqrtf(ss), 1e-12f);
      const float kf = kraw * (1.f + (a - 1.f) * kac);
      float* rec = ws + tt * REC;
      rec[lane] = kkv; rec[64 + lane] = wd; rec[128 + lane] = kf; rec[192 + lane] = kkv * a;
      if (WRITEY) {
        const float r = bf2f(rr[tt]);
        rec[256 + lane] = r;
        const float bonus = wave_sum_fast(r * kf * rkc);
        if (lane == 0) rec[384] = bonus;
      }
      if (USEV) rec[320 + lane] = bf2f(rv[tt]);
    }
    __builtin_amdgcn_wave_barrier();
    asm volatile("s_waitcnt lgkmcnt(0)" ::: "memory");
    if (t0 + TS < nsteps) LOAD_RAW(t0 + TS);
#pragma unroll 1
    for (int tt = 0; tt < TS; tt++) {
      const float* rec = ws + tt * REC;
      f32x2 o2[8];
      LD8(o2, rec + 16 * q);
      f32x2 nsa2[4];
      {
        f32x2 acc[4];
#pragma unroll
        for (int i = 0; i < 4; i++) acc[i] = s[i][0] * o2[0];
#pragma unroll
        for (int j = 1; j < 8; j++)
#pragma unroll
          for (int i = 0; i < 4; i++) acc[i] = pkfma(s[i][j], o2[j], acc[i]);
#pragma unroll
        for (int i = 0; i < 4; i++) { const float t = -quad_sum(acc[i][0] + acc[i][1]); nsa2[i] = (f32x2){t, t}; }
      }
      float vv[4];
      if (USEV) {
#pragma unroll
        for (int i = 0; i < 4; i++) vv[i] = rec[320 + rq + 16 * i];
      }
      f32x2 w2[8], b2[8];
      LD8(w2, rec + 64 + 16 * q);
      LD8(b2, rec + 192 + 16 * q);
      if (USEV) {
        LD8(o2, rec + 128 + 16 * q);
#pragma unroll
        for (int i = 0; i < 4; i++) {
          const f32x2 vv2 = (f32x2){vv[i], vv[i]};
          f32x2 tq[8];
#pragma unroll
          for (int j = 0; j < 8; j++) tq[j] = nsa2[i] * b2[j];
#pragma unroll
          for (int j = 0; j < 8; j++) tq[j] = pkfma(vv2, o2[j], tq[j]);
#pragma unroll
          for (int j = 0; j < 8; j++) s[i][j] = pkfma(s[i][j], w2[j], tq[j]);
        }
      } else {
#pragma unroll
        for (int i = 0; i < 4; i++) {
          f32x2 tq[8];
#pragma unroll
          for (int j = 0; j < 8; j++) tq[j] = nsa2[i] * b2[j];
#pragma unroll
          for (int j = 0; j < 8; j++) s[i][j] = pkfma(s[i][j], w2[j], tq[j]);
        }
      }
      if (WRITEY) {
        LD8(o2, rec + 256 + 16 * q);
        float y[4];
        {
          f32x2 acc[4];
#pragma unroll
          for (int i = 0; i < 4; i++) acc[i] = s[i][0] * o2[0];
#pragma unroll
          for (int j = 1; j < 8; j++)
#pragma unroll
            for (int i = 0; i < 4; i++) acc[i] = pkfma(s[i][j], o2[j], acc[i]);
#pragma unroll
          for (int i = 0; i < 4; i++) y[i] = quad_sum(acc[i][0] + acc[i][1]);
        }
        const float ysel = (q == 0) ? y[0] : (q == 1) ? y[1] : (q == 2) ? y[2] : y[3];
        const float vsel = (q == 0) ? vv[0] : (q == 1) ? vv[1] : (q == 2) ? vv[2] : vv[3];
        const float mean = wave_sum_fast(ysel) * (1.f / 64.f);
        const float ex2 = wave_sum_fast(ysel * ysel) * (1.f / 64.f);
        const float var = fmaxf(ex2 - mean * mean, 0.f);
        float yo = (ysel - mean) * rsqrtf(var + 64e-5f) * gng + gnb + rec[384] * vsel;
        const size_t off = (size_t)(tok0 + t0 + tt) * DM + crow;
        const float gt = bf2f(P.Gb[off]);
        yo *= gt * sigmoidf_(gt);
        P.Gb[off] = f2bf(yo);
      }
    }
    __builtin_amdgcn_wave_barrier();
    asm volatile("s_waitcnt lgkmcnt(0)" ::: "memory");
  }
  if (fin) {
#pragma unroll
    for (int i = 0; i < 4; i++)
#pragma unroll
      for (int j4 = 0; j4 < 4; j4++)
        *(f32x4*)(fin + (size_t)(rq + 16 * i) * 64 + 16 * q + 4 * j4) = (f32x4){s[i][2 * j4][0], s[i][2 * j4][1], s[i][2 * j4 + 1][0], s[i][2 * j4 + 1][1]};
  }
}

__device__ __forceinline__ void phase_scan1(const Params& P, unsigned char* smem, int bid, int nb) {
  const int lane = threadIdx.x & 63, w = threadIdx.x >> 6;
  float* ws = (float*)smem + w * (TS * REC);
  float* Ploc = P.out + OUT_WK_S;
  float* Sloc = P.out + OUT_WV_S;
  const int total = NBH * (NC - 1) * 2;
  for (int u = w * nb + bid; u < total; u += 4 * nb) {
    const int kind = u & 1, rest = u >> 1;
    const int c = rest % (NC - 1), bh = rest / (NC - 1);
    const int tok0 = (bh >> 4) * TP + c * CL, h = bh & 15;
    float* fin = (kind ? Ploc : Sloc) + (size_t)(bh * (NC - 1) + c) * 4096;
    if (kind) scan_unit<1, false, false>(P, ws, lane, tok0, CL, h, nullptr, fin);
    else scan_unit<0, true, false>(P, ws, lane, tok0, CL, h, nullptr, fin);
  }
}
__device__ __forceinline__ void phase_scan2(const Params& P, unsigned char* smem, int bid, int nb) {
  const int lane = threadIdx.x & 63, w = threadIdx.x >> 6;
  float* ws = (float*)smem + w * 256;
  float* Ploc = P.out + OUT_WK_S;
  float* Sloc = P.out + OUT_WV_S;
  for (int item = bid; item < NBH * 4; item += nb) {
    const int bh = item >> 2, row0 = (item & 3) * 16 + w * 4;
    float s[4];
    {
      const float* S0 = Sloc + (size_t)(bh * (NC - 1)) * 4096;
#pragma unroll
      for (int r = 0; r < 4; r++) s[r] = S0[(row0 + r) * 64 + lane];
    }
    for (int c = 1; c < NC - 1; c++) {
      const float* Pc = Ploc + (size_t)(bh * (NC - 1) + c) * 4096;
      float* Sc = Sloc + (size_t)(bh * (NC - 1) + c) * 4096;
      float acc[4];
#pragma unroll
      for (int r = 0; r < 4; r++) { acc[r] = Sc[(row0 + r) * 64 + lane]; ws[r * 64 + lane] = s[r]; }
      __builtin_amdgcn_wave_barrier();
      asm volatile("s_waitcnt lgkmcnt(0)" ::: "memory");
#pragma unroll 1
      for (int hf = 0; hf < 2; hf++) {
        float p[32];
#pragma unroll
        for (int i = 0; i < 32; i++) p[i] = Pc[(hf * 32 + i) * 64 + lane];
#pragma unroll
        for (int r = 0; r < 4; r++) {
#pragma unroll
          for (int i4 = 0; i4 < 8; i4++) {
            const float4 sv = *(const float4*)(ws + r * 64 + hf * 32 + 4 * i4);
            acc[r] = fmaf(sv.x, p[4 * i4], acc[r]); acc[r] = fmaf(sv.y, p[4 * i4 + 1], acc[r]);
            acc[r] = fmaf(sv.z, p[4 * i4 + 2], acc[r]); acc[r] = fmaf(sv.w, p[4 * i4 + 3], acc[r]);
          }
        }
      }
      __builtin_amdgcn_wave_barrier();
      asm volatile("s_waitcnt lgkmcnt(0)" ::: "memory");
#pragma unroll
      for (int r = 0; r < 4; r++) { s[r] = acc[r]; Sc[(row0 + r) * 64 + lane] = acc[r]; }
    }
  }
}
__device__ __forceinline__ void phase_scan3(const Params& P, unsigned char* smem, int bid, int nb) {
  const int lane = threadIdx.x & 63, w = threadIdx.x >> 6;
  float* ws = (float*)smem + w * (TS * REC);
  float* Sloc = P.out + OUT_WV_S;
  const int hb = nb >> 1;
  if (bid < hb) {
    for (int u = w * hb + bid; u < NBH * NC; u += 4 * hb) {
      const int bh = u >> 5, c = u & 31;
      const int tok0 = (bh >> 4) * TP + c * CL, h = bh & 15;
      const float* ip = (c > 0) ? (Sloc + (size_t)(bh * (NC - 1) + c - 1) * 4096) : nullptr;
      float* fin = (c == NC - 1) ? (P.out + OUT_WKV_P + (size_t)bh * 4096) : nullptr;
      if (c > 0) scan_unit<2, true, true>(P, ws, lane, tok0, CL, h, ip, fin);
      else scan_unit<0, true, true>(P, ws, lane, tok0, CL, h, ip, fin);
    }
  } else {
    for (int sb = w * (nb - hb) + (bid - hb); sb < 2048; sb += 4 * (nb - hb))
      scan_unit<2, true, true>(P, ws, lane, NPR + (sb >> 4) * 8, 8, sb & 15, P.state_wkv + (size_t)sb * 4096, P.out + OUT_WKV_S + (size_t)sb * 4096);
  }
}

__device__ __forceinline__ void phase_ln(const Params& P, int layer, int bid, int nb) {
  const int lane = threadIdx.x & 63, w = threadIdx.x >> 6;
  const float* gg = P.ln_g + layer * DM; const float* bb = P.ln_b + layer * DM;
  for (int tok = bid * 4 + w; tok < NTOK; tok += nb * 4) {
    f32x4* row = (f32x4*)(P.out + OUT_Y + (size_t)tok * DM);
    f32x4 v[4];
    float sum = 0.f;
#pragma unroll
    for (int i = 0; i < 4; i++) { v[i] = row[lane + 64 * i]; sum += v[i][0] + v[i][1] + v[i][2] + v[i][3]; }
    const float mean = wave_sum(sum) * (1.f / 1024.f);
    float sq = 0.f;
#pragma unroll
    for (int i = 0; i < 4; i++) { v[i] -= mean; sq += v[i][0] * v[i][0] + v[i][1] * v[i][1] + v[i][2] * v[i][2] + v[i][3] * v[i][3]; }
    const float rs = rsqrtf(wave_sum(sq) * (1.f / 1024.f) + 1e-5f);
#pragma unroll
    for (int i = 0; i < 4; i++) {
      const f32x4 g4 = ((const f32x4*)gg)[lane + 64 * i], b4 = ((const f32x4*)bb)[lane + 64 * i];
      const f32x4 o = v[i] * rs * g4 + b4;
      row[lane + 64 * i] = o;
      if (layer == 0) { uint2 ob; ob.x = pack2(o[0], o[1]); ob.y = pack2(o[2], o[3]); ((uint2*)(P.Rb + (size_t)tok * DM))[lane + 64 * i] = ob; }
    }
  }
}

__device__ __forceinline__ void attn_prompt_item(const Params& P, unsigned char* smem, int item) {
  const int qh = item & 1, hk = (item >> 1) & 3, n = (item >> 3) & 63, b = item >> 9;
  bf16_t* Ks = (bf16_t*)smem;
  bf16_t* Vs = Ks + 192 * 72;
  const bf16_t* K1 = P.XB; const bf16_t* VT1 = P.XB + (size_t)NTOK * 512;
  const bf16_t* Q1 = P.Kb; const bf16_t* G1 = P.Vb; bf16_t* AO = P.Gb;
  const int t = threadIdx.x, lane = t & 63, w = t >> 6;
  const int g = lane >> 4, lc = lane & 15;
  const int pos0 = (n - 1) * 128 + 64 * qh;
  __syncthreads();
#pragma unroll
  for (int i = 0; i < 6; i++) {
    const int idx = t + 256 * i; const int row = idx >> 3, ch = idx & 7; const int pos = pos0 + row;
    uint4 v = make_uint4(0, 0, 0, 0);
    if (pos >= 0) v = *(const uint4*)(K1 + ((size_t)(b * TP + pos)) * 256 + hk * 64 + ch * 8);
    *(uint4*)(Ks + row * 72 + ch * 8) = v;
  }
#pragma unroll
  for (int i = 0; i < 6; i++) {
    const int idx = t + 256 * i; const int d = idx / 24, ch = idx % 24; const int pos = pos0 + ch * 8;
    uint4 v = make_uint4(0, 0, 0, 0);
    if (pos >= 0) v = *(const uint4*)(VT1 + ((size_t)((b * 4 + hk) * 64 + d)) * TP + pos);
    *(uint4*)(Vs + d * 200 + ch * 8) = v;
  }
  __syncthreads();
  const int h = hk * 4 + w;
  const float slope = exp2f(-0.5f * (float)(h + 1));
  const float sink = P.att_sinks[h];
  for (int sb = 0; sb < 2; sb++) {
    const int i0 = 64 * qh + 32 * sb;
    const int tokb = b * TP + n * 128 + i0;
    bf16x8 qf[2][2];
#pragma unroll
    for (int nn = 0; nn < 2; nn++)
#pragma unroll
      for (int ks = 0; ks < 2; ks++) qf[nn][ks] = *(const bf16x8*)(Q1 + (size_t)(tokb + 16 * nn + lc) * DM + h * 64 + ks * 32 + g * 8);
    float mrun[2] = {sink, sink}, lrun[2] = {1.f, 1.f};
    f32x4 O[4][2];
#pragma unroll
    for (int dm = 0; dm < 4; dm++) { O[dm][0] = (f32x4){0.f, 0.f, 0.f, 0.f}; O[dm][1] = (f32x4){0.f, 0.f, 0.f, 0.f}; }
    for (int kt = 0; kt < 3; kt++) {
      if (n == 0 && (qh + kt) < 2) continue;
      f32x4 S[4][2];
#pragma unroll
      for (int mm = 0; mm < 4; mm++) { S[mm][0] = (f32x4){0.f, 0.f, 0.f, 0.f}; S[mm][1] = (f32x4){0.f, 0.f, 0.f, 0.f}; }
#pragma unroll
      for (int ks = 0; ks < 2; ks++)
#pragma unroll
        for (int mm = 0; mm < 4; mm++) {
          const bf16x8 kf = *(const bf16x8*)(Ks + (kt * 64 + mm * 16 + lc) * 72 + ks * 32 + g * 8);
          S[mm][0] = __builtin_amdgcn_mfma_f32_16x16x32_bf16(kf, qf[0][ks], S[mm][0], 0, 0, 0);
          S[mm][1] = __builtin_amdgcn_mfma_f32_16x16x32_bf16(kf, qf[1][ks], S[mm][1], 0, 0, 0);
        }
#pragma unroll
      for (int nn = 0; nn < 2; nn++) {
        const int qi = i0 + 16 * nn + lc;
        float mx = mrun[nn];
#pragma unroll
        for (int mm = 0; mm < 4; mm++)
#pragma unroll
          for (int r = 0; r < 4; r++) {
            const int j = 64 * (qh + kt) + 16 * mm + 4 * g + r;
            const int dist = 128 + qi - j;
            const bool live = (dist >= 0) && (dist < 128);
            const float sv = live ? (S[mm][nn][r] * 0.125f - slope * (float)dist) : -1e30f;
            S[mm][nn][r] = sv; mx = fmaxf(mx, sv);
          }
        mx = fmaxf(mx, __shfl_xor(mx, 16)); mx = fmaxf(mx, __shfl_xor(mx, 32));
        const float corr = __expf(mrun[nn] - mx); mrun[nn] = mx;
        float sum = 0.f;
#pragma unroll
        for (int mm = 0; mm < 4; mm++)
#pragma unroll
          for (int r = 0; r < 4; r++) { const float pp = __expf(S[mm][nn][r] - mx); S[mm][nn][r] = pp; sum += pp; }
        sum += __shfl_xor(sum, 16); sum += __shfl_xor(sum, 32);
        lrun[nn] = lrun[nn] * corr + sum;
#pragma unroll
        for (int dm = 0; dm < 4; dm++) { O[dm][nn][0] *= corr; O[dm][nn][1] *= corr; O[dm][nn][2] *= corr; O[dm][nn][3] *= corr; }
      }
#pragma unroll
      for (int k2 = 0; k2 < 2; k2++) {
        bf16x8 pf[2];
#pragma unroll
        for (int nn = 0; nn < 2; nn++) {
          const unsigned u0 = pack2(S[2 * k2][nn][0], S[2 * k2][nn][1]), u1 = pack2(S[2 * k2][nn][2], S[2 * k2][nn][3]);
          const unsigned u2 = pack2(S[2 * k2 + 1][nn][0], S[2 * k2 + 1][nn][1]), u3 = pack2(S[2 * k2 + 1][nn][2], S[2 * k2 + 1][nn][3]);
          const uint4 uu = make_uint4(u0, u1, u2, u3);
          pf[nn] = *(const bf16x8*)&uu;
        }
#pragma unroll
        for (int dm = 0; dm < 4; dm++) {
          const bf16_t* vb = Vs + (dm * 16 + lc) * 200 + kt * 64 + k2 * 32 + 4 * g;
          const uint2 lo = *(const uint2*)vb, hi = *(const uint2*)(vb + 16);
          const uint4 uu = make_uint4(lo.x, lo.y, hi.x, hi.y);
          const bf16x8 vf = *(const bf16x8*)&uu;
          O[dm][0] = __builtin_amdgcn_mfma_f32_16x16x32_bf16(vf, pf[0], O[dm][0], 0, 0, 0);
          O[dm][1] = __builtin_amdgcn_mfma_f32_16x16x32_bf16(vf, pf[1], O[dm][1], 0, 0, 0);
        }
      }
    }
#pragma unroll
    for (int nn = 0; nn < 2; nn++) {
      const float inv = 1.f / lrun[nn];
      const size_t tok = (size_t)(tokb + 16 * nn + lc);
#pragma unroll
      for (int dm = 0; dm < 4; dm++) {
        const int d = dm * 16 + 4 * g;
        const uint2 gv = *(const uint2*)(G1 + tok * DM + h * 64 + d);
        const float g0 = __uint_as_float(gv.x << 16), g1 = __uint_as_float(gv.x & 0xffff0000u);
        const float g2 = __uint_as_float(gv.y << 16), g3 = __uint_as_float(gv.y & 0xffff0000u);
        uint2 o;
        o.x = pack2(O[dm][nn][0] * inv * g0 * sigmoidf_(g0), O[dm][nn][1] * inv * g1 * sigmoidf_(g1));
        o.y = pack2(O[dm][nn][2] * inv * g2 * sigmoidf_(g2), O[dm][nn][3] * inv * g3 * sigmoidf_(g3));
        *(uint2*)(AO + tok * DM + h * 64 + d) = o;
      }
    }
  }
}

__device__ __forceinline__ void attn_sample_item(const Params& P, unsigned char* smem, int item) {
  const int b = item >> 2, hk = item & 3;
  const int t = threadIdx.x, lane = t & 63, w = t >> 6;
  float* qs = (float*)smem + w * 512;
  float* ps = (float*)smem + 2048 + w * (8 * 136);
  const bf16_t* K1 = P.XB; const bf16_t* V1 = P.XB + (size_t)NTOK * 256;
  const bf16_t* Q1 = P.Kb; const bf16_t* G1 = P.Vb; bf16_t* AO = P.Gb;
  const int h = hk * 4 + w;
  const float slope = exp2f(-0.5f * (float)(h + 1));
  const float sink = P.att_sinks[h];
  const int tok0 = NPR + b * 8;
  __syncthreads();
  for (int idx = t; idx < 120 * 16; idx += 256) {
    const int row = idx >> 4, c4 = idx & 15;
    const size_t so = ((size_t)(b * 128 + row + 8)) * 256 + hk * 64 + c4 * 4;
    const size_t dofs = ((size_t)(b * 128 + row)) * 256 + hk * 64 + c4 * 4;
    *(float4*)(P.out + OUT_WK_S + dofs) = *(const float4*)(P.cache_k + so);
    *(float4*)(P.out + OUT_WV_S + dofs) = *(const float4*)(P.cache_v + so);
  }
#pragma unroll
  for (int i = 0; i < 8; i++) qs[i * 64 + lane] = bf2f(Q1[(size_t)(tok0 + i) * DM + h * 64 + lane]);
  __builtin_amdgcn_wave_barrier();
  asm volatile("s_waitcnt lgkmcnt(0)" ::: "memory");
  float sc[3][8];
#pragma unroll
  for (int ksel = 0; ksel < 3; ksel++) {
    float acc[8];
#pragma unroll
    for (int i = 0; i < 8; i++) acc[i] = 0.f;
    const float* kp = P.cache_k + ((size_t)(b * 128 + lane + 64 * (ksel & 1))) * 256 + hk * 64;
    const bf16_t* kpb = K1 + (size_t)(tok0 + (lane & 7)) * 256 + hk * 64;
#pragma unroll 2
    for (int d4 = 0; d4 < 16; d4++) {
      float4 kv;
      if (ksel < 2) kv = ((const float4*)kp)[d4];
      else { const uint2 u = ((const uint2*)kpb)[d4]; kv = make_float4(__uint_as_float(u.x << 16), __uint_as_float(u.x & 0xffff0000u), __uint_as_float(u.y << 16), __uint_as_float(u.y & 0xffff0000u)); }
#pragma unroll
      for (int i = 0; i < 8; i++) {
        const float4 qv = *(const float4*)(qs + i * 64 + 4 * d4);
        acc[i] = fmaf(qv.x, kv.x, acc[i]); acc[i] = fmaf(qv.y, kv.y, acc[i]); acc[i] = fmaf(qv.z, kv.z, acc[i]); acc[i] = fmaf(qv.w, kv.w, acc[i]);
      }
    }
#pragma unroll
    for (int i = 0; i < 8; i++) {
      int dist; bool live;
      if (ksel < 2) { const int j = lane + 64 * ksel; dist = 128 + i - j; live = (j > i); }
      else { dist = i - lane; live = (lane <= i); }
      sc[ksel][i] = live ? (acc[i] * 0.125f - slope * (float)dist) : -1e30f;
    }
  }
#pragma unroll
  for (int i = 0; i < 8; i++) {
    float mx = fmaxf(fmaxf(sc[0][i], sc[1][i]), sc[2][i]);
    mx = fmaxf(wave_max(mx), sink);
    const float p0 = __expf(sc[0][i] - mx), p1 = __expf(sc[1][i] - mx), p2 = __expf(sc[2][i] - mx);
    const float den = wave_sum(p0 + p1 + p2) + __expf(sink - mx);
    const float inv = 1.f / den;
    ps[i * 136 + lane] = p0 * inv; ps[i * 136 + 64 + lane] = p1 * inv;
    if (lane < 8) ps[i * 136 + 128 + lane] = p2 * inv;
  }
  __builtin_amdgcn_wave_barrier();
  asm volatile("s_waitcnt lgkmcnt(0)" ::: "memory");
  float o[8];
#pragma unroll
  for (int i = 0; i < 8; i++) o[i] = 0.f;
  for (int j = 0; j < 136; j++) {
    float v;
    if (j < 128) v = P.cache_v[((size_t)(b * 128 + j)) * 256 + hk * 64 + lane];
    else v = bf2f(V1[(size_t)(tok0 + j - 128) * 256 + hk * 64 + lane]);
#pragma unroll
    for (int i = 0; i < 8; i++) o[i] = fmaf(ps[i * 136 + j], v, o[i]);
  }
#pragma unroll
  for (int i = 0; i < 8; i++) {
    const size_t off = (size_t)(tok0 + i) * DM + h * 64 + lane;
    const float gt = bf2f(G1[off]);
    AO[off] = f2bf(o[i] * gt * sigmoidf_(gt));
  }
}
__device__ __forceinline__ void phase_attn(const Params& P, unsigned char* smem, int bid, int nb) {
  for (int item = bid; item < 1024 + 512; item += nb) {
    if (item < 1024) attn_prompt_item(P, smem, item);
    else attn_sample_item(P, smem, item - 1024);
  }
}

#if MULTI_LAUNCH
#define PH_BARRIER(ph)
#else
#define PH_BARRIER(ph) do { if ((ph) + 1 < P.phase_end) xcd_barrier(xb); } while (0)
#endif
#define RUN_PH(ph, call) do { if (P.phase_begin <= (ph) && (ph) < P.phase_end) { if ((REPMASK >> (ph)) & 1) { call; PH_BARRIER(ph); } call; PH_BARRIER(ph); } } while (0)

__global__ void __launch_bounds__(256, 2) fwd_kernel(Params P) {
  __shared__ __attribute__((aligned(16))) unsigned char smem[SMEM_BYTES];
  const int bid = blockIdx.x, nb = gridDim.x;
#if !MULTI_LAUNCH
  __shared__ uint4 xb_words;
  if (threadIdx.x == 0) xb_words = make_uint4(0u, 0u, 0u, 0u);
  __syncthreads();
  XcdBarrier xb = xcd_barrier_post(P.bar, (volatile LAS unsigned*)&xb_words);
#endif
#if (PHMASK >> 0) & 1
  RUN_PH(0, phase_prep(P, smem, bid, nb));
#endif
#if (PHMASK >> 1) & 1
  RUN_PH(1, gemm_phase<1>(P, smem, bid, nb));
#endif
#if (PHMASK >> 2) & 1
  RUN_PH(2, gemm_phase<2>(P, smem, bid, nb));
#endif
#if (PHMASK >> 3) & 1
  RUN_PH(3, phase_scan1(P, smem, bid, nb));
#endif
#if (PHMASK >> 4) & 1
  RUN_PH(4, phase_scan2(P, smem, bid, nb));
#endif
#if (PHMASK >> 5) & 1
  RUN_PH(5, phase_scan3(P, smem, bid, nb));
#endif
#if (PHMASK >> 6) & 1
  RUN_PH(6, gemm_phase<3>(P, smem, bid, nb));
#endif
#if (PHMASK >> 7) & 1
  RUN_PH(7, phase_ln(P, 0, bid, nb));
#endif
#if (PHMASK >> 8) & 1
  RUN_PH(8, gemm_phase<4>(P, smem, bid, nb));
#endif
#if (PHMASK >> 9) & 1
  RUN_PH(9, phase_attn(P, smem, bid, nb));
#endif
#if (PHMASK >> 10) & 1
  RUN_PH(10, gemm_phase<5>(P, smem, bid, nb));
#endif
#if (PHMASK >> 11) & 1
  RUN_PH(11, phase_ln(P, 1, bid, nb));
#endif
#if PROBE
  xcd_barrier(xb);
  gemm_phase<6>(P, smem, bid, nb);
#endif
#if !MULTI_LAUNCH
  if (P.phase_end > NPHASE) cg::this_grid().sync();
#endif
}

extern "C" void kernel_launch(void* const* d_in, const int* in_sizes, int n_in, void* d_out, int out_size, void* d_ws, size_t ws_size, hipStream_t stream) {
  Params P{};
  P.x_prompt = (const float*)d_in[0]; P.x_sample = (const float*)d_in[1]; P.state_wkv = (const float*)d_in[2]; P.state_shift = (const float*)d_in[3];
  P.cache_k = (const float*)d_in[4]; P.cache_v = (const float*)d_in[5]; P.ln_g = (const float*)d_in[6]; P.ln_b = (const float*)d_in[7];
  P.mu = (const float*)d_in[8]; P.w_in = (const float*)d_in[9]; P.w0 = (const float*)d_in[10]; P.w1 = (const float*)d_in[11]; P.w2 = (const float*)d_in[12];
  P.a0 = (const float*)d_in[13]; P.a1 = (const float*)d_in[14]; P.a2 = (const float*)d_in[15]; P.k_k = (const float*)d_in[16]; P.k_a = (const float*)d_in[17];
  P.r_k = (const float*)d_in[18]; P.gn_g = (const float*)d_in[19]; P.gn_b = (const float*)d_in[20]; P.w_out = (const float*)d_in[21];
  P.att_w_in = (const float*)d_in[22]; P.att_sinks = (const float*)d_in[23]; P.att_w_out = (const float*)d_in[24];
  P.out = (float*)d_out;
  unsigned char* ws = (unsigned char*)d_ws;
  size_t off = 0;
  auto take = [&](size_t bytes) { unsigned char* p = ws + off; off += (bytes + 255) & ~(size_t)255; return p; };
  P.bar = (unsigned*)take(16384);
  P.WtIn0 = (bf16_t*)take((size_t)4352 * DM * 2);
  P.W2t = (bf16_t*)take((size_t)DM * 64 * 2);
  P.A2t = (bf16_t*)take((size_t)DM * 64 * 2);
  P.WtOut0 = (bf16_t*)take((size_t)DM * DM * 2);
  P.WtIn1 = (bf16_t*)take((size_t)2560 * DM * 2);
  P.WtOut1 = (bf16_t*)take((size_t)DM * DM * 2);
  P.XB = (bf16_t*)take((size_t)NTOK * DM * 2);
  P.XXB = (bf16_t*)take((size_t)NTOK * DM * 2);
  P.Rb = (bf16_t*)take((size_t)NTOK * DM * 2);
  P.Kb = (bf16_t*)take((size_t)NTOK * DM * 2);
  P.Vb = (bf16_t*)take((size_t)NTOK * DM * 2);
  P.Gb = (bf16_t*)take((size_t)NTOK * DM * 2);
  P.H1 = (bf16_t*)take((size_t)NTOK * 64 * 2);
  P.H2 = (bf16_t*)take((size_t)NTOK * 64 * 2);
  P.MU16 = (bf16_t*)take((size_t)6 * DM * 2);
  if (off > ws_size) { fprintf(stderr, "workspace too small: need %zu have %zu\n", off, ws_size); return; }
#if MULTI_LAUNCH
  for (int ph = 0; ph < NPHASE; ph++) {
    P.phase_begin = ph; P.phase_end = ph + 1;
    hipLaunchKernelGGL(fwd_kernel, dim3(512), dim3(256), 0, stream, P);
  }
#else
  static int grid_blocks = 0;
  if (!grid_blocks) {
    int dev = 0, cus = 0, per_cu = 0;
    hipGetDevice(&dev);
    hipDeviceGetAttribute(&cus, hipDeviceAttributeMultiprocessorCount, dev);
    hipOccupancyMaxActiveBlocksPerMultiprocessor(&per_cu, fwd_kernel, 256, 0);
    if (per_cu > 2) per_cu = 2;
    if (per_cu < 1) per_cu = 1;
    grid_blocks = cus * per_cu;
  }
  hipMemsetAsync(P.bar, 0, 16384, stream);
  P.phase_begin = 0; P.phase_end = NPHASE;
  void* args[] = {&P};
  hipError_t e = hipLaunchCooperativeKernel((void*)fwd_kernel, dim3(grid_blocks), dim3(256), args, 0, stream);
  if (e != hipSuccess) fprintf(stderr, "cooperative launch failed: %s (grid %d)\n", hipGetErrorString(e), grid_blocks);
#endif
}
```

```cpp
#include <hip/hip_runtime.h>
#include <hip/hip_cooperative_groups.h>
#include <stdint.h>
#include <cstdio>
namespace cg = cooperative_groups;

#ifndef PHMASK
#define PHMASK 0xFFF
#endif
#ifndef PROBE
#define PROBE 0
#endif
#ifndef REPMASK
#define REPMASK 0
#endif
#ifndef MULTI_LAUNCH
#define MULTI_LAUNCH 0
#endif

typedef unsigned short bf16_t;
typedef _Float16 f16_t;
typedef __attribute__((ext_vector_type(8))) short bf16x8;
typedef __attribute__((ext_vector_type(4))) float f32x4;
typedef __attribute__((ext_vector_type(4))) unsigned u32x4;

#define DM 1024
#define NTOK 17408
#define NPR 16384
#define TP 8192
#define NC 32
#define CL 256
#define NBH 32
#define ALPHA_F 1.41421356237f
#define SMEM_BYTES (61 * 1024)
#define NPHASE 12

#define OUT_Y 0
#define OUT_WKV_P 17825792
#define OUT_SH_P 17956864
#define OUT_WK_P 17958912
#define OUT_WV_P 18024448
#define OUT_WKV_S 18089984
#define OUT_SH_S 26478592
#define OUT_WK_S 26609664
#define OUT_WV_S 30803968

struct Params {
  const float *x_prompt, *x_sample, *state_wkv, *state_shift, *cache_k, *cache_v, *ln_g, *ln_b;
  const float *mu, *w_in, *w0, *w1, *w2, *a0, *a1, *a2, *k_k, *k_a, *r_k, *gn_g, *gn_b, *w_out;
  const float *att_w_in, *att_sinks, *att_w_out;
  float* out;
  unsigned* bar;
  bf16_t *WtIn0, *W2t, *A2t, *WtOut0, *WtIn1, *WtOut1;
  bf16_t *XB, *XXB;
  bf16_t *Rb, *Kb, *Vb, *Gb;
  bf16_t *H1, *H2, *MU16;
  int phase_begin, phase_end;
};

typedef __bf16 hbf2 __attribute__((ext_vector_type(2)));
typedef float f32x2_ __attribute__((ext_vector_type(2)));
__device__ __forceinline__ unsigned pack2(float a, float b) {
  const f32x2_ v = {a, b};
  return __builtin_bit_cast(unsigned, __builtin_convertvector(v, hbf2));
}
__device__ __forceinline__ bf16_t f2bf(float f) { return (bf16_t)(pack2(f, 0.f) & 0xffffu); }
__device__ __forceinline__ float bf2f(bf16_t h) { return __uint_as_float(((unsigned)h) << 16); }
__device__ __forceinline__ float wave_sum(float x) {
#pragma unroll
  for (int o = 32; o >= 1; o >>= 1) x += __shfl_xor(x, o);
  return x;
}
__device__ __forceinline__ float wave_max(float x) {
#pragma unroll
  for (int o = 32; o >= 1; o >>= 1) x = fmaxf(x, __shfl_xor(x, o));
  return x;
}
__device__ __forceinline__ float quad_sum(float x) {
  x += __builtin_bit_cast(float, __builtin_amdgcn_update_dpp(0, __builtin_bit_cast(int, x), 0xB1, 0xF, 0xF, true));
  x += __builtin_bit_cast(float, __builtin_amdgcn_update_dpp(0, __builtin_bit_cast(int, x), 0x4E, 0xF, 0xF, true));
  return x;
}
__device__ __forceinline__ float sigmoidf_(float x) { return 1.f / (1.f + __expf(-x)); }
__device__ __forceinline__ const float* xin_row(const Params& P, int m) {
  return (m < NPR) ? (P.x_prompt + (size_t)m * DM) : (P.x_sample + (size_t)(m - NPR) * DM);
}

#define XB_TMO      128
#define XB_XCNT(j)  (256  + 64 * (j))
#define XB_XSUB(j)  (1280 + 64 * (j))
#define XB_XGEN(j)  (2304 + 64 * (j))
#define XB_TOP      3328
#define XB_TOPGEN   3392
#define XCD_BAR_WORDS 3456
#define XB_SPIN_CAP (1u << 22)
#define LAS __attribute__((address_space(3)))
__device__ __forceinline__ unsigned xb_ld(unsigned* p) { return __hip_atomic_load(p, __ATOMIC_RELAXED, __HIP_MEMORY_SCOPE_AGENT); }
__device__ __forceinline__ unsigned xb_add(unsigned* p, unsigned v) { return __hip_atomic_fetch_add(p, v, __ATOMIC_RELAXED, __HIP_MEMORY_SCOPE_AGENT); }
__device__ __forceinline__ unsigned xb_xcc_id() { return (unsigned)__builtin_amdgcn_s_getreg((3 << 11) | 20) & 0xFu; }
#define XB_SPIN(cond, bar) do { unsigned _sp = 0; while (cond) { __builtin_amdgcn_s_sleep(1); \
    if ((++_sp & 255u) == 0u) { if (xb_ld(&(bar)[XB_TMO])) break; if (_sp > XB_SPIN_CAP) { atomicAdd(&(bar)[XB_TMO], 1u); break; } } } } while (0)
struct XcdBarrier { unsigned* bar; unsigned x; volatile LAS unsigned* st; };
__device__ __forceinline__ XcdBarrier xcd_barrier_post(unsigned* bar, volatile LAS unsigned* st) {
  XcdBarrier b; b.bar = bar; b.x = xb_xcc_id(); b.st = st;
  if (threadIdx.x == 0) (void)xb_add(&bar[XB_XCNT(b.x)], 1u);
  return b;
}
__device__ __forceinline__ void xcd_barrier_complete(unsigned* bar, unsigned x, unsigned& nloc, unsigned& nx) {
  const unsigned G = gridDim.x * gridDim.y * gridDim.z;
  unsigned sum, cnt, mine, sp = 0u;
  for (;;) {
    sum = 0u; cnt = 0u; mine = 0u;
#pragma unroll
    for (unsigned j = 0; j < 16; ++j) { const unsigned c = xb_ld(&bar[XB_XCNT(j)]); sum += c; cnt += (c > 0u) ? 1u : 0u; mine = (j == x) ? c : mine; }
    if (sum == G) break;
    __builtin_amdgcn_s_sleep(1);
    if ((++sp & 255u) == 0u) { if (xb_ld(&bar[XB_TMO])) break; if (sp > XB_SPIN_CAP) { atomicAdd(&bar[XB_TMO], 1u); break; } }
  }
  nloc = mine > 0u ? mine : 1u; nx = cnt > 0u ? cnt : 1u;
}
__device__ __forceinline__ void xcd_barrier(const XcdBarrier& b) {
  asm volatile("s_waitcnt vmcnt(0)" ::: "memory");
  __syncthreads();
  if (threadIdx.x == 0) {
    unsigned* bar = b.bar;
    __builtin_amdgcn_s_waitcnt(0);
    unsigned nloc = b.st[0], nx = b.st[1];
    if (nloc == 0u) { xcd_barrier_complete(bar, b.x, nloc, nx); b.st[0] = nloc; b.st[1] = nx; }
    const unsigned old = xb_add(&bar[XB_XSUB(b.x)], 1u);
    const unsigned gen = old / nloc;
    if (old + 1u == (gen + 1u) * nloc) {
      __builtin_amdgcn_fence(__ATOMIC_RELEASE, "agent");
      asm volatile("s_waitcnt vmcnt(0)" ::: "memory");
      const unsigned og = xb_add(&bar[XB_TOP], 1u);
      const unsigned tg = og / nx;
      if (og + 1u == (tg + 1u) * nx) xb_add(&bar[XB_TOPGEN], 1u);
      else XB_SPIN(xb_ld(&bar[XB_TOPGEN]) == tg, bar);
      __builtin_amdgcn_fence(__ATOMIC_ACQUIRE, "agent");
      xb_add(&bar[XB_XGEN(b.x)], 1u);
      asm volatile("s_waitcnt vmcnt(0)" ::: "memory");
    } else {
      XB_SPIN(xb_ld(&bar[XB_XGEN(b.x)]) == gen, bar);
      __builtin_amdgcn_fence(__ATOMIC_ACQUIRE, "agent");
      asm volatile("s_waitcnt vmcnt(0)" ::: "memory");
    }
  }
  __syncthreads();
}

__device__ __forceinline__ unsigned short f2h_bits(float f) { const _Float16 h = (_Float16)f; return __builtin_bit_cast(unsigned short, h); }
__device__ __forceinline__ unsigned pack2h(float a, float b) { return (unsigned)f2h_bits(a) | ((unsigned)f2h_bits(b) << 16); }
__device__ __forceinline__ void transpose_tile(const float* __restrict__ src, int ld, int k0, int n0, bf16_t* __restrict__ dst, int ldd, float* tile, bool half = false) {
  const int t = threadIdx.x;
  {
    const int n = t & 63, kq = t >> 6;
#pragma unroll 4
    for (int i = 0; i < 16; i++) { const int k = i * 4 + kq; tile[k * 65 + n] = src[(size_t)(k0 + k) * ld + n0 + n]; }
  }
  __syncthreads();
  {
    const int k = t & 63, nq = t >> 6;
#pragma unroll 4
    for (int i = 0; i < 16; i++) { const int n2 = i * 4 + nq; const float v_ = tile[k * 65 + n2]; dst[(size_t)(n0 + n2) * ldd + k0 + k] = half ? f2h_bits(v_) : f2bf(v_); }
  }
  __syncthreads();
}

__device__ __forceinline__ void phase_prep(const Params& P, unsigned char* smem, int bid, int nb) {
  float* tile = (float*)smem;
  const int t = threadIdx.x;
  const int NITEMS = 2242 + 4352 + 130;
  for (int id = bid; id < NITEMS; id += nb) {
    if (id < 1024) { const int p = id >> 8, r = id & 255; transpose_tile(P.w_in + (size_t)p * DM * DM, DM, (r >> 4) * 64, (r & 15) * 64, P.WtIn0 + (size_t)p * DM * DM, DM, tile, true); }
    else if (id < 1040) transpose_tile(P.w1, 64, (id - 1024) * 64, 0, P.WtIn0 + (size_t)4096 * DM, DM, tile, true);
    else if (id < 1056) transpose_tile(P.a1, 64, (id - 1040) * 64, 0, P.WtIn0 + (size_t)4224 * DM, DM, tile, true);
    else if (id < 1072) transpose_tile(P.w2, DM, 0, (id - 1056) * 64, P.W2t, 64, tile);
    else if (id < 1088) transpose_tile(P.a2, DM, 0, (id - 1072) * 64, P.A2t, 64, tile);
    else if (id < 1344) { const int r = id - 1088; transpose_tile(P.w_out, DM, (r >> 4) * 64, (r & 15) * 64, P.WtOut0, DM, tile); }
    else if (id < 1984) { const int r = id - 1344; transpose_tile(P.att_w_in, 2560, (r / 40) * 64, (r % 40) * 64, P.WtIn1, DM, tile); }
    else if (id < 2240) { const int r = id - 1984; transpose_tile(P.att_w_out, DM, (r >> 4) * 64, (r & 15) * 64, P.WtOut1, DM, tile); }
    else if (id < 2242) {
      uint4* z = (uint4*)(P.WtIn0 + (size_t)(id == 2240 ? 4160 : 4288) * DM);
      for (int i = t; i < 8192; i += 256) z[i] = make_uint4(0, 0, 0, 0);
      if (id == 2240) for (int i = t; i < 6 * DM; i += 256) P.MU16[i] = f2h_bits(P.mu[i]);
    } else if (id < 2242 + 4352) {
      const int it = id - 2242;
#pragma unroll
      for (int q = 0; q < 4; q++) {
        const int m = it * 4 + q;
        const float4 x = ((const float4*)xin_row(P, m))[t];
        float4 pv = make_float4(0.f, 0.f, 0.f, 0.f);
        if (m < NPR) { if ((m & (TP - 1)) != 0) pv = ((const float4*)xin_row(P, m - 1))[t]; }
        else { const int ms = m - NPR; if ((ms & 7) != 0) pv = ((const float4*)xin_row(P, m - 1))[t]; else pv = ((const float4*)(P.state_shift + (size_t)(ms >> 3) * DM))[t]; }
        uint2 xb, xxb;
        xb.x = pack2h(x.x, x.y); xb.y = pack2h(x.z, x.w);
        xxb.x = pack2h(pv.x - x.x, pv.y - x.y); xxb.y = pack2h(pv.z - x.z, pv.w - x.w);
        ((uint2*)(P.XB + (size_t)m * DM))[t] = xb;
        ((uint2*)(P.XXB + (size_t)m * DM))[t] = xxb;
      }
    } else {
      const int r = id - (2242 + 4352);
      if (r < 2) ((float4*)(P.out + OUT_SH_P + (size_t)r * DM))[t] = ((const float4*)(P.x_prompt + ((size_t)r * TP + TP - 1) * DM))[t];
      else { const int b = r - 2; ((float4*)(P.out + OUT_SH_S + (size_t)b * DM))[t] = ((const float4*)(P.x_sample + ((size_t)b * 8 + 7) * DM))[t]; }
    }
  }
}

#define LDB 48
typedef _Float16 f16x8 __attribute__((ext_vector_type(8)));
typedef _Float16 f16x2 __attribute__((ext_vector_type(2)));
__device__ __forceinline__ unsigned xs16(unsigned x, unsigned d, unsigned m) {
  const f16x2 r = __builtin_elementwise_fma(__builtin_bit_cast(f16x2, d), __builtin_bit_cast(f16x2, m), __builtin_bit_cast(f16x2, x));
  return __builtin_bit_cast(unsigned, r);
}
template <int MODE>
__device__ __forceinline__ void gemm_tile(const Params& P, unsigned char* smem, int mt, int nt) {
  constexpr int KT = (MODE == 2) ? 1 : 16;
  bf16_t* Asb[2]; bf16_t* Bsb[2];
  Asb[0] = (bf16_t*)smem; Bsb[0] = Asb[0] + 128 * LDB; Asb[1] = Bsb[0] + 128 * LDB; Bsb[1] = Asb[1] + 128 * LDB;
  const int t = threadIdx.x, lane = t & 63, w = t >> 6;
  const int wm = w >> 1, wn = w & 1;
  const int g = lane >> 4, lc = lane & 15;
  const int lr = t >> 2, lc4 = t & 3;
  const int m0 = mt * 128, n0 = nt * 128;

  const bf16_t* Ap; const bf16_t* A2p = nullptr; const bf16_t* mup = nullptr; const bf16_t* Bp; int lda, ldb;
  if (MODE == 1) {
    const int p = (nt < 32) ? (nt >> 3) : (4 + (nt - 32));
    Ap = P.XB; A2p = P.XXB; lda = DM; mup = P.MU16 + (size_t)p * DM;
    Bp = P.WtIn0 + (size_t)((nt < 32) ? n0 : (4096 + (nt - 32) * 128)) * DM; ldb = DM;
  } else if (MODE == 2) {
    Ap = (nt < 8) ? P.H1 : P.H2; lda = 64;
    Bp = ((nt < 8) ? P.W2t : P.A2t) + (size_t)((nt & 7) * 128) * 64; ldb = 64;
  } else if (MODE == 3) { Ap = P.Gb; lda = DM; Bp = P.WtOut0 + (size_t)n0 * DM; ldb = DM; }
  else if (MODE == 4 || MODE == 6) { Ap = P.Rb; lda = DM; Bp = P.WtIn1 + (size_t)n0 * DM; ldb = DM; }
  else { Ap = P.Gb; lda = DM; Bp = P.WtOut1 + (size_t)n0 * DM; ldb = DM; }

  f32x4 acc[4][4];
#pragma unroll
  for (int i = 0; i < 4; i++)
#pragma unroll
    for (int j = 0; j < 4; j++) acc[i][j] = (f32x4){0.f, 0.f, 0.f, 0.f};

  u32x4 ra[2][2][2], rb[2][2][2], ra2[2][2][2], rmu[2][2];
  const unsigned voffA = (unsigned)(lr * lda + lc4 * 8) * 2u;
  const unsigned voffB = (unsigned)(lr * ldb + lc4 * 8) * 2u;
  const char* baseA = (const char*)(Ap + (size_t)m0 * lda);
  const char* baseA2 = (const char*)(A2p + (size_t)m0 * lda);
  const char* baseB = (const char*)Bp;
#define LOADH(S_, kt_, H_) do { if ((kt_) < KT) { \
    _Pragma("unroll") for (int ii_ = 0; ii_ < 2; ii_++) { \
      const size_t uo_ = ((size_t)(64 * ii_) * lda + (size_t)(kt_) * 64 + 32 * (H_)) * 2; \
      const size_t uob_ = ((size_t)(64 * ii_) * ldb + (size_t)(kt_) * 64 + 32 * (H_)) * 2; \
      ra[S_][H_][ii_] = *(const u32x4*)(baseA + uo_ + voffA); \
      if (MODE == 1) ra2[S_][H_][ii_] = *(const u32x4*)(baseA2 + uo_ + voffA); \
      rb[S_][H_][ii_] = *(const u32x4*)(baseB + uob_ + voffB); \
    } \
    if (MODE == 1) rmu[S_][H_] = *(const u32x4*)(mup + (kt_) * 64 + 32 * (H_) + lc4 * 8); \
  } } while (0)
#define STOREH(S_, H_, B_) do { \
    _Pragma("unroll") for (int ii_ = 0; ii_ < 2; ii_++) { \
      const int row_ = lr + 64 * ii_; \
      u32x4 av_ = ra[S_][H_][ii_]; \
      if (MODE == 1) { \
        const u32x4 xv_ = ra[S_][H_][ii_], dv_ = ra2[S_][H_][ii_], mv_ = rmu[S_][H_]; \
        av_ = (u32x4){xs16(xv_.x, dv_.x, mv_.x), xs16(xv_.y, dv_.y, mv_.y), xs16(xv_.z, dv_.z, mv_.z), xs16(xv_.w, dv_.w, mv_.w)}; \
      } \
      *(u32x4*)(Asb[B_] + row_ * LDB + lc4 * 8) = av_; \
      *(u32x4*)(Bsb[B_] + row_ * LDB + lc4 * 8) = rb[S_][H_][ii_]; \
    } \
  } while (0)
#define COMPUTE_SUB(B_) do { if (!(MODE == 6 && PROBE == 3)) { \
    bf16x8 af[4], bfr[4]; \
    _Pragma("unroll") for (int i = 0; i < 4; i++) af[i] = *(const bf16x8*)(Bsb[B_] + (wn * 64 + i * 16 + lc) * LDB + g * 8); \
    _Pragma("unroll") for (int j = 0; j < 4; j++) bfr[j] = *(const bf16x8*)(Asb[B_] + (wm * 64 + j * 16 + lc) * LDB + g * 8); \
    _Pragma("unroll") for (int i = 0; i < 4; i++) \
      _Pragma("unroll") for (int j = 0; j < 4; j++) { \
        if (MODE == 1) acc[i][j] = __builtin_amdgcn_mfma_f32_16x16x32_f16(__builtin_bit_cast(f16x8, af[i]), __builtin_bit_cast(f16x8, bfr[j]), acc[i][j], 0, 0, 0); \
        else acc[i][j] = __builtin_amdgcn_mfma_f32_16x16x32_bf16(af[i], bfr[j], acc[i][j], 0, 0, 0); \
      } \
  } } while (0)
  __syncthreads();
  LOADH(0, 0, 0); LOADH(0, 0, 1); LOADH(1, 1, 0); LOADH(1, 1, 1);
  STOREH(0, 0, 0);
  LOADH(0, 2, 0);
  __syncthreads();
  for (int kt = 0; kt < KT; kt += 2) {
    STOREH(0, 1, 1); LOADH(0, kt + 2, 1);
    COMPUTE_SUB(0);
    if (!(MODE == 6 && PROBE == 5)) __syncthreads();
    if (kt + 1 < KT) { STOREH(1, 0, 0); LOADH(1, kt + 3, 0); }
    COMPUTE_SUB(1);
    __syncthreads();
    if (kt + 1 < KT) {
      STOREH(1, 1, 1); LOADH(1, kt + 3, 1);
      COMPUTE_SUB(0);
      if (!(MODE == 6 && PROBE == 5)) __syncthreads();
      if (kt + 2 < KT) { STOREH(0, 0, 0); LOADH(0, kt + 4, 0); }
      COMPUTE_SUB(1);
      __syncthreads();
    }
  }
#pragma unroll
  for (int i = 0; i < 4; i++) {
    const int nl = wn * 64 + i * 16 + 4 * g;
#pragma unroll
    for (int j = 0; j < 4; j++) {
      const int m = m0 + wm * 64 + j * 16 + lc;
      const f32x4 v = acc[i][j];
      if (MODE == 1) {
        if (nt < 32) {
          const int p = nt >> 3, c = (nt & 7) * 128 + nl;
          bf16_t* dst = (p == 0) ? P.Rb : (p == 1) ? P.Kb : (p == 2) ? P.Vb : P.Gb;
          uint2 o; o.x = pack2(v[0], v[1]); o.y = pack2(v[2], v[3]);
          *(uint2*)(dst + (size_t)m * DM + c) = o;
        } else if (nl < 64) {
          uint2 o;
          if (nt == 32) { o.x = pack2(tanhf(v[0]), tanhf(v[1])); o.y = pack2(tanhf(v[2]), tanhf(v[3])); *(uint2*)(P.H1 + (size_t)m * 64 + nl) = o; }
          else { o.x = pack2(v[0], v[1]); o.y = pack2(v[2], v[3]); *(uint2*)(P.H2 + (size_t)m * 64 + nl) = o; }
        }
      } else if (MODE == 2) {
        const int c = (nt & 7) * 128 + nl;
        f16_t o[4];
        if (nt < 8) {
          const float4 w0v = *(const float4*)(P.w0 + c);
          const float ws[4] = {w0v.x, w0v.y, w0v.z, w0v.w};
#pragma unroll
          for (int r = 0; r < 4; r++) o[r] = (f16_t)(sigmoidf_(ws[r] + v[r]) * 0.60653065971f);
          *(uint2*)((f16_t*)P.XB + (size_t)m * DM + c) = *(uint2*)o;
        } else {
          const float4 a0v = *(const float4*)(P.a0 + c);
          const float as_[4] = {a0v.x, a0v.y, a0v.z, a0v.w};
#pragma unroll
          for (int r = 0; r < 4; r++) o[r] = (f16_t)sigmoidf_(as_[r] + v[r]);
          *(uint2*)((f16_t*)P.XXB + (size_t)m * DM + c) = *(uint2*)o;
        }
      } else if (MODE == 3 || MODE == 5) {
        const int c = n0 + nl;
        float4 res;
        if (MODE == 3) res = *(const float4*)(xin_row(P, m) + c);
        else res = *(const float4*)(P.out + OUT_Y + (size_t)m * DM + c);
        float4 o = make_float4(v[0] + ALPHA_F * res.x, v[1] + ALPHA_F * res.y, v[2] + ALPHA_F * res.z, v[3] + ALPHA_F * res.w);
        *(float4*)(P.out + OUT_Y + (size_t)m * DM + c) = o;
      } else if (MODE == 6) {
        uint2 o; o.x = pack2(v[0], v[1]); o.y = pack2(v[2], v[3]);
        *(uint2*)(P.XB + (size_t)(m & 4095) * DM + ((n0 + nl) & 1023)) = o;
      } else if (MODE == 4) {
        uint2 o; o.x = pack2(v[0], v[1]); o.y = pack2(v[2], v[3]);
        if (nt < 8) { *(uint2*)(P.Kb + (size_t)m * DM + n0 + nl) = o; }
        else if (nt >= 12) { *(uint2*)(P.Vb + (size_t)m * DM + (nt - 12) * 128 + nl) = o; }
        else {
          const bool isk = nt < 10;
          const int ck = (nt & 1) * 128 + nl;
          bf16_t* K1 = P.XB; bf16_t* V1 = P.XB + (size_t)NTOK * 256; bf16_t* VT1 = P.XB + (size_t)NTOK * 512;
          *(uint2*)((isk ? K1 : V1) + (size_t)m * 256 + ck) = o;
          const float4 fo = make_float4(v[0], v[1], v[2], v[3]);
          if (m < NPR) {
            const int b = m >> 13, tt = m & (TP - 1);
            if (!isk) {
              const int hk = ck >> 6, d = ck & 63;
              bf16_t* vt = VT1 + ((size_t)((b * 4 + hk) * 64 + d)) * TP + tt;
              vt[0] = f2bf(v[0]); vt[TP] = f2bf(v[1]); vt[2 * TP] = f2bf(v[2]); vt[3 * TP] = f2bf(v[3]);
            }
            if (tt >= TP - 128) *(float4*)(P.out + (isk ? OUT_WK_P : OUT_WV_P) + ((size_t)(b * 128 + tt - (TP - 128))) * 256 + ck) = fo;
          } else {
            const int ms = m - NPR, b = ms >> 3, tt = ms & 7;
            *(float4*)(P.out + (isk ? OUT_WK_S : OUT_WV_S) + ((size_t)(b * 128 + 120 + tt)) * 256 + ck) = fo;
          }
        }
      }
    }
  }
}
template <int MODE>
__device__ __forceinline__ void gemm_phase(const Params& P, unsigned char* smem, int bid, int nb) {
  constexpr int NT = (MODE == 1) ? 34 : (MODE == 2) ? 16 : (MODE == 4 || MODE == 6) ? 20 : 8;
  const int ntiles = 136 * NT;
  for (int tile = bid; tile < ntiles; tile += nb) gemm_tile<MODE>(P, smem, tile % 136, tile / 136);
}

#define TS 4
#define REC 392
typedef float f32x2 __attribute__((ext_vector_type(2)));
__device__ __forceinline__ f32x2 pkfma(f32x2 a, f32x2 b, f32x2 c) { return __builtin_elementwise_fma(a, b, c); }
#define DPP_ADD(x, ctrl) ((x) + __builtin_bit_cast(float, __builtin_amdgcn_update_dpp(0, __builtin_bit_cast(int, (x)), (ctrl), 0xF, 0xF, true)))
__device__ __forceinline__ float wave_sum_fast(float x) {
  x = DPP_ADD(x, 0xB1); x = DPP_ADD(x, 0x4E); x = DPP_ADD(x, 0x141); x = DPP_ADD(x, 0x140);
  const int xi = __builtin_bit_cast(int, x);
  const float t0 = __builtin_bit_cast(float, __builtin_amdgcn_readlane(xi, 0)), t1 = __builtin_bit_cast(float, __builtin_amdgcn_readlane(xi, 16));
  const float t2 = __builtin_bit_cast(float, __builtin_amdgcn_readlane(xi, 32)), t3 = __builtin_bit_cast(float, __builtin_amdgcn_readlane(xi, 48));
  return (t0 + t1) + (t2 + t3);
}
#define LD8(dst, ptr) do { _Pragma("unroll") for (int j4_ = 0; j4_ < 4; j4_++) { const f32x4 v_ = *(const f32x4*)((ptr) + 4 * j4_); \
    dst[2 * j4_] = (f32x2){v_[0], v_[1]}; dst[2 * j4_ + 1] = (f32x2){v_[2], v_[3]}; } } while (0)

template <int INIT  , bool USEV, bool WRITEY>
__device__ __forceinline__ void scan_unit(const Params& P, float* ws, int lane, int tok0, int nsteps, int h, const float* init_ptr, float* fin) {
  const int rq = lane >> 2, q = lane & 3;
  f32x2 s[4][8];
#pragma unroll
  for (int i = 0; i < 4; i++)
#pragma unroll
    for (int j = 0; j < 8; j++) {
      if (INIT == 1) s[i][j] = (f32x2){((rq + 16 * i) == (16 * q + 2 * j)) ? 1.f : 0.f, ((rq + 16 * i) == (16 * q + 2 * j + 1)) ? 1.f : 0.f};
      else s[i][j] = (f32x2){0.f, 0.f};
    }
  if (INIT == 2) {
#pragma unroll
    for (int i = 0; i < 4; i++) LD8(s[i], init_ptr + (size_t)(rq + 16 * i) * 64 + 16 * q);
  }
  const int c = h * 64 + lane;
  const float kkc = P.k_k[c], kac = P.k_a[c], rkc = P.r_k[c];
  const int crow = h * 64 + rq + 16 * q;
  const float gng = P.gn_g[crow], gnb = P.gn_b[crow];
  const f16_t* EW = (const f16_t*)P.XB;
  const f16_t* AA = (const f16_t*)P.XXB;

  bf16_t rk[TS], rv[TS], rr[TS]; f16_t ra_[TS], re_[TS];
#define LOAD_RAW(tb) do { _Pragma("unroll") for (int tt_ = 0; tt_ < TS; tt_++) { const size_t off_ = (size_t)(tok0 + (tb) + tt_) * DM + c; \
    rk[tt_] = P.Kb[off_]; ra_[tt_] = AA[off_]; re_[tt_] = EW[off_]; if (USEV) rv[tt_] = P.Vb[off_]; if (WRITEY) rr[tt_] = P.Rb[off_]; } } while (0)
  LOAD_RAW(0);
  for (int t0 = 0; t0 < nsteps; t0 += TS) {
#pragma unroll
    for (int tt = 0; tt < TS; tt++) {
      const float kraw = bf2f(rk[tt]);
      const float a = (float)ra_[tt];
      const float wd = __expf(-(float)re_[tt]);
      float kkv = kraw * kkc;
      const float ss = wave_sum_fast(kkv * kkv);
      kkv = kkv / fmaxf(sqrtf(ss), 1e-12f);
      const float kf = kraw * (1.f + (a - 1.f) * kac);
      float* rec = ws + tt * REC;
      rec[lane] = kkv; rec[64 + lane] = wd; rec[128 + lane] = kf; rec[192 + lane] = kkv * a;
      if (WRITEY) {
        const float r = bf2f(rr[tt]);
        rec[256 + lane] = r;
        const float bonus = wave_sum_fast(r * kf * rkc);
        if (lane == 0) rec[384] = bonus;
      }
      if (USEV) rec[320 + lane] = bf2f(rv[tt]);
    }
    __builtin_amdgcn_wave_barrier();
    asm volatile("s_waitcnt lgkmcnt(0)" ::: "memory");
    if (t0 + TS < nsteps) LOAD_RAW(t0 + TS);
#pragma unroll 1
    for (int tt = 0; tt < TS; tt++) {
      const float* rec = ws + tt * REC;
      f32x2 o2[8];
      LD8(o2, rec + 16 * q);
      f32x2 nsa2[4];
      {
        f32x2 acc[4];
#pragma unroll
        for (int i = 0; i < 4; i++) acc[i] = s[i][0] * o2[0];
#pragma unroll
        for (int j = 1; j < 8; j++)
#pragma unroll
          for (int i = 0; i < 4; i++) acc[i] = pkfma(s[i][j], o2[j], acc[i]);
#pragma unroll
        for (int i = 0; i < 4; i++) { const float t = -quad_sum(acc[i][0] + acc[i][1]); nsa2[i] = (f32x2){t, t}; }
      }
      float vv[4];
      if (USEV) {
#pragma unroll
        for (int i = 0; i < 4; i++) vv[i] = rec[320 + rq + 16 * i];
      }
      f32x2 w2[8], b2[8];
      LD8(w2, rec + 64 + 16 * q);
      LD8(b2, rec + 192 + 16 * q);
      if (USEV) {
        LD8(o2, rec + 128 + 16 * q);
#pragma unroll
        for (int i = 0; i < 4; i++) {
          const f32x2 vv2 = (f32x2){vv[i], vv[i]};
          f32x2 tq[8];
#pragma unroll
          for (int j = 0; j < 8; j++) tq[j] = nsa2[i] * b2[j];
#pragma unroll
          for (int j = 0; j < 8; j++) tq[j] = pkfma(vv2, o2[j], tq[j]);
#pragma unroll
          for (int j = 0; j < 8; j++) s[i][j] = pkfma(s[i][j], w2[j], tq[j]);
        }
      } else {
#pragma unroll
        for (int i = 0; i < 4; i++) {
          f32x2 tq[8];
#pragma unroll
          for (int j = 0; j < 8; j++) tq[j] = nsa2[i] * b2[j];
#pragma unroll
          for (int j = 0; j < 8; j++) s[i][j] = pkfma(s[i][j], w2[j], tq[j]);
        }
      }
      if (WRITEY) {
        LD8(o2, rec + 256 + 16 * q);
        float y[4];
        {
          f32x2 acc[4];
#pragma unroll
          for (int i = 0; i < 4; i++) acc[i] = s[i][0] * o2[0];
#pragma unroll
          for (int j = 1; j < 8; j++)
#pragma unroll
            for (int i = 0; i < 4; i++) acc[i] = pkfma(s[i][j], o2[j], acc[i]);
#pragma unroll
          for (int i = 0; i < 4; i++) y[i] = quad_sum(acc[i][0] + acc[i][1]);
        }
        const float ysel = (q == 0) ? y[0] : (q == 1) ? y[1] : (q == 2) ? y[2] : y[3];
        const float vsel = (q == 0) ? vv[0] : (q == 1) ? vv[1] : (q == 2) ? vv[2] : vv[3];
        const float mean = wave_sum_fast(ysel) * (1.f / 64.f);
        const float ex2 = wave_sum_fast(ysel * ysel) * (1.f / 64.f);
        const float var = fmaxf(ex2 - mean * mean, 0.f);
        float yo = (ysel - mean) * rsqrtf(var + 64e-5f) * gng + gnb + rec[384] * vsel;
        const size_t off = (size_t)(tok0 + t0 + tt) * DM + crow;
        const float gt = bf2f(P.Gb[off]);
        yo *= gt * sigmoidf_(gt);
        P.Gb[off] = f2bf(yo);
      }
    }
    __builtin_amdgcn_wave_barrier();
    asm volatile("s_waitcnt lgkmcnt(0)" ::: "memory");
  }
  if (fin) {
#pragma unroll
    for (int i = 0; i < 4; i++)
#pragma unroll
      for (int j4 = 0; j4 < 4; j4++)
        *(f32x4*)(fin + (size_t)(rq + 16 * i) * 64 + 16 * q + 4 * j4) = (f32x4){s[i][2 * j4][0], s[i][2 * j4][1], s[i][2 * j4 + 1][0], s[i][2 * j4 + 1][1]};
  }
}

__device__ __forceinline__ void phase_scan1(const Params& P, unsigned char* smem, int bid, int nb) {
  const int lane = threadIdx.x & 63, w = threadIdx.x >> 6;
  float* ws = (float*)smem + w * (TS * REC);
  float* Ploc = P.out + OUT_WK_S;
  float* Sloc = P.out + OUT_WV_S;
  const int total = NBH * (NC - 1) * 2;
  for (int u = w * nb + bid; u < total; u += 4 * nb) {
    const int kind = u & 1, rest = u >> 1;
    const int c = rest % (NC - 1), bh = rest / (NC - 1);
    const int tok0 = (bh >> 4) * TP + c * CL, h = bh & 15;
    float* fin = (kind ? Ploc : Sloc) + (size_t)(bh * (NC - 1) + c) * 4096;
    if (kind) scan_unit<1, false, false>(P, ws, lane, tok0, CL, h, nullptr, fin);
    else scan_unit<0, true, false>(P, ws, lane, tok0, CL, h, nullptr, fin);
  }
}
__device__ __forceinline__ void phase_scan2(const Params& P, unsigned char* smem, int bid, int nb) {
  const int lane = threadIdx.x & 63, w = threadIdx.x >> 6;
  float* ws = (float*)smem + w * 256;
  float* Ploc = P.out + OUT_WK_S;
  float* Sloc = P.out + OUT_WV_S;
  for (int item = bid; item < NBH * 4; item += nb) {
    const int bh = item >> 2, row0 = (item & 3) * 16 + w * 4;
    float s[4];
    {
      const float* S0 = Sloc + (size_t)(bh * (NC - 1)) * 4096;
#pragma unroll
      for (int r = 0; r < 4; r++) s[r] = S0[(row0 + r) * 64 + lane];
    }
    for (int c = 1; c < NC - 1; c++) {
      const float* Pc = Ploc + (size_t)(bh * (NC - 1) + c) * 4096;
      float* Sc = Sloc + (size_t)(bh * (NC - 1) + c) * 4096;
      float acc[4];
#pragma unroll
      for (int r = 0; r < 4; r++) { acc[r] = Sc[(row0 + r) * 64 + lane]; ws[r * 64 + lane] = s[r]; }
      __builtin_amdgcn_wave_barrier();
      asm volatile("s_waitcnt lgkmcnt(0)" ::: "memory");
#pragma unroll 1
      for (int hf = 0; hf < 2; hf++) {
        float p[32];
#pragma unroll
        for (int i = 0; i < 32; i++) p[i] = Pc[(hf * 32 + i) * 64 + lane];
#pragma unroll
        for (int r = 0; r < 4; r++) {
#pragma unroll
          for (int i4 = 0; i4 < 8; i4++) {
            const float4 sv = *(const float4*)(ws + r * 64 + hf * 32 + 4 * i4);
            acc[r] = fmaf(sv.x, p[4 * i4], acc[r]); acc[r] = fmaf(sv.y, p[4 * i4 + 1], acc[r]);
            acc[r] = fmaf(sv.z, p[4 * i4 + 2], acc[r]); acc[r] = fmaf(sv.w, p[4 * i4 + 3], acc[r]);
          }
        }
      }
      __builtin_amdgcn_wave_barrier();
      asm volatile("s_waitcnt lgkmcnt(0)" ::: "memory");
#pragma unroll
      for (int r = 0; r < 4; r++) { s[r] = acc[r]; Sc[(row0 + r) * 64 + lane] = acc[r]; }
    }
  }
}
__device__ __forceinline__ void phase_scan3(const Params& P, unsigned char* smem, int bid, int nb) {
  const int lane = threadIdx.x & 63, w = threadIdx.x >> 6;
  float* ws = (float*)smem + w * (TS * REC);
  float* Sloc = P.out + OUT_WV_S;
  const int hb = nb >> 1;
  if (bid < hb) {
    for (int u = w * hb + bid; u < NBH * NC; u += 4 * hb) {
      const int bh = u >> 5, c = u & 31;
      const int tok0 = (bh >> 4) * TP + c * CL, h = bh & 15;
      const float* ip = (c > 0) ? (Sloc + (size_t)(bh * (NC - 1) + c - 1) * 4096) : nullptr;
      float* fin = (c == NC - 1) ? (P.out + OUT_WKV_P + (size_t)bh * 4096) : nullptr;
      if (c > 0) scan_unit<2, true, true>(P, ws, lane, tok0, CL, h, ip, fin);
      else scan_unit<0, true, true>(P, ws, lane, tok0, CL, h, ip, fin);
    }
  } else {
    for (int sb = w * (nb - hb) + (bid - hb); sb < 2048; sb += 4 * (nb - hb))
      scan_unit<2, true, true>(P, ws, lane, NPR + (sb >> 4) * 8, 8, sb & 15, P.state_wkv + (size_t)sb * 4096, P.out + OUT_WKV_S + (size_t)sb * 4096);
  }
}

__device__ __forceinline__ void phase_ln(const Params& P, int layer, int bid, int nb) {
  const int lane = threadIdx.x & 63, w = threadIdx.x >> 6;
  const float* gg = P.ln_g + layer * DM; const float* bb = P.ln_b + layer * DM;
  for (int tok = bid * 4 + w; tok < NTOK; tok += nb * 4) {
    f32x4* row = (f32x4*)(P.out + OUT_Y + (size_t)tok * DM);
    f32x4 v[4];
    float sum = 0.f;
#pragma unroll
    for (int i = 0; i < 4; i++) { v[i] = row[lane + 64 * i]; sum += v[i][0] + v[i][1] + v[i][2] + v[i][3]; }
    const float mean = wave_sum(sum) * (1.f / 1024.f);
    float sq = 0.f;
#pragma unroll
    for (int i = 0; i < 4; i++) { v[i] -= mean; sq += v[i][0] * v[i][0] + v[i][1] * v[i][1] + v[i][2] * v[i][2] + v[i][3] * v[i][3]; }
    const float rs = rsqrtf(wave_sum(sq) * (1.f / 1024.f) + 1e-5f);
#pragma unroll
    for (int i = 0; i < 4; i++) {
      const f32x4 g4 = ((const f32x4*)gg)[lane + 64 * i], b4 = ((const f32x4*)bb)[lane + 64 * i];
      const f32x4 o = v[i] * rs * g4 + b4;
      row[lane + 64 * i] = o;
      if (layer == 0) { uint2 ob; ob.x = pack2(o[0], o[1]); ob.y = pack2(o[2], o[3]); ((uint2*)(P.Rb + (size_t)tok * DM))[lane + 64 * i] = ob; }
    }
  }
}

__device__ __forceinline__ void attn_prompt_item(const Params& P, unsigned char* smem, int item) {
  const int qh = item & 1, hk = (item >> 1) & 3, n = (item >> 3) & 63, b = item >> 9;
  bf16_t* Ks = (bf16_t*)smem;
  bf16_t* Vs = Ks + 192 * 72;
  const bf16_t* K1 = P.XB; const bf16_t* VT1 = P.XB + (size_t)NTOK * 512;
  const bf16_t* Q1 = P.Kb; const bf16_t* G1 = P.Vb; bf16_t* AO = P.Gb;
  const int t = threadIdx.x, lane = t & 63, w = t >> 6;
  const int g = lane >> 4, lc = lane & 15;
  const int pos0 = (n - 1) * 128 + 64 * qh;
  __syncthreads();
#pragma unroll
  for (int i = 0; i < 6; i++) {
    const int idx = t + 256 * i; const int row = idx >> 3, ch = idx & 7; const int pos = pos0 + row;
    uint4 v = make_uint4(0, 0, 0, 0);
    if (pos >= 0) v = *(const uint4*)(K1 + ((size_t)(b * TP + pos)) * 256 + hk * 64 + ch * 8);
    *(uint4*)(Ks + row * 72 + ch * 8) = v;
  }
#pragma unroll
  for (int i = 0; i < 6; i++) {
    const int idx = t + 256 * i; const int d = idx / 24, ch = idx % 24; const int pos = pos0 + ch * 8;
    uint4 v = make_uint4(0, 0, 0, 0);
    if (pos >= 0) v = *(const uint4*)(VT1 + ((size_t)((b * 4 + hk) * 64 + d)) * TP + pos);
    *(uint4*)(Vs + d * 200 + ch * 8) = v;
  }
  __syncthreads();
  const int h = hk * 4 + w;
  const float slope = exp2f(-0.5f * (float)(h + 1));
  const float sink = P.att_sinks[h];
  for (int sb = 0; sb < 2; sb++) {
    const int i0 = 64 * qh + 32 * sb;
    const int tokb = b * TP + n * 128 + i0;
    bf16x8 qf[2][2];
#pragma unroll
    for (int nn = 0; nn < 2; nn++)
#pragma unroll
      for (int ks = 0; ks < 2; ks++) qf[nn][ks] = *(const bf16x8*)(Q1 + (size_t)(tokb + 16 * nn + lc) * DM + h * 64 + ks * 32 + g * 8);
    float mrun[2] = {sink, sink}, lrun[2] = {1.f, 1.f};
    f32x4 O[4][2];
#pragma unroll
    for (int dm = 0; dm < 4; dm++) { O[dm][0] = (f32x4){0.f, 0.f, 0.f, 0.f}; O[dm][1] = (f32x4){0.f, 0.f, 0.f, 0.f}; }
    for (int kt = 0; kt < 3; kt++) {
      if (n == 0 && (qh + kt) < 2) continue;
      f32x4 S[4][2];
#pragma unroll
      for (int mm = 0; mm < 4; mm++) { S[mm][0] = (f32x4){0.f, 0.f, 0.f, 0.f}; S[mm][1] = (f32x4){0.f, 0.f, 0.f, 0.f}; }
#pragma unroll
      for (int ks = 0; ks < 2; ks++)
#pragma unroll
        for (int mm = 0; mm < 4; mm++) {
          const bf16x8 kf = *(const bf16x8*)(Ks + (kt * 64 + mm * 16 + lc) * 72 + ks * 32 + g * 8);
          S[mm][0] = __builtin_amdgcn_mfma_f32_16x16x32_bf16(kf, qf[0][ks], S[mm][0], 0, 0, 0);
          S[mm][1] = __builtin_amdgcn_mfma_f32_16x16x32_bf16(kf, qf[1][ks], S[mm][1], 0, 0, 0);
        }
#pragma unroll
      for (int nn = 0; nn < 2; nn++) {
        const int qi = i0 + 16 * nn + lc;
        float mx = mrun[nn];
#pragma unroll
        for (int mm = 0; mm < 4; mm++)
#pragma unroll
          for (int r = 0; r < 4; r++) {
            const int j = 64 * (qh + kt) + 16 * mm + 4 * g + r;
            const int dist = 128 + qi - j;
            const bool live = (dist >= 0) && (dist < 128);
            const float sv = live ? (S[mm][nn][r] * 0.125f - slope * (float)dist) : -1e30f;
            S[mm][nn][r] = sv; mx = fmaxf(mx, sv);
          }
        mx = fmaxf(mx, __shfl_xor(mx, 16)); mx = fmaxf(mx, __shfl_xor(mx, 32));
        const float corr = __expf(mrun[nn] - mx); mrun[nn] = mx;
        float sum = 0.f;
#pragma unroll
        for (int mm = 0; mm < 4; mm++)
#pragma unroll
          for (int r = 0; r < 4; r++) { const float pp = __expf(S[mm][nn][r] - mx); S[mm][nn][r] = pp; sum += pp; }
        sum += __shfl_xor(sum, 16); sum += __shfl_xor(sum, 32);
        lrun[nn] = lrun[nn] * corr + sum;
#pragma unroll
        for (int dm = 0; dm < 4; dm++) { O[dm][nn][0] *= corr; O[dm][nn][1] *= corr; O[dm][nn][2] *= corr; O[dm][nn][3] *= corr; }
      }
#pragma unroll
      for (int k2 = 0; k2 < 2; k2++) {
        bf16x8 pf[2];
#pragma unroll
        for (int nn = 0; nn < 2; nn++) {
          const unsigned u0 = pack2(S[2 * k2][nn][0], S[2 * k2][nn][1]), u1 = pack2(S[2 * k2][nn][2], S[2 * k2][nn][3]);
          const unsigned u2 = pack2(S[2 * k2 + 1][nn][0], S[2 * k2 + 1][nn][1]), u3 = pack2(S[2 * k2 + 1][nn][2], S[2 * k2 + 1][nn][3]);
          const uint4 uu = make_uint4(u0, u1, u2, u3);
          pf[nn] = *(const bf16x8*)&uu;
        }
#pragma unroll
        for (int dm = 0; dm < 4; dm++) {
          const bf16_t* vb = Vs + (dm * 16 + lc) * 200 + kt * 64 + k2 * 32 + 4 * g;
          const uint2 lo = *(const uint2*)vb, hi = *(const uint2*)(vb + 16);
          const uint4 uu = make_uint4(lo.x, lo.y, hi.x, hi.y);
          const bf16x8 vf = *(const bf16x8*)&uu;
          O[dm][0] = __builtin_amdgcn_mfma_f32_16x16x32_bf16(vf, pf[0], O[dm][0], 0, 0, 0);
          O[dm][1] = __builtin_amdgcn_mfma_f32_16x16x32_bf16(vf, pf[1], O[dm][1], 0, 0, 0);
        }
      }
    }
#pragma unroll
    for (int nn = 0; nn < 2; nn++) {
      const float inv = 1.f / lrun[nn];
      const size_t tok = (size_t)(tokb + 16 * nn + lc);
#pragma unroll
      for (int dm = 0; dm < 4; dm++) {
        const int d = dm * 16 + 4 * g;
        const uint2 gv = *(const uint2*)(G1 + tok * DM + h * 64 + d);
        const float g0 = __uint_as_float(gv.x << 16), g1 = __uint_as_float(gv.x & 0xffff0000u);
        const float g2 = __uint_as_float(gv.y << 16), g3 = __uint_as_float(gv.y & 0xffff0000u);
        uint2 o;
        o.x = pack2(O[dm][nn][0] * inv * g0 * sigmoidf_(g0), O[dm][nn][1] * inv * g1 * sigmoidf_(g1));
        o.y = pack2(O[dm][nn][2] * inv * g2 * sigmoidf_(g2), O[dm][nn][3] * inv * g3 * sigmoidf_(g3));
        *(uint2*)(AO + tok * DM + h * 64 + d) = o;
      }
    }
  }
}

__device__ __forceinline__ void attn_sample_item(const Params& P, unsigned char* smem, int item) {
  const int b = item >> 2, hk = item & 3;
  const int t = threadIdx.x, lane = t & 63, w = t >> 6;
  float* kv = (float*)smem;
  float* qs = kv + 136 * 65 + w * 512;
  float* ps = kv + 136 * 65 + 2048 + w * (8 * 136);
  const bf16_t* K1 = P.XB; const bf16_t* V1 = P.XB + (size_t)NTOK * 256;
  const bf16_t* Q1 = P.Kb; const bf16_t* G1 = P.Vb; bf16_t* AO = P.Gb;
  const int h = hk * 4 + w;
  const float slope = exp2f(-0.5f * (float)(h + 1));
  const float sink = P.att_sinks[h];
  const int tok0 = NPR + b * 8;
  __syncthreads();
#pragma unroll 2
  for (int it = 0; it < 8; it++) {
    const int idx = t + 256 * it; const int row = idx >> 4, c4 = idx & 15;
    const size_t so = ((size_t)(b * 128 + row)) * 256 + hk * 64 + c4 * 4;
    const float4 kx = *(const float4*)(P.cache_k + so);
    const float4 vx = *(const float4*)(P.cache_v + so);
    float* kd = kv + row * 65 + c4 * 4;
    kd[0] = kx.x; kd[1] = kx.y; kd[2] = kx.z; kd[3] = kx.w;
    if (row >= 8) {
      const size_t dofs = ((size_t)(b * 128 + row - 8)) * 256 + hk * 64 + c4 * 4;
      *(float4*)(P.out + OUT_WK_S + dofs) = kx;
      *(float4*)(P.out + OUT_WV_S + dofs) = vx;
    }
  }
#pragma unroll
  for (int it = 0; it < 2; it++) {
    const int idx = t + 256 * it; const int r8 = idx >> 6, d = idx & 63;
    kv[(128 + r8) * 65 + d] = bf2f(K1[(size_t)(tok0 + r8) * 256 + hk * 64 + d]);
  }
#pragma unroll
  for (int i = 0; i < 8; i++) qs[i * 64 + lane] = bf2f(Q1[(size_t)(tok0 + i) * DM + h * 64 + lane]);
  __syncthreads();
  float sc[3][8];
#pragma unroll
  for (int ksel = 0; ksel < 3; ksel++) {
    float acc[8];
#pragma unroll
    for (int i = 0; i < 8; i++) acc[i] = 0.f;
    const float* kr = kv + ((ksel < 2) ? (lane + 64 * ksel) : (128 + (lane & 7))) * 65;
#pragma unroll 2
    for (int d4 = 0; d4 < 16; d4++) {
      const float k0 = kr[4 * d4], k1 = kr[4 * d4 + 1], k2 = kr[4 * d4 + 2], k3 = kr[4 * d4 + 3];
#pragma unroll
      for (int i = 0; i < 8; i++) {
        const float4 qv = *(const float4*)(qs + i * 64 + 4 * d4);
        acc[i] = fmaf(qv.x, k0, acc[i]); acc[i] = fmaf(qv.y, k1, acc[i]); acc[i] = fmaf(qv.z, k2, acc[i]); acc[i] = fmaf(qv.w, k3, acc[i]);
      }
    }
#pragma unroll
    for (int i = 0; i < 8; i++) {
      int dist; bool live;
      if (ksel < 2) { const int j = lane + 64 * ksel; dist = 128 + i - j; live = (j > i); }
      else { dist = i - lane; live = (lane <= i); }
      sc[ksel][i] = live ? (acc[i] * 0.125f - slope * (float)dist) : -1e30f;
    }
  }
#pragma unroll
  for (int i = 0; i < 8; i++) {
    float mx = fmaxf(fmaxf(sc[0][i], sc[1][i]), sc[2][i]);
    mx = fmaxf(wave_max(mx), sink);
    const float p0 = __expf(sc[0][i] - mx), p1 = __expf(sc[1][i] - mx), p2 = __expf(sc[2][i] - mx);
    const float den = wave_sum(p0 + p1 + p2) + __expf(sink - mx);
    const float inv = 1.f / den;
    ps[i * 136 + lane] = p0 * inv; ps[i * 136 + 64 + lane] = p1 * inv;
    if (lane < 8) ps[i * 136 + 128 + lane] = p2 * inv;
  }
  __syncthreads();
#pragma unroll 4
  for (int it = 0; it < 8; it++) {
    const int idx = t + 256 * it; const int row = idx >> 4, c4 = idx & 15;
    *(float4*)(kv + row * 64 + c4 * 4) = *(const float4*)(P.cache_v + ((size_t)(b * 128 + row)) * 256 + hk * 64 + c4 * 4);
  }
#pragma unroll
  for (int it = 0; it < 2; it++) {
    const int idx = t + 256 * it; const int r8 = idx >> 6, d = idx & 63;
    kv[(128 + r8) * 64 + d] = bf2f(V1[(size_t)(tok0 + r8) * 256 + hk * 64 + d]);
  }
  __syncthreads();
  float o[8];
#pragma unroll
  for (int i = 0; i < 8; i++) o[i] = 0.f;
#pragma unroll 2
  for (int j0 = 0; j0 < 136; j0 += 4) {
    const float v0 = kv[(j0) * 64 + lane], v1 = kv[(j0 + 1) * 64 + lane], v2 = kv[(j0 + 2) * 64 + lane], v3 = kv[(j0 + 3) * 64 + lane];
#pragma unroll
    for (int i = 0; i < 8; i++) {
      const float4 pa = *(const float4*)(ps + i * 136 + j0);
      o[i] = fmaf(pa.x, v0, o[i]); o[i] = fmaf(pa.y, v1, o[i]); o[i] = fmaf(pa.z, v2, o[i]); o[i] = fmaf(pa.w, v3, o[i]);
    }
  }
#pragma unroll
  for (int i = 0; i < 8; i++) {
    const size_t off = (size_t)(tok0 + i) * DM + h * 64 + lane;
    const float gt = bf2f(G1[off]);
    AO[off] = f2bf(o[i] * gt * sigmoidf_(gt));
  }
}
__device__ __forceinline__ void phase_attn(const Params& P, unsigned char* smem, int bid, int nb) {
#if PROBE == 7
  for (int item = bid; item < 1024; item += nb) attn_prompt_item(P, smem, item);
#elif PROBE == 8
  for (int item = bid; item < 512; item += nb) attn_sample_item(P, smem, item);
#endif
  for (int item = bid; item < 1024 + 512; item += nb) {
    if (item < 1024) attn_prompt_item(P, smem, item);
    else attn_sample_item(P, smem, item - 1024);
  }
}

#if MULTI_LAUNCH
#define PH_BARRIER(ph)
#else
#define PH_BARRIER(ph) do { if ((ph) + 1 < P.phase_end) xcd_barrier(xb); } while (0)
#endif
#define RUN_PH(ph, call) do { if (P.phase_begin <= (ph) && (ph) < P.phase_end) { if ((REPMASK >> (ph)) & 1) { call; PH_BARRIER(ph); } call; PH_BARRIER(ph); } } while (0)

__global__ void __launch_bounds__(256, 2) fwd_kernel(Params P) {
  __shared__ __attribute__((aligned(16))) unsigned char smem[SMEM_BYTES];
  const int bid = blockIdx.x, nb = gridDim.x;
#if !MULTI_LAUNCH
  __shared__ uint4 xb_words;
  if (threadIdx.x == 0) xb_words = make_uint4(0u, 0u, 0u, 0u);
  __syncthreads();
  XcdBarrier xb = xcd_barrier_post(P.bar, (volatile LAS unsigned*)&xb_words);
#endif
#if (PHMASK >> 0) & 1
  RUN_PH(0, phase_prep(P, smem, bid, nb));
#endif
#if (PHMASK >> 1) & 1
  RUN_PH(1, gemm_phase<1>(P, smem, bid, nb));
#endif
#if (PHMASK >> 2) & 1
  RUN_PH(2, gemm_phase<2>(P, smem, bid, nb));
#endif
#if (PHMASK >> 3) & 1
  RUN_PH(3, phase_scan1(P, smem, bid, nb));
#endif
#if (PHMASK >> 4) & 1
  RUN_PH(4, phase_scan2(P, smem, bid, nb));
#endif
#if (PHMASK >> 5) & 1
  RUN_PH(5, phase_scan3(P, smem, bid, nb));
#endif
#if (PHMASK >> 6) & 1
  RUN_PH(6, gemm_phase<3>(P, smem, bid, nb));
#endif
#if (PHMASK >> 7) & 1
  RUN_PH(7, phase_ln(P, 0, bid, nb));
#endif
#if (PHMASK >> 8) & 1
  RUN_PH(8, gemm_phase<4>(P, smem, bid, nb));
#endif
#if (PHMASK >> 9) & 1
  RUN_PH(9, phase_attn(P, smem, bid, nb));
#endif
#if (PHMASK >> 10) & 1
  RUN_PH(10, gemm_phase<5>(P, smem, bid, nb));
#endif
#if (PHMASK >> 11) & 1
  RUN_PH(11, phase_ln(P, 1, bid, nb));
#endif
#if PROBE && PROBE < 7
  xcd_barrier(xb);
  gemm_phase<6>(P, smem, bid, nb);
#endif
#if !MULTI_LAUNCH
  if (P.phase_end > NPHASE) cg::this_grid().sync();
#endif
}

extern "C" void kernel_launch(void* const* d_in, const int* in_sizes, int n_in, void* d_out, int out_size, void* d_ws, size_t ws_size, hipStream_t stream) {
  Params P{};
  P.x_prompt = (const float*)d_in[0]; P.x_sample = (const float*)d_in[1]; P.state_wkv = (const float*)d_in[2]; P.state_shift = (const float*)d_in[3];
  P.cache_k = (const float*)d_in[4]; P.cache_v = (const float*)d_in[5]; P.ln_g = (const float*)d_in[6]; P.ln_b = (const float*)d_in[7];
  P.mu = (const float*)d_in[8]; P.w_in = (const float*)d_in[9]; P.w0 = (const float*)d_in[10]; P.w1 = (const float*)d_in[11]; P.w2 = (const float*)d_in[12];
  P.a0 = (const float*)d_in[13]; P.a1 = (const float*)d_in[14]; P.a2 = (const float*)d_in[15]; P.k_k = (const float*)d_in[16]; P.k_a = (const float*)d_in[17];
  P.r_k = (const float*)d_in[18]; P.gn_g = (const float*)d_in[19]; P.gn_b = (const float*)d_in[20]; P.w_out = (const float*)d_in[21];
  P.att_w_in = (const float*)d_in[22]; P.att_sinks = (const float*)d_in[23]; P.att_w_out = (const float*)d_in[24];
  P.out = (float*)d_out;
  unsigned char* ws = (unsigned char*)d_ws;
  size_t off = 0;
  auto take = [&](size_t bytes) { unsigned char* p = ws + off; off += (bytes + 255) & ~(size_t)255; return p; };
  P.bar = (unsigned*)take(16384);
  P.WtIn0 = (bf16_t*)take((size_t)4352 * DM * 2);
  P.W2t = (bf16_t*)take((size_t)DM * 64 * 2);
  P.A2t = (bf16_t*)take((size_t)DM * 64 * 2);
  P.WtOut0 = (bf16_t*)take((size_t)DM * DM * 2);
  P.WtIn1 = (bf16_t*)take((size_t)2560 * DM * 2);
  P.WtOut1 = (bf16_t*)take((size_t)DM * DM * 2);
  P.XB = (bf16_t*)take((size_t)NTOK * DM * 2);
  P.XXB = (bf16_t*)take((size_t)NTOK * DM * 2);
  P.Rb = (bf16_t*)take((size_t)NTOK * DM * 2);
  P.Kb = (bf16_t*)take((size_t)NTOK * DM * 2);
  P.Vb = (bf16_t*)take((size_t)NTOK * DM * 2);
  P.Gb = (bf16_t*)take((size_t)NTOK * DM * 2);
  P.H1 = (bf16_t*)take((size_t)NTOK * 64 * 2);
  P.H2 = (bf16_t*)take((size_t)NTOK * 64 * 2);
  P.MU16 = (bf16_t*)take((size_t)6 * DM * 2);
  if (off > ws_size) { fprintf(stderr, "workspace too small: need %zu have %zu\n", off, ws_size); return; }
#if MULTI_LAUNCH
  for (int ph = 0; ph < NPHASE; ph++) {
    P.phase_begin = ph; P.phase_end = ph + 1;
    hipLaunchKernelGGL(fwd_kernel, dim3(512), dim3(256), 0, stream, P);
  }
#else
  static int grid_blocks = 0;
  if (!grid_blocks) {
    int dev = 0, cus = 0, per_cu = 0;
    hipGetDevice(&dev);
    hipDeviceGetAttribute(&cus, hipDeviceAttributeMultiprocessorCount, dev);
    hipOccupancyMaxActiveBlocksPerMultiprocessor(&per_cu, fwd_kernel, 256, 0);
    if (per_cu > 2) per_cu = 2;
    if (per_cu < 1) per_cu = 1;
    grid_blocks = cus * per_cu;
  }
  hipMemsetAsync(P.bar, 0, 16384, stream);
  P.phase_begin = 0; P.phase_end = NPHASE;
  void* args[] = {&P};
  hipError_t e = hipLaunchCooperativeKernel((void*)fwd_kernel, dim3(grid_blocks), dim3(256), args, 0, stream);
  if (e != hipSuccess) fprintf(stderr, "cooperative launch failed: %s (grid %d)\n", hipGetErrorString(e), grid_blocks);
#endif
}
```

```cpp
#include <hip/hip_runtime.h>
#include <hip/hip_cooperative_groups.h>
#include <stdint.h>
#include <cstdio>
namespace cg = cooperative_groups;

#ifndef PHMASK
#define PHMASK 0xFFF
#endif
#ifndef PROBE
#define PROBE 0
#endif
#ifndef REPMASK
#define REPMASK 0
#endif
#ifndef MULTI_LAUNCH
#define MULTI_LAUNCH 0
#endif

typedef unsigned short bf16_t;
typedef _Float16 f16_t;
typedef __attribute__((ext_vector_type(8))) short bf16x8;
typedef __attribute__((ext_vector_type(4))) float f32x4;
typedef __attribute__((ext_vector_type(4))) unsigned u32x4;

#define DM 1024
#define NTOK 17408
#define NPR 16384
#define TP 8192
#define NC 32
#define CL 256
#define NBH 32
#define ALPHA_F 1.41421356237f
#define SMEM_BYTES (61 * 1024)
#define NPHASE 12

#define OUT_Y 0
#define OUT_WKV_P 17825792
#define OUT_SH_P 17956864
#define OUT_WK_P 17958912
#define OUT_WV_P 18024448
#define OUT_WKV_S 18089984
#define OUT_SH_S 26478592
#define OUT_WK_S 26609664
#define OUT_WV_S 30803968

struct Params {
  const float *x_prompt, *x_sample, *state_wkv, *state_shift, *cache_k, *cache_v, *ln_g, *ln_b;
  const float *mu, *w_in, *w0, *w1, *w2, *a0, *a1, *a2, *k_k, *k_a, *r_k, *gn_g, *gn_b, *w_out;
  const float *att_w_in, *att_sinks, *att_w_out;
  float* out;
  unsigned* bar;
  bf16_t *WtIn0, *W2t, *A2t, *WtOut0, *WtIn1, *WtOut1;
  bf16_t *XB, *XXB;
  bf16_t *Rb, *Kb, *Vb, *Gb;
  bf16_t *H1, *H2, *MU16;
  int phase_begin, phase_end;
};

typedef __bf16 hbf2 __attribute__((ext_vector_type(2)));
typedef float f32x2_ __attribute__((ext_vector_type(2)));
__device__ __forceinline__ unsigned pack2(float a, float b) {
  const f32x2_ v = {a, b};
  return __builtin_bit_cast(unsigned, __builtin_convertvector(v, hbf2));
}
__device__ __forceinline__ bf16_t f2bf(float f) { return (bf16_t)(pack2(f, 0.f) & 0xffffu); }
__device__ __forceinline__ float bf2f(bf16_t h) { return __uint_as_float(((unsigned)h) << 16); }
__device__ __forceinline__ float wave_sum(float x) {
#pragma unroll
  for (int o = 32; o >= 1; o >>= 1) x += __shfl_xor(x, o);
  return x;
}
__device__ __forceinline__ float wave_max(float x) {
#pragma unroll
  for (int o = 32; o >= 1; o >>= 1) x = fmaxf(x, __shfl_xor(x, o));
  return x;
}
__device__ __forceinline__ float quad_sum(float x) {
  x += __builtin_bit_cast(float, __builtin_amdgcn_update_dpp(0, __builtin_bit_cast(int, x), 0xB1, 0xF, 0xF, true));
  x += __builtin_bit_cast(float, __builtin_amdgcn_update_dpp(0, __builtin_bit_cast(int, x), 0x4E, 0xF, 0xF, true));
  return x;
}
__device__ __forceinline__ float sigmoidf_(float x) { return 1.f / (1.f + __expf(-x)); }
__device__ __forceinline__ const float* xin_row(const Params& P, int m) {
  return (m < NPR) ? (P.x_prompt + (size_t)m * DM) : (P.x_sample + (size_t)(m - NPR) * DM);
}

#define XB_TMO      128
#define XB_XCNT(j)  (256  + 64 * (j))
#define XB_XSUB(j)  (1280 + 64 * (j))
#define XB_XGEN(j)  (2304 + 64 * (j))
#define XB_TOP      3328
#define XB_TOPGEN   3392
#define XCD_BAR_WORDS 3456
#define XB_SPIN_CAP (1u << 22)
#define LAS __attribute__((address_space(3)))
__device__ __forceinline__ unsigned xb_ld(unsigned* p) { return __hip_atomic_load(p, __ATOMIC_RELAXED, __HIP_MEMORY_SCOPE_AGENT); }
__device__ __forceinline__ unsigned xb_add(unsigned* p, unsigned v) { return __hip_atomic_fetch_add(p, v, __ATOMIC_RELAXED, __HIP_MEMORY_SCOPE_AGENT); }
__device__ __forceinline__ unsigned xb_xcc_id() { return (unsigned)__builtin_amdgcn_s_getreg((3 << 11) | 20) & 0xFu; }
#define XB_SPIN(cond, bar) do { unsigned _sp = 0; while (cond) { __builtin_amdgcn_s_sleep(1); \
    if ((++_sp & 255u) == 0u) { if (xb_ld(&(bar)[XB_TMO])) break; if (_sp > XB_SPIN_CAP) { atomicAdd(&(bar)[XB_TMO], 1u); break; } } } } while (0)
struct XcdBarrier { unsigned* bar; unsigned x; volatile LAS unsigned* st; };
__device__ __forceinline__ XcdBarrier xcd_barrier_post(unsigned* bar, volatile LAS unsigned* st) {
  XcdBarrier b; b.bar = bar; b.x = xb_xcc_id(); b.st = st;
  if (threadIdx.x == 0) (void)xb_add(&bar[XB_XCNT(b.x)], 1u);
  return b;
}
__device__ __forceinline__ void xcd_barrier_complete(unsigned* bar, unsigned x, unsigned& nloc, unsigned& nx) {
  const unsigned G = gridDim.x * gridDim.y * gridDim.z;
  unsigned sum, cnt, mine, sp = 0u;
  for (;;) {
    sum = 0u; cnt = 0u; mine = 0u;
#pragma unroll
    for (unsigned j = 0; j < 16; ++j) { const unsigned c = xb_ld(&bar[XB_XCNT(j)]); sum += c; cnt += (c > 0u) ? 1u : 0u; mine = (j == x) ? c : mine; }
    if (sum == G) break;
    __builtin_amdgcn_s_sleep(1);
    if ((++sp & 255u) == 0u) { if (xb_ld(&bar[XB_TMO])) break; if (sp > XB_SPIN_CAP) { atomicAdd(&bar[XB_TMO], 1u); break; } }
  }
  nloc = mine > 0u ? mine : 1u; nx = cnt > 0u ? cnt : 1u;
}
__device__ __forceinline__ void xcd_barrier(const XcdBarrier& b) {
  asm volatile("s_waitcnt vmcnt(0)" ::: "memory");
  __syncthreads();
  if (threadIdx.x == 0) {
    unsigned* bar = b.bar;
    __builtin_amdgcn_s_waitcnt(0);
    unsigned nloc = b.st[0], nx = b.st[1];
    if (nloc == 0u) { xcd_barrier_complete(bar, b.x, nloc, nx); b.st[0] = nloc; b.st[1] = nx; }
    const unsigned old = xb_add(&bar[XB_XSUB(b.x)], 1u);
    const unsigned gen = old / nloc;
    if (old + 1u == (gen + 1u) * nloc) {
      __builtin_amdgcn_fence(__ATOMIC_RELEASE, "agent");
      asm volatile("s_waitcnt vmcnt(0)" ::: "memory");
      const unsigned og = xb_add(&bar[XB_TOP], 1u);
      const unsigned tg = og / nx;
      if (og + 1u == (tg + 1u) * nx) xb_add(&bar[XB_TOPGEN], 1u);
      else XB_SPIN(xb_ld(&bar[XB_TOPGEN]) == tg, bar);
      __builtin_amdgcn_fence(__ATOMIC_ACQUIRE, "agent");
      xb_add(&bar[XB_XGEN(b.x)], 1u);
      asm volatile("s_waitcnt vmcnt(0)" ::: "memory");
    } else {
      XB_SPIN(xb_ld(&bar[XB_XGEN(b.x)]) == gen, bar);
      __builtin_amdgcn_fence(__ATOMIC_ACQUIRE, "agent");
      asm volatile("s_waitcnt vmcnt(0)" ::: "memory");
    }
  }
  __syncthreads();
}

__device__ __forceinline__ unsigned short f2h_bits(float f) { const _Float16 h = (_Float16)f; return __builtin_bit_cast(unsigned short, h); }
__device__ __forceinline__ unsigned pack2h(float a, float b) { return (unsigned)f2h_bits(a) | ((unsigned)f2h_bits(b) << 16); }
__device__ __forceinline__ void transpose_tile(const float* __restrict__ src, int ld, int k0, int n0, bf16_t* __restrict__ dst, int ldd, float* tile, bool half = false) {
  const int t = threadIdx.x;
  {
    const int n = t & 63, kq = t >> 6;
#pragma unroll 4
    for (int i = 0; i < 16; i++) { const int k = i * 4 + kq; tile[k * 65 + n] = src[(size_t)(k0 + k) * ld + n0 + n]; }
  }
  __syncthreads();
  {
    const int k = t & 63, nq = t >> 6;
#pragma unroll 4
    for (int i = 0; i < 16; i++) { const int n2 = i * 4 + nq; const float v_ = tile[k * 65 + n2]; dst[(size_t)(n0 + n2) * ldd + k0 + k] = half ? f2h_bits(v_) : f2bf(v_); }
  }
  __syncthreads();
}

__device__ __forceinline__ void phase_prep(const Params& P, unsigned char* smem, int bid, int nb) {
  float* tile = (float*)smem;
  const int t = threadIdx.x;
  const int NITEMS = 2242 + 4352 + 130;
  for (int id = bid; id < NITEMS; id += nb) {
    if (id < 1024) { const int p = id >> 8, r = id & 255; transpose_tile(P.w_in + (size_t)p * DM * DM, DM, (r >> 4) * 64, (r & 15) * 64, P.WtIn0 + (size_t)p * DM * DM, DM, tile, true); }
    else if (id < 1040) transpose_tile(P.w1, 64, (id - 1024) * 64, 0, P.WtIn0 + (size_t)4096 * DM, DM, tile, true);
    else if (id < 1056) transpose_tile(P.a1, 64, (id - 1040) * 64, 0, P.WtIn0 + (size_t)4224 * DM, DM, tile, true);
    else if (id < 1072) transpose_tile(P.w2, DM, 0, (id - 1056) * 64, P.W2t, 64, tile);
    else if (id < 1088) transpose_tile(P.a2, DM, 0, (id - 1072) * 64, P.A2t, 64, tile);
    else if (id < 1344) { const int r = id - 1088; transpose_tile(P.w_out, DM, (r >> 4) * 64, (r & 15) * 64, P.WtOut0, DM, tile); }
    else if (id < 1984) { const int r = id - 1344; transpose_tile(P.att_w_in, 2560, (r / 40) * 64, (r % 40) * 64, P.WtIn1, DM, tile); }
    else if (id < 2240) { const int r = id - 1984; transpose_tile(P.att_w_out, DM, (r >> 4) * 64, (r & 15) * 64, P.WtOut1, DM, tile); }
    else if (id < 2242) {
      uint4* z = (uint4*)(P.WtIn0 + (size_t)(id == 2240 ? 4160 : 4288) * DM);
      for (int i = t; i < 8192; i += 256) z[i] = make_uint4(0, 0, 0, 0);
      if (id == 2240) for (int i = t; i < 6 * DM; i += 256) P.MU16[i] = f2h_bits(P.mu[i]);
    } else if (id < 2242 + 4352) {
      const int it = id - 2242;
#pragma unroll
      for (int q = 0; q < 4; q++) {
        const int m = it * 4 + q;
        const float4 x = ((const float4*)xin_row(P, m))[t];
        float4 pv = make_float4(0.f, 0.f, 0.f, 0.f);
        if (m < NPR) { if ((m & (TP - 1)) != 0) pv = ((const float4*)xin_row(P, m - 1))[t]; }
        else { const int ms = m - NPR; if ((ms & 7) != 0) pv = ((const float4*)xin_row(P, m - 1))[t]; else pv = ((const float4*)(P.state_shift + (size_t)(ms >> 3) * DM))[t]; }
        uint2 xb, xxb;
        xb.x = pack2h(x.x, x.y); xb.y = pack2h(x.z, x.w);
        xxb.x = pack2h(pv.x - x.x, pv.y - x.y); xxb.y = pack2h(pv.z - x.z, pv.w - x.w);
        ((uint2*)(P.XB + (size_t)m * DM))[t] = xb;
        ((uint2*)(P.XXB + (size_t)m * DM))[t] = xxb;
      }
    } else {
      const int r = id - (2242 + 4352);
      if (r < 2) ((float4*)(P.out + OUT_SH_P + (size_t)r * DM))[t] = ((const float4*)(P.x_prompt + ((size_t)r * TP + TP - 1) * DM))[t];
      else { const int b = r - 2; ((float4*)(P.out + OUT_SH_S + (size_t)b * DM))[t] = ((const float4*)(P.x_sample + ((size_t)b * 8 + 7) * DM))[t]; }
    }
  }
}

#define LDB 48
typedef _Float16 f16x8 __attribute__((ext_vector_type(8)));
typedef _Float16 f16x2 __attribute__((ext_vector_type(2)));
__device__ __forceinline__ unsigned xs16(unsigned x, unsigned d, unsigned m) {
  const f16x2 r = __builtin_elementwise_fma(__builtin_bit_cast(f16x2, d), __builtin_bit_cast(f16x2, m), __builtin_bit_cast(f16x2, x));
  return __builtin_bit_cast(unsigned, r);
}
template <int MODE>
__device__ __forceinline__ void gemm_tile(const Params& P, unsigned char* smem, int mt, int nt) {
  constexpr int KT = (MODE == 2) ? 1 : 16;
  bf16_t* Asb[2]; bf16_t* Bsb[2];
  Asb[0] = (bf16_t*)smem; Bsb[0] = Asb[0] + 128 * LDB; Asb[1] = Bsb[0] + 128 * LDB; Bsb[1] = Asb[1] + 128 * LDB;
  const int t = threadIdx.x, lane = t & 63, w = t >> 6;
  const int wm = w >> 1, wn = w & 1;
  const int g = lane >> 4, lc = lane & 15;
  const int lr = t >> 2, lc4 = t & 3;
  const int m0 = mt * 128, n0 = nt * 128;

  const bf16_t* Ap; const bf16_t* A2p = nullptr; const bf16_t* mup = nullptr; const bf16_t* Bp; int lda, ldb;
  if (MODE == 1) {
    const int p = (nt < 32) ? (nt >> 3) : (4 + (nt - 32));
    Ap = P.XB; A2p = P.XXB; lda = DM; mup = P.MU16 + (size_t)p * DM;
    Bp = P.WtIn0 + (size_t)((nt < 32) ? n0 : (4096 + (nt - 32) * 128)) * DM; ldb = DM;
  } else if (MODE == 2) {
    Ap = (nt < 8) ? P.H1 : P.H2; lda = 64;
    Bp = ((nt < 8) ? P.W2t : P.A2t) + (size_t)((nt & 7) * 128) * 64; ldb = 64;
  } else if (MODE == 3) { Ap = P.Gb; lda = DM; Bp = P.WtOut0 + (size_t)n0 * DM; ldb = DM; }
  else if (MODE == 4 || MODE == 6) { Ap = P.Rb; lda = DM; Bp = P.WtIn1 + (size_t)n0 * DM; ldb = DM; }
  else { Ap = P.Gb; lda = DM; Bp = P.WtOut1 + (size_t)n0 * DM; ldb = DM; }

  f32x4 acc[4][4];
#pragma unroll
  for (int i = 0; i < 4; i++)
#pragma unroll
    for (int j = 0; j < 4; j++) acc[i][j] = (f32x4){0.f, 0.f, 0.f, 0.f};

  u32x4 ra[2][2][2], rb[2][2][2], ra2[2][2][2], rmu[2][2];
  const unsigned voffA = (unsigned)(lr * lda + lc4 * 8) * 2u;
  const unsigned voffB = (unsigned)(lr * ldb + lc4 * 8) * 2u;
  const char* baseA = (const char*)(Ap + (size_t)m0 * lda);
  const char* baseA2 = (const char*)(A2p + (size_t)m0 * lda);
  const char* baseB = (const char*)Bp;
#define LOADH(S_, kt_, H_) do { if ((kt_) < KT) { \
    _Pragma("unroll") for (int ii_ = 0; ii_ < 2; ii_++) { \
      const size_t uo_ = ((size_t)(64 * ii_) * lda + (size_t)(kt_) * 64 + 32 * (H_)) * 2; \
      const size_t uob_ = ((size_t)(64 * ii_) * ldb + (size_t)(kt_) * 64 + 32 * (H_)) * 2; \
      ra[S_][H_][ii_] = *(const u32x4*)(baseA + uo_ + voffA); \
      if (MODE == 1) ra2[S_][H_][ii_] = *(const u32x4*)(baseA2 + uo_ + voffA); \
      rb[S_][H_][ii_] = *(const u32x4*)(baseB + uob_ + voffB); \
    } \
    if (MODE == 1) rmu[S_][H_] = *(const u32x4*)(mup + (kt_) * 64 + 32 * (H_) + lc4 * 8); \
  } } while (0)
#define STOREH(S_, H_, B_) do { \
    _Pragma("unroll") for (int ii_ = 0; ii_ < 2; ii_++) { \
      const int row_ = lr + 64 * ii_; \
      u32x4 av_ = ra[S_][H_][ii_]; \
      if (MODE == 1) { \
        const u32x4 xv_ = ra[S_][H_][ii_], dv_ = ra2[S_][H_][ii_], mv_ = rmu[S_][H_]; \
        av_ = (u32x4){xs16(xv_.x, dv_.x, mv_.x), xs16(xv_.y, dv_.y, mv_.y), xs16(xv_.z, dv_.z, mv_.z), xs16(xv_.w, dv_.w, mv_.w)}; \
      } \
      *(u32x4*)(Asb[B_] + row_ * LDB + lc4 * 8) = av_; \
      *(u32x4*)(Bsb[B_] + row_ * LDB + lc4 * 8) = rb[S_][H_][ii_]; \
    } \
  } while (0)
#define COMPUTE_SUB(B_) do { if (!(MODE == 6 && PROBE == 3)) { \
    bf16x8 af[4], bfr[4]; \
    _Pragma("unroll") for (int i = 0; i < 4; i++) af[i] = *(const bf16x8*)(Bsb[B_] + (wn * 64 + i * 16 + lc) * LDB + g * 8); \
    _Pragma("unroll") for (int j = 0; j < 4; j++) bfr[j] = *(const bf16x8*)(Asb[B_] + (wm * 64 + j * 16 + lc) * LDB + g * 8); \
    _Pragma("unroll") for (int i = 0; i < 4; i++) \
      _Pragma("unroll") for (int j = 0; j < 4; j++) { \
        if (MODE == 1) acc[i][j] = __builtin_amdgcn_mfma_f32_16x16x32_f16(__builtin_bit_cast(f16x8, af[i]), __builtin_bit_cast(f16x8, bfr[j]), acc[i][j], 0, 0, 0); \
        else acc[i][j] = __builtin_amdgcn_mfma_f32_16x16x32_bf16(af[i], bfr[j], acc[i][j], 0, 0, 0); \
      } \
  } } while (0)
  __syncthreads();
  LOADH(0, 0, 0); LOADH(0, 0, 1); LOADH(1, 1, 0); LOADH(1, 1, 1);
  STOREH(0, 0, 0);
  LOADH(0, 2, 0);
  __syncthreads();
  for (int kt = 0; kt < KT; kt += 2) {
    STOREH(0, 1, 1); LOADH(0, kt + 2, 1);
    COMPUTE_SUB(0);
    if (!(MODE == 6 && PROBE == 5)) __syncthreads();
    if (kt + 1 < KT) { STOREH(1, 0, 0); LOADH(1, kt + 3, 0); }
    COMPUTE_SUB(1);
    __syncthreads();
    if (kt + 1 < KT) {
      STOREH(1, 1, 1); LOADH(1, kt + 3, 1);
      COMPUTE_SUB(0);
      if (!(MODE == 6 && PROBE == 5)) __syncthreads();
      if (kt + 2 < KT) { STOREH(0, 0, 0); LOADH(0, kt + 4, 0); }
      COMPUTE_SUB(1);
      __syncthreads();
    }
  }
#pragma unroll
  for (int i = 0; i < 4; i++) {
    const int nl = wn * 64 + i * 16 + 4 * g;
#pragma unroll
    for (int j = 0; j < 4; j++) {
      const int m = m0 + wm * 64 + j * 16 + lc;
      const f32x4 v = acc[i][j];
      if (MODE == 1) {
        if (nt < 32) {
          const int p = nt >> 3, c = (nt & 7) * 128 + nl;
          bf16_t* dst = (p == 0) ? P.Rb : (p == 1) ? P.Kb : (p == 2) ? P.Vb : P.Gb;
          uint2 o; o.x = pack2(v[0], v[1]); o.y = pack2(v[2], v[3]);
          *(uint2*)(dst + (size_t)m * DM + c) = o;
        } else if (nl < 64) {
          uint2 o;
          if (nt == 32) { o.x = pack2(tanhf(v[0]), tanhf(v[1])); o.y = pack2(tanhf(v[2]), tanhf(v[3])); *(uint2*)(P.H1 + (size_t)m * 64 + nl) = o; }
          else { o.x = pack2(v[0], v[1]); o.y = pack2(v[2], v[3]); *(uint2*)(P.H2 + (size_t)m * 64 + nl) = o; }
        }
      } else if (MODE == 2) {
        const int c = (nt & 7) * 128 + nl;
        f16_t o[4];
        if (nt < 8) {
          const float4 w0v = *(const float4*)(P.w0 + c);
          const float ws[4] = {w0v.x, w0v.y, w0v.z, w0v.w};
#pragma unroll
          for (int r = 0; r < 4; r++) o[r] = (f16_t)(sigmoidf_(ws[r] + v[r]) * 0.60653065971f);
          *(uint2*)((f16_t*)P.XB + (size_t)m * DM + c) = *(uint2*)o;
        } else {
          const float4 a0v = *(const float4*)(P.a0 + c);
          const float as_[4] = {a0v.x, a0v.y, a0v.z, a0v.w};
#pragma unroll
          for (int r = 0; r < 4; r++) o[r] = (f16_t)sigmoidf_(as_[r] + v[r]);
          *(uint2*)((f16_t*)P.XXB + (size_t)m * DM + c) = *(uint2*)o;
        }
      } else if (MODE == 3 || MODE == 5) {
        const int c = n0 + nl;
        float4 res;
        if (MODE == 3) res = *(const float4*)(xin_row(P, m) + c);
        else res = *(const float4*)(P.out + OUT_Y + (size_t)m * DM + c);
        float4 o = make_float4(v[0] + ALPHA_F * res.x, v[1] + ALPHA_F * res.y, v[2] + ALPHA_F * res.z, v[3] + ALPHA_F * res.w);
        *(float4*)(P.out + OUT_Y + (size_t)m * DM + c) = o;
      } else if (MODE == 6) {
        uint2 o; o.x = pack2(v[0], v[1]); o.y = pack2(v[2], v[3]);
        *(uint2*)(P.XB + (size_t)(m & 4095) * DM + ((n0 + nl) & 1023)) = o;
      } else if (MODE == 4) {
        uint2 o; o.x = pack2(v[0], v[1]); o.y = pack2(v[2], v[3]);
        if (nt < 8) { *(uint2*)(P.Kb + (size_t)m * DM + n0 + nl) = o; }
        else if (nt >= 12) { *(uint2*)(P.Vb + (size_t)m * DM + (nt - 12) * 128 + nl) = o; }
        else {
          const bool isk = nt < 10;
          const int ck = (nt & 1) * 128 + nl;
          bf16_t* K1 = P.XB; bf16_t* V1 = P.XB + (size_t)NTOK * 256; bf16_t* VT1 = P.XB + (size_t)NTOK * 512;
          *(uint2*)((isk ? K1 : V1) + (size_t)m * 256 + ck) = o;
          const float4 fo = make_float4(v[0], v[1], v[2], v[3]);
          if (m < NPR) {
            const int b = m >> 13, tt = m & (TP - 1);
            if (!isk) {
              const int hk = ck >> 6, d = ck & 63;
              bf16_t* vt = VT1 + ((size_t)((b * 4 + hk) * 64 + d)) * TP + tt;
              vt[0] = f2bf(v[0]); vt[TP] = f2bf(v[1]); vt[2 * TP] = f2bf(v[2]); vt[3 * TP] = f2bf(v[3]);
            }
            if (tt >= TP - 128) *(float4*)(P.out + (isk ? OUT_WK_P : OUT_WV_P) + ((size_t)(b * 128 + tt - (TP - 128))) * 256 + ck) = fo;
          } else {
            const int ms = m - NPR, b = ms >> 3, tt = ms & 7;
            *(float4*)(P.out + (isk ? OUT_WK_S : OUT_WV_S) + ((size_t)(b * 128 + 120 + tt)) * 256 + ck) = fo;
          }
        }
      }
    }
  }
}
template <int MODE>
__device__ __forceinline__ void gemm_phase(const Params& P, unsigned char* smem, int bid, int nb) {
  constexpr int NT = (MODE == 1) ? 34 : (MODE == 2) ? 16 : (MODE == 4 || MODE == 6) ? 20 : 8;
  const int ntiles = 136 * NT;
  for (int tile = bid; tile < ntiles; tile += nb) gemm_tile<MODE>(P, smem, tile % 136, tile / 136);
}

#define TS 8
#define REC 392
typedef float f32x2 __attribute__((ext_vector_type(2)));
__device__ __forceinline__ f32x2 pkfma(f32x2 a, f32x2 b, f32x2 c) { return __builtin_elementwise_fma(a, b, c); }
#define DPP_ADD(x, ctrl) ((x) + __builtin_bit_cast(float, __builtin_amdgcn_update_dpp(0, __builtin_bit_cast(int, (x)), (ctrl), 0xF, 0xF, true)))
__device__ __forceinline__ float wave_sum_fast(float x) {
  x = DPP_ADD(x, 0xB1); x = DPP_ADD(x, 0x4E); x = DPP_ADD(x, 0x141); x = DPP_ADD(x, 0x140);
  const int xi = __builtin_bit_cast(int, x);
  const float t0 = __builtin_bit_cast(float, __builtin_amdgcn_readlane(xi, 0)), t1 = __builtin_bit_cast(float, __builtin_amdgcn_readlane(xi, 16));
  const float t2 = __builtin_bit_cast(float, __builtin_amdgcn_readlane(xi, 32)), t3 = __builtin_bit_cast(float, __builtin_amdgcn_readlane(xi, 48));
  return (t0 + t1) + (t2 + t3);
}
#define LD8(dst, ptr) do { _Pragma("unroll") for (int j4_ = 0; j4_ < 4; j4_++) { const f32x4 v_ = *(const f32x4*)((ptr) + 4 * j4_); \
    dst[2 * j4_] = (f32x2){v_[0], v_[1]}; dst[2 * j4_ + 1] = (f32x2){v_[2], v_[3]}; } } while (0)

template <int INIT  , bool USEV, bool WRITEY>
__device__ __forceinline__ void scan_unit(const Params& P, float* ws, int lane, int tok0, int nsteps, int h, const float* init_ptr, float* fin) {
  const int rq = lane >> 2, q = lane & 3;
  f32x2 s[4][8];
#pragma unroll
  for (int i = 0; i < 4; i++)
#pragma unroll
    for (int j = 0; j < 8; j++) {
      if (INIT == 1) s[i][j] = (f32x2){((rq + 16 * i) == (16 * q + 2 * j)) ? 1.f : 0.f, ((rq + 16 * i) == (16 * q + 2 * j + 1)) ? 1.f : 0.f};
      else s[i][j] = (f32x2){0.f, 0.f};
    }
  if (INIT == 2) {
#pragma unroll
    for (int i = 0; i < 4; i++) LD8(s[i], init_ptr + (size_t)(rq + 16 * i) * 64 + 16 * q);
  }
  const int c = h * 64 + lane;
  const float kkc = P.k_k[c], kac = P.k_a[c], rkc = P.r_k[c];
  const int crow = h * 64 + rq + 16 * q;
  const float gng = P.gn_g[crow], gnb = P.gn_b[crow];
  const f16_t* EW = (const f16_t*)P.XB;
  const f16_t* AA = (const f16_t*)P.XXB;

  bf16_t rk[TS], rv[TS], rr[TS]; f16_t ra_[TS], re_[TS];
#define LOAD_RAW(tb) do { _Pragma("unroll") for (int tt_ = 0; tt_ < TS; tt_++) { const size_t off_ = (size_t)(tok0 + (tb) + tt_) * DM + c; \
    rk[tt_] = P.Kb[off_]; ra_[tt_] = AA[off_]; re_[tt_] = EW[off_]; if (USEV) rv[tt_] = P.Vb[off_]; if (WRITEY) rr[tt_] = P.Rb[off_]; } } while (0)
  LOAD_RAW(0);
  for (int t0 = 0; t0 < nsteps; t0 += TS) {
    {
      float gcum = 1.f;
#pragma unroll
      for (int tt = 0; tt < TS; tt++) {
        const float kraw = bf2f(rk[tt]);
        const float a = (float)ra_[tt];
        const float wd = __expf(-(float)re_[tt]);
        float kkv = kraw * kkc;
        const float ss = wave_sum_fast(kkv * kkv);
        kkv = kkv / fmaxf(sqrtf(ss), 1e-12f);
        const float kf = kraw * (1.f + (a - 1.f) * kac);
        float* rec = ws + tt * REC;
        rec[lane] = kkv * gcum;
        gcum *= wd;
        const float ginv = 1.f / gcum;
        rec[128 + lane] = kf * ginv; rec[192 + lane] = kkv * a * ginv;
        if (WRITEY) {
          const float r = bf2f(rr[tt]);
          rec[256 + lane] = r * gcum;
          const float bonus = wave_sum_fast(r * kf * rkc);
          if (lane == 0) rec[384] = bonus;
        }
        if (USEV) rec[320 + lane] = bf2f(rv[tt]);
      }
      ws[TS * REC + lane] = gcum;
    }
    __builtin_amdgcn_wave_barrier();
    asm volatile("s_waitcnt lgkmcnt(0)" ::: "memory");
    if (t0 + TS < nsteps) LOAD_RAW(t0 + TS);
#pragma unroll 1
    for (int tt = 0; tt < TS; tt++) {
      const float* rec = ws + tt * REC;
      f32x2 o2[8];
      LD8(o2, rec + 16 * q);
      f32x2 nsa2[4];
      {
        f32x2 acc[4];
#pragma unroll
        for (int i = 0; i < 4; i++) acc[i] = s[i][0] * o2[0];
#pragma unroll
        for (int j = 1; j < 8; j++)
#pragma unroll
          for (int i = 0; i < 4; i++) acc[i] = pkfma(s[i][j], o2[j], acc[i]);
#pragma unroll
        for (int i = 0; i < 4; i++) { const float t = -quad_sum(acc[i][0] + acc[i][1]); nsa2[i] = (f32x2){t, t}; }
      }
      float vv[4];
      if (USEV) {
#pragma unroll
        for (int i = 0; i < 4; i++) vv[i] = rec[320 + rq + 16 * i];
      }
      f32x2 b2[8];
      LD8(b2, rec + 192 + 16 * q);
      if (USEV) LD8(o2, rec + 128 + 16 * q);
#pragma unroll
      for (int i = 0; i < 4; i++) {
#pragma unroll
        for (int j = 0; j < 8; j++) s[i][j] = pkfma(nsa2[i], b2[j], s[i][j]);
        if (USEV) {
          const f32x2 vv2 = (f32x2){vv[i], vv[i]};
#pragma unroll
          for (int j = 0; j < 8; j++) s[i][j] = pkfma(vv2, o2[j], s[i][j]);
        }
      }
      if (WRITEY) {
        LD8(o2, rec + 256 + 16 * q);
        float y[4];
        {
          f32x2 acc[4];
#pragma unroll
          for (int i = 0; i < 4; i++) acc[i] = s[i][0] * o2[0];
#pragma unroll
          for (int j = 1; j < 8; j++)
#pragma unroll
            for (int i = 0; i < 4; i++) acc[i] = pkfma(s[i][j], o2[j], acc[i]);
#pragma unroll
          for (int i = 0; i < 4; i++) y[i] = quad_sum(acc[i][0] + acc[i][1]);
        }
        const float ysel = (q == 0) ? y[0] : (q == 1) ? y[1] : (q == 2) ? y[2] : y[3];
        const float vsel = (q == 0) ? vv[0] : (q == 1) ? vv[1] : (q == 2) ? vv[2] : vv[3];
        const float mean = wave_sum_fast(ysel) * (1.f / 64.f);
        const float ex2 = wave_sum_fast(ysel * ysel) * (1.f / 64.f);
        const float var = fmaxf(ex2 - mean * mean, 0.f);
        float yo = (ysel - mean) * rsqrtf(var + 64e-5f) * gng + gnb + rec[384] * vsel;
        const size_t off = (size_t)(tok0 + t0 + tt) * DM + crow;
        const float gt = bf2f(P.Gb[off]);
        yo *= gt * sigmoidf_(gt);
        P.Gb[off] = f2bf(yo);
      }
    }
    {
      f32x2 ge[8];
      LD8(ge, ws + TS * REC + 16 * q);
#pragma unroll
      for (int i = 0; i < 4; i++)
#pragma unroll
        for (int j = 0; j < 8; j++) s[i][j] *= ge[j];
    }
    __builtin_amdgcn_wave_barrier();
    asm volatile("s_waitcnt lgkmcnt(0)" ::: "memory");
  }
  if (fin) {
#pragma unroll
    for (int i = 0; i < 4; i++)
#pragma unroll
      for (int j4 = 0; j4 < 4; j4++)
        *(f32x4*)(fin + (size_t)(rq + 16 * i) * 64 + 16 * q + 4 * j4) = (f32x4){s[i][2 * j4][0], s[i][2 * j4][1], s[i][2 * j4 + 1][0], s[i][2 * j4 + 1][1]};
  }
}

__device__ __forceinline__ void phase_scan1(const Params& P, unsigned char* smem, int bid, int nb) {
  const int lane = threadIdx.x & 63, w = threadIdx.x >> 6;
  float* ws = (float*)smem + w * (TS * REC + 64);
  float* Ploc = P.out + OUT_WK_S;
  float* Sloc = P.out + OUT_WV_S;
  const int total = NBH * (NC - 1) * 2;
  for (int u = w * nb + bid; u < total; u += 4 * nb) {
    const int kind = u & 1, rest = u >> 1;
    const int c = rest % (NC - 1), bh = rest / (NC - 1);
    const int tok0 = (bh >> 4) * TP + c * CL, h = bh & 15;
    float* fin = (kind ? Ploc : Sloc) + (size_t)(bh * (NC - 1) + c) * 4096;
    if (kind) scan_unit<1, false, false>(P, ws, lane, tok0, CL, h, nullptr, fin);
    else scan_unit<0, true, false>(P, ws, lane, tok0, CL, h, nullptr, fin);
  }
}
__device__ __forceinline__ void phase_scan2(const Params& P, unsigned char* smem, int bid, int nb) {
  const int lane = threadIdx.x & 63, w = threadIdx.x >> 6;
  float* ws = (float*)smem + w * 256;
  float* Ploc = P.out + OUT_WK_S;
  float* Sloc = P.out + OUT_WV_S;
  for (int item = bid; item < NBH * 4; item += nb) {
    const int bh = item >> 2, row0 = (item & 3) * 16 + w * 4;
    float s[4];
    {
      const float* S0 = Sloc + (size_t)(bh * (NC - 1)) * 4096;
#pragma unroll
      for (int r = 0; r < 4; r++) s[r] = S0[(row0 + r) * 64 + lane];
    }
    for (int c = 1; c < NC - 1; c++) {
      const float* Pc = Ploc + (size_t)(bh * (NC - 1) + c) * 4096;
      float* Sc = Sloc + (size_t)(bh * (NC - 1) + c) * 4096;
      float acc[4];
#pragma unroll
      for (int r = 0; r < 4; r++) { acc[r] = Sc[(row0 + r) * 64 + lane]; ws[r * 64 + lane] = s[r]; }
      __builtin_amdgcn_wave_barrier();
      asm volatile("s_waitcnt lgkmcnt(0)" ::: "memory");
#pragma unroll 1
      for (int hf = 0; hf < 2; hf++) {
        float p[32];
#pragma unroll
        for (int i = 0; i < 32; i++) p[i] = Pc[(hf * 32 + i) * 64 + lane];
#pragma unroll
        for (int r = 0; r < 4; r++) {
#pragma unroll
          for (int i4 = 0; i4 < 8; i4++) {
            const float4 sv = *(const float4*)(ws + r * 64 + hf * 32 + 4 * i4);
            acc[r] = fmaf(sv.x, p[4 * i4], acc[r]); acc[r] = fmaf(sv.y, p[4 * i4 + 1], acc[r]);
            acc[r] = fmaf(sv.z, p[4 * i4 + 2], acc[r]); acc[r] = fmaf(sv.w, p[4 * i4 + 3], acc[r]);
          }
        }
      }
      __builtin_amdgcn_wave_barrier();
      asm volatile("s_waitcnt lgkmcnt(0)" ::: "memory");
#pragma unroll
      for (int r = 0; r < 4; r++) { s[r] = acc[r]; Sc[(row0 + r) * 64 + lane] = acc[r]; }
    }
  }
}
__device__ __forceinline__ void phase_scan3(const Params& P, unsigned char* smem, int bid, int nb) {
  const int lane = threadIdx.x & 63, w = threadIdx.x >> 6;
  float* ws = (float*)smem + w * (TS * REC + 64);
  float* Sloc = P.out + OUT_WV_S;
  const int hb = nb >> 1;
  if (bid < hb) {
    for (int u = w * hb + bid; u < NBH * NC; u += 4 * hb) {
      const int bh = u >> 5, c = u & 31;
      const int tok0 = (bh >> 4) * TP + c * CL, h = bh & 15;
      const float* ip = (c > 0) ? (Sloc + (size_t)(bh * (NC - 1) + c - 1) * 4096) : nullptr;
      float* fin = (c == NC - 1) ? (P.out + OUT_WKV_P + (size_t)bh * 4096) : nullptr;
      if (c > 0) scan_unit<2, true, true>(P, ws, lane, tok0, CL, h, ip, fin);
      else scan_unit<0, true, true>(P, ws, lane, tok0, CL, h, ip, fin);
    }
  } else {
    for (int sb = w * (nb - hb) + (bid - hb); sb < 2048; sb += 4 * (nb - hb))
      scan_unit<2, true, true>(P, ws, lane, NPR + (sb >> 4) * 8, 8, sb & 15, P.state_wkv + (size_t)sb * 4096, P.out + OUT_WKV_S + (size_t)sb * 4096);
  }
}

__device__ __forceinline__ void phase_ln(const Params& P, int layer, int bid, int nb) {
  const int lane = threadIdx.x & 63, w = threadIdx.x >> 6;
  const float* gg = P.ln_g + layer * DM; const float* bb = P.ln_b + layer * DM;
  for (int tok = bid * 4 + w; tok < NTOK; tok += nb * 4) {
    f32x4* row = (f32x4*)(P.out + OUT_Y + (size_t)tok * DM);
    f32x4 v[4];
    float sum = 0.f;
#pragma unroll
    for (int i = 0; i < 4; i++) { v[i] = row[lane + 64 * i]; sum += v[i][0] + v[i][1] + v[i][2] + v[i][3]; }
    const float mean = wave_sum(sum) * (1.f / 1024.f);
    float sq = 0.f;
#pragma unroll
    for (int i = 0; i < 4; i++) { v[i] -= mean; sq += v[i][0] * v[i][0] + v[i][1] * v[i][1] + v[i][2] * v[i][2] + v[i][3] * v[i][3]; }
    const float rs = rsqrtf(wave_sum(sq) * (1.f / 1024.f) + 1e-5f);
#pragma unroll
    for (int i = 0; i < 4; i++) {
      const f32x4 g4 = ((const f32x4*)gg)[lane + 64 * i], b4 = ((const f32x4*)bb)[lane + 64 * i];
      const f32x4 o = v[i] * rs * g4 + b4;
      row[lane + 64 * i] = o;
      if (layer == 0) { uint2 ob; ob.x = pack2(o[0], o[1]); ob.y = pack2(o[2], o[3]); ((uint2*)(P.Rb + (size_t)tok * DM))[lane + 64 * i] = ob; }
    }
  }
}

__device__ __forceinline__ void attn_prompt_item(const Params& P, unsigned char* smem, int item) {
  const int qh = item & 1, hk = (item >> 1) & 3, n = (item >> 3) & 63, b = item >> 9;
  bf16_t* Ks = (bf16_t*)smem;
  bf16_t* Vs = Ks + 192 * 72;
  const bf16_t* K1 = P.XB; const bf16_t* VT1 = P.XB + (size_t)NTOK * 512;
  const bf16_t* Q1 = P.Kb; const bf16_t* G1 = P.Vb; bf16_t* AO = P.Gb;
  const int t = threadIdx.x, lane = t & 63, w = t >> 6;
  const int g = lane >> 4, lc = lane & 15;
  const int pos0 = (n - 1) * 128 + 64 * qh;
  __syncthreads();
#pragma unroll
  for (int i = 0; i < 6; i++) {
    const int idx = t + 256 * i; const int row = idx >> 3, ch = idx & 7; const int pos = pos0 + row;
    uint4 v = make_uint4(0, 0, 0, 0);
    if (pos >= 0) v = *(const uint4*)(K1 + ((size_t)(b * TP + pos)) * 256 + hk * 64 + ch * 8);
    *(uint4*)(Ks + row * 72 + ch * 8) = v;
  }
#pragma unroll
  for (int i = 0; i < 6; i++) {
    const int idx = t + 256 * i; const int d = idx / 24, ch = idx % 24; const int pos = pos0 + ch * 8;
    uint4 v = make_uint4(0, 0, 0, 0);
    if (pos >= 0) v = *(const uint4*)(VT1 + ((size_t)((b * 4 + hk) * 64 + d)) * TP + pos);
    *(uint4*)(Vs + d * 200 + ch * 8) = v;
  }
  __syncthreads();
  const int h = hk * 4 + w;
  const float slope = exp2f(-0.5f * (float)(h + 1));
  const float sink = P.att_sinks[h];
  for (int sb = 0; sb < 2; sb++) {
    const int i0 = 64 * qh + 32 * sb;
    const int tokb = b * TP + n * 128 + i0;
    bf16x8 qf[2][2];
#pragma unroll
    for (int nn = 0; nn < 2; nn++)
#pragma unroll
      for (int ks = 0; ks < 2; ks++) qf[nn][ks] = *(const bf16x8*)(Q1 + (size_t)(tokb + 16 * nn + lc) * DM + h * 64 + ks * 32 + g * 8);
    float mrun[2] = {sink, sink}, lrun[2] = {1.f, 1.f};
    f32x4 O[4][2];
#pragma unroll
    for (int dm = 0; dm < 4; dm++) { O[dm][0] = (f32x4){0.f, 0.f, 0.f, 0.f}; O[dm][1] = (f32x4){0.f, 0.f, 0.f, 0.f}; }
    for (int kt = 0; kt < 3; kt++) {
      if (n == 0 && (qh + kt) < 2) continue;
      f32x4 S[4][2];
#pragma unroll
      for (int mm = 0; mm < 4; mm++) { S[mm][0] = (f32x4){0.f, 0.f, 0.f, 0.f}; S[mm][1] = (f32x4){0.f, 0.f, 0.f, 0.f}; }
#pragma unroll
      for (int ks = 0; ks < 2; ks++)
#pragma unroll
        for (int mm = 0; mm < 4; mm++) {
          const bf16x8 kf = *(const bf16x8*)(Ks + (kt * 64 + mm * 16 + lc) * 72 + ks * 32 + g * 8);
          S[mm][0] = __builtin_amdgcn_mfma_f32_16x16x32_bf16(kf, qf[0][ks], S[mm][0], 0, 0, 0);
          S[mm][1] = __builtin_amdgcn_mfma_f32_16x16x32_bf16(kf, qf[1][ks], S[mm][1], 0, 0, 0);
        }
#pragma unroll
      for (int nn = 0; nn < 2; nn++) {
        const int qi = i0 + 16 * nn + lc;
        float mx = mrun[nn];
#pragma unroll
        for (int mm = 0; mm < 4; mm++)
#pragma unroll
          for (int r = 0; r < 4; r++) {
            const int j = 64 * (qh + kt) + 16 * mm + 4 * g + r;
            const int dist = 128 + qi - j;
            const bool live = (dist >= 0) && (dist < 128);
            const float sv = live ? (S[mm][nn][r] * 0.125f - slope * (float)dist) : -1e30f;
            S[mm][nn][r] = sv; mx = fmaxf(mx, sv);
          }
        mx = fmaxf(mx, __shfl_xor(mx, 16)); mx = fmaxf(mx, __shfl_xor(mx, 32));
        const float corr = __expf(mrun[nn] - mx); mrun[nn] = mx;
        float sum = 0.f;
#pragma unroll
        for (int mm = 0; mm < 4; mm++)
#pragma unroll
          for (int r = 0; r < 4; r++) { const float pp = __expf(S[mm][nn][r] - mx); S[mm][nn][r] = pp; sum += pp; }
        sum += __shfl_xor(sum, 16); sum += __shfl_xor(sum, 32);
        lrun[nn] = lrun[nn] * corr + sum;
#pragma unroll
        for (int dm = 0; dm < 4; dm++) { O[dm][nn][0] *= corr; O[dm][nn][1] *= corr; O[dm][nn][2] *= corr; O[dm][nn][3] *= corr; }
      }
#pragma unroll
      for (int k2 = 0; k2 < 2; k2++) {
        bf16x8 pf[2];
#pragma unroll
        for (int nn = 0; nn < 2; nn++) {
          const unsigned u0 = pack2(S[2 * k2][nn][0], S[2 * k2][nn][1]), u1 = pack2(S[2 * k2][nn][2], S[2 * k2][nn][3]);
          const unsigned u2 = pack2(S[2 * k2 + 1][nn][0], S[2 * k2 + 1][nn][1]), u3 = pack2(S[2 * k2 + 1][nn][2], S[2 * k2 + 1][nn][3]);
          const uint4 uu = make_uint4(u0, u1, u2, u3);
          pf[nn] = *(const bf16x8*)&uu;
        }
#pragma unroll
        for (int dm = 0; dm < 4; dm++) {
          const bf16_t* vb = Vs + (dm * 16 + lc) * 200 + kt * 64 + k2 * 32 + 4 * g;
          const uint2 lo = *(const uint2*)vb, hi = *(const uint2*)(vb + 16);
          const uint4 uu = make_uint4(lo.x, lo.y, hi.x, hi.y);
          const bf16x8 vf = *(const bf16x8*)&uu;
          O[dm][0] = __builtin_amdgcn_mfma_f32_16x16x32_bf16(vf, pf[0], O[dm][0], 0, 0, 0);
          O[dm][1] = __builtin_amdgcn_mfma_f32_16x16x32_bf16(vf, pf[1], O[dm][1], 0, 0, 0);
        }
      }
    }
#pragma unroll
    for (int nn = 0; nn < 2; nn++) {
      const float inv = 1.f / lrun[nn];
      const size_t tok = (size_t)(tokb + 16 * nn + lc);
#pragma unroll
      for (int dm = 0; dm < 4; dm++) {
        const int d = dm * 16 + 4 * g;
        const uint2 gv = *(const uint2*)(G1 + tok * DM + h * 64 + d);
        const float g0 = __uint_as_float(gv.x << 16), g1 = __uint_as_float(gv.x & 0xffff0000u);
        const float g2 = __uint_as_float(gv.y << 16), g3 = __uint_as_float(gv.y & 0xffff0000u);
        uint2 o;
        o.x = pack2(O[dm][nn][0] * inv * g0 * sigmoidf_(g0), O[dm][nn][1] * inv * g1 * sigmoidf_(g1));
        o.y = pack2(O[dm][nn][2] * inv * g2 * sigmoidf_(g2), O[dm][nn][3] * inv * g3 * sigmoidf_(g3));
        *(uint2*)(AO + tok * DM + h * 64 + d) = o;
      }
    }
  }
}

__device__ __forceinline__ void attn_sample_item(const Params& P, unsigned char* smem, int item) {
  const int b = item >> 2, hk = item & 3;
  const int t = threadIdx.x, lane = t & 63, w = t >> 6;
  float* kv = (float*)smem;
  float* qs = kv + 136 * 65 + w * 512;
  float* ps = kv + 136 * 65 + 2048 + w * (8 * 136);
  const bf16_t* K1 = P.XB; const bf16_t* V1 = P.XB + (size_t)NTOK * 256;
  const bf16_t* Q1 = P.Kb; const bf16_t* G1 = P.Vb; bf16_t* AO = P.Gb;
  const int h = hk * 4 + w;
  const float slope = exp2f(-0.5f * (float)(h + 1));
  const float sink = P.att_sinks[h];
  const int tok0 = NPR + b * 8;
  __syncthreads();
#pragma unroll 2
  for (int it = 0; it < 8; it++) {
    const int idx = t + 256 * it; const int row = idx >> 4, c4 = idx & 15;
    const size_t so = ((size_t)(b * 128 + row)) * 256 + hk * 64 + c4 * 4;
    const float4 kx = *(const float4*)(P.cache_k + so);
    const float4 vx = *(const float4*)(P.cache_v + so);
    float* kd = kv + row * 65 + c4 * 4;
    kd[0] = kx.x; kd[1] = kx.y; kd[2] = kx.z; kd[3] = kx.w;
    if (row >= 8) {
      const size_t dofs = ((size_t)(b * 128 + row - 8)) * 256 + hk * 64 + c4 * 4;
      *(float4*)(P.out + OUT_WK_S + dofs) = kx;
      *(float4*)(P.out + OUT_WV_S + dofs) = vx;
    }
  }
#pragma unroll
  for (int it = 0; it < 2; it++) {
    const int idx = t + 256 * it; const int r8 = idx >> 6, d = idx & 63;
    kv[(128 + r8) * 65 + d] = bf2f(K1[(size_t)(tok0 + r8) * 256 + hk * 64 + d]);
  }
#pragma unroll
  for (int i = 0; i < 8; i++) qs[i * 64 + lane] = bf2f(Q1[(size_t)(tok0 + i) * DM + h * 64 + lane]);
  __syncthreads();
  float sc[3][8];
#pragma unroll
  for (int ksel = 0; ksel < 3; ksel++) {
    float acc[8];
#pragma unroll
    for (int i = 0; i < 8; i++) acc[i] = 0.f;
    const float* kr = kv + ((ksel < 2) ? (lane + 64 * ksel) : (128 + (lane & 7))) * 65;
#pragma unroll 2
    for (int d4 = 0; d4 < 16; d4++) {
      const float k0 = kr[4 * d4], k1 = kr[4 * d4 + 1], k2 = kr[4 * d4 + 2], k3 = kr[4 * d4 + 3];
#pragma unroll
      for (int i = 0; i < 8; i++) {
        const float4 qv = *(const float4*)(qs + i * 64 + 4 * d4);
        acc[i] = fmaf(qv.x, k0, acc[i]); acc[i] = fmaf(qv.y, k1, acc[i]); acc[i] = fmaf(qv.z, k2, acc[i]); acc[i] = fmaf(qv.w, k3, acc[i]);
      }
    }
#pragma unroll
    for (int i = 0; i < 8; i++) {
      int dist; bool live;
      if (ksel < 2) { const int j = lane + 64 * ksel; dist = 128 + i - j; live = (j > i); }
      else { dist = i - lane; live = (lane <= i); }
      sc[ksel][i] = live ? (acc[i] * 0.125f - slope * (float)dist) : -1e30f;
    }
  }
#pragma unroll
  for (int i = 0; i < 8; i++) {
    float mx = fmaxf(fmaxf(sc[0][i], sc[1][i]), sc[2][i]);
    mx = fmaxf(wave_max(mx), sink);
    const float p0 = __expf(sc[0][i] - mx), p1 = __expf(sc[1][i] - mx), p2 = __expf(sc[2][i] - mx);
    const float den = wave_sum(p0 + p1 + p2) + __expf(sink - mx);
    const float inv = 1.f / den;
    ps[i * 136 + lane] = p0 * inv; ps[i * 136 + 64 + lane] = p1 * inv;
    if (lane < 8) ps[i * 136 + 128 + lane] = p2 * inv;
  }
  __syncthreads();
#pragma unroll 4
  for (int it = 0; it < 8; it++) {
    const int idx = t + 256 * it; const int row = idx >> 4, c4 = idx & 15;
    *(float4*)(kv + row * 64 + c4 * 4) = *(const float4*)(P.cache_v + ((size_t)(b * 128 + row)) * 256 + hk * 64 + c4 * 4);
  }
#pragma unroll
  for (int it = 0; it < 2; it++) {
    const int idx = t + 256 * it; const int r8 = idx >> 6, d = idx & 63;
    kv[(128 + r8) * 64 + d] = bf2f(V1[(size_t)(tok0 + r8) * 256 + hk * 64 + d]);
  }
  __syncthreads();
  float o[8];
#pragma unroll
  for (int i = 0; i < 8; i++) o[i] = 0.f;
#pragma unroll 2
  for (int j0 = 0; j0 < 136; j0 += 4) {
    const float v0 = kv[(j0) * 64 + lane], v1 = kv[(j0 + 1) * 64 + lane], v2 = kv[(j0 + 2) * 64 + lane], v3 = kv[(j0 + 3) * 64 + lane];
#pragma unroll
    for (int i = 0; i < 8; i++) {
      const float4 pa = *(const float4*)(ps + i * 136 + j0);
      o[i] = fmaf(pa.x, v0, o[i]); o[i] = fmaf(pa.y, v1, o[i]); o[i] = fmaf(pa.z, v2, o[i]); o[i] = fmaf(pa.w, v3, o[i]);
    }
  }
#pragma unroll
  for (int i = 0; i < 8; i++) {
    const size_t off = (size_t)(tok0 + i) * DM + h * 64 + lane;
    const float gt = bf2f(G1[off]);
    AO[off] = f2bf(o[i] * gt * sigmoidf_(gt));
  }
}
__device__ __forceinline__ void phase_attn(const Params& P, unsigned char* smem, int bid, int nb) {
#if PROBE == 7
  for (int item = bid; item < 1024; item += nb) attn_prompt_item(P, smem, item);
#elif PROBE == 8
  for (int item = bid; item < 512; item += nb) attn_sample_item(P, smem, item);
#endif
  for (int item = bid; item < 1024 + 512; item += nb) {
    if (item < 1024) attn_prompt_item(P, smem, item);
    else attn_sample_item(P, smem, item - 1024);
  }
}

#if MULTI_LAUNCH
#define PH_BARRIER(ph)
#else
#define PH_BARRIER(ph) do { if ((ph) + 1 < P.phase_end) xcd_barrier(xb); } while (0)
#endif
#define RUN_PH(ph, call) do { if (P.phase_begin <= (ph) && (ph) < P.phase_end) { if ((REPMASK >> (ph)) & 1) { call; PH_BARRIER(ph); } call; PH_BARRIER(ph); } } while (0)

__global__ void __launch_bounds__(256, 2) fwd_kernel(Params P) {
  __shared__ __attribute__((aligned(16))) unsigned char smem[SMEM_BYTES];
  const int bid = blockIdx.x, nb = gridDim.x;
#if !MULTI_LAUNCH
  __shared__ uint4 xb_words;
  if (threadIdx.x == 0) xb_words = make_uint4(0u, 0u, 0u, 0u);
  __syncthreads();
  XcdBarrier xb = xcd_barrier_post(P.bar, (volatile LAS unsigned*)&xb_words);
#endif
#if (PHMASK >> 0) & 1
  RUN_PH(0, phase_prep(P, smem, bid, nb));
#endif
#if (PHMASK >> 1) & 1
  RUN_PH(1, gemm_phase<1>(P, smem, bid, nb));
#endif
#if (PHMASK >> 2) & 1
  RUN_PH(2, gemm_phase<2>(P, smem, bid, nb));
#endif
#if (PHMASK >> 3) & 1
  RUN_PH(3, phase_scan1(P, smem, bid, nb));
#endif
#if (PHMASK >> 4) & 1
  RUN_PH(4, phase_scan2(P, smem, bid, nb));
#endif
#if (PHMASK >> 5) & 1
  RUN_PH(5, phase_scan3(P, smem, bid, nb));
#endif
#if (PHMASK >> 6) & 1
  RUN_PH(6, gemm_phase<3>(P, smem, bid, nb));
#endif
#if (PHMASK >> 7) & 1
  RUN_PH(7, phase_ln(P, 0, bid, nb));
#endif
#if (PHMASK >> 8) & 1
  RUN_PH(8, gemm_phase<4>(P, smem, bid, nb));
#endif
#if (PHMASK >> 9) & 1
  RUN_PH(9, phase_attn(P, smem, bid, nb));
#endif
#if (PHMASK >> 10) & 1
  RUN_PH(10, gemm_phase<5>(P, smem, bid, nb));
#endif
#if (PHMASK >> 11) & 1
  RUN_PH(11, phase_ln(P, 1, bid, nb));
#endif
#if PROBE && PROBE < 7
  xcd_barrier(xb);
  gemm_phase<6>(P, smem, bid, nb);
#endif
#if !MULTI_LAUNCH
  if (P.phase_end > NPHASE) cg::this_grid().sync();
#endif
}

extern "C" void kernel_launch(void* const* d_in, const int* in_sizes, int n_in, void* d_out, int out_size, void* d_ws, size_t ws_size, hipStream_t stream) {
  Params P{};
  P.x_prompt = (const float*)d_in[0]; P.x_sample = (const float*)d_in[1]; P.state_wkv = (const float*)d_in[2]; P.state_shift = (const float*)d_in[3];
  P.cache_k = (const float*)d_in[4]; P.cache_v = (const float*)d_in[5]; P.ln_g = (const float*)d_in[6]; P.ln_b = (const float*)d_in[7];
  P.mu = (const float*)d_in[8]; P.w_in = (const float*)d_in[9]; P.w0 = (const float*)d_in[10]; P.w1 = (const float*)d_in[11]; P.w2 = (const float*)d_in[12];
  P.a0 = (const float*)d_in[13]; P.a1 = (const float*)d_in[14]; P.a2 = (const float*)d_in[15]; P.k_k = (const float*)d_in[16]; P.k_a = (const float*)d_in[17];
  P.r_k = (const float*)d_in[18]; P.gn_g = (const float*)d_in[19]; P.gn_b = (const float*)d_in[20]; P.w_out = (const float*)d_in[21];
  P.att_w_in = (const float*)d_in[22]; P.att_sinks = (const float*)d_in[23]; P.att_w_out = (const float*)d_in[24];
  P.out = (float*)d_out;
  unsigned char* ws = (unsigned char*)d_ws;
  size_t off = 0;
  auto take = [&](size_t bytes) { unsigned char* p = ws + off; off += (bytes + 255) & ~(size_t)255; return p; };
  P.bar = (unsigned*)take(16384);
  P.WtIn0 = (bf16_t*)take((size_t)4352 * DM * 2);
  P.W2t = (bf16_t*)take((size_t)DM * 64 * 2);
  P.A2t = (bf16_t*)take((size_t)DM * 64 * 2);
  P.WtOut0 = (bf16_t*)take((size_t)DM * DM * 2);
  P.WtIn1 = (bf16_t*)take((size_t)2560 * DM * 2);
  P.WtOut1 = (bf16_t*)take((size_t)DM * DM * 2);
  P.XB = (bf16_t*)take((size_t)NTOK * DM * 2);
  P.XXB = (bf16_t*)take((size_t)NTOK * DM * 2);
  P.Rb = (bf16_t*)take((size_t)NTOK * DM * 2);
  P.Kb = (bf16_t*)take((size_t)NTOK * DM * 2);
  P.Vb = (bf16_t*)take((size_t)NTOK * DM * 2);
  P.Gb = (bf16_t*)take((size_t)NTOK * DM * 2);
  P.H1 = (bf16_t*)take((size_t)NTOK * 64 * 2);
  P.H2 = (bf16_t*)take((size_t)NTOK * 64 * 2);
  P.MU16 = (bf16_t*)take((size_t)6 * DM * 2);
  if (off > ws_size) { fprintf(stderr, "workspace too small: need %zu have %zu\n", off, ws_size); return; }
#if MULTI_LAUNCH
  for (int ph = 0; ph < NPHASE; ph++) {
    P.phase_begin = ph; P.phase_end = ph + 1;
    hipLaunchKernelGGL(fwd_kernel, dim3(512), dim3(256), 0, stream, P);
  }
#else
  static int grid_blocks = 0;
  if (!grid_blocks) {
    int dev = 0, cus = 0, per_cu = 0;
    hipGetDevice(&dev);
    hipDeviceGetAttribute(&cus, hipDeviceAttributeMultiprocessorCount, dev);
    hipOccupancyMaxActiveBlocksPerMultiprocessor(&per_cu, fwd_kernel, 256, 0);
    if (per_cu > 2) per_cu = 2;
    if (per_cu < 1) per_cu = 1;
    grid_blocks = cus * per_cu;
  }
  hipMemsetAsync(P.bar, 0, 16384, stream);
  P.phase_begin = 0; P.phase_end = NPHASE;
  void* args[] = {&P};
  hipError_t e = hipLaunchCooperativeKernel((void*)fwd_kernel, dim3(grid_blocks), dim3(256), args, 0, stream);
  if (e != hipSuccess) fprintf(stderr, "cooperative launch failed: %s (grid %d)\n", hipGetErrorString(e), grid_blocks);
#endif
}
```

```cpp
#include <hip/hip_runtime.h>
#include <hip/hip_cooperative_groups.h>
#include <stdint.h>
#include <cstdio>
namespace cg = cooperative_groups;

#ifndef PHMASK
#define PHMASK 0xFFF
#endif
#ifndef PROBE
#define PROBE 0
#endif
#ifndef REPMASK
#define REPMASK 0
#endif
#ifndef MULTI_LAUNCH
#define MULTI_LAUNCH 0
#endif

typedef unsigned short bf16_t;
typedef _Float16 f16_t;
typedef __attribute__((ext_vector_type(8))) short bf16x8;
typedef __attribute__((ext_vector_type(4))) float f32x4;
typedef __attribute__((ext_vector_type(4))) unsigned u32x4;

#define DM 1024
#define NTOK 17408
#define NPR 16384
#define TP 8192
#define NC 32
#define CL 256
#define NBH 32
#define ALPHA_F 1.41421356237f
#define SMEM_BYTES (61 * 1024)
#define NPHASE 12

#define OUT_Y 0
#define OUT_WKV_P 17825792
#define OUT_SH_P 17956864
#define OUT_WK_P 17958912
#define OUT_WV_P 18024448
#define OUT_WKV_S 18089984
#define OUT_SH_S 26478592
#define OUT_WK_S 26609664
#define OUT_WV_S 30803968

struct Params {
  const float *x_prompt, *x_sample, *state_wkv, *state_shift, *cache_k, *cache_v, *ln_g, *ln_b;
  const float *mu, *w_in, *w0, *w1, *w2, *a0, *a1, *a2, *k_k, *k_a, *r_k, *gn_g, *gn_b, *w_out;
  const float *att_w_in, *att_sinks, *att_w_out;
  float* out;
  unsigned* bar;
  bf16_t *WtIn0, *W2t, *A2t, *WtOut0, *WtIn1, *WtOut1;
  bf16_t *XB, *XXB;
  bf16_t *Rb, *Kb, *Vb, *Gb;
  bf16_t *H1, *H2, *MU16;
  int phase_begin, phase_end;
};

typedef __bf16 hbf2 __attribute__((ext_vector_type(2)));
typedef float f32x2_ __attribute__((ext_vector_type(2)));
__device__ __forceinline__ unsigned pack2(float a, float b) {
  const f32x2_ v = {a, b};
  return __builtin_bit_cast(unsigned, __builtin_convertvector(v, hbf2));
}
__device__ __forceinline__ bf16_t f2bf(float f) { return (bf16_t)(pack2(f, 0.f) & 0xffffu); }
__device__ __forceinline__ float bf2f(bf16_t h) { return __uint_as_float(((unsigned)h) << 16); }
__device__ __forceinline__ float wave_sum(float x) {
#pragma unroll
  for (int o = 32; o >= 1; o >>= 1) x += __shfl_xor(x, o);
  return x;
}
__device__ __forceinline__ float wave_max(float x) {
#pragma unroll
  for (int o = 32; o >= 1; o >>= 1) x = fmaxf(x, __shfl_xor(x, o));
  return x;
}
__device__ __forceinline__ float quad_sum(float x) {
  x += __builtin_bit_cast(float, __builtin_amdgcn_update_dpp(0, __builtin_bit_cast(int, x), 0xB1, 0xF, 0xF, true));
  x += __builtin_bit_cast(float, __builtin_amdgcn_update_dpp(0, __builtin_bit_cast(int, x), 0x4E, 0xF, 0xF, true));
  return x;
}
__device__ __forceinline__ float sigmoidf_(float x) { return 1.f / (1.f + __expf(-x)); }
__device__ __forceinline__ const float* xin_row(const Params& P, int m) {
  return (m < NPR) ? (P.x_prompt + (size_t)m * DM) : (P.x_sample + (size_t)(m - NPR) * DM);
}

#define XB_TMO      128
#define XB_XCNT(j)  (256  + 64 * (j))
#define XB_XSUB(j)  (1280 + 64 * (j))
#define XB_XGEN(j)  (2304 + 64 * (j))
#define XB_TOP      3328
#define XB_TOPGEN   3392
#define XCD_BAR_WORDS 3456
#define XB_SPIN_CAP (1u << 22)
#define LAS __attribute__((address_space(3)))
__device__ __forceinline__ unsigned xb_ld(unsigned* p) { return __hip_atomic_load(p, __ATOMIC_RELAXED, __HIP_MEMORY_SCOPE_AGENT); }
__device__ __forceinline__ unsigned xb_add(unsigned* p, unsigned v) { return __hip_atomic_fetch_add(p, v, __ATOMIC_RELAXED, __HIP_MEMORY_SCOPE_AGENT); }
__device__ __forceinline__ unsigned xb_xcc_id() { return (unsigned)__builtin_amdgcn_s_getreg((3 << 11) | 20) & 0xFu; }
#define XB_SPIN(cond, bar) do { unsigned _sp = 0; while (cond) { __builtin_amdgcn_s_sleep(1); \
    if ((++_sp & 255u) == 0u) { if (xb_ld(&(bar)[XB_TMO])) break; if (_sp > XB_SPIN_CAP) { atomicAdd(&(bar)[XB_TMO], 1u); break; } } } } while (0)
struct XcdBarrier { unsigned* bar; unsigned x; volatile LAS unsigned* st; };
__device__ __forceinline__ XcdBarrier xcd_barrier_post(unsigned* bar, volatile LAS unsigned* st) {
  XcdBarrier b; b.bar = bar; b.x = xb_xcc_id(); b.st = st;
  if (threadIdx.x == 0) (void)xb_add(&bar[XB_XCNT(b.x)], 1u);
  return b;
}
__device__ __forceinline__ void xcd_barrier_complete(unsigned* bar, unsigned x, unsigned& nloc, unsigned& nx) {
  const unsigned G = gridDim.x * gridDim.y * gridDim.z;
  unsigned sum, cnt, mine, sp = 0u;
  for (;;) {
    sum = 0u; cnt = 0u; mine = 0u;
#pragma unroll
    for (unsigned j = 0; j < 16; ++j) { const unsigned c = xb_ld(&bar[XB_XCNT(j)]); sum += c; cnt += (c > 0u) ? 1u : 0u; mine = (j == x) ? c : mine; }
    if (sum == G) break;
    __builtin_amdgcn_s_sleep(1);
    if ((++sp & 255u) == 0u) { if (xb_ld(&bar[XB_TMO])) break; if (sp > XB_SPIN_CAP) { atomicAdd(&bar[XB_TMO], 1u); break; } }
  }
  nloc = mine > 0u ? mine : 1u; nx = cnt > 0u ? cnt : 1u;
}
__device__ __forceinline__ void xcd_barrier(const XcdBarrier& b) {
  asm volatile("s_waitcnt vmcnt(0)" ::: "memory");
  __syncthreads();
  if (threadIdx.x == 0) {
    unsigned* bar = b.bar;
    __builtin_amdgcn_s_waitcnt(0);
    unsigned nloc = b.st[0], nx = b.st[1];
    if (nloc == 0u) { xcd_barrier_complete(bar, b.x, nloc, nx); b.st[0] = nloc; b.st[1] = nx; }
    const unsigned old = xb_add(&bar[XB_XSUB(b.x)], 1u);
    const unsigned gen = old / nloc;
    if (old + 1u == (gen + 1u) * nloc) {
      __builtin_amdgcn_fence(__ATOMIC_RELEASE, "agent");
      asm volatile("s_waitcnt vmcnt(0)" ::: "memory");
      const unsigned og = xb_add(&bar[XB_TOP], 1u);
      const unsigned tg = og / nx;
      if (og + 1u == (tg + 1u) * nx) xb_add(&bar[XB_TOPGEN], 1u);
      else XB_SPIN(xb_ld(&bar[XB_TOPGEN]) == tg, bar);
      __builtin_amdgcn_fence(__ATOMIC_ACQUIRE, "agent");
      xb_add(&bar[XB_XGEN(b.x)], 1u);
      asm volatile("s_waitcnt vmcnt(0)" ::: "memory");
    } else {
      XB_SPIN(xb_ld(&bar[XB_XGEN(b.x)]) == gen, bar);
      __builtin_amdgcn_fence(__ATOMIC_ACQUIRE, "agent");
      asm volatile("s_waitcnt vmcnt(0)" ::: "memory");
    }
  }
  __syncthreads();
}

__device__ __forceinline__ unsigned short f2h_bits(float f) { const _Float16 h = (_Float16)f; return __builtin_bit_cast(unsigned short, h); }
__device__ __forceinline__ unsigned pack2h(float a, float b) { return (unsigned)f2h_bits(a) | ((unsigned)f2h_bits(b) << 16); }
__device__ __forceinline__ void transpose_tile(const float* __restrict__ src, int ld, int k0, int n0, bf16_t* __restrict__ dst, int ldd, float* tile, bool half = false) {
  const int t = threadIdx.x;
  {
    const int n = t & 63, kq = t >> 6;
#pragma unroll 4
    for (int i = 0; i < 16; i++) { const int k = i * 4 + kq; tile[k * 65 + n] = src[(size_t)(k0 + k) * ld + n0 + n]; }
  }
  __syncthreads();
  {
    const int k = t & 63, nq = t >> 6;
#pragma unroll 4
    for (int i = 0; i < 16; i++) { const int n2 = i * 4 + nq; const float v_ = tile[k * 65 + n2]; dst[(size_t)(n0 + n2) * ldd + k0 + k] = half ? f2h_bits(v_) : f2bf(v_); }
  }
  __syncthreads();
}

__device__ __forceinline__ void phase_prep(const Params& P, unsigned char* smem, int bid, int nb) {
  float* tile = (float*)smem;
  const int t = threadIdx.x;
  const int NITEMS = 2242 + 4352 + 130;
  for (int id = bid; id < NITEMS; id += nb) {
    if (id < 1024) { const int p = id >> 8, r = id & 255; transpose_tile(P.w_in + (size_t)p * DM * DM, DM, (r >> 4) * 64, (r & 15) * 64, P.WtIn0 + (size_t)p * DM * DM, DM, tile, true); }
    else if (id < 1040) transpose_tile(P.w1, 64, (id - 1024) * 64, 0, P.WtIn0 + (size_t)4096 * DM, DM, tile, true);
    else if (id < 1056) transpose_tile(P.a1, 64, (id - 1040) * 64, 0, P.WtIn0 + (size_t)4224 * DM, DM, tile, true);
    else if (id < 1072) transpose_tile(P.w2, DM, 0, (id - 1056) * 64, P.W2t, 64, tile);
    else if (id < 1088) transpose_tile(P.a2, DM, 0, (id - 1072) * 64, P.A2t, 64, tile);
    else if (id < 1344) { const int r = id - 1088; transpose_tile(P.w_out, DM, (r >> 4) * 64, (r & 15) * 64, P.WtOut0, DM, tile); }
    else if (id < 1984) { const int r = id - 1344; transpose_tile(P.att_w_in, 2560, (r / 40) * 64, (r % 40) * 64, P.WtIn1, DM, tile); }
    else if (id < 2240) { const int r = id - 1984; transpose_tile(P.att_w_out, DM, (r >> 4) * 64, (r & 15) * 64, P.WtOut1, DM, tile); }
    else if (id < 2242) {
      uint4* z = (uint4*)(P.WtIn0 + (size_t)(id == 2240 ? 4160 : 4288) * DM);
      for (int i = t; i < 8192; i += 256) z[i] = make_uint4(0, 0, 0, 0);
      if (id == 2240) for (int i = t; i < 6 * DM; i += 256) P.MU16[i] = f2h_bits(P.mu[i]);
    } else if (id < 2242 + 4352) {
      const int it = id - 2242;
#pragma unroll
      for (int q = 0; q < 4; q++) {
        const int m = it * 4 + q;
        const float4 x = ((const float4*)xin_row(P, m))[t];
        float4 pv = make_float4(0.f, 0.f, 0.f, 0.f);
        if (m < NPR) { if ((m & (TP - 1)) != 0) pv = ((const float4*)xin_row(P, m - 1))[t]; }
        else { const int ms = m - NPR; if ((ms & 7) != 0) pv = ((const float4*)xin_row(P, m - 1))[t]; else pv = ((const float4*)(P.state_shift + (size_t)(ms >> 3) * DM))[t]; }
        uint2 xb, xxb;
        xb.x = pack2h(x.x, x.y); xb.y = pack2h(x.z, x.w);
        xxb.x = pack2h(pv.x - x.x, pv.y - x.y); xxb.y = pack2h(pv.z - x.z, pv.w - x.w);
        ((uint2*)(P.XB + (size_t)m * DM))[t] = xb;
        ((uint2*)(P.XXB + (size_t)m * DM))[t] = xxb;
      }
    } else {
      const int r = id - (2242 + 4352);
      if (r < 2) ((float4*)(P.out + OUT_SH_P + (size_t)r * DM))[t] = ((const float4*)(P.x_prompt + ((size_t)r * TP + TP - 1) * DM))[t];
      else { const int b = r - 2; ((float4*)(P.out + OUT_SH_S + (size_t)b * DM))[t] = ((const float4*)(P.x_sample + ((size_t)b * 8 + 7) * DM))[t]; }
    }
  }
}

#define LDB 48
typedef _Float16 f16x8 __attribute__((ext_vector_type(8)));
typedef _Float16 f16x2 __attribute__((ext_vector_type(2)));
__device__ __forceinline__ unsigned xs16(unsigned x, unsigned d, unsigned m) {
  const f16x2 r = __builtin_elementwise_fma(__builtin_bit_cast(f16x2, d), __builtin_bit_cast(f16x2, m), __builtin_bit_cast(f16x2, x));
  return __builtin_bit_cast(unsigned, r);
}
template <int MODE>
__device__ __forceinline__ void gemm_tile(const Params& P, unsigned char* smem, int mt, int nt) {
  constexpr int KT = (MODE == 2) ? 1 : 16;
  bf16_t* Asb[2]; bf16_t* Bsb[2];
  Asb[0] = (bf16_t*)smem; Bsb[0] = Asb[0] + 128 * LDB; Asb[1] = Bsb[0] + 128 * LDB; Bsb[1] = Asb[1] + 128 * LDB;
  const int t = threadIdx.x, lane = t & 63, w = t >> 6;
  const int wm = w >> 1, wn = w & 1;
  const int g = lane >> 4, lc = lane & 15;
  const int lr = t >> 2, lc4 = t & 3;
  const int m0 = mt * 128, n0 = nt * 128;

  const bf16_t* Ap; const bf16_t* A2p = nullptr; const bf16_t* mup = nullptr; const bf16_t* Bp; int lda, ldb;
  if (MODE == 1) {
    const int p = (nt < 32) ? (nt >> 3) : (4 + (nt - 32));
    Ap = P.XB; A2p = P.XXB; lda = DM; mup = P.MU16 + (size_t)p * DM;
    Bp = P.WtIn0 + (size_t)((nt < 32) ? n0 : (4096 + (nt - 32) * 128)) * DM; ldb = DM;
  } else if (MODE == 2) {
    Ap = (nt < 8) ? P.H1 : P.H2; lda = 64;
    Bp = ((nt < 8) ? P.W2t : P.A2t) + (size_t)((nt & 7) * 128) * 64; ldb = 64;
  } else if (MODE == 3) { Ap = P.Gb; lda = DM; Bp = P.WtOut0 + (size_t)n0 * DM; ldb = DM; }
  else if (MODE == 4 || MODE == 6) { Ap = P.Rb; lda = DM; Bp = P.WtIn1 + (size_t)n0 * DM; ldb = DM; }
  else { Ap = P.Gb; lda = DM; Bp = P.WtOut1 + (size_t)n0 * DM; ldb = DM; }

  f32x4 acc[4][4];
#pragma unroll
  for (int i = 0; i < 4; i++)
#pragma unroll
    for (int j = 0; j < 4; j++) acc[i][j] = (f32x4){0.f, 0.f, 0.f, 0.f};

  u32x4 ra[2][2][2], rb[2][2][2], ra2[2][2][2], rmu[2][2];
  const unsigned voffA = (unsigned)(lr * lda + lc4 * 8) * 2u;
  const unsigned voffB = (unsigned)(lr * ldb + lc4 * 8) * 2u;
  const char* baseA = (const char*)(Ap + (size_t)m0 * lda);
  const char* baseA2 = (const char*)(A2p + (size_t)m0 * lda);
  const char* baseB = (const char*)Bp;
#define LOADH(S_, kt_, H_) do { if ((kt_) < KT) { \
    _Pragma("unroll") for (int ii_ = 0; ii_ < 2; ii_++) { \
      const size_t uo_ = ((size_t)(64 * ii_) * lda + (size_t)(kt_) * 64 + 32 * (H_)) * 2; \
      const size_t uob_ = ((size_t)(64 * ii_) * ldb + (size_t)(kt_) * 64 + 32 * (H_)) * 2; \
      ra[S_][H_][ii_] = *(const u32x4*)(baseA + uo_ + voffA); \
      if (MODE == 1) ra2[S_][H_][ii_] = *(const u32x4*)(baseA2 + uo_ + voffA); \
      rb[S_][H_][ii_] = *(const u32x4*)(baseB + uob_ + voffB); \
    } \
    if (MODE == 1) rmu[S_][H_] = *(const u32x4*)(mup + (kt_) * 64 + 32 * (H_) + lc4 * 8); \
  } } while (0)
#define STOREH(S_, H_, B_) do { \
    _Pragma("unroll") for (int ii_ = 0; ii_ < 2; ii_++) { \
      const int row_ = lr + 64 * ii_; \
      u32x4 av_ = ra[S_][H_][ii_]; \
      if (MODE == 1) { \
        const u32x4 xv_ = ra[S_][H_][ii_], dv_ = ra2[S_][H_][ii_], mv_ = rmu[S_][H_]; \
        av_ = (u32x4){xs16(xv_.x, dv_.x, mv_.x), xs16(xv_.y, dv_.y, mv_.y), xs16(xv_.z, dv_.z, mv_.z), xs16(xv_.w, dv_.w, mv_.w)}; \
      } \
      *(u32x4*)(Asb[B_] + row_ * LDB + lc4 * 8) = av_; \
      *(u32x4*)(Bsb[B_] + row_ * LDB + lc4 * 8) = rb[S_][H_][ii_]; \
    } \
  } while (0)
#define COMPUTE_SUB(B_) do { if (!(MODE == 6 && PROBE == 3)) { \
    bf16x8 af[4], bfr[4]; \
    _Pragma("unroll") for (int i = 0; i < 4; i++) af[i] = *(const bf16x8*)(Bsb[B_] + (wn * 64 + i * 16 + lc) * LDB + g * 8); \
    _Pragma("unroll") for (int j = 0; j < 4; j++) bfr[j] = *(const bf16x8*)(Asb[B_] + (wm * 64 + j * 16 + lc) * LDB + g * 8); \
    _Pragma("unroll") for (int i = 0; i < 4; i++) \
      _Pragma("unroll") for (int j = 0; j < 4; j++) { \
        if (MODE == 1) acc[i][j] = __builtin_amdgcn_mfma_f32_16x16x32_f16(__builtin_bit_cast(f16x8, af[i]), __builtin_bit_cast(f16x8, bfr[j]), acc[i][j], 0, 0, 0); \
        else acc[i][j] = __builtin_amdgcn_mfma_f32_16x16x32_bf16(af[i], bfr[j], acc[i][j], 0, 0, 0); \
      } \
  } } while (0)
  __syncthreads();
  LOADH(0, 0, 0); LOADH(0, 0, 1); LOADH(1, 1, 0); LOADH(1, 1, 1);
  STOREH(0, 0, 0);
  LOADH(0, 2, 0);
  __syncthreads();
  for (int kt = 0; kt < KT; kt += 2) {
    STOREH(0, 1, 1); LOADH(0, kt + 2, 1);
    COMPUTE_SUB(0);
    if (!(MODE == 6 && PROBE == 5)) __syncthreads();
    if (kt + 1 < KT) { STOREH(1, 0, 0); LOADH(1, kt + 3, 0); }
    COMPUTE_SUB(1);
    __syncthreads();
    if (kt + 1 < KT) {
      STOREH(1, 1, 1); LOADH(1, kt + 3, 1);
      COMPUTE_SUB(0);
      if (!(MODE == 6 && PROBE == 5)) __syncthreads();
      if (kt + 2 < KT) { STOREH(0, 0, 0); LOADH(0, kt + 4, 0); }
      COMPUTE_SUB(1);
      __syncthreads();
    }
  }
#pragma unroll
  for (int i = 0; i < 4; i++) {
    const int nl = wn * 64 + i * 16 + 4 * g;
#pragma unroll
    for (int j = 0; j < 4; j++) {
      const int m = m0 + wm * 64 + j * 16 + lc;
      const f32x4 v = acc[i][j];
      if (MODE == 1) {
        if (nt < 32) {
          const int p = nt >> 3, c = (nt & 7) * 128 + nl;
          bf16_t* dst = (p == 0) ? P.Rb : (p == 1) ? P.Kb : (p == 2) ? P.Vb : P.Gb;
          uint2 o; o.x = pack2(v[0], v[1]); o.y = pack2(v[2], v[3]);
          *(uint2*)(dst + (size_t)m * DM + c) = o;
        } else if (nl < 64) {
          uint2 o;
          if (nt == 32) { o.x = pack2(tanhf(v[0]), tanhf(v[1])); o.y = pack2(tanhf(v[2]), tanhf(v[3])); *(uint2*)(P.H1 + (size_t)m * 64 + nl) = o; }
          else { o.x = pack2(v[0], v[1]); o.y = pack2(v[2], v[3]); *(uint2*)(P.H2 + (size_t)m * 64 + nl) = o; }
        }
      } else if (MODE == 2) {
        const int c = (nt & 7) * 128 + nl;
        f16_t o[4];
        if (nt < 8) {
          const float4 w0v = *(const float4*)(P.w0 + c);
          const float ws[4] = {w0v.x, w0v.y, w0v.z, w0v.w};
#pragma unroll
          for (int r = 0; r < 4; r++) o[r] = (f16_t)(sigmoidf_(ws[r] + v[r]) * 0.60653065971f);
          *(uint2*)(((f16_t*)(P.out + OUT_Y)) + (size_t)m * DM + c) = *(uint2*)o;
        } else {
          const float4 a0v = *(const float4*)(P.a0 + c);
          const float as_[4] = {a0v.x, a0v.y, a0v.z, a0v.w};
#pragma unroll
          for (int r = 0; r < 4; r++) o[r] = (f16_t)sigmoidf_(as_[r] + v[r]);
          *(uint2*)(((f16_t*)(P.out + OUT_Y) + (size_t)NTOK * DM) + (size_t)m * DM + c) = *(uint2*)o;
        }
      } else if (MODE == 3 || MODE == 5) {
        const int c = n0 + nl;
        float4 res;
        if (MODE == 3) res = *(const float4*)(xin_row(P, m) + c);
        else res = *(const float4*)(P.out + OUT_Y + (size_t)m * DM + c);
        float4 o = make_float4(v[0] + ALPHA_F * res.x, v[1] + ALPHA_F * res.y, v[2] + ALPHA_F * res.z, v[3] + ALPHA_F * res.w);
        *(float4*)(P.out + OUT_Y + (size_t)m * DM + c) = o;
      } else if (MODE == 6) {
        uint2 o; o.x = pack2(v[0], v[1]); o.y = pack2(v[2], v[3]);
        *(uint2*)(P.XB + (size_t)(m & 4095) * DM + ((n0 + nl) & 1023)) = o;
      } else if (MODE == 4) {
        uint2 o; o.x = pack2(v[0], v[1]); o.y = pack2(v[2], v[3]);
        if (nt < 8) { *(uint2*)(P.Kb + (size_t)m * DM + n0 + nl) = o; }
        else if (nt >= 12) { *(uint2*)(P.Vb + (size_t)m * DM + (nt - 12) * 128 + nl) = o; }
        else {
          const bool isk = nt < 10;
          const int ck = (nt & 1) * 128 + nl;
          bf16_t* K1 = P.XB; bf16_t* V1 = P.XB + (size_t)NTOK * 256; bf16_t* VT1 = P.XB + (size_t)NTOK * 512;
          *(uint2*)((isk ? K1 : V1) + (size_t)m * 256 + ck) = o;
          const float4 fo = make_float4(v[0], v[1], v[2], v[3]);
          if (m < NPR) {
            const int b = m >> 13, tt = m & (TP - 1);
            if (!isk) {
              const int hk = ck >> 6, d = ck & 63;
              bf16_t* vt = VT1 + ((size_t)((b * 4 + hk) * 64 + d)) * TP + tt;
              vt[0] = f2bf(v[0]); vt[TP] = f2bf(v[1]); vt[2 * TP] = f2bf(v[2]); vt[3 * TP] = f2bf(v[3]);
            }
            if (tt >= TP - 128) *(float4*)(P.out + (isk ? OUT_WK_P : OUT_WV_P) + ((size_t)(b * 128 + tt - (TP - 128))) * 256 + ck) = fo;
          } else {
            const int ms = m - NPR, b = ms >> 3, tt = ms & 7;
            *(float4*)(P.out + (isk ? OUT_WK_S : OUT_WV_S) + ((size_t)(b * 128 + 120 + tt)) * 256 + ck) = fo;
          }
        }
      }
    }
  }
}
__device__ __forceinline__ void gemm1_part(const Params& P, unsigned char* smem, int part, int first, int stride) {
  const int nnt = part ? 16 : 18;
  for (int tile = first; tile < 136 * nnt; tile += stride) {
    const int mt = tile % 136, ntl = tile / 136;
    const int nt = part ? ((ntl < 8) ? ntl : (24 + ntl - 8)) : ((ntl < 16) ? (8 + ntl) : (32 + ntl - 16));
    gemm_tile<1>(P, smem, mt, nt);
  }
}
template <int MODE>
__device__ __forceinline__ void gemm_phase(const Params& P, unsigned char* smem, int bid, int nb) {
  constexpr int NT = (MODE == 1) ? 34 : (MODE == 2) ? 16 : (MODE == 4 || MODE == 6) ? 20 : 8;
  const int ntiles = 136 * NT;
  for (int tile = bid; tile < ntiles; tile += nb) gemm_tile<MODE>(P, smem, tile % 136, tile / 136);
}

#define TS 8
#define REC 392
typedef float f32x2 __attribute__((ext_vector_type(2)));
__device__ __forceinline__ f32x2 pkfma(f32x2 a, f32x2 b, f32x2 c) { return __builtin_elementwise_fma(a, b, c); }
#define DPP_ADD(x, ctrl) ((x) + __builtin_bit_cast(float, __builtin_amdgcn_update_dpp(0, __builtin_bit_cast(int, (x)), (ctrl), 0xF, 0xF, true)))
__device__ __forceinline__ float wave_sum_fast(float x) {
  x = DPP_ADD(x, 0xB1); x = DPP_ADD(x, 0x4E); x = DPP_ADD(x, 0x141); x = DPP_ADD(x, 0x140);
  const int xi = __builtin_bit_cast(int, x);
  const float t0 = __builtin_bit_cast(float, __builtin_amdgcn_readlane(xi, 0)), t1 = __builtin_bit_cast(float, __builtin_amdgcn_readlane(xi, 16));
  const float t2 = __builtin_bit_cast(float, __builtin_amdgcn_readlane(xi, 32)), t3 = __builtin_bit_cast(float, __builtin_amdgcn_readlane(xi, 48));
  return (t0 + t1) + (t2 + t3);
}
#define LD8(dst, ptr) do { _Pragma("unroll") for (int j4_ = 0; j4_ < 4; j4_++) { const f32x4 v_ = *(const f32x4*)((ptr) + 4 * j4_); \
    dst[2 * j4_] = (f32x2){v_[0], v_[1]}; dst[2 * j4_ + 1] = (f32x2){v_[2], v_[3]}; } } while (0)

template <int INIT  , bool USEV, bool WRITEY>
__device__ __forceinline__ void scan_unit(const Params& P, float* ws, int lane, int tok0, int nsteps, int h, const float* init_ptr, float* fin) {
  const int rq = lane >> 2, q = lane & 3;
  f32x2 s[4][8];
#pragma unroll
  for (int i = 0; i < 4; i++)
#pragma unroll
    for (int j = 0; j < 8; j++) {
      if (INIT == 1) s[i][j] = (f32x2){((rq + 16 * i) == (16 * q + 2 * j)) ? 1.f : 0.f, ((rq + 16 * i) == (16 * q + 2 * j + 1)) ? 1.f : 0.f};
      else s[i][j] = (f32x2){0.f, 0.f};
    }
  if (INIT == 2) {
#pragma unroll
    for (int i = 0; i < 4; i++) LD8(s[i], init_ptr + (size_t)(rq + 16 * i) * 64 + 16 * q);
  }
  const int c = h * 64 + lane;
  const float kkc = P.k_k[c], kac = P.k_a[c], rkc = P.r_k[c];
  const int crow = h * 64 + rq + 16 * q;
  const float gng = P.gn_g[crow], gnb = P.gn_b[crow];
  const f16_t* EW = ((const f16_t*)(P.out + OUT_Y));
  const f16_t* AA = ((const f16_t*)(P.out + OUT_Y) + (size_t)NTOK * DM);

  bf16_t rk[TS], rv[TS], rr[TS]; f16_t ra_[TS], re_[TS];
#define LOAD_RAW(tb) do { _Pragma("unroll") for (int tt_ = 0; tt_ < TS; tt_++) { const size_t off_ = (size_t)(tok0 + (tb) + tt_) * DM + c; \
    rk[tt_] = P.Kb[off_]; ra_[tt_] = AA[off_]; re_[tt_] = EW[off_]; if (USEV) rv[tt_] = P.Vb[off_]; if (WRITEY) rr[tt_] = P.Rb[off_]; } } while (0)
  LOAD_RAW(0);
  for (int t0 = 0; t0 < nsteps; t0 += TS) {
    {
      float gcum = 1.f;
#pragma unroll
      for (int tt = 0; tt < TS; tt++) {
        const float kraw = bf2f(rk[tt]);
        const float a = (float)ra_[tt];
        const float wd = __expf(-(float)re_[tt]);
        float kkv = kraw * kkc;
        const float ss = wave_sum_fast(kkv * kkv);
        kkv = kkv / fmaxf(sqrtf(ss), 1e-12f);
        const float kf = kraw * (1.f + (a - 1.f) * kac);
        float* rec = ws + tt * REC;
        rec[lane] = kkv * gcum;
        gcum *= wd;
        const float ginv = 1.f / gcum;
        rec[128 + lane] = kf * ginv; rec[192 + lane] = kkv * a * ginv;
        if (WRITEY) {
          const float r = bf2f(rr[tt]);
          rec[256 + lane] = r * gcum;
          const float bonus = wave_sum_fast(r * kf * rkc);
          if (lane == 0) rec[384] = bonus;
        }
        if (USEV) rec[320 + lane] = bf2f(rv[tt]);
      }
      ws[TS * REC + lane] = gcum;
    }
    __builtin_amdgcn_wave_barrier();
    asm volatile("s_waitcnt lgkmcnt(0)" ::: "memory");
    if (t0 + TS < nsteps) LOAD_RAW(t0 + TS);
#pragma unroll 1
    for (int tt = 0; tt < TS; tt++) {
      const float* rec = ws + tt * REC;
      f32x2 o2[8];
      LD8(o2, rec + 16 * q);
      f32x2 nsa2[4];
      {
        f32x2 acc[4];
#pragma unroll
        for (int i = 0; i < 4; i++) acc[i] = s[i][0] * o2[0];
#pragma unroll
        for (int j = 1; j < 8; j++)
#pragma unroll
          for (int i = 0; i < 4; i++) acc[i] = pkfma(s[i][j], o2[j], acc[i]);
#pragma unroll
        for (int i = 0; i < 4; i++) { const float t = -quad_sum(acc[i][0] + acc[i][1]); nsa2[i] = (f32x2){t, t}; }
      }
      float vv[4];
      if (USEV) {
#pragma unroll
        for (int i = 0; i < 4; i++) vv[i] = rec[320 + rq + 16 * i];
      }
      f32x2 b2[8];
      LD8(b2, rec + 192 + 16 * q);
      if (USEV) LD8(o2, rec + 128 + 16 * q);
#pragma unroll
      for (int i = 0; i < 4; i++) {
#pragma unroll
        for (int j = 0; j < 8; j++) s[i][j] = pkfma(nsa2[i], b2[j], s[i][j]);
        if (USEV) {
          const f32x2 vv2 = (f32x2){vv[i], vv[i]};
#pragma unroll
          for (int j = 0; j < 8; j++) s[i][j] = pkfma(vv2, o2[j], s[i][j]);
        }
      }
      if (WRITEY) {
        LD8(o2, rec + 256 + 16 * q);
        float y[4];
        {
          f32x2 acc[4];
#pragma unroll
          for (int i = 0; i < 4; i++) acc[i] = s[i][0] * o2[0];
#pragma unroll
          for (int j = 1; j < 8; j++)
#pragma unroll
            for (int i = 0; i < 4; i++) acc[i] = pkfma(s[i][j], o2[j], acc[i]);
#pragma unroll
          for (int i = 0; i < 4; i++) y[i] = quad_sum(acc[i][0] + acc[i][1]);
        }
        const float ysel = (q == 0) ? y[0] : (q == 1) ? y[1] : (q == 2) ? y[2] : y[3];
        const float vsel = (q == 0) ? vv[0] : (q == 1) ? vv[1] : (q == 2) ? vv[2] : vv[3];
        const float mean = wave_sum_fast(ysel) * (1.f / 64.f);
        const float ex2 = wave_sum_fast(ysel * ysel) * (1.f / 64.f);
        const float var = fmaxf(ex2 - mean * mean, 0.f);
        float yo = (ysel - mean) * rsqrtf(var + 64e-5f) * gng + gnb + rec[384] * vsel;
        const size_t off = (size_t)(tok0 + t0 + tt) * DM + crow;
        const float gt = bf2f(P.Gb[off]);
        yo *= gt * sigmoidf_(gt);
        P.Gb[off] = f2bf(yo);
      }
    }
    {
      f32x2 ge[8];
      LD8(ge, ws + TS * REC + 16 * q);
#pragma unroll
      for (int i = 0; i < 4; i++)
#pragma unroll
        for (int j = 0; j < 8; j++) s[i][j] *= ge[j];
    }
    __builtin_amdgcn_wave_barrier();
    asm volatile("s_waitcnt lgkmcnt(0)" ::: "memory");
  }
  if (fin) {
#pragma unroll
    for (int i = 0; i < 4; i++)
#pragma unroll
      for (int j4 = 0; j4 < 4; j4++)
        *(f32x4*)(fin + (size_t)(rq + 16 * i) * 64 + 16 * q + 4 * j4) = (f32x4){s[i][2 * j4][0], s[i][2 * j4][1], s[i][2 * j4 + 1][0], s[i][2 * j4 + 1][1]};
  }
}

__device__ __forceinline__ void phase_scan1(const Params& P, unsigned char* smem, int bid, int nb) {
  const int lane = threadIdx.x & 63, w = threadIdx.x >> 6;
  float* ws = (float*)smem + w * (TS * REC + 64);
  float* Ploc = P.out + OUT_WK_S;
  float* Sloc = P.out + OUT_WV_S;
  const int hb = nb >> 1;
  if (bid >= hb) { gemm1_part(P, smem, 1, bid - hb, nb - hb); return; }
  for (int u = w * hb + bid; u < NBH * (NC - 1) * 2; u += 4 * hb) {
    const int kind = (u ^ (u / (4 * hb))) & 1, rest = u >> 1;
    const int c = rest % (NC - 1), bh = rest / (NC - 1);
    const int tok0 = (bh >> 4) * TP + c * CL, h = bh & 15;
    float* fin = (kind ? Ploc : Sloc) + (size_t)(bh * (NC - 1) + c) * 4096;
    if (kind) scan_unit<1, false, false>(P, ws, lane, tok0, CL, h, nullptr, fin);
    else scan_unit<0, true, false>(P, ws, lane, tok0, CL, h, nullptr, fin);
  }
}
__device__ __forceinline__ void phase_scan2(const Params& P, unsigned char* smem, int bid, int nb) {
  const int lane = threadIdx.x & 63, w = threadIdx.x >> 6;
  float* ws = (float*)smem + w * 256;
  float* Ploc = P.out + OUT_WK_S;
  float* Sloc = P.out + OUT_WV_S;
  for (int item = bid; item < NBH * 4; item += nb) {
    const int bh = item >> 2, row0 = (item & 3) * 16 + w * 4;
    float s[4];
    {
      const float* S0 = Sloc + (size_t)(bh * (NC - 1)) * 4096;
#pragma unroll
      for (int r = 0; r < 4; r++) s[r] = S0[(row0 + r) * 64 + lane];
    }
    for (int c = 1; c < NC - 1; c++) {
      const float* Pc = Ploc + (size_t)(bh * (NC - 1) + c) * 4096;
      float* Sc = Sloc + (size_t)(bh * (NC - 1) + c) * 4096;
      float acc[4];
#pragma unroll
      for (int r = 0; r < 4; r++) { acc[r] = Sc[(row0 + r) * 64 + lane]; ws[r * 64 + lane] = s[r]; }
      __builtin_amdgcn_wave_barrier();
      asm volatile("s_waitcnt lgkmcnt(0)" ::: "memory");
#pragma unroll 1
      for (int hf = 0; hf < 2; hf++) {
        float p[32];
#pragma unroll
        for (int i = 0; i < 32; i++) p[i] = Pc[(hf * 32 + i) * 64 + lane];
#pragma unroll
        for (int r = 0; r < 4; r++) {
#pragma unroll
          for (int i4 = 0; i4 < 8; i4++) {
            const float4 sv = *(const float4*)(ws + r * 64 + hf * 32 + 4 * i4);
            acc[r] = fmaf(sv.x, p[4 * i4], acc[r]); acc[r] = fmaf(sv.y, p[4 * i4 + 1], acc[r]);
            acc[r] = fmaf(sv.z, p[4 * i4 + 2], acc[r]); acc[r] = fmaf(sv.w, p[4 * i4 + 3], acc[r]);
          }
        }
      }
      __builtin_amdgcn_wave_barrier();
      asm volatile("s_waitcnt lgkmcnt(0)" ::: "memory");
#pragma unroll
      for (int r = 0; r < 4; r++) { s[r] = acc[r]; Sc[(row0 + r) * 64 + lane] = acc[r]; }
    }
  }
}
__device__ __forceinline__ void phase_scan3(const Params& P, unsigned char* smem, int bid, int nb) {
  const int lane = threadIdx.x & 63, w = threadIdx.x >> 6;
  float* ws = (float*)smem + w * (TS * REC + 64);
  float* Sloc = P.out + OUT_WV_S;
  const int hb = nb >> 1;
  if (bid < hb) {
    for (int u = w * hb + bid; u < NBH * NC; u += 4 * hb) {
      const int bh = u >> 5, c = u & 31;
      const int tok0 = (bh >> 4) * TP + c * CL, h = bh & 15;
      const float* ip = (c > 0) ? (Sloc + (size_t)(bh * (NC - 1) + c - 1) * 4096) : nullptr;
      float* fin = (c == NC - 1) ? (P.out + OUT_WKV_P + (size_t)bh * 4096) : nullptr;
      if (c > 0) scan_unit<2, true, true>(P, ws, lane, tok0, CL, h, ip, fin);
      else scan_unit<0, true, true>(P, ws, lane, tok0, CL, h, ip, fin);
    }
  } else {
    for (int sb = w * (nb - hb) + (bid - hb); sb < 2048; sb += 4 * (nb - hb))
      scan_unit<2, true, true>(P, ws, lane, NPR + (sb >> 4) * 8, 8, sb & 15, P.state_wkv + (size_t)sb * 4096, P.out + OUT_WKV_S + (size_t)sb * 4096);
  }
}

__device__ __forceinline__ void phase_ln(const Params& P, int layer, int bid, int nb) {
  const int lane = threadIdx.x & 63, w = threadIdx.x >> 6;
  const float* gg = P.ln_g + layer * DM; const float* bb = P.ln_b + layer * DM;
  for (int tok = bid * 4 + w; tok < NTOK; tok += nb * 4) {
    f32x4* row = (f32x4*)(P.out + OUT_Y + (size_t)tok * DM);
    f32x4 v[4];
    float sum = 0.f;
#pragma unroll
    for (int i = 0; i < 4; i++) { v[i] = row[lane + 64 * i]; sum += v[i][0] + v[i][1] + v[i][2] + v[i][3]; }
    const float mean = wave_sum(sum) * (1.f / 1024.f);
    float sq = 0.f;
#pragma unroll
    for (int i = 0; i < 4; i++) { v[i] -= mean; sq += v[i][0] * v[i][0] + v[i][1] * v[i][1] + v[i][2] * v[i][2] + v[i][3] * v[i][3]; }
    const float rs = rsqrtf(wave_sum(sq) * (1.f / 1024.f) + 1e-5f);
#pragma unroll
    for (int i = 0; i < 4; i++) {
      const f32x4 g4 = ((const f32x4*)gg)[lane + 64 * i], b4 = ((const f32x4*)bb)[lane + 64 * i];
      const f32x4 o = v[i] * rs * g4 + b4;
      row[lane + 64 * i] = o;
      if (layer == 0) { uint2 ob; ob.x = pack2(o[0], o[1]); ob.y = pack2(o[2], o[3]); ((uint2*)(P.Rb + (size_t)tok * DM))[lane + 64 * i] = ob; }
    }
  }
}

__device__ __forceinline__ void attn_prompt_item(const Params& P, unsigned char* smem, int item) {
  const int qh = item & 1, hk = (item >> 1) & 3, n = (item >> 3) & 63, b = item >> 9;
  bf16_t* Ks = (bf16_t*)smem;
  bf16_t* Vs = Ks + 192 * 72;
  const bf16_t* K1 = P.XB; const bf16_t* VT1 = P.XB + (size_t)NTOK * 512;
  const bf16_t* Q1 = P.Kb; const bf16_t* G1 = P.Vb; bf16_t* AO = P.Gb;
  const int t = threadIdx.x, lane = t & 63, w = t >> 6;
  const int g = lane >> 4, lc = lane & 15;
  const int pos0 = (n - 1) * 128 + 64 * qh;
  __syncthreads();
#pragma unroll
  for (int i = 0; i < 6; i++) {
    const int idx = t + 256 * i; const int row = idx >> 3, ch = idx & 7; const int pos = pos0 + row;
    uint4 v = make_uint4(0, 0, 0, 0);
    if (pos >= 0) v = *(const uint4*)(K1 + ((size_t)(b * TP + pos)) * 256 + hk * 64 + ch * 8);
    *(uint4*)(Ks + row * 72 + ch * 8) = v;
  }
#pragma unroll
  for (int i = 0; i < 6; i++) {
    const int idx = t + 256 * i; const int d = idx / 24, ch = idx % 24; const int pos = pos0 + ch * 8;
    uint4 v = make_uint4(0, 0, 0, 0);
    if (pos >= 0) v = *(const uint4*)(VT1 + ((size_t)((b * 4 + hk) * 64 + d)) * TP + pos);
    *(uint4*)(Vs + d * 200 + ch * 8) = v;
  }
  __syncthreads();
  const int h = hk * 4 + w;
  const float slope = exp2f(-0.5f * (float)(h + 1));
  const float sink = P.att_sinks[h];
  for (int sb = 0; sb < 2; sb++) {
    const int i0 = 64 * qh + 32 * sb;
    const int tokb = b * TP + n * 128 + i0;
    bf16x8 qf[2][2];
#pragma unroll
    for (int nn = 0; nn < 2; nn++)
#pragma unroll
      for (int ks = 0; ks < 2; ks++) qf[nn][ks] = *(const bf16x8*)(Q1 + (size_t)(tokb + 16 * nn + lc) * DM + h * 64 + ks * 32 + g * 8);
    float mrun[2] = {sink, sink}, lrun[2] = {1.f, 1.f};
    f32x4 O[4][2];
#pragma unroll
    for (int dm = 0; dm < 4; dm++) { O[dm][0] = (f32x4){0.f, 0.f, 0.f, 0.f}; O[dm][1] = (f32x4){0.f, 0.f, 0.f, 0.f}; }
    for (int kt = 0; kt < 3; kt++) {
      if (n == 0 && (qh + kt) < 2) continue;
      f32x4 S[4][2];
#pragma unroll
      for (int mm = 0; mm < 4; mm++) { S[mm][0] = (f32x4){0.f, 0.f, 0.f, 0.f}; S[mm][1] = (f32x4){0.f, 0.f, 0.f, 0.f}; }
#pragma unroll
      for (int ks = 0; ks < 2; ks++)
#pragma unroll
        for (int mm = 0; mm < 4; mm++) {
          const bf16x8 kf = *(const bf16x8*)(Ks + (kt * 64 + mm * 16 + lc) * 72 + ks * 32 + g * 8);
          S[mm][0] = __builtin_amdgcn_mfma_f32_16x16x32_bf16(kf, qf[0][ks], S[mm][0], 0, 0, 0);
          S[mm][1] = __builtin_amdgcn_mfma_f32_16x16x32_bf16(kf, qf[1][ks], S[mm][1], 0, 0, 0);
        }
#pragma unroll
      for (int nn = 0; nn < 2; nn++) {
        const int qi = i0 + 16 * nn + lc;
        float mx = mrun[nn];
#pragma unroll
        for (int mm = 0; mm < 4; mm++)
#pragma unroll
          for (int r = 0; r < 4; r++) {
            const int j = 64 * (qh + kt) + 16 * mm + 4 * g + r;
            const int dist = 128 + qi - j;
            const bool live = (dist >= 0) && (dist < 128);
            const float sv = live ? (S[mm][nn][r] * 0.125f - slope * (float)dist) : -1e30f;
            S[mm][nn][r] = sv; mx = fmaxf(mx, sv);
          }
        mx = fmaxf(mx, __shfl_xor(mx, 16)); mx = fmaxf(mx, __shfl_xor(mx, 32));
        const float corr = __expf(mrun[nn] - mx); mrun[nn] = mx;
        float sum = 0.f;
#pragma unroll
        for (int mm = 0; mm < 4; mm++)
#pragma unroll
          for (int r = 0; r < 4; r++) { const float pp = __expf(S[mm][nn][r] - mx); S[mm][nn][r] = pp; sum += pp; }
        sum += __shfl_xor(sum, 16); sum += __shfl_xor(sum, 32);
        lrun[nn] = lrun[nn] * corr + sum;
#pragma unroll
        for (int dm = 0; dm < 4; dm++) { O[dm][nn][0] *= corr; O[dm][nn][1] *= corr; O[dm][nn][2] *= corr; O[dm][nn][3] *= corr; }
      }
#pragma unroll
      for (int k2 = 0; k2 < 2; k2++) {
        bf16x8 pf[2];
#pragma unroll
        for (int nn = 0; nn < 2; nn++) {
          const unsigned u0 = pack2(S[2 * k2][nn][0], S[2 * k2][nn][1]), u1 = pack2(S[2 * k2][nn][2], S[2 * k2][nn][3]);
          const unsigned u2 = pack2(S[2 * k2 + 1][nn][0], S[2 * k2 + 1][nn][1]), u3 = pack2(S[2 * k2 + 1][nn][2], S[2 * k2 + 1][nn][3]);
          const uint4 uu = make_uint4(u0, u1, u2, u3);
          pf[nn] = *(const bf16x8*)&uu;
        }
#pragma unroll
        for (int dm = 0; dm < 4; dm++) {
          const bf16_t* vb = Vs + (dm * 16 + lc) * 200 + kt * 64 + k2 * 32 + 4 * g;
          const uint2 lo = *(const uint2*)vb, hi = *(const uint2*)(vb + 16);
          const uint4 uu = make_uint4(lo.x, lo.y, hi.x, hi.y);
          const bf16x8 vf = *(const bf16x8*)&uu;
          O[dm][0] = __builtin_amdgcn_mfma_f32_16x16x32_bf16(vf, pf[0], O[dm][0], 0, 0, 0);
          O[dm][1] = __builtin_amdgcn_mfma_f32_16x16x32_bf16(vf, pf[1], O[dm][1], 0, 0, 0);
        }
      }
    }
#pragma unroll
    for (int nn = 0; nn < 2; nn++) {
      const float inv = 1.f / lrun[nn];
      const size_t tok = (size_t)(tokb + 16 * nn + lc);
#pragma unroll
      for (int dm = 0; dm < 4; dm++) {
        const int d = dm * 16 + 4 * g;
        const uint2 gv = *(const uint2*)(G1 + tok * DM + h * 64 + d);
        const float g0 = __uint_as_float(gv.x << 16), g1 = __uint_as_float(gv.x & 0xffff0000u);
        const float g2 = __uint_as_float(gv.y << 16), g3 = __uint_as_float(gv.y & 0xffff0000u);
        uint2 o;
        o.x = pack2(O[dm][nn][0] * inv * g0 * sigmoidf_(g0), O[dm][nn][1] * inv * g1 * sigmoidf_(g1));
        o.y = pack2(O[dm][nn][2] * inv * g2 * sigmoidf_(g2), O[dm][nn][3] * inv * g3 * sigmoidf_(g3));
        *(uint2*)(AO + tok * DM + h * 64 + d) = o;
      }
    }
  }
}

__device__ __forceinline__ void attn_sample_item(const Params& P, unsigned char* smem, int item) {
  const int b = item >> 2, hk = item & 3;
  const int t = threadIdx.x, lane = t & 63, w = t >> 6;
  float* kv = (float*)smem;
  float* qs = kv + 136 * 65 + w * 512;
  float* ps = kv + 136 * 65 + 2048 + w * (8 * 136);
  const bf16_t* K1 = P.XB; const bf16_t* V1 = P.XB + (size_t)NTOK * 256;
  const bf16_t* Q1 = P.Kb; const bf16_t* G1 = P.Vb; bf16_t* AO = P.Gb;
  const int h = hk * 4 + w;
  const float slope = exp2f(-0.5f * (float)(h + 1));
  const float sink = P.att_sinks[h];
  const int tok0 = NPR + b * 8;
  __syncthreads();
#pragma unroll 2
  for (int it = 0; it < 8; it++) {
    const int idx = t + 256 * it; const int row = idx >> 4, c4 = idx & 15;
    const size_t so = ((size_t)(b * 128 + row)) * 256 + hk * 64 + c4 * 4;
    const float4 kx = *(const float4*)(P.cache_k + so);
    const float4 vx = *(const float4*)(P.cache_v + so);
    float* kd = kv + row * 65 + c4 * 4;
    kd[0] = kx.x; kd[1] = kx.y; kd[2] = kx.z; kd[3] = kx.w;
    if (row >= 8) {
      const size_t dofs = ((size_t)(b * 128 + row - 8)) * 256 + hk * 64 + c4 * 4;
      *(float4*)(P.out + OUT_WK_S + dofs) = kx;
      *(float4*)(P.out + OUT_WV_S + dofs) = vx;
    }
  }
#pragma unroll
  for (int it = 0; it < 2; it++) {
    const int idx = t + 256 * it; const int r8 = idx >> 6, d = idx & 63;
    kv[(128 + r8) * 65 + d] = bf2f(K1[(size_t)(tok0 + r8) * 256 + hk * 64 + d]);
  }
#pragma unroll
  for (int i = 0; i < 8; i++) qs[i * 64 + lane] = bf2f(Q1[(size_t)(tok0 + i) * DM + h * 64 + lane]);
  __syncthreads();
  float sc[3][8];
#pragma unroll
  for (int ksel = 0; ksel < 3; ksel++) {
    float acc[8];
#pragma unroll
    for (int i = 0; i < 8; i++) acc[i] = 0.f;
    const float* kr = kv + ((ksel < 2) ? (lane + 64 * ksel) : (128 + (lane & 7))) * 65;
#pragma unroll 2
    for (int d4 = 0; d4 < 16; d4++) {
      const float k0 = kr[4 * d4], k1 = kr[4 * d4 + 1], k2 = kr[4 * d4 + 2], k3 = kr[4 * d4 + 3];
#pragma unroll
      for (int i = 0; i < 8; i++) {
        const float4 qv = *(const float4*)(qs + i * 64 + 4 * d4);
        acc[i] = fmaf(qv.x, k0, acc[i]); acc[i] = fmaf(qv.y, k1, acc[i]); acc[i] = fmaf(qv.z, k2, acc[i]); acc[i] = fmaf(qv.w, k3, acc[i]);
      }
    }
#pragma unroll
    for (int i = 0; i < 8; i++) {
      int dist; bool live;
      if (ksel < 2) { const int j = lane + 64 * ksel; dist = 128 + i - j; live = (j > i); }
      else { dist = i - lane; live = (lane <= i); }
      sc[ksel][i] = live ? (acc[i] * 0.125f - slope * (float)dist) : -1e30f;
    }
  }
#pragma unroll
  for (int i = 0; i < 8; i++) {
    float mx = fmaxf(fmaxf(sc[0][i], sc[1][i]), sc[2][i]);
    mx = fmaxf(wave_max(mx), sink);
    const float p0 = __expf(sc[0][i] - mx), p1 = __expf(sc[1][i] - mx), p2 = __expf(sc[2][i] - mx);
    const float den = wave_sum(p0 + p1 + p2) + __expf(sink - mx);
    const float inv = 1.f / den;
    ps[i * 136 + lane] = p0 * inv; ps[i * 136 + 64 + lane] = p1 * inv;
    if (lane < 8) ps[i * 136 + 128 + lane] = p2 * inv;
  }
  __syncthreads();
#pragma unroll 4
  for (int it = 0; it < 8; it++) {
    const int idx = t + 256 * it; const int row = idx >> 4, c4 = idx & 15;
    *(float4*)(kv + row * 64 + c4 * 4) = *(const float4*)(P.cache_v + ((size_t)(b * 128 + row)) * 256 + hk * 64 + c4 * 4);
  }
#pragma unroll
  for (int it = 0; it < 2; it++) {
    const int idx = t + 256 * it; const int r8 = idx >> 6, d = idx & 63;
    kv[(128 + r8) * 64 + d] = bf2f(V1[(size_t)(tok0 + r8) * 256 + hk * 64 + d]);
  }
  __syncthreads();
  float o[8];
#pragma unroll
  for (int i = 0; i < 8; i++) o[i] = 0.f;
#pragma unroll 2
  for (int j0 = 0; j0 < 136; j0 += 4) {
    const float v0 = kv[(j0) * 64 + lane], v1 = kv[(j0 + 1) * 64 + lane], v2 = kv[(j0 + 2) * 64 + lane], v3 = kv[(j0 + 3) * 64 + lane];
#pragma unroll
    for (int i = 0; i < 8; i++) {
      const float4 pa = *(const float4*)(ps + i * 136 + j0);
      o[i] = fmaf(pa.x, v0, o[i]); o[i] = fmaf(pa.y, v1, o[i]); o[i] = fmaf(pa.z, v2, o[i]); o[i] = fmaf(pa.w, v3, o[i]);
    }
  }
#pragma unroll
  for (int i = 0; i < 8; i++) {
    const size_t off = (size_t)(tok0 + i) * DM + h * 64 + lane;
    const float gt = bf2f(G1[off]);
    AO[off] = f2bf(o[i] * gt * sigmoidf_(gt));
  }
}
__device__ __forceinline__ void phase_attn(const Params& P, unsigned char* smem, int bid, int nb) {
#if PROBE == 7
  for (int item = bid; item < 1024; item += nb) attn_prompt_item(P, smem, item);
#elif PROBE == 8
  for (int item = bid; item < 512; item += nb) attn_sample_item(P, smem, item);
#endif
  for (int item = bid; item < 1024 + 512; item += nb) {
    if (item < 1024) attn_prompt_item(P, smem, item);
    else attn_sample_item(P, smem, item - 1024);
  }
}

#if MULTI_LAUNCH
#define PH_BARRIER(ph)
#else
#define PH_BARRIER(ph) do { if ((ph) + 1 < P.phase_end) xcd_barrier(xb); } while (0)
#endif
#define RUN_PH(ph, call) do { if (P.phase_begin <= (ph) && (ph) < P.phase_end) { if ((REPMASK >> (ph)) & 1) { call; PH_BARRIER(ph); } call; PH_BARRIER(ph); } } while (0)

__global__ void __launch_bounds__(256, 2) fwd_kernel(Params P) {
  __shared__ __attribute__((aligned(16))) unsigned char smem[SMEM_BYTES];
  const int bid = blockIdx.x, nb = gridDim.x;
#if !MULTI_LAUNCH
  __shared__ uint4 xb_words;
  if (threadIdx.x == 0) xb_words = make_uint4(0u, 0u, 0u, 0u);
  __syncthreads();
  XcdBarrier xb = xcd_barrier_post(P.bar, (volatile LAS unsigned*)&xb_words);
#endif
#if (PHMASK >> 0) & 1
  RUN_PH(0, phase_prep(P, smem, bid, nb));
#endif
#if (PHMASK >> 1) & 1
  RUN_PH(1, gemm1_part(P, smem, 0, bid, nb));
#endif
#if (PHMASK >> 2) & 1
  RUN_PH(2, gemm_phase<2>(P, smem, bid, nb));
#endif
#if (PHMASK >> 3) & 1
  RUN_PH(3, phase_scan1(P, smem, bid, nb));
#endif
#if (PHMASK >> 4) & 1
  RUN_PH(4, phase_scan2(P, smem, bid, nb));
#endif
#if (PHMASK >> 5) & 1
  RUN_PH(5, phase_scan3(P, smem, bid, nb));
#endif
#if (PHMASK >> 6) & 1
  RUN_PH(6, gemm_phase<3>(P, smem, bid, nb));
#endif
#if (PHMASK >> 7) & 1
  RUN_PH(7, phase_ln(P, 0, bid, nb));
#endif
#if (PHMASK >> 8) & 1
  RUN_PH(8, gemm_phase<4>(P, smem, bid, nb));
#endif
#if (PHMASK >> 9) & 1
  RUN_PH(9, phase_attn(P, smem, bid, nb));
#endif
#if (PHMASK >> 10) & 1
  RUN_PH(10, gemm_phase<5>(P, smem, bid, nb));
#endif
#if (PHMASK >> 11) & 1
  RUN_PH(11, phase_ln(P, 1, bid, nb));
#endif
#if PROBE && PROBE < 7
  xcd_barrier(xb);
  gemm_phase<6>(P, smem, bid, nb);
#endif
#if !MULTI_LAUNCH
  if (P.phase_end > NPHASE) cg::this_grid().sync();
#endif
}

extern "C" void kernel_launch(void* const* d_in, const int* in_sizes, int n_in, void* d_out, int out_size, void* d_ws, size_t ws_size, hipStream_t stream) {
  Params P{};
  P.x_prompt = (const float*)d_in[0]; P.x_sample = (const float*)d_in[1]; P.state_wkv = (const float*)d_in[2]; P.state_shift = (const float*)d_in[3];
  P.cache_k = (const float*)d_in[4]; P.cache_v = (const float*)d_in[5]; P.ln_g = (const float*)d_in[6]; P.ln_b = (const float*)d_in[7];
  P.mu = (const float*)d_in[8]; P.w_in = (const float*)d_in[9]; P.w0 = (const float*)d_in[10]; P.w1 = (const float*)d_in[11]; P.w2 = (const float*)d_in[12];
  P.a0 = (const float*)d_in[13]; P.a1 = (const float*)d_in[14]; P.a2 = (const float*)d_in[15]; P.k_k = (const float*)d_in[16]; P.k_a = (const float*)d_in[17];
  P.r_k = (const float*)d_in[18]; P.gn_g = (const float*)d_in[19]; P.gn_b = (const float*)d_in[20]; P.w_out = (const float*)d_in[21];
  P.att_w_in = (const float*)d_in[22]; P.att_sinks = (const float*)d_in[23]; P.att_w_out = (const float*)d_in[24];
  P.out = (float*)d_out;
  unsigned char* ws = (unsigned char*)d_ws;
  size_t off = 0;
  auto take = [&](size_t bytes) { unsigned char* p = ws + off; off += (bytes + 255) & ~(size_t)255; return p; };
  P.bar = (unsigned*)take(16384);
  P.WtIn0 = (bf16_t*)take((size_t)4352 * DM * 2);
  P.W2t = (bf16_t*)take((size_t)DM * 64 * 2);
  P.A2t = (bf16_t*)take((size_t)DM * 64 * 2);
  P.WtOut0 = (bf16_t*)take((size_t)DM * DM * 2);
  P.WtIn1 = (bf16_t*)take((size_t)2560 * DM * 2);
  P.WtOut1 = (bf16_t*)take((size_t)DM * DM * 2);
  P.XB = (bf16_t*)take((size_t)NTOK * DM * 2);
  P.XXB = (bf16_t*)take((size_t)NTOK * DM * 2);
  P.Rb = (bf16_t*)take((size_t)NTOK * DM * 2);
  P.Kb = (bf16_t*)take((size_t)NTOK * DM * 2);
  P.Vb = (bf16_t*)take((size_t)NTOK * DM * 2);
  P.Gb = (bf16_t*)take((size_t)NTOK * DM * 2);
  P.H1 = (bf16_t*)take((size_t)NTOK * 64 * 2);
  P.H2 = (bf16_t*)take((size_t)NTOK * 64 * 2);
  P.MU16 = (bf16_t*)take((size_t)6 * DM * 2);
  if (off > ws_size) { fprintf(stderr, "workspace too small: need %zu have %zu\n", off, ws_size); return; }
#if MULTI_LAUNCH
  for (int ph = 0; ph < NPHASE; ph++) {
    P.phase_begin = ph; P.phase_end = ph + 1;
    hipLaunchKernelGGL(fwd_kernel, dim3(512), dim3(256), 0, stream, P);
  }
#else
  static int grid_blocks = 0;
  if (!grid_blocks) {
    int dev = 0, cus = 0, per_cu = 0;
    hipGetDevice(&dev);
    hipDeviceGetAttribute(&cus, hipDeviceAttributeMultiprocessorCount, dev);
    hipOccupancyMaxActiveBlocksPerMultiprocessor(&per_cu, fwd_kernel, 256, 0);
    if (per_cu > 2) per_cu = 2;
    if (per_cu < 1) per_cu = 1;
    grid_blocks = cus * per_cu;
  }
  hipMemsetAsync(P.bar, 0, 16384, stream);
  P.phase_begin = 0; P.phase_end = NPHASE;
  void* args[] = {&P};
  hipError_t e = hipLaunchCooperativeKernel((void*)fwd_kernel, dim3(grid_blocks), dim3(256), args, 0, stream);
  if (e != hipSuccess) fprintf(stderr, "cooperative launch failed: %s (grid %d)\n", hipGetErrorString(e), grid_blocks);
#endif
}
```

```cpp
#include <hip/hip_runtime.h>
#include <hip/hip_cooperative_groups.h>
#include <stdint.h>
#include <cstdio>
namespace cg = cooperative_groups;

#ifndef PHMASK
#define PHMASK 0xFFF
#endif
#ifndef PROBE
#define PROBE 0
#endif
#ifndef REPMASK
#define REPMASK 0
#endif
#ifndef MULTI_LAUNCH
#define MULTI_LAUNCH 0
#endif

typedef unsigned short bf16_t;
typedef _Float16 f16_t;
typedef __attribute__((ext_vector_type(8))) short bf16x8;
typedef __attribute__((ext_vector_type(4))) float f32x4;
typedef __attribute__((ext_vector_type(4))) unsigned u32x4;

#define DM 1024
#define NTOK 17408
#define NPR 16384
#define TP 8192
#define NC 32
#define CL 256
#define NBH 32
#define ALPHA_F 1.41421356237f
#define SMEM_BYTES (61 * 1024)
#define NPHASE 12

#define OUT_Y 0
#define OUT_WKV_P 17825792
#define OUT_SH_P 17956864
#define OUT_WK_P 17958912
#define OUT_WV_P 18024448
#define OUT_WKV_S 18089984
#define OUT_SH_S 26478592
#define OUT_WK_S 26609664
#define OUT_WV_S 30803968

struct Params {
  const float *x_prompt, *x_sample, *state_wkv, *state_shift, *cache_k, *cache_v, *ln_g, *ln_b;
  const float *mu, *w_in, *w0, *w1, *w2, *a0, *a1, *a2, *k_k, *k_a, *r_k, *gn_g, *gn_b, *w_out;
  const float *att_w_in, *att_sinks, *att_w_out;
  float* out;
  unsigned* bar;
  bf16_t *WtIn0, *W2t, *A2t, *WtOut0, *WtIn1, *WtOut1;
  bf16_t *XB, *XXB;
  bf16_t *Rb, *Kb, *Vb, *Gb;
  bf16_t *H1, *H2, *MU16;
  int phase_begin, phase_end;
};

typedef __bf16 hbf2 __attribute__((ext_vector_type(2)));
typedef float f32x2_ __attribute__((ext_vector_type(2)));
__device__ __forceinline__ unsigned pack2(float a, float b) {
  const f32x2_ v = {a, b};
  return __builtin_bit_cast(unsigned, __builtin_convertvector(v, hbf2));
}
__device__ __forceinline__ bf16_t f2bf(float f) { return (bf16_t)(pack2(f, 0.f) & 0xffffu); }
__device__ __forceinline__ float bf2f(bf16_t h) { return __uint_as_float(((unsigned)h) << 16); }
__device__ __forceinline__ float wave_sum(float x) {
#pragma unroll
  for (int o = 32; o >= 1; o >>= 1) x += __shfl_xor(x, o);
  return x;
}
__device__ __forceinline__ float wave_max(float x) {
#pragma unroll
  for (int o = 32; o >= 1; o >>= 1) x = fmaxf(x, __shfl_xor(x, o));
  return x;
}
__device__ __forceinline__ float quad_sum(float x) {
  x += __builtin_bit_cast(float, __builtin_amdgcn_update_dpp(0, __builtin_bit_cast(int, x), 0xB1, 0xF, 0xF, true));
  x += __builtin_bit_cast(float, __builtin_amdgcn_update_dpp(0, __builtin_bit_cast(int, x), 0x4E, 0xF, 0xF, true));
  return x;
}
__device__ __forceinline__ float sigmoidf_(float x) { return __builtin_amdgcn_rcpf(1.f + __expf(-x)); }
__device__ __forceinline__ const float* xin_row(const Params& P, int m) {
  return (m < NPR) ? (P.x_prompt + (size_t)m * DM) : (P.x_sample + (size_t)(m - NPR) * DM);
}

#define XB_TMO      128
#define XB_XCNT(j)  (256  + 64 * (j))
#define XB_XSUB(j)  (1280 + 64 * (j))
#define XB_XGEN(j)  (2304 + 64 * (j))
#define XB_TOP      3328
#define XB_TOPGEN   3392
#define XCD_BAR_WORDS 3456
#define XB_SPIN_CAP (1u << 22)
#define LAS __attribute__((address_space(3)))
__device__ __forceinline__ unsigned xb_ld(unsigned* p) { return __hip_atomic_load(p, __ATOMIC_RELAXED, __HIP_MEMORY_SCOPE_AGENT); }
__device__ __forceinline__ unsigned xb_add(unsigned* p, unsigned v) { return __hip_atomic_fetch_add(p, v, __ATOMIC_RELAXED, __HIP_MEMORY_SCOPE_AGENT); }
__device__ __forceinline__ unsigned xb_xcc_id() { return (unsigned)__builtin_amdgcn_s_getreg((3 << 11) | 20) & 0xFu; }
#define XB_SPIN(cond, bar) do { unsigned _sp = 0; while (cond) { __builtin_amdgcn_s_sleep(1); \
    if ((++_sp & 255u) == 0u) { if (xb_ld(&(bar)[XB_TMO])) break; if (_sp > XB_SPIN_CAP) { atomicAdd(&(bar)[XB_TMO], 1u); break; } } } } while (0)
struct XcdBarrier { unsigned* bar; unsigned x; volatile LAS unsigned* st; };
__device__ __forceinline__ XcdBarrier xcd_barrier_post(unsigned* bar, volatile LAS unsigned* st) {
  XcdBarrier b; b.bar = bar; b.x = xb_xcc_id(); b.st = st;
  if (threadIdx.x == 0) (void)xb_add(&bar[XB_XCNT(b.x)], 1u);
  return b;
}
__device__ __forceinline__ void xcd_barrier_complete(unsigned* bar, unsigned x, unsigned& nloc, unsigned& nx) {
  const unsigned G = gridDim.x * gridDim.y * gridDim.z;
  unsigned sum, cnt, mine, sp = 0u;
  for (;;) {
    sum = 0u; cnt = 0u; mine = 0u;
#pragma unroll
    for (unsigned j = 0; j < 16; ++j) { const unsigned c = xb_ld(&bar[XB_XCNT(j)]); sum += c; cnt += (c > 0u) ? 1u : 0u; mine = (j == x) ? c : mine; }
    if (sum == G) break;
    __builtin_amdgcn_s_sleep(1);
    if ((++sp & 255u) == 0u) { if (xb_ld(&bar[XB_TMO])) break; if (sp > XB_SPIN_CAP) { atomicAdd(&bar[XB_TMO], 1u); break; } }
  }
  nloc = mine > 0u ? mine : 1u; nx = cnt > 0u ? cnt : 1u;
}
__device__ __forceinline__ void xcd_barrier(const XcdBarrier& b) {
  asm volatile("s_waitcnt vmcnt(0)" ::: "memory");
  __syncthreads();
  if (threadIdx.x == 0) {
    unsigned* bar = b.bar;
    __builtin_amdgcn_s_waitcnt(0);
    unsigned nloc = b.st[0], nx = b.st[1];
    if (nloc == 0u) { xcd_barrier_complete(bar, b.x, nloc, nx); b.st[0] = nloc; b.st[1] = nx; }
    const unsigned old = xb_add(&bar[XB_XSUB(b.x)], 1u);
    const unsigned gen = old / nloc;
    if (old + 1u == (gen + 1u) * nloc) {
      __builtin_amdgcn_fence(__ATOMIC_RELEASE, "agent");
      asm volatile("s_waitcnt vmcnt(0)" ::: "memory");
      const unsigned og = xb_add(&bar[XB_TOP], 1u);
      const unsigned tg = og / nx;
      if (og + 1u == (tg + 1u) * nx) xb_add(&bar[XB_TOPGEN], 1u);
      else XB_SPIN(xb_ld(&bar[XB_TOPGEN]) == tg, bar);
      __builtin_amdgcn_fence(__ATOMIC_ACQUIRE, "agent");
      xb_add(&bar[XB_XGEN(b.x)], 1u);
      asm volatile("s_waitcnt vmcnt(0)" ::: "memory");
    } else {
      XB_SPIN(xb_ld(&bar[XB_XGEN(b.x)]) == gen, bar);
      __builtin_amdgcn_fence(__ATOMIC_ACQUIRE, "agent");
      asm volatile("s_waitcnt vmcnt(0)" ::: "memory");
    }
  }
  __syncthreads();
}

__device__ __forceinline__ unsigned short f2h_bits(float f) { const _Float16 h = (_Float16)f; return __builtin_bit_cast(unsigned short, h); }
__device__ __forceinline__ unsigned pack2h(float a, float b) { return (unsigned)f2h_bits(a) | ((unsigned)f2h_bits(b) << 16); }
__device__ __forceinline__ void transpose_tile(const float* __restrict__ src, int ld, int k0, int n0, bf16_t* __restrict__ dst, int ldd, float* tile, bool half = false) {
  const int t = threadIdx.x;
  {
    const int n = t & 63, kq = t >> 6;
#pragma unroll 4
    for (int i = 0; i < 16; i++) { const int k = i * 4 + kq; tile[k * 65 + n] = src[(size_t)(k0 + k) * ld + n0 + n]; }
  }
  __syncthreads();
  {
    const int k = t & 63, nq = t >> 6;
#pragma unroll 4
    for (int i = 0; i < 16; i++) { const int n2 = i * 4 + nq; const float v_ = tile[k * 65 + n2]; dst[(size_t)(n0 + n2) * ldd + k0 + k] = half ? f2h_bits(v_) : f2bf(v_); }
  }
  __syncthreads();
}

__device__ __forceinline__ void phase_prep(const Params& P, unsigned char* smem, int bid, int nb) {
  float* tile = (float*)smem;
  const int t = threadIdx.x;
  const int NITEMS = 2242 + 4352 + 130;
  for (int id = bid; id < NITEMS; id += nb) {
    if (id < 1024) { const int p = id >> 8, r = id & 255; transpose_tile(P.w_in + (size_t)p * DM * DM, DM, (r >> 4) * 64, (r & 15) * 64, P.WtIn0 + (size_t)p * DM * DM, DM, tile, true); }
    else if (id < 1040) transpose_tile(P.w1, 64, (id - 1024) * 64, 0, P.WtIn0 + (size_t)4096 * DM, DM, tile, true);
    else if (id < 1056) transpose_tile(P.a1, 64, (id - 1040) * 64, 0, P.WtIn0 + (size_t)4224 * DM, DM, tile, true);
    else if (id < 1072) transpose_tile(P.w2, DM, 0, (id - 1056) * 64, P.W2t, 64, tile);
    else if (id < 1088) transpose_tile(P.a2, DM, 0, (id - 1072) * 64, P.A2t, 64, tile);
    else if (id < 1344) { const int r = id - 1088; transpose_tile(P.w_out, DM, (r >> 4) * 64, (r & 15) * 64, P.WtOut0, DM, tile); }
    else if (id < 1984) { const int r = id - 1344; transpose_tile(P.att_w_in, 2560, (r / 40) * 64, (r % 40) * 64, P.WtIn1, DM, tile); }
    else if (id < 2240) { const int r = id - 1984; transpose_tile(P.att_w_out, DM, (r >> 4) * 64, (r & 15) * 64, P.WtOut1, DM, tile); }
    else if (id < 2242) {
      uint4* z = (uint4*)(P.WtIn0 + (size_t)(id == 2240 ? 4160 : 4288) * DM);
      for (int i = t; i < 8192; i += 256) z[i] = make_uint4(0, 0, 0, 0);
      if (id == 2240) for (int i = t; i < 6 * DM; i += 256) P.MU16[i] = f2h_bits(P.mu[i]);
    } else if (id < 2242 + 4352) {
      const int it = id - 2242;
#pragma unroll
      for (int q = 0; q < 4; q++) {
        const int m = it * 4 + q;
        const float4 x = ((const float4*)xin_row(P, m))[t];
        float4 pv = make_float4(0.f, 0.f, 0.f, 0.f);
        if (m < NPR) { if ((m & (TP - 1)) != 0) pv = ((const float4*)xin_row(P, m - 1))[t]; }
        else { const int ms = m - NPR; if ((ms & 7) != 0) pv = ((const float4*)xin_row(P, m - 1))[t]; else pv = ((const float4*)(P.state_shift + (size_t)(ms >> 3) * DM))[t]; }
        uint2 xb, xxb;
        xb.x = pack2h(x.x, x.y); xb.y = pack2h(x.z, x.w);
        xxb.x = pack2h(pv.x - x.x, pv.y - x.y); xxb.y = pack2h(pv.z - x.z, pv.w - x.w);
        ((uint2*)(P.XB + (size_t)m * DM))[t] = xb;
        ((uint2*)(P.XXB + (size_t)m * DM))[t] = xxb;
      }
    } else {
      const int r = id - (2242 + 4352);
      if (r < 2) ((float4*)(P.out + OUT_SH_P + (size_t)r * DM))[t] = ((const float4*)(P.x_prompt + ((size_t)r * TP + TP - 1) * DM))[t];
      else { const int b = r - 2; ((float4*)(P.out + OUT_SH_S + (size_t)b * DM))[t] = ((const float4*)(P.x_sample + ((size_t)b * 8 + 7) * DM))[t]; }
    }
  }
}

#define LDB 48
typedef _Float16 f16x8 __attribute__((ext_vector_type(8)));
typedef _Float16 f16x2 __attribute__((ext_vector_type(2)));
__device__ __forceinline__ unsigned xs16(unsigned x, unsigned d, unsigned m) {
  const f16x2 r = __builtin_elementwise_fma(__builtin_bit_cast(f16x2, d), __builtin_bit_cast(f16x2, m), __builtin_bit_cast(f16x2, x));
  return __builtin_bit_cast(unsigned, r);
}
template <int MODE>
__device__ __forceinline__ void gemm_tile(const Params& P, unsigned char* smem, int mt, int nt) {
  constexpr int KT = (MODE == 2) ? 1 : 16;
  bf16_t* Asb[2]; bf16_t* Bsb[2];
  Asb[0] = (bf16_t*)smem; Bsb[0] = Asb[0] + 128 * LDB; Asb[1] = Bsb[0] + 128 * LDB; Bsb[1] = Asb[1] + 128 * LDB;
  const int t = threadIdx.x, lane = t & 63, w = t >> 6;
  const int wm = w >> 1, wn = w & 1;
  const int g = lane >> 4, lc = lane & 15;
  const int lr = t >> 2, lc4 = t & 3;
  const int m0 = mt * 128, n0 = nt * 128;

  const bf16_t* Ap; const bf16_t* A2p = nullptr; const bf16_t* mup = nullptr; const bf16_t* Bp; int lda, ldb;
  if (MODE == 1) {
    const int p = (nt < 32) ? (nt >> 3) : (4 + (nt - 32));
    Ap = P.XB; A2p = P.XXB; lda = DM; mup = P.MU16 + (size_t)p * DM;
    Bp = P.WtIn0 + (size_t)((nt < 32) ? n0 : (4096 + (nt - 32) * 128)) * DM; ldb = DM;
  } else if (MODE == 2) {
    Ap = (nt < 8) ? P.H1 : P.H2; lda = 64;
    Bp = ((nt < 8) ? P.W2t : P.A2t) + (size_t)((nt & 7) * 128) * 64; ldb = 64;
  } else if (MODE == 3) { Ap = P.Gb; lda = DM; Bp = P.WtOut0 + (size_t)n0 * DM; ldb = DM; }
  else if (MODE == 4 || MODE == 6) { Ap = P.Rb; lda = DM; Bp = P.WtIn1 + (size_t)n0 * DM; ldb = DM; }
  else { Ap = P.Gb; lda = DM; Bp = P.WtOut1 + (size_t)n0 * DM; ldb = DM; }

  f32x4 acc[4][4];
#pragma unroll
  for (int i = 0; i < 4; i++)
#pragma unroll
    for (int j = 0; j < 4; j++) acc[i][j] = (f32x4){0.f, 0.f, 0.f, 0.f};

  u32x4 ra[2][2][2], rb[2][2][2], ra2[2][2][2], rmu[2][2];
  const unsigned voffA = (unsigned)(lr * lda + lc4 * 8) * 2u;
  const unsigned voffB = (unsigned)(lr * ldb + lc4 * 8) * 2u;
  const char* baseA = (const char*)(Ap + (size_t)m0 * lda);
  const char* baseA2 = (const char*)(A2p + (size_t)m0 * lda);
  const char* baseB = (const char*)Bp;
#define LOADH(S_, kt_, H_) do { if ((kt_) < KT) { \
    _Pragma("unroll") for (int ii_ = 0; ii_ < 2; ii_++) { \
      const size_t uo_ = ((size_t)(64 * ii_) * lda + (size_t)(kt_) * 64 + 32 * (H_)) * 2; \
      const size_t uob_ = ((size_t)(64 * ii_) * ldb + (size_t)(kt_) * 64 + 32 * (H_)) * 2; \
      ra[S_][H_][ii_] = *(const u32x4*)(baseA + uo_ + voffA); \
      if (MODE == 1) ra2[S_][H_][ii_] = *(const u32x4*)(baseA2 + uo_ + voffA); \
      rb[S_][H_][ii_] = *(const u32x4*)(baseB + uob_ + voffB); \
    } \
    if (MODE == 1) rmu[S_][H_] = *(const u32x4*)(mup + (kt_) * 64 + 32 * (H_) + lc4 * 8); \
  } } while (0)
#define STOREH(S_, H_, B_) do { \
    _Pragma("unroll") for (int ii_ = 0; ii_ < 2; ii_++) { \
      const int row_ = lr + 64 * ii_; \
      u32x4 av_ = ra[S_][H_][ii_]; \
      if (MODE == 1) { \
        const u32x4 xv_ = ra[S_][H_][ii_], dv_ = ra2[S_][H_][ii_], mv_ = rmu[S_][H_]; \
        av_ = (u32x4){xs16(xv_.x, dv_.x, mv_.x), xs16(xv_.y, dv_.y, mv_.y), xs16(xv_.z, dv_.z, mv_.z), xs16(xv_.w, dv_.w, mv_.w)}; \
      } \
      *(u32x4*)(Asb[B_] + row_ * LDB + lc4 * 8) = av_; \
      *(u32x4*)(Bsb[B_] + row_ * LDB + lc4 * 8) = rb[S_][H_][ii_]; \
    } \
  } while (0)
#define COMPUTE_SUB(B_) do { if (!(MODE == 6 && PROBE == 3)) { \
    bf16x8 af[4], bfr[4]; \
    _Pragma("unroll") for (int i = 0; i < 4; i++) af[i] = *(const bf16x8*)(Bsb[B_] + (wn * 64 + i * 16 + lc) * LDB + g * 8); \
    _Pragma("unroll") for (int j = 0; j < 4; j++) bfr[j] = *(const bf16x8*)(Asb[B_] + (wm * 64 + j * 16 + lc) * LDB + g * 8); \
    _Pragma("unroll") for (int i = 0; i < 4; i++) \
      _Pragma("unroll") for (int j = 0; j < 4; j++) { \
        if (MODE == 1) acc[i][j] = __builtin_amdgcn_mfma_f32_16x16x32_f16(__builtin_bit_cast(f16x8, af[i]), __builtin_bit_cast(f16x8, bfr[j]), acc[i][j], 0, 0, 0); \
        else acc[i][j] = __builtin_amdgcn_mfma_f32_16x16x32_bf16(af[i], bfr[j], acc[i][j], 0, 0, 0); \
      } \
  } } while (0)
  __syncthreads();
  LOADH(0, 0, 0); LOADH(0, 0, 1); LOADH(1, 1, 0); LOADH(1, 1, 1);
  STOREH(0, 0, 0);
  LOADH(0, 2, 0);
  __syncthreads();
  for (int kt = 0; kt < KT; kt += 2) {
    STOREH(0, 1, 1); LOADH(0, kt + 2, 1);
    COMPUTE_SUB(0);
    if (!(MODE == 6 && PROBE == 5)) __syncthreads();
    if (kt + 1 < KT) { STOREH(1, 0, 0); LOADH(1, kt + 3, 0); }
    COMPUTE_SUB(1);
    __syncthreads();
    if (kt + 1 < KT) {
      STOREH(1, 1, 1); LOADH(1, kt + 3, 1);
      COMPUTE_SUB(0);
      if (!(MODE == 6 && PROBE == 5)) __syncthreads();
      if (kt + 2 < KT) { STOREH(0, 0, 0); LOADH(0, kt + 4, 0); }
      COMPUTE_SUB(1);
      __syncthreads();
    }
  }
#pragma unroll
  for (int i = 0; i < 4; i++) {
    const int nl = wn * 64 + i * 16 + 4 * g;
#pragma unroll
    for (int j = 0; j < 4; j++) {
      const int m = m0 + wm * 64 + j * 16 + lc;
      const f32x4 v = acc[i][j];
      if (MODE == 1) {
        if (nt < 32) {
          const int p = nt >> 3, c = (nt & 7) * 128 + nl;
          bf16_t* dst = (p == 0) ? P.Rb : (p == 1) ? P.Kb : (p == 2) ? P.Vb : P.Gb;
          uint2 o; o.x = pack2(v[0], v[1]); o.y = pack2(v[2], v[3]);
          *(uint2*)(dst + (size_t)m * DM + c) = o;
        } else if (nl < 64) {
          uint2 o;
          if (nt == 32) { o.x = pack2(tanhf(v[0]), tanhf(v[1])); o.y = pack2(tanhf(v[2]), tanhf(v[3])); *(uint2*)(P.H1 + (size_t)m * 64 + nl) = o; }
          else { o.x = pack2(v[0], v[1]); o.y = pack2(v[2], v[3]); *(uint2*)(P.H2 + (size_t)m * 64 + nl) = o; }
        }
      } else if (MODE == 2) {
        const int c = (nt & 7) * 128 + nl;
        f16_t o[4];
        if (nt < 8) {
          const float4 w0v = *(const float4*)(P.w0 + c);
          const float ws[4] = {w0v.x, w0v.y, w0v.z, w0v.w};
#pragma unroll
          for (int r = 0; r < 4; r++) o[r] = (f16_t)(sigmoidf_(ws[r] + v[r]) * 0.60653065971f);
          *(uint2*)(((f16_t*)(P.out + OUT_Y)) + (size_t)m * DM + c) = *(uint2*)o;
        } else {
          const float4 a0v = *(const float4*)(P.a0 + c);
          const float as_[4] = {a0v.x, a0v.y, a0v.z, a0v.w};
#pragma unroll
          for (int r = 0; r < 4; r++) o[r] = (f16_t)sigmoidf_(as_[r] + v[r]);
          *(uint2*)(((f16_t*)(P.out + OUT_Y) + (size_t)NTOK * DM) + (size_t)m * DM + c) = *(uint2*)o;
        }
      } else if (MODE == 3 || MODE == 5) {
        const int c = n0 + nl;
        float4 res;
        if (MODE == 3) res = *(const float4*)(xin_row(P, m) + c);
        else res = *(const float4*)(P.out + OUT_Y + (size_t)m * DM + c);
        float4 o = make_float4(v[0] + ALPHA_F * res.x, v[1] + ALPHA_F * res.y, v[2] + ALPHA_F * res.z, v[3] + ALPHA_F * res.w);
        *(float4*)(P.out + OUT_Y + (size_t)m * DM + c) = o;
      } else if (MODE == 6) {
        uint2 o; o.x = pack2(v[0], v[1]); o.y = pack2(v[2], v[3]);
        *(uint2*)(P.XB + (size_t)(m & 4095) * DM + ((n0 + nl) & 1023)) = o;
      } else if (MODE == 4) {
        uint2 o; o.x = pack2(v[0], v[1]); o.y = pack2(v[2], v[3]);
        if (nt < 8) { *(uint2*)(P.Kb + (size_t)m * DM + n0 + nl) = o; }
        else if (nt >= 12) { *(uint2*)(P.Vb + (size_t)m * DM + (nt - 12) * 128 + nl) = o; }
        else {
          const bool isk = nt < 10;
          const int ck = (nt & 1) * 128 + nl;
          bf16_t* K1 = P.XB; bf16_t* V1 = P.XB + (size_t)NTOK * 256; bf16_t* VT1 = P.XB + (size_t)NTOK * 512;
          *(uint2*)((isk ? K1 : V1) + (size_t)m * 256 + ck) = o;
          const float4 fo = make_float4(v[0], v[1], v[2], v[3]);
          if (m < NPR) {
            const int b = m >> 13, tt = m & (TP - 1);
            if (!isk) {
              const int hk = ck >> 6, d = ck & 63;
              bf16_t* vt = VT1 + ((size_t)((b * 4 + hk) * 64 + d)) * TP + tt;
              vt[0] = f2bf(v[0]); vt[TP] = f2bf(v[1]); vt[2 * TP] = f2bf(v[2]); vt[3 * TP] = f2bf(v[3]);
            }
            if (tt >= TP - 128) *(float4*)(P.out + (isk ? OUT_WK_P : OUT_WV_P) + ((size_t)(b * 128 + tt - (TP - 128))) * 256 + ck) = fo;
          } else {
            const int ms = m - NPR, b = ms >> 3, tt = ms & 7;
            *(float4*)(P.out + (isk ? OUT_WK_S : OUT_WV_S) + ((size_t)(b * 128 + 120 + tt)) * 256 + ck) = fo;
          }
        }
      }
    }
  }
}
__device__ __forceinline__ void gemm1_part(const Params& P, unsigned char* smem, int part, int first, int stride) {
  const int nnt = part ? 16 : 18;
  for (int tile = first; tile < 136 * nnt; tile += stride) {
    const int mt = tile % 136, ntl = tile / 136;
    const int nt = part ? ((ntl < 8) ? ntl : (24 + ntl - 8)) : ((ntl < 16) ? (8 + ntl) : (32 + ntl - 16));
    gemm_tile<1>(P, smem, mt, nt);
  }
}
template <int MODE>
__device__ __forceinline__ void gemm_phase(const Params& P, unsigned char* smem, int bid, int nb) {
  constexpr int NT = (MODE == 1) ? 34 : (MODE == 2) ? 16 : (MODE == 4 || MODE == 6) ? 20 : 8;
  const int ntiles = 136 * NT;
  for (int tile = bid; tile < ntiles; tile += nb) gemm_tile<MODE>(P, smem, tile % 136, tile / 136);
}

#define TS 8
#define REC 392
typedef float f32x2 __attribute__((ext_vector_type(2)));
__device__ __forceinline__ f32x2 pkfma(f32x2 a, f32x2 b, f32x2 c) { return __builtin_elementwise_fma(a, b, c); }
#define DPP_ADD(x, ctrl) ((x) + __builtin_bit_cast(float, __builtin_amdgcn_update_dpp(0, __builtin_bit_cast(int, (x)), (ctrl), 0xF, 0xF, true)))
__device__ __forceinline__ float wave_sum_fast(float x) {
  x = DPP_ADD(x, 0xB1); x = DPP_ADD(x, 0x4E); x = DPP_ADD(x, 0x141); x = DPP_ADD(x, 0x140);
  const int xi = __builtin_bit_cast(int, x);
  const float t0 = __builtin_bit_cast(float, __builtin_amdgcn_readlane(xi, 0)), t1 = __builtin_bit_cast(float, __builtin_amdgcn_readlane(xi, 16));
  const float t2 = __builtin_bit_cast(float, __builtin_amdgcn_readlane(xi, 32)), t3 = __builtin_bit_cast(float, __builtin_amdgcn_readlane(xi, 48));
  return (t0 + t1) + (t2 + t3);
}
#define LD8(dst, ptr) do { _Pragma("unroll") for (int j4_ = 0; j4_ < 4; j4_++) { const f32x4 v_ = *(const f32x4*)((ptr) + 4 * j4_); \
    dst[2 * j4_] = (f32x2){v_[0], v_[1]}; dst[2 * j4_ + 1] = (f32x2){v_[2], v_[3]}; } } while (0)

template <int INIT  , bool USEV, bool WRITEY>
__device__ __forceinline__ void scan_unit(const Params& P, float* ws, int lane, int tok0, int nsteps, int h, const float* init_ptr, float* fin) {
  const int rq = lane >> 2, q = lane & 3;
  f32x2 s[4][8];
#pragma unroll
  for (int i = 0; i < 4; i++)
#pragma unroll
    for (int j = 0; j < 8; j++) {
      if (INIT == 1) s[i][j] = (f32x2){((rq + 16 * i) == (16 * q + 2 * j)) ? 1.f : 0.f, ((rq + 16 * i) == (16 * q + 2 * j + 1)) ? 1.f : 0.f};
      else s[i][j] = (f32x2){0.f, 0.f};
    }
  if (INIT == 2) {
#pragma unroll
    for (int i = 0; i < 4; i++) LD8(s[i], init_ptr + (size_t)(rq + 16 * i) * 64 + 16 * q);
  }
  const int c = h * 64 + lane;
  const float kkc = P.k_k[c], kac = P.k_a[c], rkc = P.r_k[c];
  const int crow = h * 64 + rq + 16 * q;
  const float gng = P.gn_g[crow], gnb = P.gn_b[crow];
  const f16_t* EW = ((const f16_t*)(P.out + OUT_Y));
  const f16_t* AA = ((const f16_t*)(P.out + OUT_Y) + (size_t)NTOK * DM);

  bf16_t rk[TS], rv[TS], rr[TS]; f16_t ra_[TS], re_[TS];
#define LOAD_RAW(tb) do { _Pragma("unroll") for (int tt_ = 0; tt_ < TS; tt_++) { const size_t off_ = (size_t)(tok0 + (tb) + tt_) * DM + c; \
    rk[tt_] = P.Kb[off_]; ra_[tt_] = AA[off_]; re_[tt_] = EW[off_]; if (USEV) rv[tt_] = P.Vb[off_]; if (WRITEY) rr[tt_] = P.Rb[off_]; } } while (0)
  LOAD_RAW(0);
  for (int t0 = 0; t0 < nsteps; t0 += TS) {
    {
      float gcum = 1.f;
#pragma unroll
      for (int tt = 0; tt < TS; tt++) {
        const float kraw = bf2f(rk[tt]);
        const float a = (float)ra_[tt];
        const float wd = __expf(-(float)re_[tt]);
        float kkv = kraw * kkc;
        const float ss = wave_sum_fast(kkv * kkv);
        kkv = kkv * __builtin_amdgcn_rsqf(fmaxf(ss, 1e-24f));
        const float kf = kraw * (1.f + (a - 1.f) * kac);
        float* rec = ws + tt * REC;
        rec[lane] = kkv * gcum;
        gcum *= wd;
        const float ginv = __builtin_amdgcn_rcpf(gcum);
        rec[128 + lane] = kf * ginv; rec[192 + lane] = kkv * a * ginv;
        if (WRITEY) {
          const float r = bf2f(rr[tt]);
          rec[256 + lane] = r * gcum;
          const float bonus = wave_sum_fast(r * kf * rkc);
          if (lane == 0) rec[384] = bonus;
        }
        if (USEV) rec[320 + lane] = bf2f(rv[tt]);
      }
      ws[TS * REC + lane] = gcum;
    }
    __builtin_amdgcn_wave_barrier();
    asm volatile("s_waitcnt lgkmcnt(0)" ::: "memory");
    if (t0 + TS < nsteps) LOAD_RAW(t0 + TS);
#pragma unroll 1
    for (int tt = 0; tt < TS; tt++) {
      const float* rec = ws + tt * REC;
      f32x2 o2[8];
      LD8(o2, rec + 16 * q);
      f32x2 nsa2[4];
      {
        f32x2 acc[4];
#pragma unroll
        for (int i = 0; i < 4; i++) acc[i] = s[i][0] * o2[0];
#pragma unroll
        for (int j = 1; j < 8; j++)
#pragma unroll
          for (int i = 0; i < 4; i++) acc[i] = pkfma(s[i][j], o2[j], acc[i]);
#pragma unroll
        for (int i = 0; i < 4; i++) { const float t = -quad_sum(acc[i][0] + acc[i][1]); nsa2[i] = (f32x2){t, t}; }
      }
      float vv[4];
      if (USEV) {
#pragma unroll
        for (int i = 0; i < 4; i++) vv[i] = rec[320 + rq + 16 * i];
      }
      f32x2 b2[8];
      LD8(b2, rec + 192 + 16 * q);
      if (USEV) LD8(o2, rec + 128 + 16 * q);
#pragma unroll
      for (int i = 0; i < 4; i++) {
#pragma unroll
        for (int j = 0; j < 8; j++) s[i][j] = pkfma(nsa2[i], b2[j], s[i][j]);
        if (USEV) {
          const f32x2 vv2 = (f32x2){vv[i], vv[i]};
#pragma unroll
          for (int j = 0; j < 8; j++) s[i][j] = pkfma(vv2, o2[j], s[i][j]);
        }
      }
      if (WRITEY) {
        LD8(o2, rec + 256 + 16 * q);
        float y[4];
        {
          f32x2 acc[4];
#pragma unroll
          for (int i = 0; i < 4; i++) acc[i] = s[i][0] * o2[0];
#pragma unroll
          for (int j = 1; j < 8; j++)
#pragma unroll
            for (int i = 0; i < 4; i++) acc[i] = pkfma(s[i][j], o2[j], acc[i]);
#pragma unroll
          for (int i = 0; i < 4; i++) y[i] = quad_sum(acc[i][0] + acc[i][1]);
        }
        const float ysel = (q == 0) ? y[0] : (q == 1) ? y[1] : (q == 2) ? y[2] : y[3];
        const float vsel = (q == 0) ? vv[0] : (q == 1) ? vv[1] : (q == 2) ? vv[2] : vv[3];
        const float mean = wave_sum_fast(ysel) * (1.f / 64.f);
        const float ex2 = wave_sum_fast(ysel * ysel) * (1.f / 64.f);
        const float var = fmaxf(ex2 - mean * mean, 0.f);
        float yo = (ysel - mean) * rsqrtf(var + 64e-5f) * gng + gnb + rec[384] * vsel;
        const size_t off = (size_t)(tok0 + t0 + tt) * DM + crow;
        const float gt = bf2f(P.Gb[off]);
        yo *= gt * sigmoidf_(gt);
        P.Gb[off] = f2bf(yo);
      }
    }
    {
      f32x2 ge[8];
      LD8(ge, ws + TS * REC + 16 * q);
#pragma unroll
      for (int i = 0; i < 4; i++)
#pragma unroll
        for (int j = 0; j < 8; j++) s[i][j] *= ge[j];
    }
    __builtin_amdgcn_wave_barrier();
    asm volatile("s_waitcnt lgkmcnt(0)" ::: "memory");
  }
  if (fin) {
#pragma unroll
    for (int i = 0; i < 4; i++)
#pragma unroll
      for (int j4 = 0; j4 < 4; j4++)
        *(f32x4*)(fin + (size_t)(rq + 16 * i) * 64 + 16 * q + 4 * j4) = (f32x4){s[i][2 * j4][0], s[i][2 * j4][1], s[i][2 * j4 + 1][0], s[i][2 * j4 + 1][1]};
  }
}

__device__ __forceinline__ void phase_scan1(const Params& P, unsigned char* smem, int bid, int nb) {
  const int lane = threadIdx.x & 63, w = threadIdx.x >> 6;
  float* ws = (float*)smem + w * (TS * REC + 64);
  float* Ploc = P.out + OUT_WK_S;
  float* Sloc = P.out + OUT_WV_S;
  const int hb = nb >> 1;
  if (bid >= hb) { gemm1_part(P, smem, 1, bid - hb, nb - hb); return; }
  for (int u = w * hb + bid; u < NBH * (NC - 1) * 2; u += 4 * hb) {
    const int kind = (u ^ (u / (4 * hb))) & 1, rest = u >> 1;
    const int c = rest % (NC - 1), bh = rest / (NC - 1);
    const int tok0 = (bh >> 4) * TP + c * CL, h = bh & 15;
    float* fin = (kind ? Ploc : Sloc) + (size_t)(bh * (NC - 1) + c) * 4096;
    if (kind) scan_unit<1, false, false>(P, ws, lane, tok0, CL, h, nullptr, fin);
    else scan_unit<0, true, false>(P, ws, lane, tok0, CL, h, nullptr, fin);
  }
}
__device__ __forceinline__ void phase_scan2(const Params& P, unsigned char* smem, int bid, int nb) {
  const int lane = threadIdx.x & 63, w = threadIdx.x >> 6;
  float* ws = (float*)smem + w * 256;
  float* Ploc = P.out + OUT_WK_S;
  float* Sloc = P.out + OUT_WV_S;
  for (int item = bid; item < NBH * 4; item += nb) {
    const int bh = item >> 2, row0 = (item & 3) * 16 + w * 4;
    float s[4];
    {
      const float* S0 = Sloc + (size_t)(bh * (NC - 1)) * 4096;
#pragma unroll
      for (int r = 0; r < 4; r++) s[r] = S0[(row0 + r) * 64 + lane];
    }
    for (int c = 1; c < NC - 1; c++) {
      const float* Pc = Ploc + (size_t)(bh * (NC - 1) + c) * 4096;
      float* Sc = Sloc + (size_t)(bh * (NC - 1) + c) * 4096;
      float acc[4];
#pragma unroll
      for (int r = 0; r < 4; r++) { acc[r] = Sc[(row0 + r) * 64 + lane]; ws[r * 64 + lane] = s[r]; }
      __builtin_amdgcn_wave_barrier();
      asm volatile("s_waitcnt lgkmcnt(0)" ::: "memory");
#pragma unroll 1
      for (int hf = 0; hf < 2; hf++) {
        float p[32];
#pragma unroll
        for (int i = 0; i < 32; i++) p[i] = Pc[(hf * 32 + i) * 64 + lane];
#pragma unroll
        for (int r = 0; r < 4; r++) {
#pragma unroll
          for (int i4 = 0; i4 < 8; i4++) {
            const float4 sv = *(const float4*)(ws + r * 64 + hf * 32 + 4 * i4);
            acc[r] = fmaf(sv.x, p[4 * i4], acc[r]); acc[r] = fmaf(sv.y, p[4 * i4 + 1], acc[r]);
            acc[r] = fmaf(sv.z, p[4 * i4 + 2], acc[r]); acc[r] = fmaf(sv.w, p[4 * i4 + 3], acc[r]);
          }
        }
      }
      __builtin_amdgcn_wave_barrier();
      asm volatile("s_waitcnt lgkmcnt(0)" ::: "memory");
#pragma unroll
      for (int r = 0; r < 4; r++) { s[r] = acc[r]; Sc[(row0 + r) * 64 + lane] = acc[r]; }
    }
  }
}
__device__ __forceinline__ void phase_scan3(const Params& P, unsigned char* smem, int bid, int nb) {
  const int lane = threadIdx.x & 63, w = threadIdx.x >> 6;
  float* ws = (float*)smem + w * (TS * REC + 64);
  float* Sloc = P.out + OUT_WV_S;
  const int hb = nb >> 1;
  if (bid < hb) {
    for (int u = w * hb + bid; u < NBH * NC; u += 4 * hb) {
      const int bh = u >> 5, c = u & 31;
      const int tok0 = (bh >> 4) * TP + c * CL, h = bh & 15;
      const float* ip = (c > 0) ? (Sloc + (size_t)(bh * (NC - 1) + c - 1) * 4096) : nullptr;
      float* fin = (c == NC - 1) ? (P.out + OUT_WKV_P + (size_t)bh * 4096) : nullptr;
      if (c > 0) scan_unit<2, true, true>(P, ws, lane, tok0, CL, h, ip, fin);
      else scan_unit<0, true, true>(P, ws, lane, tok0, CL, h, ip, fin);
    }
  } else {
    for (int sb = w * (nb - hb) + (bid - hb); sb < 2048; sb += 4 * (nb - hb))
      scan_unit<2, true, true>(P, ws, lane, NPR + (sb >> 4) * 8, 8, sb & 15, P.state_wkv + (size_t)sb * 4096, P.out + OUT_WKV_S + (size_t)sb * 4096);
  }
}

__device__ __forceinline__ void phase_ln(const Params& P, int layer, int bid, int nb) {
  const int lane = threadIdx.x & 63, w = threadIdx.x >> 6;
  const float* gg = P.ln_g + layer * DM; const float* bb = P.ln_b + layer * DM;
  for (int tok = bid * 4 + w; tok < NTOK; tok += nb * 4) {
    f32x4* row = (f32x4*)(P.out + OUT_Y + (size_t)tok * DM);
    f32x4 v[4];
    float sum = 0.f;
#pragma unroll
    for (int i = 0; i < 4; i++) { v[i] = row[lane + 64 * i]; sum += v[i][0] + v[i][1] + v[i][2] + v[i][3]; }
    const float mean = wave_sum(sum) * (1.f / 1024.f);
    float sq = 0.f;
#pragma unroll
    for (int i = 0; i < 4; i++) { v[i] -= mean; sq += v[i][0] * v[i][0] + v[i][1] * v[i][1] + v[i][2] * v[i][2] + v[i][3] * v[i][3]; }
    const float rs = rsqrtf(wave_sum(sq) * (1.f / 1024.f) + 1e-5f);
#pragma unroll
    for (int i = 0; i < 4; i++) {
      const f32x4 g4 = ((const f32x4*)gg)[lane + 64 * i], b4 = ((const f32x4*)bb)[lane + 64 * i];
      const f32x4 o = v[i] * rs * g4 + b4;
      row[lane + 64 * i] = o;
      if (layer == 0) { uint2 ob; ob.x = pack2(o[0], o[1]); ob.y = pack2(o[2], o[3]); ((uint2*)(P.Rb + (size_t)tok * DM))[lane + 64 * i] = ob; }
    }
  }
}

__device__ __forceinline__ void attn_prompt_item(const Params& P, unsigned char* smem, int item) {
  const int qh = item & 1, hk = (item >> 1) & 3, n = (item >> 3) & 63, b = item >> 9;
  bf16_t* Ks = (bf16_t*)smem;
  bf16_t* Vs = Ks + 192 * 72;
  const bf16_t* K1 = P.XB; const bf16_t* VT1 = P.XB + (size_t)NTOK * 512;
  const bf16_t* Q1 = P.Kb; const bf16_t* G1 = P.Vb; bf16_t* AO = P.Gb;
  const int t = threadIdx.x, lane = t & 63, w = t >> 6;
  const int g = lane >> 4, lc = lane & 15;
  const int pos0 = (n - 1) * 128 + 64 * qh;
  __syncthreads();
#pragma unroll
  for (int i = 0; i < 6; i++) {
    const int idx = t + 256 * i; const int row = idx >> 3, ch = idx & 7; const int pos = pos0 + row;
    uint4 v = make_uint4(0, 0, 0, 0);
    if (pos >= 0) v = *(const uint4*)(K1 + ((size_t)(b * TP + pos)) * 256 + hk * 64 + ch * 8);
    *(uint4*)(Ks + row * 72 + ch * 8) = v;
  }
#pragma unroll
  for (int i = 0; i < 6; i++) {
    const int idx = t + 256 * i; const int d = idx / 24, ch = idx % 24; const int pos = pos0 + ch * 8;
    uint4 v = make_uint4(0, 0, 0, 0);
    if (pos >= 0) v = *(const uint4*)(VT1 + ((size_t)((b * 4 + hk) * 64 + d)) * TP + pos);
    *(uint4*)(Vs + d * 200 + ch * 8) = v;
  }
  __syncthreads();
  const int h = hk * 4 + w;
  const float slope = exp2f(-0.5f * (float)(h + 1));
  const float sink = P.att_sinks[h];
  for (int sb = 0; sb < 2; sb++) {
    const int i0 = 64 * qh + 32 * sb;
    const int tokb = b * TP + n * 128 + i0;
    bf16x8 qf[2][2];
#pragma unroll
    for (int nn = 0; nn < 2; nn++)
#pragma unroll
      for (int ks = 0; ks < 2; ks++) qf[nn][ks] = *(const bf16x8*)(Q1 + (size_t)(tokb + 16 * nn + lc) * DM + h * 64 + ks * 32 + g * 8);
    float mrun[2] = {sink, sink}, lrun[2] = {1.f, 1.f};
    f32x4 O[4][2];
#pragma unroll
    for (int dm = 0; dm < 4; dm++) { O[dm][0] = (f32x4){0.f, 0.f, 0.f, 0.f}; O[dm][1] = (f32x4){0.f, 0.f, 0.f, 0.f}; }
    for (int kt = 0; kt < 3; kt++) {
      if (n == 0 && (qh + kt) < 2) continue;
      f32x4 S[4][2];
#pragma unroll
      for (int mm = 0; mm < 4; mm++) { S[mm][0] = (f32x4){0.f, 0.f, 0.f, 0.f}; S[mm][1] = (f32x4){0.f, 0.f, 0.f, 0.f}; }
#pragma unroll
      for (int ks = 0; ks < 2; ks++)
#pragma unroll
        for (int mm = 0; mm < 4; mm++) {
          const bf16x8 kf = *(const bf16x8*)(Ks + (kt * 64 + mm * 16 + lc) * 72 + ks * 32 + g * 8);
          S[mm][0] = __builtin_amdgcn_mfma_f32_16x16x32_bf16(kf, qf[0][ks], S[mm][0], 0, 0, 0);
          S[mm][1] = __builtin_amdgcn_mfma_f32_16x16x32_bf16(kf, qf[1][ks], S[mm][1], 0, 0, 0);
        }
#pragma unroll
      for (int nn = 0; nn < 2; nn++) {
        const int qi = i0 + 16 * nn + lc;
        float mx = mrun[nn];
#pragma unroll
        for (int mm = 0; mm < 4; mm++)
#pragma unroll
          for (int r = 0; r < 4; r++) {
            const int j = 64 * (qh + kt) + 16 * mm + 4 * g + r;
            const int dist = 128 + qi - j;
            const bool live = (dist >= 0) && (dist < 128);
            const float sv = live ? (S[mm][nn][r] * 0.125f - slope * (float)dist) : -1e30f;
            S[mm][nn][r] = sv; mx = fmaxf(mx, sv);
          }
        mx = fmaxf(mx, __shfl_xor(mx, 16)); mx = fmaxf(mx, __shfl_xor(mx, 32));
        const float corr = __expf(mrun[nn] - mx); mrun[nn] = mx;
        float sum = 0.f;
#pragma unroll
        for (int mm = 0; mm < 4; mm++)
#pragma unroll
          for (int r = 0; r < 4; r++) { const float pp = __expf(S[mm][nn][r] - mx); S[mm][nn][r] = pp; sum += pp; }
        sum += __shfl_xor(sum, 16); sum += __shfl_xor(sum, 32);
        lrun[nn] = lrun[nn] * corr + sum;
#pragma unroll
        for (int dm = 0; dm < 4; dm++) { O[dm][nn][0] *= corr; O[dm][nn][1] *= corr; O[dm][nn][2] *= corr; O[dm][nn][3] *= corr; }
      }
#pragma unroll
      for (int k2 = 0; k2 < 2; k2++) {
        bf16x8 pf[2];
#pragma unroll
        for (int nn = 0; nn < 2; nn++) {
          const unsigned u0 = pack2(S[2 * k2][nn][0], S[2 * k2][nn][1]), u1 = pack2(S[2 * k2][nn][2], S[2 * k2][nn][3]);
          const unsigned u2 = pack2(S[2 * k2 + 1][nn][0], S[2 * k2 + 1][nn][1]), u3 = pack2(S[2 * k2 + 1][nn][2], S[2 * k2 + 1][nn][3]);
          const uint4 uu = make_uint4(u0, u1, u2, u3);
          pf[nn] = *(const bf16x8*)&uu;
        }
#pragma unroll
        for (int dm = 0; dm < 4; dm++) {
          const bf16_t* vb = Vs + (dm * 16 + lc) * 200 + kt * 64 + k2 * 32 + 4 * g;
          const uint2 lo = *(const uint2*)vb, hi = *(const uint2*)(vb + 16);
          const uint4 uu = make_uint4(lo.x, lo.y, hi.x, hi.y);
          const bf16x8 vf = *(const bf16x8*)&uu;
          O[dm][0] = __builtin_amdgcn_mfma_f32_16x16x32_bf16(vf, pf[0], O[dm][0], 0, 0, 0);
          O[dm][1] = __builtin_amdgcn_mfma_f32_16x16x32_bf16(vf, pf[1], O[dm][1], 0, 0, 0);
        }
      }
    }
#pragma unroll
    for (int nn = 0; nn < 2; nn++) {
      const float inv = 1.f / lrun[nn];
      const size_t tok = (size_t)(tokb + 16 * nn + lc);
#pragma unroll
      for (int dm = 0; dm < 4; dm++) {
        const int d = dm * 16 + 4 * g;
        const uint2 gv = *(const uint2*)(G1 + tok * DM + h * 64 + d);
        const float g0 = __uint_as_float(gv.x << 16), g1 = __uint_as_float(gv.x & 0xffff0000u);
        const float g2 = __uint_as_float(gv.y << 16), g3 = __uint_as_float(gv.y & 0xffff0000u);
        uint2 o;
        o.x = pack2(O[dm][nn][0] * inv * g0 * sigmoidf_(g0), O[dm][nn][1] * inv * g1 * sigmoidf_(g1));
        o.y = pack2(O[dm][nn][2] * inv * g2 * sigmoidf_(g2), O[dm][nn][3] * inv * g3 * sigmoidf_(g3));
        *(uint2*)(AO + tok * DM + h * 64 + d) = o;
      }
    }
  }
}

__device__ __forceinline__ void attn_sample_item(const Params& P, unsigned char* smem, int item) {
  const int b = item >> 2, hk = item & 3;
  const int t = threadIdx.x, lane = t & 63, w = t >> 6;
  float* kv = (float*)smem;
  float* qs = kv + 136 * 65 + w * 512;
  float* ps = kv + 136 * 65 + 2048 + w * (8 * 136);
  const bf16_t* K1 = P.XB; const bf16_t* V1 = P.XB + (size_t)NTOK * 256;
  const bf16_t* Q1 = P.Kb; const bf16_t* G1 = P.Vb; bf16_t* AO = P.Gb;
  const int h = hk * 4 + w;
  const float slope = exp2f(-0.5f * (float)(h + 1));
  const float sink = P.att_sinks[h];
  const int tok0 = NPR + b * 8;
  __syncthreads();
#pragma unroll 2
  for (int it = 0; it < 8; it++) {
    const int idx = t + 256 * it; const int row = idx >> 4, c4 = idx & 15;
    const size_t so = ((size_t)(b * 128 + row)) * 256 + hk * 64 + c4 * 4;
    const float4 kx = *(const float4*)(P.cache_k + so);
    const float4 vx = *(const float4*)(P.cache_v + so);
    float* kd = kv + row * 65 + c4 * 4;
    kd[0] = kx.x; kd[1] = kx.y; kd[2] = kx.z; kd[3] = kx.w;
    if (row >= 8) {
      const size_t dofs = ((size_t)(b * 128 + row - 8)) * 256 + hk * 64 + c4 * 4;
      *(float4*)(P.out + OUT_WK_S + dofs) = kx;
      *(float4*)(P.out + OUT_WV_S + dofs) = vx;
    }
  }
#pragma unroll
  for (int it = 0; it < 2; it++) {
    const int idx = t + 256 * it; const int r8 = idx >> 6, d = idx & 63;
    kv[(128 + r8) * 65 + d] = bf2f(K1[(size_t)(tok0 + r8) * 256 + hk * 64 + d]);
  }
#pragma unroll
  for (int i = 0; i < 8; i++) qs[i * 64 + lane] = bf2f(Q1[(size_t)(tok0 + i) * DM + h * 64 + lane]);
  __syncthreads();
  float sc[3][8];
#pragma unroll
  for (int ksel = 0; ksel < 3; ksel++) {
    float acc[8];
#pragma unroll
    for (int i = 0; i < 8; i++) acc[i] = 0.f;
    const float* kr = kv + ((ksel < 2) ? (lane + 64 * ksel) : (128 + (lane & 7))) * 65;
#pragma unroll 2
    for (int d4 = 0; d4 < 16; d4++) {
      const float k0 = kr[4 * d4], k1 = kr[4 * d4 + 1], k2 = kr[4 * d4 + 2], k3 = kr[4 * d4 + 3];
#pragma unroll
      for (int i = 0; i < 8; i++) {
        const float4 qv = *(const float4*)(qs + i * 64 + 4 * d4);
        acc[i] = fmaf(qv.x, k0, acc[i]); acc[i] = fmaf(qv.y, k1, acc[i]); acc[i] = fmaf(qv.z, k2, acc[i]); acc[i] = fmaf(qv.w, k3, acc[i]);
      }
    }
#pragma unroll
    for (int i = 0; i < 8; i++) {
      int dist; bool live;
      if (ksel < 2) { const int j = lane + 64 * ksel; dist = 128 + i - j; live = (j > i); }
      else { dist = i - lane; live = (lane <= i); }
      sc[ksel][i] = live ? (acc[i] * 0.125f - slope * (float)dist) : -1e30f;
    }
  }
#pragma unroll
  for (int i = 0; i < 8; i++) {
    float mx = fmaxf(fmaxf(sc[0][i], sc[1][i]), sc[2][i]);
    mx = fmaxf(wave_max(mx), sink);
    const float p0 = __expf(sc[0][i] - mx), p1 = __expf(sc[1][i] - mx), p2 = __expf(sc[2][i] - mx);
    const float den = wave_sum(p0 + p1 + p2) + __expf(sink - mx);
    const float inv = 1.f / den;
    ps[i * 136 + lane] = p0 * inv; ps[i * 136 + 64 + lane] = p1 * inv;
    if (lane < 8) ps[i * 136 + 128 + lane] = p2 * inv;
  }
  __syncthreads();
#pragma unroll 4
  for (int it = 0; it < 8; it++) {
    const int idx = t + 256 * it; const int row = idx >> 4, c4 = idx & 15;
    *(float4*)(kv + row * 64 + c4 * 4) = *(const float4*)(P.cache_v + ((size_t)(b * 128 + row)) * 256 + hk * 64 + c4 * 4);
  }
#pragma unroll
  for (int it = 0; it < 2; it++) {
    const int idx = t + 256 * it; const int r8 = idx >> 6, d = idx & 63;
    kv[(128 + r8) * 64 + d] = bf2f(V1[(size_t)(tok0 + r8) * 256 + hk * 64 + d]);
  }
  __syncthreads();
  float o[8];
#pragma unroll
  for (int i = 0; i < 8; i++) o[i] = 0.f;
#pragma unroll 2
  for (int j0 = 0; j0 < 136; j0 += 4) {
    const float v0 = kv[(j0) * 64 + lane], v1 = kv[(j0 + 1) * 64 + lane], v2 = kv[(j0 + 2) * 64 + lane], v3 = kv[(j0 + 3) * 64 + lane];
#pragma unroll
    for (int i = 0; i < 8; i++) {
      const float4 pa = *(const float4*)(ps + i * 136 + j0);
      o[i] = fmaf(pa.x, v0, o[i]); o[i] = fmaf(pa.y, v1, o[i]); o[i] = fmaf(pa.z, v2, o[i]); o[i] = fmaf(pa.w, v3, o[i]);
    }
  }
#pragma unroll
  for (int i = 0; i < 8; i++) {
    const size_t off = (size_t)(tok0 + i) * DM + h * 64 + lane;
    const float gt = bf2f(G1[off]);
    AO[off] = f2bf(o[i] * gt * sigmoidf_(gt));
  }
}
__device__ __forceinline__ void phase_attn(const Params& P, unsigned char* smem, int bid, int nb) {
#if PROBE == 7
  for (int item = bid; item < 1024; item += nb) attn_prompt_item(P, smem, item);
#elif PROBE == 8
  for (int item = bid; item < 512; item += nb) attn_sample_item(P, smem, item);
#endif
  for (int item = bid; item < 1024 + 512; item += nb) {
    if (item < 1024) attn_prompt_item(P, smem, item);
    else attn_sample_item(P, smem, item - 1024);
  }
}

#if MULTI_LAUNCH
#define PH_BARRIER(ph)
#else
#define PH_BARRIER(ph) do { if ((ph) + 1 < P.phase_end) xcd_barrier(xb); } while (0)
#endif
#define RUN_PH(ph, call) do { if (P.phase_begin <= (ph) && (ph) < P.phase_end) { if ((REPMASK >> (ph)) & 1) { call; PH_BARRIER(ph); } call; PH_BARRIER(ph); } } while (0)

__global__ void __launch_bounds__(256, 2) fwd_kernel(Params P) {
  __shared__ __attribute__((aligned(16))) unsigned char smem[SMEM_BYTES];
  const int bid = blockIdx.x, nb = gridDim.x;
#if !MULTI_LAUNCH
  __shared__ uint4 xb_words;
  if (threadIdx.x == 0) xb_words = make_uint4(0u, 0u, 0u, 0u);
  __syncthreads();
  XcdBarrier xb = xcd_barrier_post(P.bar, (volatile LAS unsigned*)&xb_words);
#endif
#if (PHMASK >> 0) & 1
  RUN_PH(0, phase_prep(P, smem, bid, nb));
#endif
#if (PHMASK >> 1) & 1
  RUN_PH(1, gemm1_part(P, smem, 0, bid, nb));
#endif
#if (PHMASK >> 2) & 1
  RUN_PH(2, gemm_phase<2>(P, smem, bid, nb));
#endif
#if (PHMASK >> 3) & 1
  RUN_PH(3, phase_scan1(P, smem, bid, nb));
#endif
#if (PHMASK >> 4) & 1
  RUN_PH(4, phase_scan2(P, smem, bid, nb));
#endif
#if (PHMASK >> 5) & 1
  RUN_PH(5, phase_scan3(P, smem, bid, nb));
#endif
#if (PHMASK >> 6) & 1
  RUN_PH(6, gemm_phase<3>(P, smem, bid, nb));
#endif
#if (PHMASK >> 7) & 1
  RUN_PH(7, phase_ln(P, 0, bid, nb));
#endif
#if (PHMASK >> 8) & 1
  RUN_PH(8, gemm_phase<4>(P, smem, bid, nb));
#endif
#if (PHMASK >> 9) & 1
  RUN_PH(9, phase_attn(P, smem, bid, nb));
#endif
#if (PHMASK >> 10) & 1
  RUN_PH(10, gemm_phase<5>(P, smem, bid, nb));
#endif
#if (PHMASK >> 11) & 1
  RUN_PH(11, phase_ln(P, 1, bid, nb));
#endif
#if PROBE && PROBE < 7
  xcd_barrier(xb);
  gemm_phase<6>(P, smem, bid, nb);
#endif
#if !MULTI_LAUNCH
  if (P.phase_end > NPHASE) cg::this_grid().sync();
#endif
}

extern "C" void kernel_launch(void* const* d_in, const int* in_sizes, int n_in, void* d_out, int out_size, void* d_ws, size_t ws_size, hipStream_t stream) {
  Params P{};
  P.x_prompt = (const float*)d_in[0]; P.x_sample = (const float*)d_in[1]; P.state_wkv = (const float*)d_in[2]; P.state_shift = (const float*)d_in[3];
  P.cache_k = (const float*)d_in[4]; P.cache_v = (const float*)d_in[5]; P.ln_g = (const float*)d_in[6]; P.ln_b = (const float*)d_in[7];
  P.mu = (const float*)d_in[8]; P.w_in = (const float*)d_in[9]; P.w0 = (const float*)d_in[10]; P.w1 = (const float*)d_in[11]; P.w2 = (const float*)d_in[12];
  P.a0 = (const float*)d_in[13]; P.a1 = (const float*)d_in[14]; P.a2 = (const float*)d_in[15]; P.k_k = (const float*)d_in[16]; P.k_a = (const float*)d_in[17];
  P.r_k = (const float*)d_in[18]; P.gn_g = (const float*)d_in[19]; P.gn_b = (const float*)d_in[20]; P.w_out = (const float*)d_in[21];
  P.att_w_in = (const float*)d_in[22]; P.att_sinks = (const float*)d_in[23]; P.att_w_out = (const float*)d_in[24];
  P.out = (float*)d_out;
  unsigned char* ws = (unsigned char*)d_ws;
  size_t off = 0;
  auto take = [&](size_t bytes) { unsigned char* p = ws + off; off += (bytes + 255) & ~(size_t)255; return p; };
  P.bar = (unsigned*)take(16384);
  P.WtIn0 = (bf16_t*)take((size_t)4352 * DM * 2);
  P.W2t = (bf16_t*)take((size_t)DM * 64 * 2);
  P.A2t = (bf16_t*)take((size_t)DM * 64 * 2);
  P.WtOut0 = (bf16_t*)take((size_t)DM * DM * 2);
  P.WtIn1 = (bf16_t*)take((size_t)2560 * DM * 2);
  P.WtOut1 = (bf16_t*)take((size_t)DM * DM * 2);
  P.XB = (bf16_t*)take((size_t)NTOK * DM * 2);
  P.XXB = (bf16_t*)take((size_t)NTOK * DM * 2);
  P.Rb = (bf16_t*)take((size_t)NTOK * DM * 2);
  P.Kb = (bf16_t*)take((size_t)NTOK * DM * 2);
  P.Vb = (bf16_t*)take((size_t)NTOK * DM * 2);
  P.Gb = (bf16_t*)take((size_t)NTOK * DM * 2);
  P.H1 = (bf16_t*)take((size_t)NTOK * 64 * 2);
  P.H2 = (bf16_t*)take((size_t)NTOK * 64 * 2);
  P.MU16 = (bf16_t*)take((size_t)6 * DM * 2);
  if (off > ws_size) { fprintf(stderr, "workspace too small: need %zu have %zu\n", off, ws_size); return; }
#if MULTI_LAUNCH
  for (int ph = 0; ph < NPHASE; ph++) {
    P.phase_begin = ph; P.phase_end = ph + 1;
    hipLaunchKernelGGL(fwd_kernel, dim3(512), dim3(256), 0, stream, P);
  }
#else
  static int grid_blocks = 0;
  if (!grid_blocks) {
    int dev = 0, cus = 0, per_cu = 0;
    hipGetDevice(&dev);
    hipDeviceGetAttribute(&cus, hipDeviceAttributeMultiprocessorCount, dev);
    hipOccupancyMaxActiveBlocksPerMultiprocessor(&per_cu, fwd_kernel, 256, 0);
    if (per_cu > 2) per_cu = 2;
    if (per_cu < 1) per_cu = 1;
    grid_blocks = cus * per_cu;
  }
  hipMemsetAsync(P.bar, 0, 16384, stream);
  P.phase_begin = 0; P.phase_end = NPHASE;
  void* args[] = {&P};
  hipError_t e = hipLaunchCooperativeKernel((void*)fwd_kernel, dim3(grid_blocks), dim3(256), args, 0, stream);
  if (e != hipSuccess) fprintf(stderr, "cooperative launch failed: %s (grid %d)\n", hipGetErrorString(e), grid_blocks);
#endif
}
```

```cpp
#include <hip/hip_runtime.h>
#include <hip/hip_cooperative_groups.h>
#include <stdint.h>
#include <cstdio>
namespace cg = cooperative_groups;

#ifndef PHMASK
#define PHMASK 0xFFF
#endif
#ifndef PROBE
#define PROBE 0
#endif
#ifndef REPMASK
#define REPMASK 0
#endif
#ifndef MULTI_LAUNCH
#define MULTI_LAUNCH 0
#endif

typedef unsigned short bf16_t;
typedef _Float16 f16_t;
typedef __attribute__((ext_vector_type(8))) short bf16x8;
typedef __attribute__((ext_vector_type(4))) float f32x4;
typedef __attribute__((ext_vector_type(4))) unsigned u32x4;

#define DM 1024
#define NTOK 17408
#define NPR 16384
#define TP 8192
#define NC 32
#define CL 256
#define NBH 32
#define ALPHA_F 1.41421356237f
#define SMEM_BYTES (61 * 1024)
#define NPHASE 12

#define OUT_Y 0
#define OUT_WKV_P 17825792
#define OUT_SH_P 17956864
#define OUT_WK_P 17958912
#define OUT_WV_P 18024448
#define OUT_WKV_S 18089984
#define OUT_SH_S 26478592
#define OUT_WK_S 26609664
#define OUT_WV_S 30803968

struct Params {
  const float *x_prompt, *x_sample, *state_wkv, *state_shift, *cache_k, *cache_v, *ln_g, *ln_b;
  const float *mu, *w_in, *w0, *w1, *w2, *a0, *a1, *a2, *k_k, *k_a, *r_k, *gn_g, *gn_b, *w_out;
  const float *att_w_in, *att_sinks, *att_w_out;
  float* out;
  unsigned* bar;
  bf16_t *WtIn0, *W2t, *A2t, *WtOut0, *WtIn1, *WtOut1;
  bf16_t *XB, *XXB;
  bf16_t *Rb, *Kb, *Vb, *Gb;
  bf16_t *H1, *H2, *MU16;
  float* INVN;
  int phase_begin, phase_end;
};

typedef __bf16 hbf2 __attribute__((ext_vector_type(2)));
typedef float f32x2_ __attribute__((ext_vector_type(2)));
__device__ __forceinline__ unsigned pack2(float a, float b) {
  const f32x2_ v = {a, b};
  return __builtin_bit_cast(unsigned, __builtin_convertvector(v, hbf2));
}
__device__ __forceinline__ bf16_t f2bf(float f) { return (bf16_t)(pack2(f, 0.f) & 0xffffu); }
__device__ __forceinline__ float bf2f(bf16_t h) { return __uint_as_float(((unsigned)h) << 16); }
__device__ __forceinline__ float wave_sum(float x) {
#pragma unroll
  for (int o = 32; o >= 1; o >>= 1) x += __shfl_xor(x, o);
  return x;
}
__device__ __forceinline__ float wave_max(float x) {
#pragma unroll
  for (int o = 32; o >= 1; o >>= 1) x = fmaxf(x, __shfl_xor(x, o));
  return x;
}
__device__ __forceinline__ float quad_sum(float x) {
  x += __builtin_bit_cast(float, __builtin_amdgcn_update_dpp(0, __builtin_bit_cast(int, x), 0xB1, 0xF, 0xF, true));
  x += __builtin_bit_cast(float, __builtin_amdgcn_update_dpp(0, __builtin_bit_cast(int, x), 0x4E, 0xF, 0xF, true));
  return x;
}
__device__ __forceinline__ float sigmoidf_(float x) { return __builtin_amdgcn_rcpf(1.f + __expf(-x)); }
__device__ __forceinline__ const float* xin_row(const Params& P, int m) {
  return (m < NPR) ? (P.x_prompt + (size_t)m * DM) : (P.x_sample + (size_t)(m - NPR) * DM);
}

#define XB_TMO      128
#define XB_XCNT(j)  (256  + 64 * (j))
#define XB_XSUB(j)  (1280 + 64 * (j))
#define XB_XGEN(j)  (2304 + 64 * (j))
#define XB_TOP      3328
#define XB_TOPGEN   3392
#define XCD_BAR_WORDS 3456
#define XB_SPIN_CAP (1u << 22)
#define LAS __attribute__((address_space(3)))
__device__ __forceinline__ unsigned xb_ld(unsigned* p) { return __hip_atomic_load(p, __ATOMIC_RELAXED, __HIP_MEMORY_SCOPE_AGENT); }
__device__ __forceinline__ unsigned xb_add(unsigned* p, unsigned v) { return __hip_atomic_fetch_add(p, v, __ATOMIC_RELAXED, __HIP_MEMORY_SCOPE_AGENT); }
__device__ __forceinline__ unsigned xb_xcc_id() { return (unsigned)__builtin_amdgcn_s_getreg((3 << 11) | 20) & 0xFu; }
#define XB_SPIN(cond, bar) do { unsigned _sp = 0; while (cond) { __builtin_amdgcn_s_sleep(1); \
    if ((++_sp & 255u) == 0u) { if (xb_ld(&(bar)[XB_TMO])) break; if (_sp > XB_SPIN_CAP) { atomicAdd(&(bar)[XB_TMO], 1u); break; } } } } while (0)
struct XcdBarrier { unsigned* bar; unsigned x; volatile LAS unsigned* st; };
__device__ __forceinline__ XcdBarrier xcd_barrier_post(unsigned* bar, volatile LAS unsigned* st) {
  XcdBarrier b; b.bar = bar; b.x = xb_xcc_id(); b.st = st;
  if (threadIdx.x == 0) (void)xb_add(&bar[XB_XCNT(b.x)], 1u);
  return b;
}
__device__ __forceinline__ void xcd_barrier_complete(unsigned* bar, unsigned x, unsigned& nloc, unsigned& nx) {
  const unsigned G = gridDim.x * gridDim.y * gridDim.z;
  unsigned sum, cnt, mine, sp = 0u;
  for (;;) {
    sum = 0u; cnt = 0u; mine = 0u;
#pragma unroll
    for (unsigned j = 0; j < 16; ++j) { const unsigned c = xb_ld(&bar[XB_XCNT(j)]); sum += c; cnt += (c > 0u) ? 1u : 0u; mine = (j == x) ? c : mine; }
    if (sum == G) break;
    __builtin_amdgcn_s_sleep(1);
    if ((++sp & 255u) == 0u) { if (xb_ld(&bar[XB_TMO])) break; if (sp > XB_SPIN_CAP) { atomicAdd(&bar[XB_TMO], 1u); break; } }
  }
  nloc = mine > 0u ? mine : 1u; nx = cnt > 0u ? cnt : 1u;
}
__device__ __forceinline__ void xcd_barrier(const XcdBarrier& b) {
  asm volatile("s_waitcnt vmcnt(0)" ::: "memory");
  __syncthreads();
  if (threadIdx.x == 0) {
    unsigned* bar = b.bar;
    __builtin_amdgcn_s_waitcnt(0);
    unsigned nloc = b.st[0], nx = b.st[1];
    if (nloc == 0u) { xcd_barrier_complete(bar, b.x, nloc, nx); b.st[0] = nloc; b.st[1] = nx; }
    const unsigned old = xb_add(&bar[XB_XSUB(b.x)], 1u);
    const unsigned gen = old / nloc;
    if (old + 1u == (gen + 1u) * nloc) {
      __builtin_amdgcn_fence(__ATOMIC_RELEASE, "agent");
      asm volatile("s_waitcnt vmcnt(0)" ::: "memory");
      const unsigned og = xb_add(&bar[XB_TOP], 1u);
      const unsigned tg = og / nx;
      if (og + 1u == (tg + 1u) * nx) xb_add(&bar[XB_TOPGEN], 1u);
      else XB_SPIN(xb_ld(&bar[XB_TOPGEN]) == tg, bar);
      __builtin_amdgcn_fence(__ATOMIC_ACQUIRE, "agent");
      xb_add(&bar[XB_XGEN(b.x)], 1u);
      asm volatile("s_waitcnt vmcnt(0)" ::: "memory");
    } else {
      XB_SPIN(xb_ld(&bar[XB_XGEN(b.x)]) == gen, bar);
      __builtin_amdgcn_fence(__ATOMIC_ACQUIRE, "agent");
      asm volatile("s_waitcnt vmcnt(0)" ::: "memory");
    }
  }
  __syncthreads();
}

__device__ __forceinline__ unsigned short f2h_bits(float f) { const _Float16 h = (_Float16)f; return __builtin_bit_cast(unsigned short, h); }
__device__ __forceinline__ unsigned pack2h(float a, float b) { return (unsigned)f2h_bits(a) | ((unsigned)f2h_bits(b) << 16); }
__device__ __forceinline__ void transpose_tile(const float* __restrict__ src, int ld, int k0, int n0, bf16_t* __restrict__ dst, int ldd, float* tile, bool half = false) {
  const int t = threadIdx.x;
  {
    const int n = t & 63, kq = t >> 6;
#pragma unroll 4
    for (int i = 0; i < 16; i++) { const int k = i * 4 + kq; tile[k * 65 + n] = src[(size_t)(k0 + k) * ld + n0 + n]; }
  }
  __syncthreads();
  {
    const int k = t & 63, nq = t >> 6;
#pragma unroll 4
    for (int i = 0; i < 16; i++) { const int n2 = i * 4 + nq; const float v_ = tile[k * 65 + n2]; dst[(size_t)(n0 + n2) * ldd + k0 + k] = half ? f2h_bits(v_) : f2bf(v_); }
  }
  __syncthreads();
}

__device__ __forceinline__ void phase_prep(const Params& P, unsigned char* smem, int bid, int nb) {
  float* tile = (float*)smem;
  const int t = threadIdx.x;
  const int NITEMS = 2242 + 4352 + 130;
  for (int id = bid; id < NITEMS; id += nb) {
    if (id < 1024) { const int p = id >> 8, r = id & 255; transpose_tile(P.w_in + (size_t)p * DM * DM, DM, (r >> 4) * 64, (r & 15) * 64, P.WtIn0 + (size_t)p * DM * DM, DM, tile, true); }
    else if (id < 1040) transpose_tile(P.w1, 64, (id - 1024) * 64, 0, P.WtIn0 + (size_t)4096 * DM, DM, tile, true);
    else if (id < 1056) transpose_tile(P.a1, 64, (id - 1040) * 64, 0, P.WtIn0 + (size_t)4224 * DM, DM, tile, true);
    else if (id < 1072) transpose_tile(P.w2, DM, 0, (id - 1056) * 64, P.W2t, 64, tile);
    else if (id < 1088) transpose_tile(P.a2, DM, 0, (id - 1072) * 64, P.A2t, 64, tile);
    else if (id < 1344) { const int r = id - 1088; transpose_tile(P.w_out, DM, (r >> 4) * 64, (r & 15) * 64, P.WtOut0, DM, tile); }
    else if (id < 1984) { const int r = id - 1344; transpose_tile(P.att_w_in, 2560, (r / 40) * 64, (r % 40) * 64, P.WtIn1, DM, tile); }
    else if (id < 2240) { const int r = id - 1984; transpose_tile(P.att_w_out, DM, (r >> 4) * 64, (r & 15) * 64, P.WtOut1, DM, tile); }
    else if (id < 2242) {
      uint4* z = (uint4*)(P.WtIn0 + (size_t)(id == 2240 ? 4160 : 4288) * DM);
      for (int i = t; i < 8192; i += 256) z[i] = make_uint4(0, 0, 0, 0);
      if (id == 2240) for (int i = t; i < 6 * DM; i += 256) P.MU16[i] = f2h_bits(P.mu[i]);
    } else if (id < 2242 + 4352) {
      const int it = id - 2242;
#pragma unroll
      for (int q = 0; q < 4; q++) {
        const int m = it * 4 + q;
        const float4 x = ((const float4*)xin_row(P, m))[t];
        float4 pv = make_float4(0.f, 0.f, 0.f, 0.f);
        if (m < NPR) { if ((m & (TP - 1)) != 0) pv = ((const float4*)xin_row(P, m - 1))[t]; }
        else { const int ms = m - NPR; if ((ms & 7) != 0) pv = ((const float4*)xin_row(P, m - 1))[t]; else pv = ((const float4*)(P.state_shift + (size_t)(ms >> 3) * DM))[t]; }
        uint2 xb, xxb;
        xb.x = pack2h(x.x, x.y); xb.y = pack2h(x.z, x.w);
        xxb.x = pack2h(pv.x - x.x, pv.y - x.y); xxb.y = pack2h(pv.z - x.z, pv.w - x.w);
        ((uint2*)(P.XB + (size_t)m * DM))[t] = xb;
        ((uint2*)(P.XXB + (size_t)m * DM))[t] = xxb;
      }
    } else {
      const int r = id - (2242 + 4352);
      if (r < 2) ((float4*)(P.out + OUT_SH_P + (size_t)r * DM))[t] = ((const float4*)(P.x_prompt + ((size_t)r * TP + TP - 1) * DM))[t];
      else { const int b = r - 2; ((float4*)(P.out + OUT_SH_S + (size_t)b * DM))[t] = ((const float4*)(P.x_sample + ((size_t)b * 8 + 7) * DM))[t]; }
    }
  }
}

#define LDB 48
typedef _Float16 f16x8 __attribute__((ext_vector_type(8)));
typedef _Float16 f16x2 __attribute__((ext_vector_type(2)));
__device__ __forceinline__ unsigned xs16(unsigned x, unsigned d, unsigned m) {
  const f16x2 r = __builtin_elementwise_fma(__builtin_bit_cast(f16x2, d), __builtin_bit_cast(f16x2, m), __builtin_bit_cast(f16x2, x));
  return __builtin_bit_cast(unsigned, r);
}
template <int MODE>
__device__ __forceinline__ void gemm_tile(const Params& P, unsigned char* smem, int mt, int nt) {
  constexpr int KT = (MODE == 2) ? 1 : 16;
  bf16_t* Asb[2]; bf16_t* Bsb[2];
  Asb[0] = (bf16_t*)smem; Bsb[0] = Asb[0] + 128 * LDB; Asb[1] = Bsb[0] + 128 * LDB; Bsb[1] = Asb[1] + 128 * LDB;
  const int t = threadIdx.x, lane = t & 63, w = t >> 6;
  const int wm = w >> 1, wn = w & 1;
  const int g = lane >> 4, lc = lane & 15;
  const int lr = t >> 2, lc4 = t & 3;
  const int m0 = mt * 128, n0 = nt * 128;

  const bf16_t* Ap; const bf16_t* A2p = nullptr; const bf16_t* mup = nullptr; const bf16_t* Bp; int lda, ldb;
  if (MODE == 1) {
    const int p = (nt < 32) ? (nt >> 3) : (4 + (nt - 32));
    Ap = P.XB; A2p = P.XXB; lda = DM; mup = P.MU16 + (size_t)p * DM;
    Bp = P.WtIn0 + (size_t)((nt < 32) ? n0 : (4096 + (nt - 32) * 128)) * DM; ldb = DM;
  } else if (MODE == 2) {
    Ap = (nt < 8) ? P.H1 : P.H2; lda = 64;
    Bp = ((nt < 8) ? P.W2t : P.A2t) + (size_t)((nt & 7) * 128) * 64; ldb = 64;
  } else if (MODE == 3) { Ap = P.Gb; lda = DM; Bp = P.WtOut0 + (size_t)n0 * DM; ldb = DM; }
  else if (MODE == 4 || MODE == 6) { Ap = P.Rb; lda = DM; Bp = P.WtIn1 + (size_t)n0 * DM; ldb = DM; }
  else { Ap = P.Gb; lda = DM; Bp = P.WtOut1 + (size_t)n0 * DM; ldb = DM; }

  f32x4 acc[4][4];
#pragma unroll
  for (int i = 0; i < 4; i++)
#pragma unroll
    for (int j = 0; j < 4; j++) acc[i][j] = (f32x4){0.f, 0.f, 0.f, 0.f};

  u32x4 ra[2][2][2], rb[2][2][2], ra2[2][2][2], rmu[2][2];
  const unsigned voffA = (unsigned)(lr * lda + lc4 * 8) * 2u;
  const unsigned voffB = (unsigned)(lr * ldb + lc4 * 8) * 2u;
  const char* baseA = (const char*)(Ap + (size_t)m0 * lda);
  const char* baseA2 = (const char*)(A2p + (size_t)m0 * lda);
  const char* baseB = (const char*)Bp;
#define LOADH(S_, kt_, H_) do { if ((kt_) < KT) { \
    _Pragma("unroll") for (int ii_ = 0; ii_ < 2; ii_++) { \
      const size_t uo_ = ((size_t)(64 * ii_) * lda + (size_t)(kt_) * 64 + 32 * (H_)) * 2; \
      const size_t uob_ = ((size_t)(64 * ii_) * ldb + (size_t)(kt_) * 64 + 32 * (H_)) * 2; \
      ra[S_][H_][ii_] = *(const u32x4*)(baseA + uo_ + voffA); \
      if (MODE == 1) ra2[S_][H_][ii_] = *(const u32x4*)(baseA2 + uo_ + voffA); \
      rb[S_][H_][ii_] = *(const u32x4*)(baseB + uob_ + voffB); \
    } \
    if (MODE == 1) rmu[S_][H_] = *(const u32x4*)(mup + (kt_) * 64 + 32 * (H_) + lc4 * 8); \
  } } while (0)
#define STOREH(S_, H_, B_) do { \
    _Pragma("unroll") for (int ii_ = 0; ii_ < 2; ii_++) { \
      const int row_ = lr + 64 * ii_; \
      u32x4 av_ = ra[S_][H_][ii_]; \
      if (MODE == 1) { \
        const u32x4 xv_ = ra[S_][H_][ii_], dv_ = ra2[S_][H_][ii_], mv_ = rmu[S_][H_]; \
        av_ = (u32x4){xs16(xv_.x, dv_.x, mv_.x), xs16(xv_.y, dv_.y, mv_.y), xs16(xv_.z, dv_.z, mv_.z), xs16(xv_.w, dv_.w, mv_.w)}; \
      } \
      *(u32x4*)(Asb[B_] + row_ * LDB + lc4 * 8) = av_; \
      *(u32x4*)(Bsb[B_] + row_ * LDB + lc4 * 8) = rb[S_][H_][ii_]; \
    } \
  } while (0)
#define COMPUTE_SUB(B_) do { if (!(MODE == 6 && PROBE == 3)) { \
    bf16x8 af[4], bfr[4]; \
    _Pragma("unroll") for (int i = 0; i < 4; i++) af[i] = *(const bf16x8*)(Bsb[B_] + (wn * 64 + i * 16 + lc) * LDB + g * 8); \
    _Pragma("unroll") for (int j = 0; j < 4; j++) bfr[j] = *(const bf16x8*)(Asb[B_] + (wm * 64 + j * 16 + lc) * LDB + g * 8); \
    _Pragma("unroll") for (int i = 0; i < 4; i++) \
      _Pragma("unroll") for (int j = 0; j < 4; j++) { \
        if (MODE == 1) acc[i][j] = __builtin_amdgcn_mfma_f32_16x16x32_f16(__builtin_bit_cast(f16x8, af[i]), __builtin_bit_cast(f16x8, bfr[j]), acc[i][j], 0, 0, 0); \
        else acc[i][j] = __builtin_amdgcn_mfma_f32_16x16x32_bf16(af[i], bfr[j], acc[i][j], 0, 0, 0); \
      } \
  } } while (0)
  __syncthreads();
  LOADH(0, 0, 0); LOADH(0, 0, 1); LOADH(1, 1, 0); LOADH(1, 1, 1);
  STOREH(0, 0, 0);
  LOADH(0, 2, 0);
  __syncthreads();
  for (int kt = 0; kt < KT; kt += 2) {
    STOREH(0, 1, 1); LOADH(0, kt + 2, 1);
    COMPUTE_SUB(0);
    if (!(MODE == 6 && PROBE == 5)) __syncthreads();
    if (kt + 1 < KT) { STOREH(1, 0, 0); LOADH(1, kt + 3, 0); }
    COMPUTE_SUB(1);
    __syncthreads();
    if (kt + 1 < KT) {
      STOREH(1, 1, 1); LOADH(1, kt + 3, 1);
      COMPUTE_SUB(0);
      if (!(MODE == 6 && PROBE == 5)) __syncthreads();
      if (kt + 2 < KT) { STOREH(0, 0, 0); LOADH(0, kt + 4, 0); }
      COMPUTE_SUB(1);
      __syncthreads();
    }
  }
  if (MODE == 1 && nt >= 8 && nt < 16) {
    const int hh = (nt & 7) * 2 + wn;
    float kkw[4][4];
#pragma unroll
    for (int i = 0; i < 4; i++) { const float4 kq = *(const float4*)(P.k_k + hh * 64 + i * 16 + 4 * g); kkw[i][0] = kq.x; kkw[i][1] = kq.y; kkw[i][2] = kq.z; kkw[i][3] = kq.w; }
#pragma unroll
    for (int j = 0; j < 4; j++) {
      float ssq = 0.f;
#pragma unroll
      for (int i = 0; i < 4; i++) {
        const unsigned u0 = pack2(acc[i][j][0], acc[i][j][1]), u1 = pack2(acc[i][j][2], acc[i][j][3]);
        const float q0 = __uint_as_float(u0 << 16) * kkw[i][0], q1 = __uint_as_float(u0 & 0xffff0000u) * kkw[i][1];
        const float q2 = __uint_as_float(u1 << 16) * kkw[i][2], q3 = __uint_as_float(u1 & 0xffff0000u) * kkw[i][3];
        ssq = fmaf(q0, q0, ssq); ssq = fmaf(q1, q1, ssq); ssq = fmaf(q2, q2, ssq); ssq = fmaf(q3, q3, ssq);
      }
      ssq += __shfl_xor(ssq, 16); ssq += __shfl_xor(ssq, 32);
      if (g == 0) P.INVN[(size_t)(m0 + wm * 64 + j * 16 + lc) * 16 + hh] = __builtin_amdgcn_rsqf(fmaxf(ssq, 1e-24f));
    }
  }
#pragma unroll
  for (int i = 0; i < 4; i++) {
    const int nl = wn * 64 + i * 16 + 4 * g;
#pragma unroll
    for (int j = 0; j < 4; j++) {
      const int m = m0 + wm * 64 + j * 16 + lc;
      const f32x4 v = acc[i][j];
      if (MODE == 1) {
        if (nt < 32) {
          const int p = nt >> 3, c = (nt & 7) * 128 + nl;
          bf16_t* dst = (p == 0) ? P.Rb : (p == 1) ? P.Kb : (p == 2) ? P.Vb : P.Gb;
          uint2 o; o.x = pack2(v[0], v[1]); o.y = pack2(v[2], v[3]);
          *(uint2*)(dst + (size_t)m * DM + c) = o;
        } else if (nl < 64) {
          uint2 o;
          if (nt == 32) { o.x = pack2(tanhf(v[0]), tanhf(v[1])); o.y = pack2(tanhf(v[2]), tanhf(v[3])); *(uint2*)(P.H1 + (size_t)m * 64 + nl) = o; }
          else { o.x = pack2(v[0], v[1]); o.y = pack2(v[2], v[3]); *(uint2*)(P.H2 + (size_t)m * 64 + nl) = o; }
        }
      } else if (MODE == 2) {
        const int c = (nt & 7) * 128 + nl;
        f16_t o[4];
        if (nt < 8) {
          const float4 w0v = *(const float4*)(P.w0 + c);
          const float ws[4] = {w0v.x, w0v.y, w0v.z, w0v.w};
#pragma unroll
          for (int r = 0; r < 4; r++) o[r] = (f16_t)(sigmoidf_(ws[r] + v[r]) * 0.60653065971f);
          *(uint2*)(((f16_t*)(P.out + OUT_Y)) + (size_t)m * DM + c) = *(uint2*)o;
        } else {
          const float4 a0v = *(const float4*)(P.a0 + c);
          const float as_[4] = {a0v.x, a0v.y, a0v.z, a0v.w};
#pragma unroll
          for (int r = 0; r < 4; r++) o[r] = (f16_t)sigmoidf_(as_[r] + v[r]);
          *(uint2*)(((f16_t*)(P.out + OUT_Y) + (size_t)NTOK * DM) + (size_t)m * DM + c) = *(uint2*)o;
        }
      } else if (MODE == 3 || MODE == 5) {
        const int c = n0 + nl;
        float4 res;
        if (MODE == 3) res = *(const float4*)(xin_row(P, m) + c);
        else res = *(const float4*)(P.out + OUT_Y + (size_t)m * DM + c);
        float4 o = make_float4(v[0] + ALPHA_F * res.x, v[1] + ALPHA_F * res.y, v[2] + ALPHA_F * res.z, v[3] + ALPHA_F * res.w);
        *(float4*)(P.out + OUT_Y + (size_t)m * DM + c) = o;
      } else if (MODE == 6) {
        uint2 o; o.x = pack2(v[0], v[1]); o.y = pack2(v[2], v[3]);
        *(uint2*)(P.XB + (size_t)(m & 4095) * DM + ((n0 + nl) & 1023)) = o;
      } else if (MODE == 4) {
        uint2 o; o.x = pack2(v[0], v[1]); o.y = pack2(v[2], v[3]);
        if (nt < 8) { *(uint2*)(P.Kb + (size_t)m * DM + n0 + nl) = o; }
        else if (nt >= 12) { *(uint2*)(P.Vb + (size_t)m * DM + (nt - 12) * 128 + nl) = o; }
        else {
          const bool isk = nt < 10;
          const int ck = (nt & 1) * 128 + nl;
          bf16_t* K1 = P.XB; bf16_t* V1 = P.XB + (size_t)NTOK * 256; bf16_t* VT1 = P.XB + (size_t)NTOK * 512;
          *(uint2*)((isk ? K1 : V1) + (size_t)m * 256 + ck) = o;
          const float4 fo = make_float4(v[0], v[1], v[2], v[3]);
          if (m < NPR) {
            const int b = m >> 13, tt = m & (TP - 1);
            if (!isk) {
              const int hk = ck >> 6, d = ck & 63;
              bf16_t* vt = VT1 + ((size_t)((b * 4 + hk) * 64 + d)) * TP + tt;
              vt[0] = f2bf(v[0]); vt[TP] = f2bf(v[1]); vt[2 * TP] = f2bf(v[2]); vt[3 * TP] = f2bf(v[3]);
            }
            if (tt >= TP - 128) *(float4*)(P.out + (isk ? OUT_WK_P : OUT_WV_P) + ((size_t)(b * 128 + tt - (TP - 128))) * 256 + ck) = fo;
          } else {
            const int ms = m - NPR, b = ms >> 3, tt = ms & 7;
            *(float4*)(P.out + (isk ? OUT_WK_S : OUT_WV_S) + ((size_t)(b * 128 + 120 + tt)) * 256 + ck) = fo;
          }
        }
      }
    }
  }
}
__device__ __forceinline__ void gemm1_part(const Params& P, unsigned char* smem, int part, int first, int stride) {
  const int nnt = part ? 16 : 18;
  for (int tile = first; tile < 136 * nnt; tile += stride) {
    const int mt = tile % 136, ntl = tile / 136;
    const int nt = part ? ((ntl < 8) ? ntl : (24 + ntl - 8)) : ((ntl < 16) ? (8 + ntl) : (32 + ntl - 16));
    gemm_tile<1>(P, smem, mt, nt);
  }
}
template <int MODE>
__device__ __forceinline__ void gemm_phase(const Params& P, unsigned char* smem, int bid, int nb) {
  constexpr int NT = (MODE == 1) ? 34 : (MODE == 2) ? 16 : (MODE == 4 || MODE == 6) ? 20 : 8;
  const int ntiles = 136 * NT;
  for (int tile = bid; tile < ntiles; tile += nb) gemm_tile<MODE>(P, smem, tile % 136, tile / 136);
}

#define TS 8
#define REC 392
typedef float f32x2 __attribute__((ext_vector_type(2)));
__device__ __forceinline__ f32x2 pkfma(f32x2 a, f32x2 b, f32x2 c) { return __builtin_elementwise_fma(a, b, c); }
#define DPP_ADD(x, ctrl) ((x) + __builtin_bit_cast(float, __builtin_amdgcn_update_dpp(0, __builtin_bit_cast(int, (x)), (ctrl), 0xF, 0xF, true)))
__device__ __forceinline__ float wave_sum_fast(float x) {
  x = DPP_ADD(x, 0xB1); x = DPP_ADD(x, 0x4E); x = DPP_ADD(x, 0x141); x = DPP_ADD(x, 0x140);
  const int xi = __builtin_bit_cast(int, x);
  const float t0 = __builtin_bit_cast(float, __builtin_amdgcn_readlane(xi, 0)), t1 = __builtin_bit_cast(float, __builtin_amdgcn_readlane(xi, 16));
  const float t2 = __builtin_bit_cast(float, __builtin_amdgcn_readlane(xi, 32)), t3 = __builtin_bit_cast(float, __builtin_amdgcn_readlane(xi, 48));
  return (t0 + t1) + (t2 + t3);
}
#define LD8(dst, ptr) do { _Pragma("unroll") for (int j4_ = 0; j4_ < 4; j4_++) { const f32x4 v_ = *(const f32x4*)((ptr) + 4 * j4_); \
    dst[2 * j4_] = (f32x2){v_[0], v_[1]}; dst[2 * j4_ + 1] = (f32x2){v_[2], v_[3]}; } } while (0)

template <int INIT  , bool USEV, bool WRITEY>
__device__ __forceinline__ void scan_unit(const Params& P, float* ws, int lane, int tok0, int nsteps, int h, const float* init_ptr, float* fin) {
  const int rq = lane >> 2, q = lane & 3;
  f32x2 s[4][8];
#pragma unroll
  for (int i = 0; i < 4; i++)
#pragma unroll
    for (int j = 0; j < 8; j++) {
      if (INIT == 1) s[i][j] = (f32x2){((rq + 16 * i) == (16 * q + 2 * j)) ? 1.f : 0.f, ((rq + 16 * i) == (16 * q + 2 * j + 1)) ? 1.f : 0.f};
      else s[i][j] = (f32x2){0.f, 0.f};
    }
  if (INIT == 2) {
#pragma unroll
    for (int i = 0; i < 4; i++) LD8(s[i], init_ptr + (size_t)(rq + 16 * i) * 64 + 16 * q);
  }
  const int c = h * 64 + lane;
  const float kkc = P.k_k[c], kac = P.k_a[c], rkc = P.r_k[c];
  const int crow = h * 64 + rq + 16 * q;
  const float gng = P.gn_g[crow], gnb = P.gn_b[crow];
  const f16_t* EW = ((const f16_t*)(P.out + OUT_Y));
  const f16_t* AA = ((const f16_t*)(P.out + OUT_Y) + (size_t)NTOK * DM);

  bf16_t rk[TS], rv[TS], rr[TS]; f16_t ra_[TS], re_[TS]; float rn_[TS];
#define LOAD_RAW(tb) do { const size_t ub_ = (size_t)(tok0 + (tb)) * DM; \
    const bf16_t* kb_ = P.Kb + ub_; const f16_t* ab_ = AA + ub_; const f16_t* eb_ = EW + ub_; const bf16_t* vb_ = P.Vb + ub_; const bf16_t* rb_ = P.Rb + ub_; \
    _Pragma("unroll") for (int tt_ = 0; tt_ < TS; tt_++) { const unsigned off_ = (unsigned)(tt_ * DM + c); \
    rn_[tt_] = P.INVN[(size_t)(tok0 + (tb) + tt_) * 16 + h]; rk[tt_] = kb_[off_]; ra_[tt_] = ab_[off_]; re_[tt_] = eb_[off_]; if (USEV) rv[tt_] = vb_[off_]; if (WRITEY) rr[tt_] = rb_[off_]; } } while (0)
  LOAD_RAW(0);
  for (int t0 = 0; t0 < nsteps; t0 += TS) {
    {
      float gcum = 1.f;
#pragma unroll
      for (int tt = 0; tt < TS; tt++) {
        const float kraw = bf2f(rk[tt]);
        const float a = (float)ra_[tt];
        const float wd = __expf(-(float)re_[tt]);
        const float kkv = kraw * kkc * rn_[tt];
        const float kf = kraw * (1.f + (a - 1.f) * kac);
        float* rec = ws + tt * REC;
        rec[lane] = kkv * gcum;
        gcum *= wd;
        const float ginv = __builtin_amdgcn_rcpf(gcum);
        rec[128 + lane] = kf * ginv; rec[192 + lane] = kkv * a * ginv;
        if (WRITEY) {
          const float r = bf2f(rr[tt]);
          rec[256 + lane] = r * gcum;
          const float bonus = wave_sum_fast(r * kf * rkc);
          if (lane == 0) rec[384] = bonus;
        }
        if (USEV) rec[320 + lane] = bf2f(rv[tt]);
      }
      ws[TS * REC + lane] = gcum;
    }
    __builtin_amdgcn_wave_barrier();
    asm volatile("s_waitcnt lgkmcnt(0)" ::: "memory");
    if (t0 + TS < nsteps) LOAD_RAW(t0 + TS);
#pragma unroll 1
    for (int tt = 0; tt < TS; tt++) {
      const float* rec = ws + tt * REC;
      f32x2 o2[8], b2[8], kf2[8];
      LD8(o2, rec + 16 * q);
      LD8(b2, rec + 192 + 16 * q);
      if (USEV) LD8(kf2, rec + 128 + 16 * q);
      f32x2 nsa2[4];
      {
        f32x2 acc[4];
#pragma unroll
        for (int i = 0; i < 4; i++) acc[i] = s[i][0] * o2[0];
#pragma unroll
        for (int j = 1; j < 8; j++)
#pragma unroll
          for (int i = 0; i < 4; i++) acc[i] = pkfma(s[i][j], o2[j], acc[i]);
#pragma unroll
        for (int i = 0; i < 4; i++) { const float t = -quad_sum(acc[i][0] + acc[i][1]); nsa2[i] = (f32x2){t, t}; }
      }
      float vv[4];
      if (USEV) {
#pragma unroll
        for (int i = 0; i < 4; i++) vv[i] = rec[320 + rq + 16 * i];
      }
      if (WRITEY) LD8(o2, rec + 256 + 16 * q);
#pragma unroll
      for (int i = 0; i < 4; i++) {
#pragma unroll
        for (int j = 0; j < 8; j++) s[i][j] = pkfma(nsa2[i], b2[j], s[i][j]);
        if (USEV) {
          const f32x2 vv2 = (f32x2){vv[i], vv[i]};
#pragma unroll
          for (int j = 0; j < 8; j++) s[i][j] = pkfma(vv2, kf2[j], s[i][j]);
        }
      }
      if (WRITEY) {
        float y[4];
        {
          f32x2 acc[4];
#pragma unroll
          for (int i = 0; i < 4; i++) acc[i] = s[i][0] * o2[0];
#pragma unroll
          for (int j = 1; j < 8; j++)
#pragma unroll
            for (int i = 0; i < 4; i++) acc[i] = pkfma(s[i][j], o2[j], acc[i]);
#pragma unroll
          for (int i = 0; i < 4; i++) y[i] = quad_sum(acc[i][0] + acc[i][1]);
        }
        const float ysel = (q == 0) ? y[0] : (q == 1) ? y[1] : (q == 2) ? y[2] : y[3];
        const float vsel = (q == 0) ? vv[0] : (q == 1) ? vv[1] : (q == 2) ? vv[2] : vv[3];
        const float mean = wave_sum_fast(ysel) * (1.f / 64.f);
        const float ex2 = wave_sum_fast(ysel * ysel) * (1.f / 64.f);
        const float var = fmaxf(ex2 - mean * mean, 0.f);
        float yo = (ysel - mean) * rsqrtf(var + 64e-5f) * gng + gnb + rec[384] * vsel;
        const size_t off = (size_t)(tok0 + t0 + tt) * DM + crow;
        const float gt = bf2f(P.Gb[off]);
        yo *= gt * sigmoidf_(gt);
        P.Gb[off] = f2bf(yo);
      }
    }
    {
      f32x2 ge[8];
      LD8(ge, ws + TS * REC + 16 * q);
#pragma unroll
      for (int i = 0; i < 4; i++)
#pragma unroll
        for (int j = 0; j < 8; j++) s[i][j] *= ge[j];
    }
    __builtin_amdgcn_wave_barrier();
    asm volatile("s_waitcnt lgkmcnt(0)" ::: "memory");
  }
  if (fin) {
#pragma unroll
    for (int i = 0; i < 4; i++)
#pragma unroll
      for (int j4 = 0; j4 < 4; j4++)
        *(f32x4*)(fin + (size_t)(rq + 16 * i) * 64 + 16 * q + 4 * j4) = (f32x4){s[i][2 * j4][0], s[i][2 * j4][1], s[i][2 * j4 + 1][0], s[i][2 * j4 + 1][1]};
  }
}

__device__ __forceinline__ void phase_scan1(const Params& P, unsigned char* smem, int bid, int nb) {
  const int lane = threadIdx.x & 63, w = __builtin_amdgcn_readfirstlane((int)(threadIdx.x >> 6));
  float* ws = (float*)smem + w * (TS * REC + 64);
  float* Ploc = P.out + OUT_WK_S;
  float* Sloc = P.out + OUT_WV_S;
  const int hb = nb >> 1;
  if (bid >= hb) { gemm1_part(P, smem, 1, bid - hb, nb - hb); return; }
  for (int u = w * hb + bid; u < NBH * (NC - 1) * 2; u += 4 * hb) {
    const int kind = (u ^ (u / (4 * hb))) & 1, rest = u >> 1;
    const int c = rest % (NC - 1), bh = rest / (NC - 1);
    const int tok0 = (bh >> 4) * TP + c * CL, h = bh & 15;
    float* fin = (kind ? Ploc : Sloc) + (size_t)(bh * (NC - 1) + c) * 4096;
    if (kind) scan_unit<1, false, false>(P, ws, lane, tok0, CL, h, nullptr, fin);
    else scan_unit<0, true, false>(P, ws, lane, tok0, CL, h, nullptr, fin);
  }
}
__device__ __forceinline__ void phase_scan2(const Params& P, unsigned char* smem, int bid, int nb) {
  const int lane = threadIdx.x & 63, w = __builtin_amdgcn_readfirstlane((int)(threadIdx.x >> 6));
  float* ws = (float*)smem + w * 256;
  float* Ploc = P.out + OUT_WK_S;
  float* Sloc = P.out + OUT_WV_S;
  for (int item = bid; item < NBH * 4; item += nb) {
    const int bh = item >> 2, row0 = (item & 3) * 16 + w * 4;
    float s[4];
    {
      const float* S0 = Sloc + (size_t)(bh * (NC - 1)) * 4096;
#pragma unroll
      for (int r = 0; r < 4; r++) s[r] = S0[(row0 + r) * 64 + lane];
    }
    for (int c = 1; c < NC - 1; c++) {
      const float* Pc = Ploc + (size_t)(bh * (NC - 1) + c) * 4096;
      float* Sc = Sloc + (size_t)(bh * (NC - 1) + c) * 4096;
      float acc[4];
#pragma unroll
      for (int r = 0; r < 4; r++) { acc[r] = Sc[(row0 + r) * 64 + lane]; ws[r * 64 + lane] = s[r]; }
      __builtin_amdgcn_wave_barrier();
      asm volatile("s_waitcnt lgkmcnt(0)" ::: "memory");
#pragma unroll 1
      for (int hf = 0; hf < 2; hf++) {
        float p[32];
#pragma unroll
        for (int i = 0; i < 32; i++) p[i] = Pc[(hf * 32 + i) * 64 + lane];
#pragma unroll
        for (int r = 0; r < 4; r++) {
#pragma unroll
          for (int i4 = 0; i4 < 8; i4++) {
            const float4 sv = *(const float4*)(ws + r * 64 + hf * 32 + 4 * i4);
            acc[r] = fmaf(sv.x, p[4 * i4], acc[r]); acc[r] = fmaf(sv.y, p[4 * i4 + 1], acc[r]);
            acc[r] = fmaf(sv.z, p[4 * i4 + 2], acc[r]); acc[r] = fmaf(sv.w, p[4 * i4 + 3], acc[r]);
          }
        }
      }
      __builtin_amdgcn_wave_barrier();
      asm volatile("s_waitcnt lgkmcnt(0)" ::: "memory");
#pragma unroll
      for (int r = 0; r < 4; r++) { s[r] = acc[r]; Sc[(row0 + r) * 64 + lane] = acc[r]; }
    }
  }
}
__device__ __forceinline__ void phase_scan3(const Params& P, unsigned char* smem, int bid, int nb) {
  const int lane = threadIdx.x & 63, w = __builtin_amdgcn_readfirstlane((int)(threadIdx.x >> 6));
  float* ws = (float*)smem + w * (TS * REC + 64);
  float* Sloc = P.out + OUT_WV_S;
  const int hb = nb >> 1;
  if (bid < hb) {
    for (int u = w * hb + bid; u < NBH * NC; u += 4 * hb) {
      const int bh = u >> 5, c = u & 31;
      const int tok0 = (bh >> 4) * TP + c * CL, h = bh & 15;
      const float* ip = (c > 0) ? (Sloc + (size_t)(bh * (NC - 1) + c - 1) * 4096) : nullptr;
      float* fin = (c == NC - 1) ? (P.out + OUT_WKV_P + (size_t)bh * 4096) : nullptr;
      if (c > 0) scan_unit<2, true, true>(P, ws, lane, tok0, CL, h, ip, fin);
      else scan_unit<0, true, true>(P, ws, lane, tok0, CL, h, ip, fin);
    }
  } else {
    for (int sb = w * (nb - hb) + (bid - hb); sb < 2048; sb += 4 * (nb - hb))
      scan_unit<2, true, true>(P, ws, lane, NPR + (sb >> 4) * 8, 8, sb & 15, P.state_wkv + (size_t)sb * 4096, P.out + OUT_WKV_S + (size_t)sb * 4096);
  }
}

__device__ __forceinline__ void phase_ln(const Params& P, int layer, int bid, int nb) {
  const int lane = threadIdx.x & 63, w = __builtin_amdgcn_readfirstlane((int)(threadIdx.x >> 6));
  const float* gg = P.ln_g + layer * DM; const float* bb = P.ln_b + layer * DM;
  for (int tok = bid * 4 + w; tok < NTOK; tok += nb * 4) {
    f32x4* row = (f32x4*)(P.out + OUT_Y + (size_t)tok * DM);
    f32x4 v[4];
    float sum = 0.f;
#pragma unroll
    for (int i = 0; i < 4; i++) { v[i] = row[lane + 64 * i]; sum += v[i][0] + v[i][1] + v[i][2] + v[i][3]; }
    const float mean = wave_sum(sum) * (1.f / 1024.f);
    float sq = 0.f;
#pragma unroll
    for (int i = 0; i < 4; i++) { v[i] -= mean; sq += v[i][0] * v[i][0] + v[i][1] * v[i][1] + v[i][2] * v[i][2] + v[i][3] * v[i][3]; }
    const float rs = rsqrtf(wave_sum(sq) * (1.f / 1024.f) + 1e-5f);
#pragma unroll
    for (int i = 0; i < 4; i++) {
      const f32x4 g4 = ((const f32x4*)gg)[lane + 64 * i], b4 = ((const f32x4*)bb)[lane + 64 * i];
      const f32x4 o = v[i] * rs * g4 + b4;
      row[lane + 64 * i] = o;
      if (layer == 0) { uint2 ob; ob.x = pack2(o[0], o[1]); ob.y = pack2(o[2], o[3]); ((uint2*)(P.Rb + (size_t)tok * DM))[lane + 64 * i] = ob; }
    }
  }
}

__device__ __forceinline__ void attn_prompt_item(const Params& P, unsigned char* smem, int item) {
  const int qh = item & 1, hk = (item >> 1) & 3, n = (item >> 3) & 63, b = item >> 9;
  bf16_t* Ks = (bf16_t*)smem;
  bf16_t* Vs = Ks + 192 * 72;
  const bf16_t* K1 = P.XB; const bf16_t* VT1 = P.XB + (size_t)NTOK * 512;
  const bf16_t* Q1 = P.Kb; const bf16_t* G1 = P.Vb; bf16_t* AO = P.Gb;
  const int t = threadIdx.x, lane = t & 63, w = t >> 6;
  const int g = lane >> 4, lc = lane & 15;
  const int pos0 = (n - 1) * 128 + 64 * qh;
  __syncthreads();
#pragma unroll
  for (int i = 0; i < 6; i++) {
    const int idx = t + 256 * i; const int row = idx >> 3, ch = idx & 7; const int pos = pos0 + row;
    uint4 v = make_uint4(0, 0, 0, 0);
    if (pos >= 0) v = *(const uint4*)(K1 + ((size_t)(b * TP + pos)) * 256 + hk * 64 + ch * 8);
    *(uint4*)(Ks + row * 72 + ch * 8) = v;
  }
#pragma unroll
  for (int i = 0; i < 6; i++) {
    const int idx = t + 256 * i; const int d = idx / 24, ch = idx % 24; const int pos = pos0 + ch * 8;
    uint4 v = make_uint4(0, 0, 0, 0);
    if (pos >= 0) v = *(const uint4*)(VT1 + ((size_t)((b * 4 + hk) * 64 + d)) * TP + pos);
    *(uint4*)(Vs + d * 200 + ch * 8) = v;
  }
  __syncthreads();
  const int h = hk * 4 + w;
  const float slope = exp2f(-0.5f * (float)(h + 1));
  const float sink = P.att_sinks[h];
  for (int sb = 0; sb < 2; sb++) {
    const int i0 = 64 * qh + 32 * sb;
    const int tokb = b * TP + n * 128 + i0;
    bf16x8 qf[2][2];
#pragma unroll
    for (int nn = 0; nn < 2; nn++)
#pragma unroll
      for (int ks = 0; ks < 2; ks++) qf[nn][ks] = *(const bf16x8*)(Q1 + (size_t)(tokb + 16 * nn + lc) * DM + h * 64 + ks * 32 + g * 8);
    float mrun[2] = {sink, sink}, lrun[2] = {1.f, 1.f};
    f32x4 O[4][2];
#pragma unroll
    for (int dm = 0; dm < 4; dm++) { O[dm][0] = (f32x4){0.f, 0.f, 0.f, 0.f}; O[dm][1] = (f32x4){0.f, 0.f, 0.f, 0.f}; }
    for (int kt = 0; kt < 3; kt++) {
      if (n == 0 && (qh + kt) < 2) continue;
      f32x4 S[4][2];
#pragma unroll
      for (int mm = 0; mm < 4; mm++) { S[mm][0] = (f32x4){0.f, 0.f, 0.f, 0.f}; S[mm][1] = (f32x4){0.f, 0.f, 0.f, 0.f}; }
#pragma unroll
      for (int ks = 0; ks < 2; ks++)
#pragma unroll
        for (int mm = 0; mm < 4; mm++) {
          const bf16x8 kf = *(const bf16x8*)(Ks + (kt * 64 + mm * 16 + lc) * 72 + ks * 32 + g * 8);
          S[mm][0] = __builtin_amdgcn_mfma_f32_16x16x32_bf16(kf, qf[0][ks], S[mm][0], 0, 0, 0);
          S[mm][1] = __builtin_amdgcn_mfma_f32_16x16x32_bf16(kf, qf[1][ks], S[mm][1], 0, 0, 0);
        }
#pragma unroll
      for (int nn = 0; nn < 2; nn++) {
        const int qi = i0 + 16 * nn + lc;
        float mx = mrun[nn];
#pragma unroll
        for (int mm = 0; mm < 4; mm++)
#pragma unroll
          for (int r = 0; r < 4; r++) {
            const int j = 64 * (qh + kt) + 16 * mm + 4 * g + r;
            const int dist = 128 + qi - j;
            const bool live = (dist >= 0) && (dist < 128);
            const float sv = live ? (S[mm][nn][r] * 0.125f - slope * (float)dist) : -1e30f;
            S[mm][nn][r] = sv; mx = fmaxf(mx, sv);
          }
        mx = fmaxf(mx, __shfl_xor(mx, 16)); mx = fmaxf(mx, __shfl_xor(mx, 32));
        const float corr = __expf(mrun[nn] - mx); mrun[nn] = mx;
        float sum = 0.f;
#pragma unroll
        for (int mm = 0; mm < 4; mm++)
#pragma unroll
          for (int r = 0; r < 4; r++) { const float pp = __expf(S[mm][nn][r] - mx); S[mm][nn][r] = pp; sum += pp; }
        sum += __shfl_xor(sum, 16); sum += __shfl_xor(sum, 32);
        lrun[nn] = lrun[nn] * corr + sum;
#pragma unroll
        for (int dm = 0; dm < 4; dm++) { O[dm][nn][0] *= corr; O[dm][nn][1] *= corr; O[dm][nn][2] *= corr; O[dm][nn][3] *= corr; }
      }
#pragma unroll
      for (int k2 = 0; k2 < 2; k2++) {
        bf16x8 pf[2];
#pragma unroll
        for (int nn = 0; nn < 2; nn++) {
          const unsigned u0 = pack2(S[2 * k2][nn][0], S[2 * k2][nn][1]), u1 = pack2(S[2 * k2][nn][2], S[2 * k2][nn][3]);
          const unsigned u2 = pack2(S[2 * k2 + 1][nn][0], S[2 * k2 + 1][nn][1]), u3 = pack2(S[2 * k2 + 1][nn][2], S[2 * k2 + 1][nn][3]);
          const uint4 uu = make_uint4(u0, u1, u2, u3);
          pf[nn] = *(const bf16x8*)&uu;
        }
#pragma unroll
        for (int dm = 0; dm < 4; dm++) {
          const bf16_t* vb = Vs + (dm * 16 + lc) * 200 + kt * 64 + k2 * 32 + 4 * g;
          const uint2 lo = *(const uint2*)vb, hi = *(const uint2*)(vb + 16);
          const uint4 uu = make_uint4(lo.x, lo.y, hi.x, hi.y);
          const bf16x8 vf = *(const bf16x8*)&uu;
          O[dm][0] = __builtin_amdgcn_mfma_f32_16x16x32_bf16(vf, pf[0], O[dm][0], 0, 0, 0);
          O[dm][1] = __builtin_amdgcn_mfma_f32_16x16x32_bf16(vf, pf[1], O[dm][1], 0, 0, 0);
        }
      }
    }
#pragma unroll
    for (int nn = 0; nn < 2; nn++) {
      const float inv = 1.f / lrun[nn];
      const size_t tok = (size_t)(tokb + 16 * nn + lc);
#pragma unroll
      for (int dm = 0; dm < 4; dm++) {
        const int d = dm * 16 + 4 * g;
        const uint2 gv = *(const uint2*)(G1 + tok * DM + h * 64 + d);
        const float g0 = __uint_as_float(gv.x << 16), g1 = __uint_as_float(gv.x & 0xffff0000u);
        const float g2 = __uint_as_float(gv.y << 16), g3 = __uint_as_float(gv.y & 0xffff0000u);
        uint2 o;
        o.x = pack2(O[dm][nn][0] * inv * g0 * sigmoidf_(g0), O[dm][nn][1] * inv * g1 * sigmoidf_(g1));
        o.y = pack2(O[dm][nn][2] * inv * g2 * sigmoidf_(g2), O[dm][nn][3] * inv * g3 * sigmoidf_(g3));
        *(uint2*)(AO + tok * DM + h * 64 + d) = o;
      }
    }
  }
}

__device__ __forceinline__ void attn_sample_item(const Params& P, unsigned char* smem, int item) {
  const int b = item >> 2, hk = item & 3;
  const int t = threadIdx.x, lane = t & 63, w = t >> 6;
  float* kv = (float*)smem;
  float* qs = kv + 136 * 65 + w * 512;
  float* ps = kv + 136 * 65 + 2048 + w * (8 * 136);
  const bf16_t* K1 = P.XB; const bf16_t* V1 = P.XB + (size_t)NTOK * 256;
  const bf16_t* Q1 = P.Kb; const bf16_t* G1 = P.Vb; bf16_t* AO = P.Gb;
  const int h = hk * 4 + w;
  const float slope = exp2f(-0.5f * (float)(h + 1));
  const float sink = P.att_sinks[h];
  const int tok0 = NPR + b * 8;
  __syncthreads();
#pragma unroll 2
  for (int it = 0; it < 8; it++) {
    const int idx = t + 256 * it; const int row = idx >> 4, c4 = idx & 15;
    const size_t so = ((size_t)(b * 128 + row)) * 256 + hk * 64 + c4 * 4;
    const float4 kx = *(const float4*)(P.cache_k + so);
    const float4 vx = *(const float4*)(P.cache_v + so);
    float* kd = kv + row * 65 + c4 * 4;
    kd[0] = kx.x; kd[1] = kx.y; kd[2] = kx.z; kd[3] = kx.w;
    if (row >= 8) {
      const size_t dofs = ((size_t)(b * 128 + row - 8)) * 256 + hk * 64 + c4 * 4;
      *(float4*)(P.out + OUT_WK_S + dofs) = kx;
      *(float4*)(P.out + OUT_WV_S + dofs) = vx;
    }
  }
#pragma unroll
  for (int it = 0; it < 2; it++) {
    const int idx = t + 256 * it; const int r8 = idx >> 6, d = idx & 63;
    kv[(128 + r8) * 65 + d] = bf2f(K1[(size_t)(tok0 + r8) * 256 + hk * 64 + d]);
  }
#pragma unroll
  for (int i = 0; i < 8; i++) qs[i * 64 + lane] = bf2f(Q1[(size_t)(tok0 + i) * DM + h * 64 + lane]);
  __syncthreads();
  float sc[3][8];
#pragma unroll
  for (int ksel = 0; ksel < 3; ksel++) {
    float acc[8];
#pragma unroll
    for (int i = 0; i < 8; i++) acc[i] = 0.f;
    const float* kr = kv + ((ksel < 2) ? (lane + 64 * ksel) : (128 + (lane & 7))) * 65;
#pragma unroll 2
    for (int d4 = 0; d4 < 16; d4++) {
      const float k0 = kr[4 * d4], k1 = kr[4 * d4 + 1], k2 = kr[4 * d4 + 2], k3 = kr[4 * d4 + 3];
#pragma unroll
      for (int i = 0; i < 8; i++) {
        const float4 qv = *(const float4*)(qs + i * 64 + 4 * d4);
        acc[i] = fmaf(qv.x, k0, acc[i]); acc[i] = fmaf(qv.y, k1, acc[i]); acc[i] = fmaf(qv.z, k2, acc[i]); acc[i] = fmaf(qv.w, k3, acc[i]);
      }
    }
#pragma unroll
    for (int i = 0; i < 8; i++) {
      int dist; bool live;
      if (ksel < 2) { const int j = lane + 64 * ksel; dist = 128 + i - j; live = (j > i); }
      else { dist = i - lane; live = (lane <= i); }
      sc[ksel][i] = live ? (acc[i] * 0.125f - slope * (float)dist) : -1e30f;
    }
  }
#pragma unroll
  for (int i = 0; i < 8; i++) {
    float mx = fmaxf(fmaxf(sc[0][i], sc[1][i]), sc[2][i]);
    mx = fmaxf(wave_max(mx), sink);
    const float p0 = __expf(sc[0][i] - mx), p1 = __expf(sc[1][i] - mx), p2 = __expf(sc[2][i] - mx);
    const float den = wave_sum(p0 + p1 + p2) + __expf(sink - mx);
    const float inv = 1.f / den;
    ps[i * 136 + lane] = p0 * inv; ps[i * 136 + 64 + lane] = p1 * inv;
    if (lane < 8) ps[i * 136 + 128 + lane] = p2 * inv;
  }
  __syncthreads();
#pragma unroll 4
  for (int it = 0; it < 8; it++) {
    const int idx = t + 256 * it; const int row = idx >> 4, c4 = idx & 15;
    *(float4*)(kv + row * 64 + c4 * 4) = *(const float4*)(P.cache_v + ((size_t)(b * 128 + row)) * 256 + hk * 64 + c4 * 4);
  }
#pragma unroll
  for (int it = 0; it < 2; it++) {
    const int idx = t + 256 * it; const int r8 = idx >> 6, d = idx & 63;
    kv[(128 + r8) * 64 + d] = bf2f(V1[(size_t)(tok0 + r8) * 256 + hk * 64 + d]);
  }
  __syncthreads();
  float o[8];
#pragma unroll
  for (int i = 0; i < 8; i++) o[i] = 0.f;
#pragma unroll 2
  for (int j0 = 0; j0 < 136; j0 += 4) {
    const float v0 = kv[(j0) * 64 + lane], v1 = kv[(j0 + 1) * 64 + lane], v2 = kv[(j0 + 2) * 64 + lane], v3 = kv[(j0 + 3) * 64 + lane];
#pragma unroll
    for (int i = 0; i < 8; i++) {
      const float4 pa = *(const float4*)(ps + i * 136 + j0);
      o[i] = fmaf(pa.x, v0, o[i]); o[i] = fmaf(pa.y, v1, o[i]); o[i] = fmaf(pa.z, v2, o[i]); o[i] = fmaf(pa.w, v3, o[i]);
    }
  }
#pragma unroll
  for (int i = 0; i < 8; i++) {
    const size_t off = (size_t)(tok0 + i) * DM + h * 64 + lane;
    const float gt = bf2f(G1[off]);
    AO[off] = f2bf(o[i] * gt * sigmoidf_(gt));
  }
}
__device__ __forceinline__ void phase_attn(const Params& P, unsigned char* smem, int bid, int nb) {
#if PROBE == 7
  for (int item = bid; item < 1024; item += nb) attn_prompt_item(P, smem, item);
#elif PROBE == 8
  for (int item = bid; item < 512; item += nb) attn_sample_item(P, smem, item);
#endif
  for (int item = bid; item < 1024 + 512; item += nb) {
    if (item < 1024) attn_prompt_item(P, smem, item);
    else attn_sample_item(P, smem, item - 1024);
  }
}

#if MULTI_LAUNCH
#define PH_BARRIER(ph)
#else
#define PH_BARRIER(ph) do { if ((ph) + 1 < P.phase_end) xcd_barrier(xb); } while (0)
#endif
#define RUN_PH(ph, call) do { if (P.phase_begin <= (ph) && (ph) < P.phase_end) { if ((REPMASK >> (ph)) & 1) { call; PH_BARRIER(ph); } call; PH_BARRIER(ph); } } while (0)

__global__ void __launch_bounds__(256, 2) fwd_kernel(Params P) {
  __shared__ __attribute__((aligned(16))) unsigned char smem[SMEM_BYTES];
  const int bid = blockIdx.x, nb = gridDim.x;
#if !MULTI_LAUNCH
  __shared__ uint4 xb_words;
  if (threadIdx.x == 0) xb_words = make_uint4(0u, 0u, 0u, 0u);
  __syncthreads();
  XcdBarrier xb = xcd_barrier_post(P.bar, (volatile LAS unsigned*)&xb_words);
#endif
#if (PHMASK >> 0) & 1
  RUN_PH(0, phase_prep(P, smem, bid, nb));
#endif
#if (PHMASK >> 1) & 1
  RUN_PH(1, gemm1_part(P, smem, 0, bid, nb));
#endif
#if (PHMASK >> 2) & 1
  RUN_PH(2, gemm_phase<2>(P, smem, bid, nb));
#endif
#if (PHMASK >> 3) & 1
  RUN_PH(3, phase_scan1(P, smem, bid, nb));
#endif
#if (PHMASK >> 4) & 1
  RUN_PH(4, phase_scan2(P, smem, bid, nb));
#endif
#if (PHMASK >> 5) & 1
  RUN_PH(5, phase_scan3(P, smem, bid, nb));
#endif
#if (PHMASK >> 6) & 1
  RUN_PH(6, gemm_phase<3>(P, smem, bid, nb));
#endif
#if (PHMASK >> 7) & 1
  RUN_PH(7, phase_ln(P, 0, bid, nb));
#endif
#if (PHMASK >> 8) & 1
  RUN_PH(8, gemm_phase<4>(P, smem, bid, nb));
#endif
#if (PHMASK >> 9) & 1
  RUN_PH(9, phase_attn(P, smem, bid, nb));
#endif
#if (PHMASK >> 10) & 1
  RUN_PH(10, gemm_phase<5>(P, smem, bid, nb));
#endif
#if (PHMASK >> 11) & 1
  RUN_PH(11, phase_ln(P, 1, bid, nb));
#endif
#if PROBE && PROBE < 7
  xcd_barrier(xb);
  gemm_phase<6>(P, smem, bid, nb);
#endif
#if !MULTI_LAUNCH
  if (P.phase_end > NPHASE) cg::this_grid().sync();
#endif
}

extern "C" void kernel_launch(void* const* d_in, const int* in_sizes, int n_in, void* d_out, int out_size, void* d_ws, size_t ws_size, hipStream_t stream) {
  Params P{};
  P.x_prompt = (const float*)d_in[0]; P.x_sample = (const float*)d_in[1]; P.state_wkv = (const float*)d_in[2]; P.state_shift = (const float*)d_in[3];
  P.cache_k = (const float*)d_in[4]; P.cache_v = (const float*)d_in[5]; P.ln_g = (const float*)d_in[6]; P.ln_b = (const float*)d_in[7];
  P.mu = (const float*)d_in[8]; P.w_in = (const float*)d_in[9]; P.w0 = (const float*)d_in[10]; P.w1 = (const float*)d_in[11]; P.w2 = (const float*)d_in[12];
  P.a0 = (const float*)d_in[13]; P.a1 = (const float*)d_in[14]; P.a2 = (const float*)d_in[15]; P.k_k = (const float*)d_in[16]; P.k_a = (const float*)d_in[17];
  P.r_k = (const float*)d_in[18]; P.gn_g = (const float*)d_in[19]; P.gn_b = (const float*)d_in[20]; P.w_out = (const float*)d_in[21];
  P.att_w_in = (const float*)d_in[22]; P.att_sinks = (const float*)d_in[23]; P.att_w_out = (const float*)d_in[24];
  P.out = (float*)d_out;
  unsigned char* ws = (unsigned char*)d_ws;
  size_t off = 0;
  auto take = [&](size_t bytes) { unsigned char* p = ws + off; off += (bytes + 255) & ~(size_t)255; return p; };
  P.bar = (unsigned*)take(16384);
  P.WtIn0 = (bf16_t*)take((size_t)4352 * DM * 2);
  P.W2t = (bf16_t*)take((size_t)DM * 64 * 2);
  P.A2t = (bf16_t*)take((size_t)DM * 64 * 2);
  P.WtOut0 = (bf16_t*)take((size_t)DM * DM * 2);
  P.WtIn1 = (bf16_t*)take((size_t)2560 * DM * 2);
  P.WtOut1 = (bf16_t*)take((size_t)DM * DM * 2);
  P.XB = (bf16_t*)take((size_t)NTOK * DM * 2);
  P.XXB = (bf16_t*)take((size_t)NTOK * DM * 2);
  P.Rb = (bf16_t*)take((size_t)NTOK * DM * 2);
  P.Kb = (bf16_t*)take((size_t)NTOK * DM * 2);
  P.Vb = (bf16_t*)take((size_t)NTOK * DM * 2);
  P.Gb = (bf16_t*)take((size_t)NTOK * DM * 2);
  P.H1 = (bf16_t*)take((size_t)NTOK * 64 * 2);
  P.H2 = (bf16_t*)take((size_t)NTOK * 64 * 2);
  P.MU16 = (bf16_t*)take((size_t)6 * DM * 2);
  P.INVN = (float*)take((size_t)NTOK * 16 * 4);
  if (off > ws_size) { fprintf(stderr, "workspace too small: need %zu have %zu\n", off, ws_size); return; }
#if MULTI_LAUNCH
  for (int ph = 0; ph < NPHASE; ph++) {
    P.phase_begin = ph; P.phase_end = ph + 1;
    hipLaunchKernelGGL(fwd_kernel, dim3(512), dim3(256), 0, stream, P);
  }
#else
  static int grid_blocks = 0;
  if (!grid_blocks) {
    int dev = 0, cus = 0, per_cu = 0;
    hipGetDevice(&dev);
    hipDeviceGetAttribute(&cus, hipDeviceAttributeMultiprocessorCount, dev);
    hipOccupancyMaxActiveBlocksPerMultiprocessor(&per_cu, fwd_kernel, 256, 0);
    if (per_cu > 2) per_cu = 2;
    if (per_cu < 1) per_cu = 1;
    grid_blocks = cus * per_cu;
  }
  hipMemsetAsync(P.bar, 0, 16384, stream);
  P.phase_begin = 0; P.phase_end = NPHASE;
  void* args[] = {&P};
  hipError_t e = hipLaunchCooperativeKernel((void*)fwd_kernel, dim3(grid_blocks), dim3(256), args, 0, stream);
  if (e != hipSuccess) fprintf(stderr, "cooperative launch failed: %s (grid %d)\n", hipGetErrorString(e), grid_blocks);
#endif
}
```

```cpp
#include <hip/hip_runtime.h>
#include <hip/hip_cooperative_groups.h>
#include <stdint.h>
#include <cstdio>
namespace cg = cooperative_groups;

#ifndef PHMASK
#define PHMASK 0xFFF
#endif
#ifndef PROBE
#define PROBE 0
#endif
#ifndef REPMASK
#define REPMASK 0
#endif
#ifndef MULTI_LAUNCH
#define MULTI_LAUNCH 0
#endif

typedef unsigned short bf16_t;
typedef _Float16 f16_t;
typedef __attribute__((ext_vector_type(8))) short bf16x8;
typedef __attribute__((ext_vector_type(4))) float f32x4;
typedef __attribute__((ext_vector_type(4))) unsigned u32x4;

#define DM 1024
#define NTOK 17408
#define NPR 16384
#define TP 8192
#define NC 32
#define CL 256
#define NBH 32
#define ALPHA_F 1.41421356237f
#define SMEM_BYTES (61 * 1024)
#define NPHASE 12

#define OUT_Y 0
#define OUT_WKV_P 17825792
#define OUT_SH_P 17956864
#define OUT_WK_P 17958912
#define OUT_WV_P 18024448
#define OUT_WKV_S 18089984
#define OUT_SH_S 26478592
#define OUT_WK_S 26609664
#define OUT_WV_S 30803968

struct Params {
  const float *x_prompt, *x_sample, *state_wkv, *state_shift, *cache_k, *cache_v, *ln_g, *ln_b;
  const float *mu, *w_in, *w0, *w1, *w2, *a0, *a1, *a2, *k_k, *k_a, *r_k, *gn_g, *gn_b, *w_out;
  const float *att_w_in, *att_sinks, *att_w_out;
  float* out;
  unsigned* bar;
  bf16_t *WtIn0, *W2t, *A2t, *WtOut0, *WtIn1, *WtOut1;
  bf16_t *XB, *XXB;
  bf16_t *Rb, *Kb, *Vb, *Gb;
  bf16_t *H1, *H2, *MU16;
  float* INVN;
  int phase_begin, phase_end;
};

typedef __bf16 hbf2 __attribute__((ext_vector_type(2)));
typedef float f32x2_ __attribute__((ext_vector_type(2)));
__device__ __forceinline__ unsigned pack2(float a, float b) {
  const f32x2_ v = {a, b};
  return __builtin_bit_cast(unsigned, __builtin_convertvector(v, hbf2));
}
__device__ __forceinline__ bf16_t f2bf(float f) { return (bf16_t)(pack2(f, 0.f) & 0xffffu); }
__device__ __forceinline__ float bf2f(bf16_t h) { return __uint_as_float(((unsigned)h) << 16); }
__device__ __forceinline__ float wave_sum(float x) {
#pragma unroll
  for (int o = 32; o >= 1; o >>= 1) x += __shfl_xor(x, o);
  return x;
}
__device__ __forceinline__ float wave_max(float x) {
#pragma unroll
  for (int o = 32; o >= 1; o >>= 1) x = fmaxf(x, __shfl_xor(x, o));
  return x;
}
__device__ __forceinline__ float quad_sum(float x) {
  x += __builtin_bit_cast(float, __builtin_amdgcn_update_dpp(0, __builtin_bit_cast(int, x), 0xB1, 0xF, 0xF, true));
  x += __builtin_bit_cast(float, __builtin_amdgcn_update_dpp(0, __builtin_bit_cast(int, x), 0x4E, 0xF, 0xF, true));
  return x;
}
__device__ __forceinline__ float sigmoidf_(float x) { return __builtin_amdgcn_rcpf(1.f + __expf(-x)); }
__device__ __forceinline__ const float* xin_row(const Params& P, int m) {
  return (m < NPR) ? (P.x_prompt + (size_t)m * DM) : (P.x_sample + (size_t)(m - NPR) * DM);
}

#define XB_TMO      128
#define XB_XCNT(j)  (256  + 64 * (j))
#define XB_XSUB(j)  (1280 + 64 * (j))
#define XB_XGEN(j)  (2304 + 64 * (j))
#define XB_TOP      3328
#define XB_TOPGEN   3392
#define XCD_BAR_WORDS 3456
#define XB_SPIN_CAP (1u << 22)
#define LAS __attribute__((address_space(3)))
__device__ __forceinline__ unsigned xb_ld(unsigned* p) { return __hip_atomic_load(p, __ATOMIC_RELAXED, __HIP_MEMORY_SCOPE_AGENT); }
__device__ __forceinline__ unsigned xb_add(unsigned* p, unsigned v) { return __hip_atomic_fetch_add(p, v, __ATOMIC_RELAXED, __HIP_MEMORY_SCOPE_AGENT); }
__device__ __forceinline__ unsigned xb_xcc_id() { return (unsigned)__builtin_amdgcn_s_getreg((3 << 11) | 20) & 0xFu; }
#define XB_SPIN(cond, bar) do { unsigned _sp = 0; while (cond) { __builtin_amdgcn_s_sleep(1); \
    if ((++_sp & 255u) == 0u) { if (xb_ld(&(bar)[XB_TMO])) break; if (_sp > XB_SPIN_CAP) { atomicAdd(&(bar)[XB_TMO], 1u); break; } } } } while (0)
struct XcdBarrier { unsigned* bar; unsigned x; volatile LAS unsigned* st; };
__device__ __forceinline__ XcdBarrier xcd_barrier_post(unsigned* bar, volatile LAS unsigned* st) {
  XcdBarrier b; b.bar = bar; b.x = xb_xcc_id(); b.st = st;
  if (threadIdx.x == 0) (void)xb_add(&bar[XB_XCNT(b.x)], 1u);
  return b;
}
__device__ __forceinline__ void xcd_barrier_complete(unsigned* bar, unsigned x, unsigned& nloc, unsigned& nx) {
  const unsigned G = gridDim.x * gridDim.y * gridDim.z;
  unsigned sum, cnt, mine, sp = 0u;
  for (;;) {
    sum = 0u; cnt = 0u; mine = 0u;
#pragma unroll
    for (unsigned j = 0; j < 16; ++j) { const unsigned c = xb_ld(&bar[XB_XCNT(j)]); sum += c; cnt += (c > 0u) ? 1u : 0u; mine = (j == x) ? c : mine; }
    if (sum == G) break;
    __builtin_amdgcn_s_sleep(1);
    if ((++sp & 255u) == 0u) { if (xb_ld(&bar[XB_TMO])) break; if (sp > XB_SPIN_CAP) { atomicAdd(&bar[XB_TMO], 1u); break; } }
  }
  nloc = mine > 0u ? mine : 1u; nx = cnt > 0u ? cnt : 1u;
}
__device__ __forceinline__ void xcd_barrier(const XcdBarrier& b) {
  asm volatile("s_waitcnt vmcnt(0)" ::: "memory");
  __syncthreads();
  if (threadIdx.x == 0) {
    unsigned* bar = b.bar;
    __builtin_amdgcn_s_waitcnt(0);
    unsigned nloc = b.st[0], nx = b.st[1];
    if (nloc == 0u) { xcd_barrier_complete(bar, b.x, nloc, nx); b.st[0] = nloc; b.st[1] = nx; }
    const unsigned old = xb_add(&bar[XB_XSUB(b.x)], 1u);
    const unsigned gen = old / nloc;
    if (old + 1u == (gen + 1u) * nloc) {
      __builtin_amdgcn_fence(__ATOMIC_RELEASE, "agent");
      asm volatile("s_waitcnt vmcnt(0)" ::: "memory");
      const unsigned og = xb_add(&bar[XB_TOP], 1u);
      const unsigned tg = og / nx;
      if (og + 1u == (tg + 1u) * nx) xb_add(&bar[XB_TOPGEN], 1u);
      else XB_SPIN(xb_ld(&bar[XB_TOPGEN]) == tg, bar);
      __builtin_amdgcn_fence(__ATOMIC_ACQUIRE, "agent");
      xb_add(&bar[XB_XGEN(b.x)], 1u);
      asm volatile("s_waitcnt vmcnt(0)" ::: "memory");
    } else {
      XB_SPIN(xb_ld(&bar[XB_XGEN(b.x)]) == gen, bar);
      __builtin_amdgcn_fence(__ATOMIC_ACQUIRE, "agent");
      asm volatile("s_waitcnt vmcnt(0)" ::: "memory");
    }
  }
  __syncthreads();
}

__device__ __forceinline__ unsigned short f2h_bits(float f) { const _Float16 h = (_Float16)f; return __builtin_bit_cast(unsigned short, h); }
__device__ __forceinline__ unsigned pack2h(float a, float b) { return (unsigned)f2h_bits(a) | ((unsigned)f2h_bits(b) << 16); }
__device__ __forceinline__ void transpose_tile(const float* __restrict__ src, int ld, int k0, int n0, bf16_t* __restrict__ dst, int ldd, float* tile, bool half = false) {
  const int t = threadIdx.x;
  {
    const int n = t & 63, kq = t >> 6;
#pragma unroll 4
    for (int i = 0; i < 16; i++) { const int k = i * 4 + kq; tile[k * 65 + n] = src[(size_t)(k0 + k) * ld + n0 + n]; }
  }
  __syncthreads();
  {
    const int k = t & 63, nq = t >> 6;
#pragma unroll 4
    for (int i = 0; i < 16; i++) { const int n2 = i * 4 + nq; const float v_ = tile[k * 65 + n2]; dst[(size_t)(n0 + n2) * ldd + k0 + k] = half ? f2h_bits(v_) : f2bf(v_); }
  }
  __syncthreads();
}

__device__ __forceinline__ void late_weight_prep(const Params& P, unsigned char* smem, int first, int stride) {
  float* tile = (float*)smem;
  for (int id = 1088 + first; id < 2240; id += stride) {
    if (id < 1344) { const int r = id - 1088; transpose_tile(P.w_out, DM, (r >> 4) * 64, (r & 15) * 64, P.WtOut0, DM, tile); }
    else if (id < 1984) { const int r = id - 1344; transpose_tile(P.att_w_in, 2560, (r / 40) * 64, (r % 40) * 64, P.WtIn1, DM, tile); }
    else { const int r = id - 1984; transpose_tile(P.att_w_out, DM, (r >> 4) * 64, (r & 15) * 64, P.WtOut1, DM, tile); }
  }
}
__device__ __forceinline__ void phase_prep(const Params& P, unsigned char* smem, int bid, int nb) {
  float* tile = (float*)smem;
  const int t = threadIdx.x;
  const int NITEMS = 2242 + 4352 + 130;
  for (int id = bid; id < NITEMS; id += nb) {
    if (id < 1024) { const int p = id >> 8, r = id & 255; transpose_tile(P.w_in + (size_t)p * DM * DM, DM, (r >> 4) * 64, (r & 15) * 64, P.WtIn0 + (size_t)p * DM * DM, DM, tile, true); }
    else if (id < 1040) transpose_tile(P.w1, 64, (id - 1024) * 64, 0, P.WtIn0 + (size_t)4096 * DM, DM, tile, true);
    else if (id < 1056) transpose_tile(P.a1, 64, (id - 1040) * 64, 0, P.WtIn0 + (size_t)4224 * DM, DM, tile, true);
    else if (id < 1072) transpose_tile(P.w2, DM, 0, (id - 1056) * 64, P.W2t, 64, tile);
    else if (id < 1088) transpose_tile(P.a2, DM, 0, (id - 1072) * 64, P.A2t, 64, tile);
    else if (id < 2240) { }
    else if (id < 2242) {
      uint4* z = (uint4*)(P.WtIn0 + (size_t)(id == 2240 ? 4160 : 4288) * DM);
      for (int i = t; i < 8192; i += 256) z[i] = make_uint4(0, 0, 0, 0);
      if (id == 2240) for (int i = t; i < 6 * DM; i += 256) P.MU16[i] = f2h_bits(P.mu[i]);
    } else if (id < 2242 + 4352) {
      const int it = id - 2242;
#pragma unroll
      for (int q = 0; q < 4; q++) {
        const int m = it * 4 + q;
        const float4 x = ((const float4*)xin_row(P, m))[t];
        float4 pv = make_float4(0.f, 0.f, 0.f, 0.f);
        if (m < NPR) { if ((m & (TP - 1)) != 0) pv = ((const float4*)xin_row(P, m - 1))[t]; }
        else { const int ms = m - NPR; if ((ms & 7) != 0) pv = ((const float4*)xin_row(P, m - 1))[t]; else pv = ((const float4*)(P.state_shift + (size_t)(ms >> 3) * DM))[t]; }
        uint2 xb, xxb;
        xb.x = pack2h(x.x, x.y); xb.y = pack2h(x.z, x.w);
        xxb.x = pack2h(pv.x - x.x, pv.y - x.y); xxb.y = pack2h(pv.z - x.z, pv.w - x.w);
        ((uint2*)(P.XB + (size_t)m * DM))[t] = xb;
        ((uint2*)(P.XXB + (size_t)m * DM))[t] = xxb;
      }
    } else {
      const int r = id - (2242 + 4352);
      if (r < 2) ((float4*)(P.out + OUT_SH_P + (size_t)r * DM))[t] = ((const float4*)(P.x_prompt + ((size_t)r * TP + TP - 1) * DM))[t];
      else { const int b = r - 2; ((float4*)(P.out + OUT_SH_S + (size_t)b * DM))[t] = ((const float4*)(P.x_sample + ((size_t)b * 8 + 7) * DM))[t]; }
    }
  }
}

#define LDB 48
typedef _Float16 f16x8 __attribute__((ext_vector_type(8)));
typedef _Float16 f16x2 __attribute__((ext_vector_type(2)));
__device__ __forceinline__ unsigned xs16(unsigned x, unsigned d, unsigned m) {
  const f16x2 r = __builtin_elementwise_fma(__builtin_bit_cast(f16x2, d), __builtin_bit_cast(f16x2, m), __builtin_bit_cast(f16x2, x));
  return __builtin_bit_cast(unsigned, r);
}
template <int MODE>
__device__ __forceinline__ void gemm_tile(const Params& P, unsigned char* smem, int mt, int nt) {
  constexpr int KT = (MODE == 2) ? 1 : 16;
  bf16_t* Asb[2]; bf16_t* Bsb[2];
  Asb[0] = (bf16_t*)smem; Bsb[0] = Asb[0] + 128 * LDB; Asb[1] = Bsb[0] + 128 * LDB; Bsb[1] = Asb[1] + 128 * LDB;
  const int t = threadIdx.x, lane = t & 63, w = t >> 6;
  const int wm = w >> 1, wn = w & 1;
  const int g = lane >> 4, lc = lane & 15;
  const int lr = t >> 2, lc4 = t & 3;
  const int m0 = mt * 128, n0 = nt * 128;

  const bf16_t* Ap; const bf16_t* A2p = nullptr; const bf16_t* mup = nullptr; const bf16_t* Bp; int lda, ldb;
  if (MODE == 1) {
    const int p = (nt < 32) ? (nt >> 3) : (4 + (nt - 32));
    Ap = P.XB; A2p = P.XXB; lda = DM; mup = P.MU16 + (size_t)p * DM;
    Bp = P.WtIn0 + (size_t)((nt < 32) ? n0 : (4096 + (nt - 32) * 128)) * DM; ldb = DM;
  } else if (MODE == 2) {
    Ap = (nt < 8) ? P.H1 : P.H2; lda = 64;
    Bp = ((nt < 8) ? P.W2t : P.A2t) + (size_t)((nt & 7) * 128) * 64; ldb = 64;
  } else if (MODE == 3) { Ap = P.Gb; lda = DM; Bp = P.WtOut0 + (size_t)n0 * DM; ldb = DM; }
  else if (MODE == 4 || MODE == 6) { Ap = P.Rb; lda = DM; Bp = P.WtIn1 + (size_t)n0 * DM; ldb = DM; }
  else { Ap = P.Gb; lda = DM; Bp = P.WtOut1 + (size_t)n0 * DM; ldb = DM; }

  f32x4 acc[4][4];
#pragma unroll
  for (int i = 0; i < 4; i++)
#pragma unroll
    for (int j = 0; j < 4; j++) acc[i][j] = (f32x4){0.f, 0.f, 0.f, 0.f};

  u32x4 ra[2][2][2], rb[2][2][2], ra2[2][2][2], rmu[2][2];
  const unsigned voffA = (unsigned)(lr * lda + lc4 * 8) * 2u;
  const unsigned voffB = (unsigned)(lr * ldb + lc4 * 8) * 2u;
  const char* baseA = (const char*)(Ap + (size_t)m0 * lda);
  const char* baseA2 = (const char*)(A2p + (size_t)m0 * lda);
  const char* baseB = (const char*)Bp;
#define LOADH(S_, kt_, H_) do { if ((kt_) < KT) { \
    _Pragma("unroll") for (int ii_ = 0; ii_ < 2; ii_++) { \
      const size_t uo_ = ((size_t)(64 * ii_) * lda + (size_t)(kt_) * 64 + 32 * (H_)) * 2; \
      const size_t uob_ = ((size_t)(64 * ii_) * ldb + (size_t)(kt_) * 64 + 32 * (H_)) * 2; \
      ra[S_][H_][ii_] = *(const u32x4*)(baseA + uo_ + voffA); \
      if (MODE == 1) ra2[S_][H_][ii_] = *(const u32x4*)(baseA2 + uo_ + voffA); \
      rb[S_][H_][ii_] = *(const u32x4*)(baseB + uob_ + voffB); \
    } \
    if (MODE == 1) rmu[S_][H_] = *(const u32x4*)(mup + (kt_) * 64 + 32 * (H_) + lc4 * 8); \
  } } while (0)
#define STOREH(S_, H_, B_) do { \
    _Pragma("unroll") for (int ii_ = 0; ii_ < 2; ii_++) { \
      const int row_ = lr + 64 * ii_; \
      u32x4 av_ = ra[S_][H_][ii_]; \
      if (MODE == 1) { \
        const u32x4 xv_ = ra[S_][H_][ii_], dv_ = ra2[S_][H_][ii_], mv_ = rmu[S_][H_]; \
        av_ = (u32x4){xs16(xv_.x, dv_.x, mv_.x), xs16(xv_.y, dv_.y, mv_.y), xs16(xv_.z, dv_.z, mv_.z), xs16(xv_.w, dv_.w, mv_.w)}; \
      } \
      *(u32x4*)(Asb[B_] + row_ * LDB + lc4 * 8) = av_; \
      *(u32x4*)(Bsb[B_] + row_ * LDB + lc4 * 8) = rb[S_][H_][ii_]; \
    } \
  } while (0)
#define COMPUTE_SUB(B_) do { if (!(MODE == 6 && PROBE == 3)) { \
    bf16x8 af[4], bfr[4]; \
    _Pragma("unroll") for (int i = 0; i < 4; i++) af[i] = *(const bf16x8*)(Bsb[B_] + (wn * 64 + i * 16 + lc) * LDB + g * 8); \
    _Pragma("unroll") for (int j = 0; j < 4; j++) bfr[j] = *(const bf16x8*)(Asb[B_] + (wm * 64 + j * 16 + lc) * LDB + g * 8); \
    _Pragma("unroll") for (int i = 0; i < 4; i++) \
      _Pragma("unroll") for (int j = 0; j < 4; j++) { \
        if (MODE == 1) acc[i][j] = __builtin_amdgcn_mfma_f32_16x16x32_f16(__builtin_bit_cast(f16x8, af[i]), __builtin_bit_cast(f16x8, bfr[j]), acc[i][j], 0, 0, 0); \
        else acc[i][j] = __builtin_amdgcn_mfma_f32_16x16x32_bf16(af[i], bfr[j], acc[i][j], 0, 0, 0); \
      } \
  } } while (0)
  __syncthreads();
  LOADH(0, 0, 0); LOADH(0, 0, 1); LOADH(1, 1, 0); LOADH(1, 1, 1);
  STOREH(0, 0, 0);
  LOADH(0, 2, 0);
  __syncthreads();
  for (int kt = 0; kt < KT; kt += 2) {
    STOREH(0, 1, 1); LOADH(0, kt + 2, 1);
    COMPUTE_SUB(0);
    if (!(MODE == 6 && PROBE == 5)) __syncthreads();
    if (kt + 1 < KT) { STOREH(1, 0, 0); LOADH(1, kt + 3, 0); }
    COMPUTE_SUB(1);
    __syncthreads();
    if (kt + 1 < KT) {
      STOREH(1, 1, 1); LOADH(1, kt + 3, 1);
      COMPUTE_SUB(0);
      if (!(MODE == 6 && PROBE == 5)) __syncthreads();
      if (kt + 2 < KT) { STOREH(0, 0, 0); LOADH(0, kt + 4, 0); }
      COMPUTE_SUB(1);
      __syncthreads();
    }
  }
  if (MODE == 1 && nt >= 8 && nt < 16) {
    const int hh = (nt & 7) * 2 + wn;
    float kkw[4][4];
#pragma unroll
    for (int i = 0; i < 4; i++) { const float4 kq = *(const float4*)(P.k_k + hh * 64 + i * 16 + 4 * g); kkw[i][0] = kq.x; kkw[i][1] = kq.y; kkw[i][2] = kq.z; kkw[i][3] = kq.w; }
#pragma unroll
    for (int j = 0; j < 4; j++) {
      float ssq = 0.f;
#pragma unroll
      for (int i = 0; i < 4; i++) {
        const unsigned u0 = pack2(acc[i][j][0], acc[i][j][1]), u1 = pack2(acc[i][j][2], acc[i][j][3]);
        const float q0 = __uint_as_float(u0 << 16) * kkw[i][0], q1 = __uint_as_float(u0 & 0xffff0000u) * kkw[i][1];
        const float q2 = __uint_as_float(u1 << 16) * kkw[i][2], q3 = __uint_as_float(u1 & 0xffff0000u) * kkw[i][3];
        ssq = fmaf(q0, q0, ssq); ssq = fmaf(q1, q1, ssq); ssq = fmaf(q2, q2, ssq); ssq = fmaf(q3, q3, ssq);
      }
      ssq += __shfl_xor(ssq, 16); ssq += __shfl_xor(ssq, 32);
      if (g == 0) P.INVN[(size_t)(m0 + wm * 64 + j * 16 + lc) * 16 + hh] = __builtin_amdgcn_rsqf(fmaxf(ssq, 1e-24f));
    }
  }
#pragma unroll
  for (int i = 0; i < 4; i++) {
    const int nl = wn * 64 + i * 16 + 4 * g;
#pragma unroll
    for (int j = 0; j < 4; j++) {
      const int m = m0 + wm * 64 + j * 16 + lc;
      const f32x4 v = acc[i][j];
      if (MODE == 1) {
        if (nt < 32) {
          const int p = nt >> 3, c = (nt & 7) * 128 + nl;
          bf16_t* dst = (p == 0) ? P.Rb : (p == 1) ? P.Kb : (p == 2) ? P.Vb : P.Gb;
          uint2 o; o.x = pack2(v[0], v[1]); o.y = pack2(v[2], v[3]);
          *(uint2*)(dst + (size_t)m * DM + c) = o;
        } else if (nl < 64) {
          uint2 o;
          if (nt == 32) { o.x = pack2(tanhf(v[0]), tanhf(v[1])); o.y = pack2(tanhf(v[2]), tanhf(v[3])); *(uint2*)(P.H1 + (size_t)m * 64 + nl) = o; }
          else { o.x = pack2(v[0], v[1]); o.y = pack2(v[2], v[3]); *(uint2*)(P.H2 + (size_t)m * 64 + nl) = o; }
        }
      } else if (MODE == 2) {
        const int c = (nt & 7) * 128 + nl;
        f16_t o[4];
        if (nt < 8) {
          const float4 w0v = *(const float4*)(P.w0 + c);
          const float ws[4] = {w0v.x, w0v.y, w0v.z, w0v.w};
#pragma unroll
          for (int r = 0; r < 4; r++) o[r] = (f16_t)(sigmoidf_(ws[r] + v[r]) * 0.60653065971f);
          *(uint2*)(((f16_t*)(P.out + OUT_Y)) + (size_t)m * DM + c) = *(uint2*)o;
        } else {
          const float4 a0v = *(const float4*)(P.a0 + c);
          const float as_[4] = {a0v.x, a0v.y, a0v.z, a0v.w};
#pragma unroll
          for (int r = 0; r < 4; r++) o[r] = (f16_t)sigmoidf_(as_[r] + v[r]);
          *(uint2*)(((f16_t*)(P.out + OUT_Y) + (size_t)NTOK * DM) + (size_t)m * DM + c) = *(uint2*)o;
        }
      } else if (MODE == 3 || MODE == 5) {
        const int c = n0 + nl;
        float4 res;
        if (MODE == 3) res = *(const float4*)(xin_row(P, m) + c);
        else res = *(const float4*)(P.out + OUT_Y + (size_t)m * DM + c);
        float4 o = make_float4(v[0] + ALPHA_F * res.x, v[1] + ALPHA_F * res.y, v[2] + ALPHA_F * res.z, v[3] + ALPHA_F * res.w);
        *(float4*)(P.out + OUT_Y + (size_t)m * DM + c) = o;
      } else if (MODE == 6) {
        uint2 o; o.x = pack2(v[0], v[1]); o.y = pack2(v[2], v[3]);
        *(uint2*)(P.XB + (size_t)(m & 4095) * DM + ((n0 + nl) & 1023)) = o;
      } else if (MODE == 4) {
        uint2 o; o.x = pack2(v[0], v[1]); o.y = pack2(v[2], v[3]);
        if (nt < 8) { *(uint2*)(P.Kb + (size_t)m * DM + n0 + nl) = o; }
        else if (nt >= 12) { *(uint2*)(P.Vb + (size_t)m * DM + (nt - 12) * 128 + nl) = o; }
        else {
          const bool isk = nt < 10;
          const int ck = (nt & 1) * 128 + nl;
          bf16_t* K1 = P.XB; bf16_t* V1 = P.XB + (size_t)NTOK * 256; bf16_t* VT1 = P.XB + (size_t)NTOK * 512;
          *(uint2*)((isk ? K1 : V1) + (size_t)m * 256 + ck) = o;
          const float4 fo = make_float4(v[0], v[1], v[2], v[3]);
          if (m < NPR) {
            const int b = m >> 13, tt = m & (TP - 1);
            if (!isk) {
              const int hk = ck >> 6, d = ck & 63;
              bf16_t* vt = VT1 + ((size_t)((b * 4 + hk) * 64 + d)) * TP + tt;
              vt[0] = f2bf(v[0]); vt[TP] = f2bf(v[1]); vt[2 * TP] = f2bf(v[2]); vt[3 * TP] = f2bf(v[3]);
            }
            if (tt >= TP - 128) *(float4*)(P.out + (isk ? OUT_WK_P : OUT_WV_P) + ((size_t)(b * 128 + tt - (TP - 128))) * 256 + ck) = fo;
          } else {
            const int ms = m - NPR, b = ms >> 3, tt = ms & 7;
            *(float4*)(P.out + (isk ? OUT_WK_S : OUT_WV_S) + ((size_t)(b * 128 + 120 + tt)) * 256 + ck) = fo;
          }
        }
      }
    }
  }
}
__device__ __forceinline__ void gemm1_part(const Params& P, unsigned char* smem, int part, int first, int stride) {
  const int nnt = part ? 16 : 18;
  for (int tile = first; tile < 136 * nnt; tile += stride) {
    const int mt = tile % 136, ntl = tile / 136;
    const int nt = part ? ((ntl < 8) ? ntl : (24 + ntl - 8)) : ((ntl < 16) ? (8 + ntl) : (32 + ntl - 16));
    gemm_tile<1>(P, smem, mt, nt);
  }
}
template <int MODE>
__device__ __forceinline__ void gemm_phase(const Params& P, unsigned char* smem, int bid, int nb) {
  constexpr int NT = (MODE == 1) ? 34 : (MODE == 2) ? 16 : (MODE == 4 || MODE == 6) ? 20 : 8;
  const int ntiles = 136 * NT;
  for (int tile = bid; tile < ntiles; tile += nb) gemm_tile<MODE>(P, smem, tile % 136, tile / 136);
}

#define TS 8
#define REC 392
typedef float f32x2 __attribute__((ext_vector_type(2)));
__device__ __forceinline__ f32x2 pkfma(f32x2 a, f32x2 b, f32x2 c) { return __builtin_elementwise_fma(a, b, c); }
#define DPP_ADD(x, ctrl) ((x) + __builtin_bit_cast(float, __builtin_amdgcn_update_dpp(0, __builtin_bit_cast(int, (x)), (ctrl), 0xF, 0xF, true)))
__device__ __forceinline__ float wave_sum_fast(float x) {
  x = DPP_ADD(x, 0xB1); x = DPP_ADD(x, 0x4E); x = DPP_ADD(x, 0x141); x = DPP_ADD(x, 0x140);
  const int xi = __builtin_bit_cast(int, x);
  const float t0 = __builtin_bit_cast(float, __builtin_amdgcn_readlane(xi, 0)), t1 = __builtin_bit_cast(float, __builtin_amdgcn_readlane(xi, 16));
  const float t2 = __builtin_bit_cast(float, __builtin_amdgcn_readlane(xi, 32)), t3 = __builtin_bit_cast(float, __builtin_amdgcn_readlane(xi, 48));
  return (t0 + t1) + (t2 + t3);
}
#define LD8(dst, ptr) do { _Pragma("unroll") for (int j4_ = 0; j4_ < 4; j4_++) { const f32x4 v_ = *(const f32x4*)((ptr) + 4 * j4_); \
    dst[2 * j4_] = (f32x2){v_[0], v_[1]}; dst[2 * j4_ + 1] = (f32x2){v_[2], v_[3]}; } } while (0)

template <int INIT  , bool USEV, bool WRITEY>
__device__ __forceinline__ void scan_unit(const Params& P, float* ws, int lane, int tok0, int nsteps, int h, const float* init_ptr, float* fin) {
  const int rq = lane >> 2, q = lane & 3;
  f32x2 s[4][8];
#pragma unroll
  for (int i = 0; i < 4; i++)
#pragma unroll
    for (int j = 0; j < 8; j++) {
      if (INIT == 1) s[i][j] = (f32x2){((rq + 16 * i) == (16 * q + 2 * j)) ? 1.f : 0.f, ((rq + 16 * i) == (16 * q + 2 * j + 1)) ? 1.f : 0.f};
      else s[i][j] = (f32x2){0.f, 0.f};
    }
  if (INIT == 2) {
#pragma unroll
    for (int i = 0; i < 4; i++) LD8(s[i], init_ptr + (size_t)(rq + 16 * i) * 64 + 16 * q);
  }
  const int c = h * 64 + lane;
  const float kkc = P.k_k[c], kac = P.k_a[c], rkc = P.r_k[c];
  const int crow = h * 64 + rq + 16 * q;
  const float gng = P.gn_g[crow], gnb = P.gn_b[crow];
  const f16_t* EW = ((const f16_t*)(P.out + OUT_Y));
  const f16_t* AA = ((const f16_t*)(P.out + OUT_Y) + (size_t)NTOK * DM);

  bf16_t rk[TS], rv[TS], rr[TS]; f16_t ra_[TS], re_[TS]; float rn_[TS];
#define LOAD_RAW(tb) do { const size_t ub_ = (size_t)(tok0 + (tb)) * DM; \
    const bf16_t* kb_ = P.Kb + ub_; const f16_t* ab_ = AA + ub_; const f16_t* eb_ = EW + ub_; const bf16_t* vb_ = P.Vb + ub_; const bf16_t* rb_ = P.Rb + ub_; \
    _Pragma("unroll") for (int tt_ = 0; tt_ < TS; tt_++) { const unsigned off_ = (unsigned)(tt_ * DM + c); \
    rn_[tt_] = P.INVN[(size_t)(tok0 + (tb) + tt_) * 16 + h]; rk[tt_] = kb_[off_]; ra_[tt_] = ab_[off_]; re_[tt_] = eb_[off_]; if (USEV) rv[tt_] = vb_[off_]; if (WRITEY) rr[tt_] = rb_[off_]; } } while (0)
  LOAD_RAW(0);
  for (int t0 = 0; t0 < nsteps; t0 += TS) {
    {
      float gcum = 1.f;
#pragma unroll
      for (int tt = 0; tt < TS; tt++) {
        const float kraw = bf2f(rk[tt]);
        const float a = (float)ra_[tt];
        const float wd = __expf(-(float)re_[tt]);
        const float kkv = kraw * kkc * rn_[tt];
        const float kf = kraw * (1.f + (a - 1.f) * kac);
        float* rec = ws + tt * REC;
        rec[lane] = kkv * gcum;
        gcum *= wd;
        const float ginv = __builtin_amdgcn_rcpf(gcum);
        rec[128 + lane] = kf * ginv; rec[192 + lane] = kkv * a * ginv;
        if (WRITEY) {
          const float r = bf2f(rr[tt]);
          rec[256 + lane] = r * gcum;
          const float bonus = wave_sum_fast(r * kf * rkc);
          if (lane == 0) rec[384] = bonus;
        }
        if (USEV) rec[320 + lane] = bf2f(rv[tt]);
      }
      ws[TS * REC + lane] = gcum;
    }
    __builtin_amdgcn_wave_barrier();
    asm volatile("s_waitcnt lgkmcnt(0)" ::: "memory");
    if (t0 + TS < nsteps) LOAD_RAW(t0 + TS);
#pragma unroll 1
    for (int tt = 0; tt < TS; tt++) {
      const float* rec = ws + tt * REC;
      f32x2 o2[8], b2[8], kf2[8];
      LD8(o2, rec + 16 * q);
      LD8(b2, rec + 192 + 16 * q);
      if (USEV) LD8(kf2, rec + 128 + 16 * q);
      f32x2 nsa2[4];
      {
        f32x2 acc[4];
#pragma unroll
        for (int i = 0; i < 4; i++) acc[i] = s[i][0] * o2[0];
#pragma unroll
        for (int j = 1; j < 8; j++)
#pragma unroll
          for (int i = 0; i < 4; i++) acc[i] = pkfma(s[i][j], o2[j], acc[i]);
#pragma unroll
        for (int i = 0; i < 4; i++) { const float t = -quad_sum(acc[i][0] + acc[i][1]); nsa2[i] = (f32x2){t, t}; }
      }
      float vv[4];
      if (USEV) {
#pragma unroll
        for (int i = 0; i < 4; i++) vv[i] = rec[320 + rq + 16 * i];
      }
      if (WRITEY) LD8(o2, rec + 256 + 16 * q);
#pragma unroll
      for (int i = 0; i < 4; i++) {
#pragma unroll
        for (int j = 0; j < 8; j++) s[i][j] = pkfma(nsa2[i], b2[j], s[i][j]);
        if (USEV) {
          const f32x2 vv2 = (f32x2){vv[i], vv[i]};
#pragma unroll
          for (int j = 0; j < 8; j++) s[i][j] = pkfma(vv2, kf2[j], s[i][j]);
        }
      }
      if (WRITEY) {
        float y[4];
        {
          f32x2 acc[4];
#pragma unroll
          for (int i = 0; i < 4; i++) acc[i] = s[i][0] * o2[0];
#pragma unroll
          for (int j = 1; j < 8; j++)
#pragma unroll
            for (int i = 0; i < 4; i++) acc[i] = pkfma(s[i][j], o2[j], acc[i]);
#pragma unroll
          for (int i = 0; i < 4; i++) y[i] = quad_sum(acc[i][0] + acc[i][1]);
        }
        const float ysel = (q == 0) ? y[0] : (q == 1) ? y[1] : (q == 2) ? y[2] : y[3];
        const float vsel = (q == 0) ? vv[0] : (q == 1) ? vv[1] : (q == 2) ? vv[2] : vv[3];
        const float mean = wave_sum_fast(ysel) * (1.f / 64.f);
        const float ex2 = wave_sum_fast(ysel * ysel) * (1.f / 64.f);
        const float var = fmaxf(ex2 - mean * mean, 0.f);
        float yo = (ysel - mean) * rsqrtf(var + 64e-5f) * gng + gnb + rec[384] * vsel;
        const size_t off = (size_t)(tok0 + t0 + tt) * DM + crow;
        const float gt = bf2f(P.Gb[off]);
        yo *= gt * sigmoidf_(gt);
        P.Gb[off] = f2bf(yo);
      }
    }
    {
      f32x2 ge[8];
      LD8(ge, ws + TS * REC + 16 * q);
#pragma unroll
      for (int i = 0; i < 4; i++)
#pragma unroll
        for (int j = 0; j < 8; j++) s[i][j] *= ge[j];
    }
    __builtin_amdgcn_wave_barrier();
    asm volatile("s_waitcnt lgkmcnt(0)" ::: "memory");
  }
  if (fin) {
#pragma unroll
    for (int i = 0; i < 4; i++)
#pragma unroll
      for (int j4 = 0; j4 < 4; j4++)
        *(f32x4*)(fin + (size_t)(rq + 16 * i) * 64 + 16 * q + 4 * j4) = (f32x4){s[i][2 * j4][0], s[i][2 * j4][1], s[i][2 * j4 + 1][0], s[i][2 * j4 + 1][1]};
  }
}

__device__ __forceinline__ void phase_scan1(const Params& P, unsigned char* smem, int bid, int nb) {
  const int lane = threadIdx.x & 63, w = __builtin_amdgcn_readfirstlane((int)(threadIdx.x >> 6));
  float* ws = (float*)smem + w * (TS * REC + 64);
  float* Ploc = P.out + OUT_WK_S;
  float* Sloc = P.out + OUT_WV_S;
  const int hb = nb >> 1;
  if (bid >= hb) { gemm1_part(P, smem, 1, bid - hb, nb - hb); return; }
  for (int u = w * hb + bid; u < NBH * (NC - 1) * 2; u += 4 * hb) {
    const int kind = (u ^ (u / (4 * hb))) & 1, rest = u >> 1;
    const int c = rest % (NC - 1), bh = rest / (NC - 1);
    const int tok0 = (bh >> 4) * TP + c * CL, h = bh & 15;
    float* fin = (kind ? Ploc : Sloc) + (size_t)(bh * (NC - 1) + c) * 4096;
    if (kind) scan_unit<1, false, false>(P, ws, lane, tok0, CL, h, nullptr, fin);
    else scan_unit<0, true, false>(P, ws, lane, tok0, CL, h, nullptr, fin);
  }
}
__device__ __forceinline__ void phase_scan2(const Params& P, unsigned char* smem, int bid, int nb) {
  const int lane = threadIdx.x & 63, w = __builtin_amdgcn_readfirstlane((int)(threadIdx.x >> 6));
  float* ws = (float*)smem + w * 256;
  float* Ploc = P.out + OUT_WK_S;
  float* Sloc = P.out + OUT_WV_S;
  for (int item = bid; item < NBH * 4; item += nb) {
    const int bh = item >> 2, row0 = (item & 3) * 16 + w * 4;
    float s[4];
    {
      const float* S0 = Sloc + (size_t)(bh * (NC - 1)) * 4096;
#pragma unroll
      for (int r = 0; r < 4; r++) s[r] = S0[(row0 + r) * 64 + lane];
    }
    for (int c = 1; c < NC - 1; c++) {
      const float* Pc = Ploc + (size_t)(bh * (NC - 1) + c) * 4096;
      float* Sc = Sloc + (size_t)(bh * (NC - 1) + c) * 4096;
      float acc[4];
#pragma unroll
      for (int r = 0; r < 4; r++) { acc[r] = Sc[(row0 + r) * 64 + lane]; ws[r * 64 + lane] = s[r]; }
      __builtin_amdgcn_wave_barrier();
      asm volatile("s_waitcnt lgkmcnt(0)" ::: "memory");
#pragma unroll 1
      for (int hf = 0; hf < 2; hf++) {
        float p[32];
#pragma unroll
        for (int i = 0; i < 32; i++) p[i] = Pc[(hf * 32 + i) * 64 + lane];
#pragma unroll
        for (int r = 0; r < 4; r++) {
#pragma unroll
          for (int i4 = 0; i4 < 8; i4++) {
            const float4 sv = *(const float4*)(ws + r * 64 + hf * 32 + 4 * i4);
            acc[r] = fmaf(sv.x, p[4 * i4], acc[r]); acc[r] = fmaf(sv.y, p[4 * i4 + 1], acc[r]);
            acc[r] = fmaf(sv.z, p[4 * i4 + 2], acc[r]); acc[r] = fmaf(sv.w, p[4 * i4 + 3], acc[r]);
          }
        }
      }
      __builtin_amdgcn_wave_barrier();
      asm volatile("s_waitcnt lgkmcnt(0)" ::: "memory");
#pragma unroll
      for (int r = 0; r < 4; r++) { s[r] = acc[r]; Sc[(row0 + r) * 64 + lane] = acc[r]; }
    }
  }
}
__device__ __forceinline__ void phase_scan3(const Params& P, unsigned char* smem, int bid, int nb) {
  const int lane = threadIdx.x & 63, w = __builtin_amdgcn_readfirstlane((int)(threadIdx.x >> 6));
  float* ws = (float*)smem + w * (TS * REC + 64);
  float* Sloc = P.out + OUT_WV_S;
  const int hb = nb >> 1;
  if (bid < hb) {
    for (int u = w * hb + bid; u < NBH * NC; u += 4 * hb) {
      const int bh = u >> 5, c = u & 31;
      const int tok0 = (bh >> 4) * TP + c * CL, h = bh & 15;
      const float* ip = (c > 0) ? (Sloc + (size_t)(bh * (NC - 1) + c - 1) * 4096) : nullptr;
      float* fin = (c == NC - 1) ? (P.out + OUT_WKV_P + (size_t)bh * 4096) : nullptr;
      if (c > 0) scan_unit<2, true, true>(P, ws, lane, tok0, CL, h, ip, fin);
      else scan_unit<0, true, true>(P, ws, lane, tok0, CL, h, ip, fin);
    }
  } else {
    for (int sb = w * (nb - hb) + (bid - hb); sb < 2048; sb += 4 * (nb - hb))
      scan_unit<2, true, true>(P, ws, lane, NPR + (sb >> 4) * 8, 8, sb & 15, P.state_wkv + (size_t)sb * 4096, P.out + OUT_WKV_S + (size_t)sb * 4096);
    __syncthreads();
    late_weight_prep(P, smem, bid - hb, nb - hb);
  }
}

__device__ __forceinline__ void phase_ln(const Params& P, int layer, int bid, int nb) {
  const int lane = threadIdx.x & 63, w = __builtin_amdgcn_readfirstlane((int)(threadIdx.x >> 6));
  const float* gg = P.ln_g + layer * DM; const float* bb = P.ln_b + layer * DM;
  for (int tok = bid * 4 + w; tok < NTOK; tok += nb * 4) {
    f32x4* row = (f32x4*)(P.out + OUT_Y + (size_t)tok * DM);
    f32x4 v[4];
    float sum = 0.f;
#pragma unroll
    for (int i = 0; i < 4; i++) { v[i] = row[lane + 64 * i]; sum += v[i][0] + v[i][1] + v[i][2] + v[i][3]; }
    const float mean = wave_sum(sum) * (1.f / 1024.f);
    float sq = 0.f;
#pragma unroll
    for (int i = 0; i < 4; i++) { v[i] -= mean; sq += v[i][0] * v[i][0] + v[i][1] * v[i][1] + v[i][2] * v[i][2] + v[i][3] * v[i][3]; }
    const float rs = rsqrtf(wave_sum(sq) * (1.f / 1024.f) + 1e-5f);
#pragma unroll
    for (int i = 0; i < 4; i++) {
      const f32x4 g4 = ((const f32x4*)gg)[lane + 64 * i], b4 = ((const f32x4*)bb)[lane + 64 * i];
      const f32x4 o = v[i] * rs * g4 + b4;
      row[lane + 64 * i] = o;
      if (layer == 0) { uint2 ob; ob.x = pack2(o[0], o[1]); ob.y = pack2(o[2], o[3]); ((uint2*)(P.Rb + (size_t)tok * DM))[lane + 64 * i] = ob; }
    }
  }
}

__device__ __forceinline__ void attn_prompt_item(const Params& P, unsigned char* smem, int item) {
  const int qh = item & 1, hk = (item >> 1) & 3, n = (item >> 3) & 63, b = item >> 9;
  bf16_t* Ks = (bf16_t*)smem;
  bf16_t* Vs = Ks + 192 * 72;
  const bf16_t* K1 = P.XB; const bf16_t* VT1 = P.XB + (size_t)NTOK * 512;
  const bf16_t* Q1 = P.Kb; const bf16_t* G1 = P.Vb; bf16_t* AO = P.Gb;
  const int t = threadIdx.x, lane = t & 63, w = t >> 6;
  const int g = lane >> 4, lc = lane & 15;
  const int pos0 = (n - 1) * 128 + 64 * qh;
  __syncthreads();
#pragma unroll
  for (int i = 0; i < 6; i++) {
    const int idx = t + 256 * i; const int row = idx >> 3, ch = idx & 7; const int pos = pos0 + row;
    uint4 v = make_uint4(0, 0, 0, 0);
    if (pos >= 0) v = *(const uint4*)(K1 + ((size_t)(b * TP + pos)) * 256 + hk * 64 + ch * 8);
    *(uint4*)(Ks + row * 72 + ch * 8) = v;
  }
#pragma unroll
  for (int i = 0; i < 6; i++) {
    const int idx = t + 256 * i; const int d = idx / 24, ch = idx % 24; const int pos = pos0 + ch * 8;
    uint4 v = make_uint4(0, 0, 0, 0);
    if (pos >= 0) v = *(const uint4*)(VT1 + ((size_t)((b * 4 + hk) * 64 + d)) * TP + pos);
    *(uint4*)(Vs + d * 200 + ch * 8) = v;
  }
  __syncthreads();
  const int h = hk * 4 + w;
  const float slope = exp2f(-0.5f * (float)(h + 1));
  const float sink = P.att_sinks[h];
  for (int sb = 0; sb < 2; sb++) {
    const int i0 = 64 * qh + 32 * sb;
    const int tokb = b * TP + n * 128 + i0;
    bf16x8 qf[2][2];
#pragma unroll
    for (int nn = 0; nn < 2; nn++)
#pragma unroll
      for (int ks = 0; ks < 2; ks++) qf[nn][ks] = *(const bf16x8*)(Q1 + (size_t)(tokb + 16 * nn + lc) * DM + h * 64 + ks * 32 + g * 8);
    float mrun[2] = {sink, sink}, lrun[2] = {1.f, 1.f};
    f32x4 O[4][2];
#pragma unroll
    for (int dm = 0; dm < 4; dm++) { O[dm][0] = (f32x4){0.f, 0.f, 0.f, 0.f}; O[dm][1] = (f32x4){0.f, 0.f, 0.f, 0.f}; }
    for (int kt = 0; kt < 3; kt++) {
      if (n == 0 && (qh + kt) < 2) continue;
      f32x4 S[4][2];
#pragma unroll
      for (int mm = 0; mm < 4; mm++) { S[mm][0] = (f32x4){0.f, 0.f, 0.f, 0.f}; S[mm][1] = (f32x4){0.f, 0.f, 0.f, 0.f}; }
#pragma unroll
      for (int ks = 0; ks < 2; ks++)
#pragma unroll
        for (int mm = 0; mm < 4; mm++) {
          const bf16x8 kf = *(const bf16x8*)(Ks + (kt * 64 + mm * 16 + lc) * 72 + ks * 32 + g * 8);
          S[mm][0] = __builtin_amdgcn_mfma_f32_16x16x32_bf16(kf, qf[0][ks], S[mm][0], 0, 0, 0);
          S[mm][1] = __builtin_amdgcn_mfma_f32_16x16x32_bf16(kf, qf[1][ks], S[mm][1], 0, 0, 0);
        }
#pragma unroll
      for (int nn = 0; nn < 2; nn++) {
        const int qi = i0 + 16 * nn + lc;
        float mx = mrun[nn];
#pragma unroll
        for (int mm = 0; mm < 4; mm++)
#pragma unroll
          for (int r = 0; r < 4; r++) {
            const int j = 64 * (qh + kt) + 16 * mm + 4 * g + r;
            const int dist = 128 + qi - j;
            const bool live = (dist >= 0) && (dist < 128);
            const float sv = live ? (S[mm][nn][r] * 0.125f - slope * (float)dist) : -1e30f;
            S[mm][nn][r] = sv; mx = fmaxf(mx, sv);
          }
        mx = fmaxf(mx, __shfl_xor(mx, 16)); mx = fmaxf(mx, __shfl_xor(mx, 32));
        const float corr = __expf(mrun[nn] - mx); mrun[nn] = mx;
        float sum = 0.f;
#pragma unroll
        for (int mm = 0; mm < 4; mm++)
#pragma unroll
          for (int r = 0; r < 4; r++) { const float pp = __expf(S[mm][nn][r] - mx); S[mm][nn][r] = pp; sum += pp; }
        sum += __shfl_xor(sum, 16); sum += __shfl_xor(sum, 32);
        lrun[nn] = lrun[nn] * corr + sum;
#pragma unroll
        for (int dm = 0; dm < 4; dm++) { O[dm][nn][0] *= corr; O[dm][nn][1] *= corr; O[dm][nn][2] *= corr; O[dm][nn][3] *= corr; }
      }
#pragma unroll
      for (int k2 = 0; k2 < 2; k2++) {
        bf16x8 pf[2];
#pragma unroll
        for (int nn = 0; nn < 2; nn++) {
          const unsigned u0 = pack2(S[2 * k2][nn][0], S[2 * k2][nn][1]), u1 = pack2(S[2 * k2][nn][2], S[2 * k2][nn][3]);
          const unsigned u2 = pack2(S[2 * k2 + 1][nn][0], S[2 * k2 + 1][nn][1]), u3 = pack2(S[2 * k2 + 1][nn][2], S[2 * k2 + 1][nn][3]);
          const uint4 uu = make_uint4(u0, u1, u2, u3);
          pf[nn] = *(const bf16x8*)&uu;
        }
#pragma unroll
        for (int dm = 0; dm < 4; dm++) {
          const bf16_t* vb = Vs + (dm * 16 + lc) * 200 + kt * 64 + k2 * 32 + 4 * g;
          const uint2 lo = *(const uint2*)vb, hi = *(const uint2*)(vb + 16);
          const uint4 uu = make_uint4(lo.x, lo.y, hi.x, hi.y);
          const bf16x8 vf = *(const bf16x8*)&uu;
          O[dm][0] = __builtin_amdgcn_mfma_f32_16x16x32_bf16(vf, pf[0], O[dm][0], 0, 0, 0);
          O[dm][1] = __builtin_amdgcn_mfma_f32_16x16x32_bf16(vf, pf[1], O[dm][1], 0, 0, 0);
        }
      }
    }
#pragma unroll
    for (int nn = 0; nn < 2; nn++) {
      const float inv = 1.f / lrun[nn];
      const size_t tok = (size_t)(tokb + 16 * nn + lc);
#pragma unroll
      for (int dm = 0; dm < 4; dm++) {
        const int d = dm * 16 + 4 * g;
        const uint2 gv = *(const uint2*)(G1 + tok * DM + h * 64 + d);
        const float g0 = __uint_as_float(gv.x << 16), g1 = __uint_as_float(gv.x & 0xffff0000u);
        const float g2 = __uint_as_float(gv.y << 16), g3 = __uint_as_float(gv.y & 0xffff0000u);
        uint2 o;
        o.x = pack2(O[dm][nn][0] * inv * g0 * sigmoidf_(g0), O[dm][nn][1] * inv * g1 * sigmoidf_(g1));
        o.y = pack2(O[dm][nn][2] * inv * g2 * sigmoidf_(g2), O[dm][nn][3] * inv * g3 * sigmoidf_(g3));
        *(uint2*)(AO + tok * DM + h * 64 + d) = o;
      }
    }
  }
}

__device__ __forceinline__ void attn_sample_item(const Params& P, unsigned char* smem, int item) {
  const int b = item >> 2, hk = item & 3;
  const int t = threadIdx.x, lane = t & 63, w = t >> 6;
  float* kv = (float*)smem;
  float* qs = kv + 136 * 65 + w * 512;
  float* ps = kv + 136 * 65 + 2048 + w * (8 * 136);
  const bf16_t* K1 = P.XB; const bf16_t* V1 = P.XB + (size_t)NTOK * 256;
  const bf16_t* Q1 = P.Kb; const bf16_t* G1 = P.Vb; bf16_t* AO = P.Gb;
  const int h = hk * 4 + w;
  const float slope = exp2f(-0.5f * (float)(h + 1));
  const float sink = P.att_sinks[h];
  const int tok0 = NPR + b * 8;
  __syncthreads();
#pragma unroll 2
  for (int it = 0; it < 8; it++) {
    const int idx = t + 256 * it; const int row = idx >> 4, c4 = idx & 15;
    const size_t so = ((size_t)(b * 128 + row)) * 256 + hk * 64 + c4 * 4;
    const float4 kx = *(const float4*)(P.cache_k + so);
    const float4 vx = *(const float4*)(P.cache_v + so);
    float* kd = kv + row * 65 + c4 * 4;
    kd[0] = kx.x; kd[1] = kx.y; kd[2] = kx.z; kd[3] = kx.w;
    if (row >= 8) {
      const size_t dofs = ((size_t)(b * 128 + row - 8)) * 256 + hk * 64 + c4 * 4;
      *(float4*)(P.out + OUT_WK_S + dofs) = kx;
      *(float4*)(P.out + OUT_WV_S + dofs) = vx;
    }
  }
#pragma unroll
  for (int it = 0; it < 2; it++) {
    const int idx = t + 256 * it; const int r8 = idx >> 6, d = idx & 63;
    kv[(128 + r8) * 65 + d] = bf2f(K1[(size_t)(tok0 + r8) * 256 + hk * 64 + d]);
  }
#pragma unroll
  for (int i = 0; i < 8; i++) qs[i * 64 + lane] = bf2f(Q1[(size_t)(tok0 + i) * DM + h * 64 + lane]);
  __syncthreads();
  float sc[3][8];
#pragma unroll
  for (int ksel = 0; ksel < 3; ksel++) {
    float acc[8];
#pragma unroll
    for (int i = 0; i < 8; i++) acc[i] = 0.f;
    const float* kr = kv + ((ksel < 2) ? (lane + 64 * ksel) : (128 + (lane & 7))) * 65;
#pragma unroll 2
    for (int d4 = 0; d4 < 16; d4++) {
      const float k0 = kr[4 * d4], k1 = kr[4 * d4 + 1], k2 = kr[4 * d4 + 2], k3 = kr[4 * d4 + 3];
#pragma unroll
      for (int i = 0; i < 8; i++) {
        const float4 qv = *(const float4*)(qs + i * 64 + 4 * d4);
        acc[i] = fmaf(qv.x, k0, acc[i]); acc[i] = fmaf(qv.y, k1, acc[i]); acc[i] = fmaf(qv.z, k2, acc[i]); acc[i] = fmaf(qv.w, k3, acc[i]);
      }
    }
#pragma unroll
    for (int i = 0; i < 8; i++) {
      int dist; bool live;
      if (ksel < 2) { const int j = lane + 64 * ksel; dist = 128 + i - j; live = (j > i); }
      else { dist = i - lane; live = (lane <= i); }
      sc[ksel][i] = live ? (acc[i] * 0.125f - slope * (float)dist) : -1e30f;
    }
  }
#pragma unroll
  for (int i = 0; i < 8; i++) {
    float mx = fmaxf(fmaxf(sc[0][i], sc[1][i]), sc[2][i]);
    mx = fmaxf(wave_max(mx), sink);
    const float p0 = __expf(sc[0][i] - mx), p1 = __expf(sc[1][i] - mx), p2 = __expf(sc[2][i] - mx);
    const float den = wave_sum(p0 + p1 + p2) + __expf(sink - mx);
    const float inv = 1.f / den;
    ps[i * 136 + lane] = p0 * inv; ps[i * 136 + 64 + lane] = p1 * inv;
    if (lane < 8) ps[i * 136 + 128 + lane] = p2 * inv;
  }
  __syncthreads();
#pragma unroll 4
  for (int it = 0; it < 8; it++) {
    const int idx = t + 256 * it; const int row = idx >> 4, c4 = idx & 15;
    *(float4*)(kv + row * 64 + c4 * 4) = *(const float4*)(P.cache_v + ((size_t)(b * 128 + row)) * 256 + hk * 64 + c4 * 4);
  }
#pragma unroll
  for (int it = 0; it < 2; it++) {
    const int idx = t + 256 * it; const int r8 = idx >> 6, d = idx & 63;
    kv[(128 + r8) * 64 + d] = bf2f(V1[(size_t)(tok0 + r8) * 256 + hk * 64 + d]);
  }
  __syncthreads();
  float o[8];
#pragma unroll
  for (int i = 0; i < 8; i++) o[i] = 0.f;
#pragma unroll 2
  for (int j0 = 0; j0 < 136; j0 += 4) {
    const float v0 = kv[(j0) * 64 + lane], v1 = kv[(j0 + 1) * 64 + lane], v2 = kv[(j0 + 2) * 64 + lane], v3 = kv[(j0 + 3) * 64 + lane];
#pragma unroll
    for (int i = 0; i < 8; i++) {
      const float4 pa = *(const float4*)(ps + i * 136 + j0);
      o[i] = fmaf(pa.x, v0, o[i]); o[i] = fmaf(pa.y, v1, o[i]); o[i] = fmaf(pa.z, v2, o[i]); o[i] = fmaf(pa.w, v3, o[i]);
    }
  }
#pragma unroll
  for (int i = 0; i < 8; i++) {
    const size_t off = (size_t)(tok0 + i) * DM + h * 64 + lane;
    const float gt = bf2f(G1[off]);
    AO[off] = f2bf(o[i] * gt * sigmoidf_(gt));
  }
}
__device__ __forceinline__ void phase_attn(const Params& P, unsigned char* smem, int bid, int nb) {
#if PROBE == 7
  for (int item = bid; item < 1024; item += nb) attn_prompt_item(P, smem, item);
#elif PROBE == 8
  for (int item = bid; item < 512; item += nb) attn_sample_item(P, smem, item);
#endif
  for (int item = bid; item < 1024 + 512; item += nb) {
    if (item < 1024) attn_prompt_item(P, smem, item);
    else attn_sample_item(P, smem, item - 1024);
  }
}

#if MULTI_LAUNCH
#define PH_BARRIER(ph)
#else
#define PH_BARRIER(ph) do { if ((ph) + 1 < P.phase_end) xcd_barrier(xb); } while (0)
#endif
#define RUN_PH(ph, call) do { if (P.phase_begin <= (ph) && (ph) < P.phase_end) { if ((REPMASK >> (ph)) & 1) { call; PH_BARRIER(ph); } call; PH_BARRIER(ph); } } while (0)

__global__ void __launch_bounds__(256, 2) fwd_kernel(Params P) {
  __shared__ __attribute__((aligned(16))) unsigned char smem[SMEM_BYTES];
  const int bid = blockIdx.x, nb = gridDim.x;
#if !MULTI_LAUNCH
  __shared__ uint4 xb_words;
  if (threadIdx.x == 0) xb_words = make_uint4(0u, 0u, 0u, 0u);
  __syncthreads();
  XcdBarrier xb = xcd_barrier_post(P.bar, (volatile LAS unsigned*)&xb_words);
#endif
#if (PHMASK >> 0) & 1
  RUN_PH(0, phase_prep(P, smem, bid, nb));
#endif
#if (PHMASK >> 1) & 1
  RUN_PH(1, gemm1_part(P, smem, 0, bid, nb));
#endif
#if (PHMASK >> 2) & 1
  RUN_PH(2, gemm_phase<2>(P, smem, bid, nb));
#endif
#if (PHMASK >> 3) & 1
  RUN_PH(3, phase_scan1(P, smem, bid, nb));
#endif
#if (PHMASK >> 4) & 1
  RUN_PH(4, phase_scan2(P, smem, bid, nb));
#endif
#if (PHMASK >> 5) & 1
  RUN_PH(5, phase_scan3(P, smem, bid, nb));
#endif
#if (PHMASK >> 6) & 1
  RUN_PH(6, gemm_phase<3>(P, smem, bid, nb));
#endif
#if (PHMASK >> 7) & 1
  RUN_PH(7, phase_ln(P, 0, bid, nb));
#endif
#if (PHMASK >> 8) & 1
  RUN_PH(8, gemm_phase<4>(P, smem, bid, nb));
#endif
#if (PHMASK >> 9) & 1
  RUN_PH(9, phase_attn(P, smem, bid, nb));
#endif
#if (PHMASK >> 10) & 1
  RUN_PH(10, gemm_phase<5>(P, smem, bid, nb));
#endif
#if (PHMASK >> 11) & 1
  RUN_PH(11, phase_ln(P, 1, bid, nb));
#endif
#if PROBE && PROBE < 7
  xcd_barrier(xb);
  gemm_phase<6>(P, smem, bid, nb);
#endif
#if !MULTI_LAUNCH
  if (P.phase_end > NPHASE) cg::this_grid().sync();
#endif
}

extern "C" void kernel_launch(void* const* d_in, const int* in_sizes, int n_in, void* d_out, int out_size, void* d_ws, size_t ws_size, hipStream_t stream) {
  Params P{};
  P.x_prompt = (const float*)d_in[0]; P.x_sample = (const float*)d_in[1]; P.state_wkv = (const float*)d_in[2]; P.state_shift = (const float*)d_in[3];
  P.cache_k = (const float*)d_in[4]; P.cache_v = (const float*)d_in[5]; P.ln_g = (const float*)d_in[6]; P.ln_b = (const float*)d_in[7];
  P.mu = (const float*)d_in[8]; P.w_in = (const float*)d_in[9]; P.w0 = (const float*)d_in[10]; P.w1 = (const float*)d_in[11]; P.w2 = (const float*)d_in[12];
  P.a0 = (const float*)d_in[13]; P.a1 = (const float*)d_in[14]; P.a2 = (const float*)d_in[15]; P.k_k = (const float*)d_in[16]; P.k_a = (const float*)d_in[17];
  P.r_k = (const float*)d_in[18]; P.gn_g = (const float*)d_in[19]; P.gn_b = (const float*)d_in[20]; P.w_out = (const float*)d_in[21];
  P.att_w_in = (const float*)d_in[22]; P.att_sinks = (const float*)d_in[23]; P.att_w_out = (const float*)d_in[24];
  P.out = (float*)d_out;
  unsigned char* ws = (unsigned char*)d_ws;
  size_t off = 0;
  auto take = [&](size_t bytes) { unsigned char* p = ws + off; off += (bytes + 255) & ~(size_t)255; return p; };
  P.bar = (unsigned*)take(16384);
  P.WtIn0 = (bf16_t*)take((size_t)4352 * DM * 2);
  P.W2t = (bf16_t*)take((size_t)DM * 64 * 2);
  P.A2t = (bf16_t*)take((size_t)DM * 64 * 2);
  P.WtOut0 = (bf16_t*)take((size_t)DM * DM * 2);
  P.WtIn1 = (bf16_t*)take((size_t)2560 * DM * 2);
  P.WtOut1 = (bf16_t*)take((size_t)DM * DM * 2);
  P.XB = (bf16_t*)take((size_t)NTOK * DM * 2);
  P.XXB = (bf16_t*)take((size_t)NTOK * DM * 2);
  P.Rb = (bf16_t*)take((size_t)NTOK * DM * 2);
  P.Kb = (bf16_t*)take((size_t)NTOK * DM * 2);
  P.Vb = (bf16_t*)take((size_t)NTOK * DM * 2);
  P.Gb = (bf16_t*)take((size_t)NTOK * DM * 2);
  P.H1 = (bf16_t*)take((size_t)NTOK * 64 * 2);
  P.H2 = (bf16_t*)take((size_t)NTOK * 64 * 2);
  P.MU16 = (bf16_t*)take((size_t)6 * DM * 2);
  P.INVN = (float*)take((size_t)NTOK * 16 * 4);
  if (off > ws_size) { fprintf(stderr, "workspace too small: need %zu have %zu\n", off, ws_size); return; }
#if MULTI_LAUNCH
  for (int ph = 0; ph < NPHASE; ph++) {
    P.phase_begin = ph; P.phase_end = ph + 1;
    hipLaunchKernelGGL(fwd_kernel, dim3(512), dim3(256), 0, stream, P);
  }
#else
  static int grid_blocks = 0;
  if (!grid_blocks) {
    int dev = 0, cus = 0, per_cu = 0;
    hipGetDevice(&dev);
    hipDeviceGetAttribute(&cus, hipDeviceAttributeMultiprocessorCount, dev);
    hipOccupancyMaxActiveBlocksPerMultiprocessor(&per_cu, fwd_kernel, 256, 0);
    if (per_cu > 2) per_cu = 2;
    if (per_cu < 1) per_cu = 1;
    grid_blocks = cus * per_cu;
  }
  hipMemsetAsync(P.bar, 0, 16384, stream);
  P.phase_begin = 0; P.phase_end = NPHASE;
  void* args[] = {&P};
  hipError_t e = hipLaunchCooperativeKernel((void*)fwd_kernel, dim3(grid_blocks), dim3(256), args, 0, stream);
  if (e != hipSuccess) fprintf(stderr, "cooperative launch failed: %s (grid %d)\n", hipGetErrorString(e), grid_blocks);
#endif
}
```

```cpp
#include <hip/hip_runtime.h>
#include <hip/hip_cooperative_groups.h>
#include <stdint.h>
#include <cstdio>
namespace cg = cooperative_groups;

#ifndef PHMASK
#define PHMASK 0xFFF
#endif
#ifndef PROBE
#define PROBE 0
#endif
#ifndef REPMASK
#define REPMASK 0
#endif
#ifndef MULTI_LAUNCH
#define MULTI_LAUNCH 0
#endif

typedef unsigned short bf16_t;
typedef _Float16 f16_t;
typedef __attribute__((ext_vector_type(8))) short bf16x8;
typedef __attribute__((ext_vector_type(4))) float f32x4;
typedef __attribute__((ext_vector_type(4))) unsigned u32x4;

#define DM 1024
#define NTOK 17408
#define NPR 16384
#define TP 8192
#define NC 32
#define CL 256
#define NBH 32
#define ALPHA_F 1.41421356237f
#define SMEM_BYTES (61 * 1024)
#define NPHASE 12

#define OUT_Y 0
#define OUT_WKV_P 17825792
#define OUT_SH_P 17956864
#define OUT_WK_P 17958912
#define OUT_WV_P 18024448
#define OUT_WKV_S 18089984
#define OUT_SH_S 26478592
#define OUT_WK_S 26609664
#define OUT_WV_S 30803968

struct Params {
  const float *x_prompt, *x_sample, *state_wkv, *state_shift, *cache_k, *cache_v, *ln_g, *ln_b;
  const float *mu, *w_in, *w0, *w1, *w2, *a0, *a1, *a2, *k_k, *k_a, *r_k, *gn_g, *gn_b, *w_out;
  const float *att_w_in, *att_sinks, *att_w_out;
  float* out;
  unsigned* bar;
  bf16_t *WtIn0, *W2t, *A2t, *WtOut0, *WtIn1, *WtOut1;
  bf16_t *XB, *XXB;
  bf16_t *Rb, *Kb, *Vb, *Gb;
  bf16_t *H1, *H2, *MU16;
  float* INVN;
  int phase_begin, phase_end;
};

typedef __bf16 hbf2 __attribute__((ext_vector_type(2)));
typedef float f32x2_ __attribute__((ext_vector_type(2)));
__device__ __forceinline__ unsigned pack2(float a, float b) {
  const f32x2_ v = {a, b};
  return __builtin_bit_cast(unsigned, __builtin_convertvector(v, hbf2));
}
__device__ __forceinline__ bf16_t f2bf(float f) { return (bf16_t)(pack2(f, 0.f) & 0xffffu); }
__device__ __forceinline__ float bf2f(bf16_t h) { return __uint_as_float(((unsigned)h) << 16); }
__device__ __forceinline__ float wave_sum(float x) {
#pragma unroll
  for (int o = 32; o >= 1; o >>= 1) x += __shfl_xor(x, o);
  return x;
}
__device__ __forceinline__ float wave_max(float x) {
#pragma unroll
  for (int o = 32; o >= 1; o >>= 1) x = fmaxf(x, __shfl_xor(x, o));
  return x;
}
__device__ __forceinline__ float quad_sum(float x) {
  x += __builtin_bit_cast(float, __builtin_amdgcn_update_dpp(0, __builtin_bit_cast(int, x), 0xB1, 0xF, 0xF, true));
  x += __builtin_bit_cast(float, __builtin_amdgcn_update_dpp(0, __builtin_bit_cast(int, x), 0x4E, 0xF, 0xF, true));
  return x;
}
__device__ __forceinline__ float sigmoidf_(float x) { return __builtin_amdgcn_rcpf(1.f + __expf(-x)); }
__device__ __forceinline__ const float* xin_row(const Params& P, int m) {
  return (m < NPR) ? (P.x_prompt + (size_t)m * DM) : (P.x_sample + (size_t)(m - NPR) * DM);
}

#define XB_TMO      128
#define XB_XCNT(j)  (256  + 64 * (j))
#define XB_XSUB(j)  (1280 + 64 * (j))
#define XB_XGEN(j)  (2304 + 64 * (j))
#define XB_TOP      3328
#define XB_TOPGEN   3392
#define XCD_BAR_WORDS 3456
#define XB_SPIN_CAP (1u << 22)
#define LAS __attribute__((address_space(3)))
__device__ __forceinline__ unsigned xb_ld(unsigned* p) { return __hip_atomic_load(p, __ATOMIC_RELAXED, __HIP_MEMORY_SCOPE_AGENT); }
__device__ __forceinline__ unsigned xb_add(unsigned* p, unsigned v) { return __hip_atomic_fetch_add(p, v, __ATOMIC_RELAXED, __HIP_MEMORY_SCOPE_AGENT); }
__device__ __forceinline__ unsigned xb_xcc_id() { return (unsigned)__builtin_amdgcn_s_getreg((3 << 11) | 20) & 0xFu; }
#define XB_SPIN(cond, bar) do { unsigned _sp = 0; while (cond) { __builtin_amdgcn_s_sleep(1); \
    if ((++_sp & 255u) == 0u) { if (xb_ld(&(bar)[XB_TMO])) break; if (_sp > XB_SPIN_CAP) { atomicAdd(&(bar)[XB_TMO], 1u); break; } } } } while (0)
struct XcdBarrier { unsigned* bar; unsigned x; volatile LAS unsigned* st; };
__device__ __forceinline__ XcdBarrier xcd_barrier_post(unsigned* bar, volatile LAS unsigned* st) {
  XcdBarrier b; b.bar = bar; b.x = xb_xcc_id(); b.st = st;
  if (threadIdx.x == 0) (void)xb_add(&bar[XB_XCNT(b.x)], 1u);
  return b;
}
__device__ __forceinline__ void xcd_barrier_complete(unsigned* bar, unsigned x, unsigned& nloc, unsigned& nx) {
  const unsigned G = gridDim.x * gridDim.y * gridDim.z;
  unsigned sum, cnt, mine, sp = 0u;
  for (;;) {
    sum = 0u; cnt = 0u; mine = 0u;
#pragma unroll
    for (unsigned j = 0; j < 16; ++j) { const unsigned c = xb_ld(&bar[XB_XCNT(j)]); sum += c; cnt += (c > 0u) ? 1u : 0u; mine = (j == x) ? c : mine; }
    if (sum == G) break;
    __builtin_amdgcn_s_sleep(1);
    if ((++sp & 255u) == 0u) { if (xb_ld(&bar[XB_TMO])) break; if (sp > XB_SPIN_CAP) { atomicAdd(&bar[XB_TMO], 1u); break; } }
  }
  nloc = mine > 0u ? mine : 1u; nx = cnt > 0u ? cnt : 1u;
}
__device__ __forceinline__ void xcd_barrier(const XcdBarrier& b) {
  asm volatile("s_waitcnt vmcnt(0)" ::: "memory");
  __syncthreads();
  if (threadIdx.x == 0) {
    unsigned* bar = b.bar;
    __builtin_amdgcn_s_waitcnt(0);
    unsigned nloc = b.st[0], nx = b.st[1];
    if (nloc == 0u) { xcd_barrier_complete(bar, b.x, nloc, nx); b.st[0] = nloc; b.st[1] = nx; }
    const unsigned old = xb_add(&bar[XB_XSUB(b.x)], 1u);
    const unsigned gen = old / nloc;
    if (old + 1u == (gen + 1u) * nloc) {
      __builtin_amdgcn_fence(__ATOMIC_RELEASE, "agent");
      asm volatile("s_waitcnt vmcnt(0)" ::: "memory");
      const unsigned og = xb_add(&bar[XB_TOP], 1u);
      const unsigned tg = og / nx;
      if (og + 1u == (tg + 1u) * nx) xb_add(&bar[XB_TOPGEN], 1u);
      else XB_SPIN(xb_ld(&bar[XB_TOPGEN]) == tg, bar);
      __builtin_amdgcn_fence(__ATOMIC_ACQUIRE, "agent");
      xb_add(&bar[XB_XGEN(b.x)], 1u);
      asm volatile("s_waitcnt vmcnt(0)" ::: "memory");
    } else {
      XB_SPIN(xb_ld(&bar[XB_XGEN(b.x)]) == gen, bar);
      __builtin_amdgcn_fence(__ATOMIC_ACQUIRE, "agent");
      asm volatile("s_waitcnt vmcnt(0)" ::: "memory");
    }
  }
  __syncthreads();
}

__device__ __forceinline__ unsigned short f2h_bits(float f) { const _Float16 h = (_Float16)f; return __builtin_bit_cast(unsigned short, h); }
__device__ __forceinline__ unsigned pack2h(float a, float b) { return (unsigned)f2h_bits(a) | ((unsigned)f2h_bits(b) << 16); }
__device__ __forceinline__ void transpose_tile(const float* __restrict__ src, int ld, int k0, int n0, bf16_t* __restrict__ dst, int ldd, float* tile, bool half = false) {
  const int t = threadIdx.x;
  {
    const int n = t & 63, kq = t >> 6;
#pragma unroll 4
    for (int i = 0; i < 16; i++) { const int k = i * 4 + kq; tile[k * 65 + n] = src[(size_t)(k0 + k) * ld + n0 + n]; }
  }
  __syncthreads();
  {
    const int k = t & 63, nq = t >> 6;
#pragma unroll 4
    for (int i = 0; i < 16; i++) { const int n2 = i * 4 + nq; const float v_ = tile[k * 65 + n2]; dst[(size_t)(n0 + n2) * ldd + k0 + k] = half ? f2h_bits(v_) : f2bf(v_); }
  }
  __syncthreads();
}

__device__ __forceinline__ void late_weight_prep(const Params& P, unsigned char* smem, int first, int stride) {
  float* tile = (float*)smem;
  for (int id = 1088 + first; id < 2240; id += stride) {
    if (id < 1344) { const int r = id - 1088; transpose_tile(P.w_out, DM, (r >> 4) * 64, (r & 15) * 64, P.WtOut0, DM, tile); }
    else if (id < 1984) { const int r = id - 1344; transpose_tile(P.att_w_in, 2560, (r / 40) * 64, (r % 40) * 64, P.WtIn1, DM, tile); }
    else { const int r = id - 1984; transpose_tile(P.att_w_out, DM, (r >> 4) * 64, (r & 15) * 64, P.WtOut1, DM, tile); }
  }
}
__device__ __forceinline__ void phase_prep(const Params& P, unsigned char* smem, int bid, int nb) {
  float* tile = (float*)smem;
  const int t = threadIdx.x;
  const int NITEMS = 2242 + 4352 + 130;
  for (int id = bid; id < NITEMS; id += nb) {
    if (id < 1024) { const int p = id >> 8, r = id & 255; transpose_tile(P.w_in + (size_t)p * DM * DM, DM, (r >> 4) * 64, (r & 15) * 64, P.WtIn0 + (size_t)p * DM * DM, DM, tile, true); }
    else if (id < 1040) transpose_tile(P.w1, 64, (id - 1024) * 64, 0, P.WtIn0 + (size_t)4096 * DM, DM, tile, true);
    else if (id < 1056) transpose_tile(P.a1, 64, (id - 1040) * 64, 0, P.WtIn0 + (size_t)4224 * DM, DM, tile, true);
    else if (id < 1072) transpose_tile(P.w2, DM, 0, (id - 1056) * 64, P.W2t, 64, tile);
    else if (id < 1088) transpose_tile(P.a2, DM, 0, (id - 1072) * 64, P.A2t, 64, tile);
    else if (id < 2240) { }
    else if (id < 2242) {
      uint4* z = (uint4*)(P.WtIn0 + (size_t)(id == 2240 ? 4160 : 4288) * DM);
      for (int i = t; i < 8192; i += 256) z[i] = make_uint4(0, 0, 0, 0);
      if (id == 2240) for (int i = t; i < 6 * DM; i += 256) P.MU16[i] = f2h_bits(P.mu[i]);
    } else if (id < 2242 + 4352) {
      const int it = id - 2242;
#pragma unroll
      for (int q = 0; q < 4; q++) {
        const int m = it * 4 + q;
        const float4 x = ((const float4*)xin_row(P, m))[t];
        float4 pv = make_float4(0.f, 0.f, 0.f, 0.f);
        if (m < NPR) { if ((m & (TP - 1)) != 0) pv = ((const float4*)xin_row(P, m - 1))[t]; }
        else { const int ms = m - NPR; if ((ms & 7) != 0) pv = ((const float4*)xin_row(P, m - 1))[t]; else pv = ((const float4*)(P.state_shift + (size_t)(ms >> 3) * DM))[t]; }
        uint2 xb, xxb;
        xb.x = pack2h(x.x, x.y); xb.y = pack2h(x.z, x.w);
        xxb.x = pack2h(pv.x - x.x, pv.y - x.y); xxb.y = pack2h(pv.z - x.z, pv.w - x.w);
        ((uint2*)(P.XB + (size_t)m * DM))[t] = xb;
        ((uint2*)(P.XXB + (size_t)m * DM))[t] = xxb;
      }
    } else {
      const int r = id - (2242 + 4352);
      if (r < 2) ((float4*)(P.out + OUT_SH_P + (size_t)r * DM))[t] = ((const float4*)(P.x_prompt + ((size_t)r * TP + TP - 1) * DM))[t];
      else { const int b = r - 2; ((float4*)(P.out + OUT_SH_S + (size_t)b * DM))[t] = ((const float4*)(P.x_sample + ((size_t)b * 8 + 7) * DM))[t]; }
    }
  }
}

#define LDB 48
typedef _Float16 f16x8 __attribute__((ext_vector_type(8)));
typedef _Float16 f16x2 __attribute__((ext_vector_type(2)));
__device__ __forceinline__ unsigned xs16(unsigned x, unsigned d, unsigned m) {
  const f16x2 r = __builtin_elementwise_fma(__builtin_bit_cast(f16x2, d), __builtin_bit_cast(f16x2, m), __builtin_bit_cast(f16x2, x));
  return __builtin_bit_cast(unsigned, r);
}
template <int MODE>
__device__ __forceinline__ void gemm_tile(const Params& P, unsigned char* smem, int mt, int nt) {
  constexpr int KT = (MODE == 2) ? 1 : 16;
  bf16_t* Asb[2]; bf16_t* Bsb[2];
  Asb[0] = (bf16_t*)smem; Bsb[0] = Asb[0] + 128 * LDB; Asb[1] = Bsb[0] + 128 * LDB; Bsb[1] = Asb[1] + 128 * LDB;
  const int t = threadIdx.x, lane = t & 63, w = t >> 6;
  const int wm = w >> 1, wn = w & 1;
  const int g = lane >> 4, lc = lane & 15;
  const int lr = t >> 2, lc4 = t & 3;
  const int m0 = mt * 128, n0 = nt * 128;

  const bf16_t* Ap; const bf16_t* A2p = nullptr; const bf16_t* mup = nullptr; const bf16_t* Bp; int lda, ldb;
  if (MODE == 1) {
    const int p = (nt < 32) ? (nt >> 3) : (4 + (nt - 32));
    Ap = P.XB; A2p = P.XXB; lda = DM; mup = P.MU16 + (size_t)p * DM;
    Bp = P.WtIn0 + (size_t)((nt < 32) ? n0 : (4096 + (nt - 32) * 128)) * DM; ldb = DM;
  } else if (MODE == 2) {
    Ap = (nt < 8) ? P.H1 : P.H2; lda = 64;
    Bp = ((nt < 8) ? P.W2t : P.A2t) + (size_t)((nt & 7) * 128) * 64; ldb = 64;
  } else if (MODE == 3) { Ap = P.Gb; lda = DM; Bp = P.WtOut0 + (size_t)n0 * DM; ldb = DM; }
  else if (MODE == 4 || MODE == 6) { Ap = P.Rb; lda = DM; Bp = P.WtIn1 + (size_t)n0 * DM; ldb = DM; }
  else { Ap = P.Gb; lda = DM; Bp = P.WtOut1 + (size_t)n0 * DM; ldb = DM; }

  f32x4 acc[4][4];
#pragma unroll
  for (int i = 0; i < 4; i++)
#pragma unroll
    for (int j = 0; j < 4; j++) acc[i][j] = (f32x4){0.f, 0.f, 0.f, 0.f};

  u32x4 ra[2][2][2], rb[2][2][2], ra2[2][2][2], rmu[2][2];
  const unsigned voffA = (unsigned)(lr * lda + lc4 * 8) * 2u;
  const unsigned voffB = (unsigned)(lr * ldb + lc4 * 8) * 2u;
  const char* baseA = (const char*)(Ap + (size_t)m0 * lda);
  const char* baseA2 = (const char*)(A2p + (size_t)m0 * lda);
  const char* baseB = (const char*)Bp;
#define LOADH(S_, kt_, H_) do { if ((kt_) < KT) { \
    _Pragma("unroll") for (int ii_ = 0; ii_ < 2; ii_++) { \
      const size_t uo_ = ((size_t)(64 * ii_) * lda + (size_t)(kt_) * 64 + 32 * (H_)) * 2; \
      const size_t uob_ = ((size_t)(64 * ii_) * ldb + (size_t)(kt_) * 64 + 32 * (H_)) * 2; \
      ra[S_][H_][ii_] = *(const u32x4*)(baseA + uo_ + voffA); \
      if (MODE == 1) ra2[S_][H_][ii_] = *(const u32x4*)(baseA2 + uo_ + voffA); \
      rb[S_][H_][ii_] = *(const u32x4*)(baseB + uob_ + voffB); \
    } \
    if (MODE == 1) rmu[S_][H_] = *(const u32x4*)(mup + (kt_) * 64 + 32 * (H_) + lc4 * 8); \
  } } while (0)
#define STOREH(S_, H_, B_) do { \
    _Pragma("unroll") for (int ii_ = 0; ii_ < 2; ii_++) { \
      const int row_ = lr + 64 * ii_; \
      u32x4 av_ = ra[S_][H_][ii_]; \
      if (MODE == 1) { \
        const u32x4 xv_ = ra[S_][H_][ii_], dv_ = ra2[S_][H_][ii_], mv_ = rmu[S_][H_]; \
        av_ = (u32x4){xs16(xv_.x, dv_.x, mv_.x), xs16(xv_.y, dv_.y, mv_.y), xs16(xv_.z, dv_.z, mv_.z), xs16(xv_.w, dv_.w, mv_.w)}; \
      } \
      *(u32x4*)(Asb[B_] + row_ * LDB + lc4 * 8) = av_; \
      *(u32x4*)(Bsb[B_] + row_ * LDB + lc4 * 8) = rb[S_][H_][ii_]; \
    } \
  } while (0)
#define COMPUTE_SUB(B_) do { if (!(MODE == 6 && PROBE == 3)) { \
    bf16x8 af[4], bfr[4]; \
    _Pragma("unroll") for (int i = 0; i < 4; i++) af[i] = *(const bf16x8*)(Bsb[B_] + (wn * 64 + i * 16 + lc) * LDB + g * 8); \
    _Pragma("unroll") for (int j = 0; j < 4; j++) bfr[j] = *(const bf16x8*)(Asb[B_] + (wm * 64 + j * 16 + lc) * LDB + g * 8); \
    _Pragma("unroll") for (int i = 0; i < 4; i++) \
      _Pragma("unroll") for (int j = 0; j < 4; j++) { \
        if (MODE == 1) acc[i][j] = __builtin_amdgcn_mfma_f32_16x16x32_f16(__builtin_bit_cast(f16x8, af[i]), __builtin_bit_cast(f16x8, bfr[j]), acc[i][j], 0, 0, 0); \
        else acc[i][j] = __builtin_amdgcn_mfma_f32_16x16x32_bf16(af[i], bfr[j], acc[i][j], 0, 0, 0); \
      } \
  } } while (0)
  __syncthreads();
  LOADH(0, 0, 0); LOADH(0, 0, 1); LOADH(1, 1, 0); LOADH(1, 1, 1);
  STOREH(0, 0, 0);
  LOADH(0, 2, 0);
  __syncthreads();
  for (int kt = 0; kt < KT; kt += 2) {
    STOREH(0, 1, 1); LOADH(0, kt + 2, 1);
    COMPUTE_SUB(0);
    if (!(MODE == 6 && PROBE == 5)) __syncthreads();
    if (kt + 1 < KT) { STOREH(1, 0, 0); LOADH(1, kt + 3, 0); }
    COMPUTE_SUB(1);
    __syncthreads();
    if (kt + 1 < KT) {
      STOREH(1, 1, 1); LOADH(1, kt + 3, 1);
      COMPUTE_SUB(0);
      if (!(MODE == 6 && PROBE == 5)) __syncthreads();
      if (kt + 2 < KT) { STOREH(0, 0, 0); LOADH(0, kt + 4, 0); }
      COMPUTE_SUB(1);
      __syncthreads();
    }
  }
  if (MODE == 1 && nt >= 8 && nt < 16) {
    const int hh = (nt & 7) * 2 + wn;
    float kkw[4][4];
#pragma unroll
    for (int i = 0; i < 4; i++) { const float4 kq = *(const float4*)(P.k_k + hh * 64 + i * 16 + 4 * g); kkw[i][0] = kq.x; kkw[i][1] = kq.y; kkw[i][2] = kq.z; kkw[i][3] = kq.w; }
#pragma unroll
    for (int j = 0; j < 4; j++) {
      float ssq = 0.f;
#pragma unroll
      for (int i = 0; i < 4; i++) {
        const unsigned u0 = pack2(acc[i][j][0], acc[i][j][1]), u1 = pack2(acc[i][j][2], acc[i][j][3]);
        const float q0 = __uint_as_float(u0 << 16) * kkw[i][0], q1 = __uint_as_float(u0 & 0xffff0000u) * kkw[i][1];
        const float q2 = __uint_as_float(u1 << 16) * kkw[i][2], q3 = __uint_as_float(u1 & 0xffff0000u) * kkw[i][3];
        ssq = fmaf(q0, q0, ssq); ssq = fmaf(q1, q1, ssq); ssq = fmaf(q2, q2, ssq); ssq = fmaf(q3, q3, ssq);
      }
      ssq += __shfl_xor(ssq, 16); ssq += __shfl_xor(ssq, 32);
      if (g == 0) P.INVN[(size_t)(m0 + wm * 64 + j * 16 + lc) * 16 + hh] = __builtin_amdgcn_rsqf(fmaxf(ssq, 1e-24f));
    }
  }
#pragma unroll
  for (int i = 0; i < 4; i++) {
    const int nl = wn * 64 + i * 16 + 4 * g;
#pragma unroll
    for (int j = 0; j < 4; j++) {
      const int m = m0 + wm * 64 + j * 16 + lc;
      const f32x4 v = acc[i][j];
      if (MODE == 1) {
        if (nt < 32) {
          const int p = nt >> 3, c = (nt & 7) * 128 + nl;
          bf16_t* dst = (p == 0) ? P.Rb : (p == 1) ? P.Kb : (p == 2) ? P.Vb : P.Gb;
          uint2 o; o.x = pack2(v[0], v[1]); o.y = pack2(v[2], v[3]);
          *(uint2*)(dst + (size_t)m * DM + c) = o;
        } else if (nl < 64) {
          uint2 o;
          if (nt == 32) { o.x = pack2(tanhf(v[0]), tanhf(v[1])); o.y = pack2(tanhf(v[2]), tanhf(v[3])); *(uint2*)(P.H1 + (size_t)m * 64 + nl) = o; }
          else { o.x = pack2(v[0], v[1]); o.y = pack2(v[2], v[3]); *(uint2*)(P.H2 + (size_t)m * 64 + nl) = o; }
        }
      } else if (MODE == 2) {
        const int c = (nt & 7) * 128 + nl;
        f16_t o[4];
        if (nt < 8) {
          const float4 w0v = *(const float4*)(P.w0 + c);
          const float ws[4] = {w0v.x, w0v.y, w0v.z, w0v.w};
#pragma unroll
          for (int r = 0; r < 4; r++) o[r] = (f16_t)(sigmoidf_(ws[r] + v[r]) * 0.60653065971f);
          *(uint2*)(((f16_t*)(P.out + OUT_Y)) + (size_t)m * DM + c) = *(uint2*)o;
        } else {
          const float4 a0v = *(const float4*)(P.a0 + c);
          const float as_[4] = {a0v.x, a0v.y, a0v.z, a0v.w};
#pragma unroll
          for (int r = 0; r < 4; r++) o[r] = (f16_t)sigmoidf_(as_[r] + v[r]);
          *(uint2*)(((f16_t*)(P.out + OUT_Y) + (size_t)NTOK * DM) + (size_t)m * DM + c) = *(uint2*)o;
        }
      } else if (MODE == 3 || MODE == 5) {
        const int c = n0 + nl;
        float4 res;
        if (MODE == 3) res = *(const float4*)(xin_row(P, m) + c);
        else { const uint2 rb2 = *(const uint2*)(P.Rb + (size_t)m * DM + c); res = make_float4(__uint_as_float(rb2.x << 16), __uint_as_float(rb2.x & 0xffff0000u), __uint_as_float(rb2.y << 16), __uint_as_float(rb2.y & 0xffff0000u)); }
        float4 o = make_float4(v[0] + ALPHA_F * res.x, v[1] + ALPHA_F * res.y, v[2] + ALPHA_F * res.z, v[3] + ALPHA_F * res.w);
        *(float4*)(P.out + OUT_Y + (size_t)m * DM + c) = o;
      } else if (MODE == 6) {
        uint2 o; o.x = pack2(v[0], v[1]); o.y = pack2(v[2], v[3]);
        *(uint2*)(P.XB + (size_t)(m & 4095) * DM + ((n0 + nl) & 1023)) = o;
      } else if (MODE == 4) {
        uint2 o; o.x = pack2(v[0], v[1]); o.y = pack2(v[2], v[3]);
        if (nt < 8) { *(uint2*)(P.Kb + (size_t)m * DM + n0 + nl) = o; }
        else if (nt >= 12) { *(uint2*)(P.Vb + (size_t)m * DM + (nt - 12) * 128 + nl) = o; }
        else {
          const bool isk = nt < 10;
          const int ck = (nt & 1) * 128 + nl;
          bf16_t* K1 = P.XB; bf16_t* V1 = P.XB + (size_t)NTOK * 256; bf16_t* VT1 = P.XB + (size_t)NTOK * 512;
          *(uint2*)((isk ? K1 : V1) + (size_t)m * 256 + ck) = o;
          const float4 fo = make_float4(v[0], v[1], v[2], v[3]);
          if (m < NPR) {
            const int b = m >> 13, tt = m & (TP - 1);
            if (!isk) {
              const int hk = ck >> 6, d = ck & 63;
              bf16_t* vt = VT1 + ((size_t)((b * 4 + hk) * 64 + d)) * TP + tt;
              vt[0] = f2bf(v[0]); vt[TP] = f2bf(v[1]); vt[2 * TP] = f2bf(v[2]); vt[3 * TP] = f2bf(v[3]);
            }
            if (tt >= TP - 128) *(float4*)(P.out + (isk ? OUT_WK_P : OUT_WV_P) + ((size_t)(b * 128 + tt - (TP - 128))) * 256 + ck) = fo;
          } else {
            const int ms = m - NPR, b = ms >> 3, tt = ms & 7;
            *(float4*)(P.out + (isk ? OUT_WK_S : OUT_WV_S) + ((size_t)(b * 128 + 120 + tt)) * 256 + ck) = fo;
          }
        }
      }
    }
  }
}
__device__ __forceinline__ void gemm1_part(const Params& P, unsigned char* smem, int part, int first, int stride) {
  const int nnt = part ? 16 : 18;
  for (int tile = first; tile < 136 * nnt; tile += stride) {
    const int mt = tile % 136, ntl = tile / 136;
    const int nt = part ? ((ntl < 8) ? ntl : (24 + ntl - 8)) : ((ntl < 16) ? (8 + ntl) : (32 + ntl - 16));
    gemm_tile<1>(P, smem, mt, nt);
  }
}
template <int MODE>
__device__ __forceinline__ void gemm_phase(const Params& P, unsigned char* smem, int bid, int nb) {
  constexpr int NT = (MODE == 1) ? 34 : (MODE == 2) ? 16 : (MODE == 4 || MODE == 6) ? 20 : 8;
  const int ntiles = 136 * NT;
  for (int tile = bid; tile < ntiles; tile += nb) gemm_tile<MODE>(P, smem, tile % 136, tile / 136);
}

#define TS 8
#define REC 392
typedef float f32x2 __attribute__((ext_vector_type(2)));
__device__ __forceinline__ f32x2 pkfma(f32x2 a, f32x2 b, f32x2 c) { return __builtin_elementwise_fma(a, b, c); }
#define DPP_ADD(x, ctrl) ((x) + __builtin_bit_cast(float, __builtin_amdgcn_update_dpp(0, __builtin_bit_cast(int, (x)), (ctrl), 0xF, 0xF, true)))
__device__ __forceinline__ float wave_sum_fast(float x) {
  x = DPP_ADD(x, 0xB1); x = DPP_ADD(x, 0x4E); x = DPP_ADD(x, 0x141); x = DPP_ADD(x, 0x140);
  const int xi = __builtin_bit_cast(int, x);
  const float t0 = __builtin_bit_cast(float, __builtin_amdgcn_readlane(xi, 0)), t1 = __builtin_bit_cast(float, __builtin_amdgcn_readlane(xi, 16));
  const float t2 = __builtin_bit_cast(float, __builtin_amdgcn_readlane(xi, 32)), t3 = __builtin_bit_cast(float, __builtin_amdgcn_readlane(xi, 48));
  return (t0 + t1) + (t2 + t3);
}
#define LD8(dst, ptr) do { _Pragma("unroll") for (int j4_ = 0; j4_ < 4; j4_++) { const f32x4 v_ = *(const f32x4*)((ptr) + 4 * j4_); \
    dst[2 * j4_] = (f32x2){v_[0], v_[1]}; dst[2 * j4_ + 1] = (f32x2){v_[2], v_[3]}; } } while (0)

template <int INIT  , bool USEV, bool WRITEY>
__device__ __forceinline__ void scan_unit(const Params& P, float* ws, int lane, int tok0, int nsteps, int h, const float* init_ptr, float* fin) {
  const int rq = lane >> 2, q = lane & 3;
  f32x2 s[4][8];
#pragma unroll
  for (int i = 0; i < 4; i++)
#pragma unroll
    for (int j = 0; j < 8; j++) {
      if (INIT == 1) s[i][j] = (f32x2){((rq + 16 * i) == (16 * q + 2 * j)) ? 1.f : 0.f, ((rq + 16 * i) == (16 * q + 2 * j + 1)) ? 1.f : 0.f};
      else s[i][j] = (f32x2){0.f, 0.f};
    }
  if (INIT == 2) {
#pragma unroll
    for (int i = 0; i < 4; i++) LD8(s[i], init_ptr + (size_t)(rq + 16 * i) * 64 + 16 * q);
  }
  const int c = h * 64 + lane;
  const float kkc = P.k_k[c], kac = P.k_a[c], rkc = P.r_k[c];
  const int crow = h * 64 + rq + 16 * q;
  const float gng = P.gn_g[crow], gnb = P.gn_b[crow];
  const f16_t* EW = ((const f16_t*)(P.out + OUT_Y));
  const f16_t* AA = ((const f16_t*)(P.out + OUT_Y) + (size_t)NTOK * DM);

  bf16_t rk[TS], rv[TS], rr[TS]; f16_t ra_[TS], re_[TS]; float rn_[TS];
#define LOAD_RAW(tb) do { const size_t ub_ = (size_t)(tok0 + (tb)) * DM; \
    const bf16_t* kb_ = P.Kb + ub_; const f16_t* ab_ = AA + ub_; const f16_t* eb_ = EW + ub_; const bf16_t* vb_ = P.Vb + ub_; const bf16_t* rb_ = P.Rb + ub_; \
    _Pragma("unroll") for (int tt_ = 0; tt_ < TS; tt_++) { const unsigned off_ = (unsigned)(tt_ * DM + c); \
    rn_[tt_] = P.INVN[(size_t)(tok0 + (tb) + tt_) * 16 + h]; rk[tt_] = kb_[off_]; ra_[tt_] = ab_[off_]; re_[tt_] = eb_[off_]; if (USEV) rv[tt_] = vb_[off_]; if (WRITEY) rr[tt_] = rb_[off_]; } } while (0)
  LOAD_RAW(0);
  for (int t0 = 0; t0 < nsteps; t0 += TS) {
    {
      float gcum = 1.f;
#pragma unroll
      for (int tt = 0; tt < TS; tt++) {
        const float kraw = bf2f(rk[tt]);
        const float a = (float)ra_[tt];
        const float wd = __expf(-(float)re_[tt]);
        const float kkv = kraw * kkc * rn_[tt];
        const float kf = kraw * (1.f + (a - 1.f) * kac);
        float* rec = ws + tt * REC;
        rec[lane] = kkv * gcum;
        gcum *= wd;
        const float ginv = __builtin_amdgcn_rcpf(gcum);
        rec[128 + lane] = kf * ginv; rec[192 + lane] = kkv * a * ginv;
        if (WRITEY) {
          const float r = bf2f(rr[tt]);
          rec[256 + lane] = r * gcum;
          const float bonus = wave_sum_fast(r * kf * rkc);
          if (lane == 0) rec[384] = bonus;
        }
        if (USEV) rec[320 + lane] = bf2f(rv[tt]);
      }
      ws[TS * REC + lane] = gcum;
    }
    __builtin_amdgcn_wave_barrier();
    asm volatile("s_waitcnt lgkmcnt(0)" ::: "memory");
    if (t0 + TS < nsteps) LOAD_RAW(t0 + TS);
#pragma unroll 1
    for (int tt = 0; tt < TS; tt++) {
      const float* rec = ws + tt * REC;
      f32x2 o2[8], b2[8], kf2[8];
      LD8(o2, rec + 16 * q);
      LD8(b2, rec + 192 + 16 * q);
      if (USEV) LD8(kf2, rec + 128 + 16 * q);
      f32x2 nsa2[4];
      {
        f32x2 acc[4];
#pragma unroll
        for (int i = 0; i < 4; i++) acc[i] = s[i][0] * o2[0];
#pragma unroll
        for (int j = 1; j < 8; j++)
#pragma unroll
          for (int i = 0; i < 4; i++) acc[i] = pkfma(s[i][j], o2[j], acc[i]);
#pragma unroll
        for (int i = 0; i < 4; i++) { const float t = -quad_sum(acc[i][0] + acc[i][1]); nsa2[i] = (f32x2){t, t}; }
      }
      float vv[4];
      if (USEV) {
#pragma unroll
        for (int i = 0; i < 4; i++) vv[i] = rec[320 + rq + 16 * i];
      }
      if (WRITEY) LD8(o2, rec + 256 + 16 * q);
#pragma unroll
      for (int i = 0; i < 4; i++) {
#pragma unroll
        for (int j = 0; j < 8; j++) s[i][j] = pkfma(nsa2[i], b2[j], s[i][j]);
        if (USEV) {
          const f32x2 vv2 = (f32x2){vv[i], vv[i]};
#pragma unroll
          for (int j = 0; j < 8; j++) s[i][j] = pkfma(vv2, kf2[j], s[i][j]);
        }
      }
      if (WRITEY) {
        float y[4];
        {
          f32x2 acc[4];
#pragma unroll
          for (int i = 0; i < 4; i++) acc[i] = s[i][0] * o2[0];
#pragma unroll
          for (int j = 1; j < 8; j++)
#pragma unroll
            for (int i = 0; i < 4; i++) acc[i] = pkfma(s[i][j], o2[j], acc[i]);
#pragma unroll
          for (int i = 0; i < 4; i++) y[i] = quad_sum(acc[i][0] + acc[i][1]);
        }
        const float ysel = (q == 0) ? y[0] : (q == 1) ? y[1] : (q == 2) ? y[2] : y[3];
        const float vsel = (q == 0) ? vv[0] : (q == 1) ? vv[1] : (q == 2) ? vv[2] : vv[3];
        const float mean = wave_sum_fast(ysel) * (1.f / 64.f);
        const float ex2 = wave_sum_fast(ysel * ysel) * (1.f / 64.f);
        const float var = fmaxf(ex2 - mean * mean, 0.f);
        float yo = (ysel - mean) * rsqrtf(var + 64e-5f) * gng + gnb + rec[384] * vsel;
        const size_t off = (size_t)(tok0 + t0 + tt) * DM + crow;
        const float gt = bf2f(P.Gb[off]);
        yo *= gt * sigmoidf_(gt);
        P.Gb[off] = f2bf(yo);
      }
    }
    {
      f32x2 ge[8];
      LD8(ge, ws + TS * REC + 16 * q);
#pragma unroll
      for (int i = 0; i < 4; i++)
#pragma unroll
        for (int j = 0; j < 8; j++) s[i][j] *= ge[j];
    }
    __builtin_amdgcn_wave_barrier();
    asm volatile("s_waitcnt lgkmcnt(0)" ::: "memory");
  }
  if (fin) {
#pragma unroll
    for (int i = 0; i < 4; i++)
#pragma unroll
      for (int j4 = 0; j4 < 4; j4++)
        *(f32x4*)(fin + (size_t)(rq + 16 * i) * 64 + 16 * q + 4 * j4) = (f32x4){s[i][2 * j4][0], s[i][2 * j4][1], s[i][2 * j4 + 1][0], s[i][2 * j4 + 1][1]};
  }
}

__device__ __forceinline__ void phase_scan1(const Params& P, unsigned char* smem, int bid, int nb) {
  const int lane = threadIdx.x & 63, w = __builtin_amdgcn_readfirstlane((int)(threadIdx.x >> 6));
  float* ws = (float*)smem + w * (TS * REC + 64);
  float* Ploc = P.out + OUT_WK_S;
  float* Sloc = P.out + OUT_WV_S;
  const int hb = nb >> 1;
  if (bid >= hb) { gemm1_part(P, smem, 1, bid - hb, nb - hb); return; }
  for (int u = w * hb + bid; u < NBH * (NC - 1) * 2; u += 4 * hb) {
    const int kind = (u ^ (u / (4 * hb))) & 1, rest = u >> 1;
    const int c = rest % (NC - 1), bh = rest / (NC - 1);
    const int tok0 = (bh >> 4) * TP + c * CL, h = bh & 15;
    float* fin = (kind ? Ploc : Sloc) + (size_t)(bh * (NC - 1) + c) * 4096;
    if (kind) scan_unit<1, false, false>(P, ws, lane, tok0, CL, h, nullptr, fin);
    else scan_unit<0, true, false>(P, ws, lane, tok0, CL, h, nullptr, fin);
  }
}
__device__ __forceinline__ void phase_scan2(const Params& P, unsigned char* smem, int bid, int nb) {
  const int lane = threadIdx.x & 63, w = __builtin_amdgcn_readfirstlane((int)(threadIdx.x >> 6));
  float* ws = (float*)smem + w * 256;
  float* Ploc = P.out + OUT_WK_S;
  float* Sloc = P.out + OUT_WV_S;
  for (int item = bid; item < NBH * 4; item += nb) {
    const int bh = item >> 2, row0 = (item & 3) * 16 + w * 4;
    float s[4];
    {
      const float* S0 = Sloc + (size_t)(bh * (NC - 1)) * 4096;
#pragma unroll
      for (int r = 0; r < 4; r++) s[r] = S0[(row0 + r) * 64 + lane];
    }
    for (int c = 1; c < NC - 1; c++) {
      const float* Pc = Ploc + (size_t)(bh * (NC - 1) + c) * 4096;
      float* Sc = Sloc + (size_t)(bh * (NC - 1) + c) * 4096;
      float acc[4];
#pragma unroll
      for (int r = 0; r < 4; r++) { acc[r] = Sc[(row0 + r) * 64 + lane]; ws[r * 64 + lane] = s[r]; }
      __builtin_amdgcn_wave_barrier();
      asm volatile("s_waitcnt lgkmcnt(0)" ::: "memory");
#pragma unroll 1
      for (int hf = 0; hf < 2; hf++) {
        float p[32];
#pragma unroll
        for (int i = 0; i < 32; i++) p[i] = Pc[(hf * 32 + i) * 64 + lane];
#pragma unroll
        for (int r = 0; r < 4; r++) {
#pragma unroll
          for (int i4 = 0; i4 < 8; i4++) {
            const float4 sv = *(const float4*)(ws + r * 64 + hf * 32 + 4 * i4);
            acc[r] = fmaf(sv.x, p[4 * i4], acc[r]); acc[r] = fmaf(sv.y, p[4 * i4 + 1], acc[r]);
            acc[r] = fmaf(sv.z, p[4 * i4 + 2], acc[r]); acc[r] = fmaf(sv.w, p[4 * i4 + 3], acc[r]);
          }
        }
      }
      __builtin_amdgcn_wave_barrier();
      asm volatile("s_waitcnt lgkmcnt(0)" ::: "memory");
#pragma unroll
      for (int r = 0; r < 4; r++) { s[r] = acc[r]; Sc[(row0 + r) * 64 + lane] = acc[r]; }
    }
  }
}
__device__ __forceinline__ void phase_scan3(const Params& P, unsigned char* smem, int bid, int nb) {
  const int lane = threadIdx.x & 63, w = __builtin_amdgcn_readfirstlane((int)(threadIdx.x >> 6));
  float* ws = (float*)smem + w * (TS * REC + 64);
  float* Sloc = P.out + OUT_WV_S;
  const int hb = nb >> 1;
  if (bid < hb) {
    for (int u = w * hb + bid; u < NBH * NC; u += 4 * hb) {
      const int bh = u >> 5, c = u & 31;
      const int tok0 = (bh >> 4) * TP + c * CL, h = bh & 15;
      const float* ip = (c > 0) ? (Sloc + (size_t)(bh * (NC - 1) + c - 1) * 4096) : nullptr;
      float* fin = (c == NC - 1) ? (P.out + OUT_WKV_P + (size_t)bh * 4096) : nullptr;
      if (c > 0) scan_unit<2, true, true>(P, ws, lane, tok0, CL, h, ip, fin);
      else scan_unit<0, true, true>(P, ws, lane, tok0, CL, h, ip, fin);
    }
  } else {
    for (int sb = w * (nb - hb) + (bid - hb); sb < 2048; sb += 4 * (nb - hb))
      scan_unit<2, true, true>(P, ws, lane, NPR + (sb >> 4) * 8, 8, sb & 15, P.state_wkv + (size_t)sb * 4096, P.out + OUT_WKV_S + (size_t)sb * 4096);
    __syncthreads();
    late_weight_prep(P, smem, bid - hb, nb - hb);
  }
}

__device__ __forceinline__ void phase_ln(const Params& P, int layer, int bid, int nb) {
  const int lane = threadIdx.x & 63, w = __builtin_amdgcn_readfirstlane((int)(threadIdx.x >> 6));
  const float* gg = P.ln_g + layer * DM; const float* bb = P.ln_b + layer * DM;
  for (int tok = bid * 4 + w; tok < NTOK; tok += nb * 4) {
    f32x4* row = (f32x4*)(P.out + OUT_Y + (size_t)tok * DM);
    f32x4 v[4];
    float sum = 0.f;
#pragma unroll
    for (int i = 0; i < 4; i++) { v[i] = row[lane + 64 * i]; sum += v[i][0] + v[i][1] + v[i][2] + v[i][3]; }
    const float mean = wave_sum(sum) * (1.f / 1024.f);
    float sq = 0.f;
#pragma unroll
    for (int i = 0; i < 4; i++) { v[i] -= mean; sq += v[i][0] * v[i][0] + v[i][1] * v[i][1] + v[i][2] * v[i][2] + v[i][3] * v[i][3]; }
    const float rs = rsqrtf(wave_sum(sq) * (1.f / 1024.f) + 1e-5f);
#pragma unroll
    for (int i = 0; i < 4; i++) {
      const f32x4 g4 = ((const f32x4*)gg)[lane + 64 * i], b4 = ((const f32x4*)bb)[lane + 64 * i];
      const f32x4 o = v[i] * rs * g4 + b4;
      if (layer != 0) row[lane + 64 * i] = o;
      if (layer == 0) { uint2 ob; ob.x = pack2(o[0], o[1]); ob.y = pack2(o[2], o[3]); ((uint2*)(P.Rb + (size_t)tok * DM))[lane + 64 * i] = ob; }
    }
  }
}

__device__ __forceinline__ void attn_prompt_item(const Params& P, unsigned char* smem, int item) {
  const int qh = item & 1, hk = (item >> 1) & 3, n = (item >> 3) & 63, b = item >> 9;
  bf16_t* Ks = (bf16_t*)smem;
  bf16_t* Vs = Ks + 192 * 72;
  const bf16_t* K1 = P.XB; const bf16_t* VT1 = P.XB + (size_t)NTOK * 512;
  const bf16_t* Q1 = P.Kb; const bf16_t* G1 = P.Vb; bf16_t* AO = P.Gb;
  const int t = threadIdx.x, lane = t & 63, w = t >> 6;
  const int g = lane >> 4, lc = lane & 15;
  const int pos0 = (n - 1) * 128 + 64 * qh;
  __syncthreads();
#pragma unroll
  for (int i = 0; i < 6; i++) {
    const int idx = t + 256 * i; const int row = idx >> 3, ch = idx & 7; const int pos = pos0 + row;
    uint4 v = make_uint4(0, 0, 0, 0);
    if (pos >= 0) v = *(const uint4*)(K1 + ((size_t)(b * TP + pos)) * 256 + hk * 64 + ch * 8);
    *(uint4*)(Ks + row * 72 + ch * 8) = v;
  }
#pragma unroll
  for (int i = 0; i < 6; i++) {
    const int idx = t + 256 * i; const int d = idx / 24, ch = idx % 24; const int pos = pos0 + ch * 8;
    uint4 v = make_uint4(0, 0, 0, 0);
    if (pos >= 0) v = *(const uint4*)(VT1 + ((size_t)((b * 4 + hk) * 64 + d)) * TP + pos);
    *(uint4*)(Vs + d * 200 + ch * 8) = v;
  }
  __syncthreads();
  const int h = hk * 4 + w;
  const float slope = exp2f(-0.5f * (float)(h + 1));
  const float sink = P.att_sinks[h];
  for (int sb = 0; sb < 2; sb++) {
    const int i0 = 64 * qh + 32 * sb;
    const int tokb = b * TP + n * 128 + i0;
    bf16x8 qf[2][2];
#pragma unroll
    for (int nn = 0; nn < 2; nn++)
#pragma unroll
      for (int ks = 0; ks < 2; ks++) qf[nn][ks] = *(const bf16x8*)(Q1 + (size_t)(tokb + 16 * nn + lc) * DM + h * 64 + ks * 32 + g * 8);
    float mrun[2] = {sink, sink}, lrun[2] = {1.f, 1.f};
    f32x4 O[4][2];
#pragma unroll
    for (int dm = 0; dm < 4; dm++) { O[dm][0] = (f32x4){0.f, 0.f, 0.f, 0.f}; O[dm][1] = (f32x4){0.f, 0.f, 0.f, 0.f}; }
    for (int kt = 0; kt < 3; kt++) {
      if (n == 0 && (qh + kt) < 2) continue;
      f32x4 S[4][2];
#pragma unroll
      for (int mm = 0; mm < 4; mm++) { S[mm][0] = (f32x4){0.f, 0.f, 0.f, 0.f}; S[mm][1] = (f32x4){0.f, 0.f, 0.f, 0.f}; }
#pragma unroll
      for (int ks = 0; ks < 2; ks++)
#pragma unroll
        for (int mm = 0; mm < 4; mm++) {
          const bf16x8 kf = *(const bf16x8*)(Ks + (kt * 64 + mm * 16 + lc) * 72 + ks * 32 + g * 8);
          S[mm][0] = __builtin_amdgcn_mfma_f32_16x16x32_bf16(kf, qf[0][ks], S[mm][0], 0, 0, 0);
          S[mm][1] = __builtin_amdgcn_mfma_f32_16x16x32_bf16(kf, qf[1][ks], S[mm][1], 0, 0, 0);
        }
#pragma unroll
      for (int nn = 0; nn < 2; nn++) {
        const int qi = i0 + 16 * nn + lc;
        float mx = mrun[nn];
#pragma unroll
        for (int mm = 0; mm < 4; mm++)
#pragma unroll
          for (int r = 0; r < 4; r++) {
            const int j = 64 * (qh + kt) + 16 * mm + 4 * g + r;
            const int dist = 128 + qi - j;
            const bool live = (dist >= 0) && (dist < 128);
            const float sv = live ? (S[mm][nn][r] * 0.125f - slope * (float)dist) : -1e30f;
            S[mm][nn][r] = sv; mx = fmaxf(mx, sv);
          }
        mx = fmaxf(mx, __shfl_xor(mx, 16)); mx = fmaxf(mx, __shfl_xor(mx, 32));
        const float corr = __expf(mrun[nn] - mx); mrun[nn] = mx;
        float sum = 0.f;
#pragma unroll
        for (int mm = 0; mm < 4; mm++)
#pragma unroll
          for (int r = 0; r < 4; r++) { const float pp = __expf(S[mm][nn][r] - mx); S[mm][nn][r] = pp; sum += pp; }
        sum += __shfl_xor(sum, 16); sum += __shfl_xor(sum, 32);
        lrun[nn] = lrun[nn] * corr + sum;
#pragma unroll
        for (int dm = 0; dm < 4; dm++) { O[dm][nn][0] *= corr; O[dm][nn][1] *= corr; O[dm][nn][2] *= corr; O[dm][nn][3] *= corr; }
      }
#pragma unroll
      for (int k2 = 0; k2 < 2; k2++) {
        bf16x8 pf[2];
#pragma unroll
        for (int nn = 0; nn < 2; nn++) {
          const unsigned u0 = pack2(S[2 * k2][nn][0], S[2 * k2][nn][1]), u1 = pack2(S[2 * k2][nn][2], S[2 * k2][nn][3]);
          const unsigned u2 = pack2(S[2 * k2 + 1][nn][0], S[2 * k2 + 1][nn][1]), u3 = pack2(S[2 * k2 + 1][nn][2], S[2 * k2 + 1][nn][3]);
          const uint4 uu = make_uint4(u0, u1, u2, u3);
          pf[nn] = *(const bf16x8*)&uu;
        }
#pragma unroll
        for (int dm = 0; dm < 4; dm++) {
          const bf16_t* vb = Vs + (dm * 16 + lc) * 200 + kt * 64 + k2 * 32 + 4 * g;
          const uint2 lo = *(const uint2*)vb, hi = *(const uint2*)(vb + 16);
          const uint4 uu = make_uint4(lo.x, lo.y, hi.x, hi.y);
          const bf16x8 vf = *(const bf16x8*)&uu;
          O[dm][0] = __builtin_amdgcn_mfma_f32_16x16x32_bf16(vf, pf[0], O[dm][0], 0, 0, 0);
          O[dm][1] = __builtin_amdgcn_mfma_f32_16x16x32_bf16(vf, pf[1], O[dm][1], 0, 0, 0);
        }
      }
    }
#pragma unroll
    for (int nn = 0; nn < 2; nn++) {
      const float inv = 1.f / lrun[nn];
      const size_t tok = (size_t)(tokb + 16 * nn + lc);
#pragma unroll
      for (int dm = 0; dm < 4; dm++) {
        const int d = dm * 16 + 4 * g;
        const uint2 gv = *(const uint2*)(G1 + tok * DM + h * 64 + d);
        const float g0 = __uint_as_float(gv.x << 16), g1 = __uint_as_float(gv.x & 0xffff0000u);
        const float g2 = __uint_as_float(gv.y << 16), g3 = __uint_as_float(gv.y & 0xffff0000u);
        uint2 o;
        o.x = pack2(O[dm][nn][0] * inv * g0 * sigmoidf_(g0), O[dm][nn][1] * inv * g1 * sigmoidf_(g1));
        o.y = pack2(O[dm][nn][2] * inv * g2 * sigmoidf_(g2), O[dm][nn][3] * inv * g3 * sigmoidf_(g3));
        *(uint2*)(AO + tok * DM + h * 64 + d) = o;
      }
    }
  }
}

__device__ __forceinline__ void attn_sample_item(const Params& P, unsigned char* smem, int item) {
  const int b = item >> 2, hk = item & 3;
  const int t = threadIdx.x, lane = t & 63, w = t >> 6;
  float* kv = (float*)smem;
  float* qs = kv + 136 * 65 + w * 512;
  float* ps = kv + 136 * 65 + 2048 + w * (8 * 136);
  const bf16_t* K1 = P.XB; const bf16_t* V1 = P.XB + (size_t)NTOK * 256;
  const bf16_t* Q1 = P.Kb; const bf16_t* G1 = P.Vb; bf16_t* AO = P.Gb;
  const int h = hk * 4 + w;
  const float slope = exp2f(-0.5f * (float)(h + 1));
  const float sink = P.att_sinks[h];
  const int tok0 = NPR + b * 8;
  __syncthreads();
#pragma unroll 2
  for (int it = 0; it < 8; it++) {
    const int idx = t + 256 * it; const int row = idx >> 4, c4 = idx & 15;
    const size_t so = ((size_t)(b * 128 + row)) * 256 + hk * 64 + c4 * 4;
    const float4 kx = *(const float4*)(P.cache_k + so);
    const float4 vx = *(const float4*)(P.cache_v + so);
    float* kd = kv + row * 65 + c4 * 4;
    kd[0] = kx.x; kd[1] = kx.y; kd[2] = kx.z; kd[3] = kx.w;
    if (row >= 8) {
      const size_t dofs = ((size_t)(b * 128 + row - 8)) * 256 + hk * 64 + c4 * 4;
      *(float4*)(P.out + OUT_WK_S + dofs) = kx;
      *(float4*)(P.out + OUT_WV_S + dofs) = vx;
    }
  }
#pragma unroll
  for (int it = 0; it < 2; it++) {
    const int idx = t + 256 * it; const int r8 = idx >> 6, d = idx & 63;
    kv[(128 + r8) * 65 + d] = bf2f(K1[(size_t)(tok0 + r8) * 256 + hk * 64 + d]);
  }
#pragma unroll
  for (int i = 0; i < 8; i++) qs[i * 64 + lane] = bf2f(Q1[(size_t)(tok0 + i) * DM + h * 64 + lane]);
  __syncthreads();
  float sc[3][8];
#pragma unroll
  for (int ksel = 0; ksel < 3; ksel++) {
    float acc[8];
#pragma unroll
    for (int i = 0; i < 8; i++) acc[i] = 0.f;
    const float* kr = kv + ((ksel < 2) ? (lane + 64 * ksel) : (128 + (lane & 7))) * 65;
#pragma unroll 2
    for (int d4 = 0; d4 < 16; d4++) {
      const float k0 = kr[4 * d4], k1 = kr[4 * d4 + 1], k2 = kr[4 * d4 + 2], k3 = kr[4 * d4 + 3];
#pragma unroll
      for (int i = 0; i < 8; i++) {
        const float4 qv = *(const float4*)(qs + i * 64 + 4 * d4);
        acc[i] = fmaf(qv.x, k0, acc[i]); acc[i] = fmaf(qv.y, k1, acc[i]); acc[i] = fmaf(qv.z, k2, acc[i]); acc[i] = fmaf(qv.w, k3, acc[i]);
      }
    }
#pragma unroll
    for (int i = 0; i < 8; i++) {
      int dist; bool live;
      if (ksel < 2) { const int j = lane + 64 * ksel; dist = 128 + i - j; live = (j > i); }
      else { dist = i - lane; live = (lane <= i); }
      sc[ksel][i] = live ? (acc[i] * 0.125f - slope * (float)dist) : -1e30f;
    }
  }
#pragma unroll
  for (int i = 0; i < 8; i++) {
    float mx = fmaxf(fmaxf(sc[0][i], sc[1][i]), sc[2][i]);
    mx = fmaxf(wave_max(mx), sink);
    const float p0 = __expf(sc[0][i] - mx), p1 = __expf(sc[1][i] - mx), p2 = __expf(sc[2][i] - mx);
    const float den = wave_sum(p0 + p1 + p2) + __expf(sink - mx);
    const float inv = 1.f / den;
    ps[i * 136 + lane] = p0 * inv; ps[i * 136 + 64 + lane] = p1 * inv;
    if (lane < 8) ps[i * 136 + 128 + lane] = p2 * inv;
  }
  __syncthreads();
#pragma unroll 4
  for (int it = 0; it < 8; it++) {
    const int idx = t + 256 * it; const int row = idx >> 4, c4 = idx & 15;
    *(float4*)(kv + row * 64 + c4 * 4) = *(const float4*)(P.cache_v + ((size_t)(b * 128 + row)) * 256 + hk * 64 + c4 * 4);
  }
#pragma unroll
  for (int it = 0; it < 2; it++) {
    const int idx = t + 256 * it; const int r8 = idx >> 6, d = idx & 63;
    kv[(128 + r8) * 64 + d] = bf2f(V1[(size_t)(tok0 + r8) * 256 + hk * 64 + d]);
  }
  __syncthreads();
  float o[8];
#pragma unroll
  for (int i = 0; i < 8; i++) o[i] = 0.f;
#pragma unroll 2
  for (int j0 = 0; j0 < 136; j0 += 4) {
    const float v0 = kv[(j0) * 64 + lane], v1 = kv[(j0 + 1) * 64 + lane], v2 = kv[(j0 + 2) * 64 + lane], v3 = kv[(j0 + 3) * 64 + lane];
#pragma unroll
    for (int i = 0; i < 8; i++) {
      const float4 pa = *(const float4*)(ps + i * 136 + j0);
      o[i] = fmaf(pa.x, v0, o[i]); o[i] = fmaf(pa.y, v1, o[i]); o[i] = fmaf(pa.z, v2, o[i]); o[i] = fmaf(pa.w, v3, o[i]);
    }
  }
#pragma unroll
  for (int i = 0; i < 8; i++) {
    const size_t off = (size_t)(tok0 + i) * DM + h * 64 + lane;
    const float gt = bf2f(G1[off]);
    AO[off] = f2bf(o[i] * gt * sigmoidf_(gt));
  }
}
__device__ __forceinline__ void phase_attn(const Params& P, unsigned char* smem, int bid, int nb) {
#if PROBE == 7
  for (int item = bid; item < 1024; item += nb) attn_prompt_item(P, smem, item);
#elif PROBE == 8
  for (int item = bid; item < 512; item += nb) attn_sample_item(P, smem, item);
#endif
  for (int item = bid; item < 1024 + 512; item += nb) {
    if (item < 1024) attn_prompt_item(P, smem, item);
    else attn_sample_item(P, smem, item - 1024);
  }
}

#if MULTI_LAUNCH
#define PH_BARRIER(ph)
#else
#define PH_BARRIER(ph) do { if ((ph) + 1 < P.phase_end) xcd_barrier(xb); } while (0)
#endif
#define RUN_PH(ph, call) do { if (P.phase_begin <= (ph) && (ph) < P.phase_end) { if ((REPMASK >> (ph)) & 1) { call; PH_BARRIER(ph); } call; PH_BARRIER(ph); } } while (0)

__global__ void __launch_bounds__(256, 2) fwd_kernel(Params P) {
  __shared__ __attribute__((aligned(16))) unsigned char smem[SMEM_BYTES];
  const int bid = blockIdx.x, nb = gridDim.x;
#if !MULTI_LAUNCH
  __shared__ uint4 xb_words;
  if (threadIdx.x == 0) xb_words = make_uint4(0u, 0u, 0u, 0u);
  __syncthreads();
  XcdBarrier xb = xcd_barrier_post(P.bar, (volatile LAS unsigned*)&xb_words);
#endif
#if (PHMASK >> 0) & 1
  RUN_PH(0, phase_prep(P, smem, bid, nb));
#endif
#if (PHMASK >> 1) & 1
  RUN_PH(1, gemm1_part(P, smem, 0, bid, nb));
#endif
#if (PHMASK >> 2) & 1
  RUN_PH(2, gemm_phase<2>(P, smem, bid, nb));
#endif
#if (PHMASK >> 3) & 1
  RUN_PH(3, phase_scan1(P, smem, bid, nb));
#endif
#if (PHMASK >> 4) & 1
  RUN_PH(4, phase_scan2(P, smem, bid, nb));
#endif
#if (PHMASK >> 5) & 1
  RUN_PH(5, phase_scan3(P, smem, bid, nb));
#endif
#if (PHMASK >> 6) & 1
  RUN_PH(6, gemm_phase<3>(P, smem, bid, nb));
#endif
#if (PHMASK >> 7) & 1
  RUN_PH(7, phase_ln(P, 0, bid, nb));
#endif
#if (PHMASK >> 8) & 1
  RUN_PH(8, gemm_phase<4>(P, smem, bid, nb));
#endif
#if (PHMASK >> 9) & 1
  RUN_PH(9, phase_attn(P, smem, bid, nb));
#endif
#if (PHMASK >> 10) & 1
  RUN_PH(10, gemm_phase<5>(P, smem, bid, nb));
#endif
#if (PHMASK >> 11) & 1
  RUN_PH(11, phase_ln(P, 1, bid, nb));
#endif
#if PROBE && PROBE < 7
  xcd_barrier(xb);
  gemm_phase<6>(P, smem, bid, nb);
#endif
#if !MULTI_LAUNCH
  if (P.phase_end > NPHASE) cg::this_grid().sync();
#endif
}

extern "C" void kernel_launch(void* const* d_in, const int* in_sizes, int n_in, void* d_out, int out_size, void* d_ws, size_t ws_size, hipStream_t stream) {
  Params P{};
  P.x_prompt = (const float*)d_in[0]; P.x_sample = (const float*)d_in[1]; P.state_wkv = (const float*)d_in[2]; P.state_shift = (const float*)d_in[3];
  P.cache_k = (const float*)d_in[4]; P.cache_v = (const float*)d_in[5]; P.ln_g = (const float*)d_in[6]; P.ln_b = (const float*)d_in[7];
  P.mu = (const float*)d_in[8]; P.w_in = (const float*)d_in[9]; P.w0 = (const float*)d_in[10]; P.w1 = (const float*)d_in[11]; P.w2 = (const float*)d_in[12];
  P.a0 = (const float*)d_in[13]; P.a1 = (const float*)d_in[14]; P.a2 = (const float*)d_in[15]; P.k_k = (const float*)d_in[16]; P.k_a = (const float*)d_in[17];
  P.r_k = (const float*)d_in[18]; P.gn_g = (const float*)d_in[19]; P.gn_b = (const float*)d_in[20]; P.w_out = (const float*)d_in[21];
  P.att_w_in = (const float*)d_in[22]; P.att_sinks = (const float*)d_in[23]; P.att_w_out = (const float*)d_in[24];
  P.out = (float*)d_out;
  unsigned char* ws = (unsigned char*)d_ws;
  size_t off = 0;
  auto take = [&](size_t bytes) { unsigned char* p = ws + off; off += (bytes + 255) & ~(size_t)255; return p; };
  P.bar = (unsigned*)take(16384);
  P.WtIn0 = (bf16_t*)take((size_t)4352 * DM * 2);
  P.W2t = (bf16_t*)take((size_t)DM * 64 * 2);
  P.A2t = (bf16_t*)take((size_t)DM * 64 * 2);
  P.WtOut0 = (bf16_t*)take((size_t)DM * DM * 2);
  P.WtIn1 = (bf16_t*)take((size_t)2560 * DM * 2);
  P.WtOut1 = (bf16_t*)take((size_t)DM * DM * 2);
  P.XB = (bf16_t*)take((size_t)NTOK * DM * 2);
  P.XXB = (bf16_t*)take((size_t)NTOK * DM * 2);
  P.Rb = (bf16_t*)take((size_t)NTOK * DM * 2);
  P.Kb = (bf16_t*)take((size_t)NTOK * DM * 2);
  P.Vb = (bf16_t*)take((size_t)NTOK * DM * 2);
  P.Gb = (bf16_t*)take((size_t)NTOK * DM * 2);
  P.H1 = (bf16_t*)take((size_t)NTOK * 64 * 2);
  P.H2 = (bf16_t*)take((size_t)NTOK * 64 * 2);
  P.MU16 = (bf16_t*)take((size_t)6 * DM * 2);
  P.INVN = (float*)take((size_t)NTOK * 16 * 4);
  if (off > ws_size) { fprintf(stderr, "workspace too small: need %zu have %zu\n", off, ws_size); return; }
#if MULTI_LAUNCH
  for (int ph = 0; ph < NPHASE; ph++) {
    P.phase_begin = ph; P.phase_end = ph + 1;
    hipLaunchKernelGGL(fwd_kernel, dim3(512), dim3(256), 0, stream, P);
  }
#else
  static int grid_blocks = 0;
  if (!grid_blocks) {
    int dev = 0, cus = 0, per_cu = 0;
    hipGetDevice(&dev);
    hipDeviceGetAttribute(&cus, hipDeviceAttributeMultiprocessorCount, dev);
    hipOccupancyMaxActiveBlocksPerMultiprocessor(&per_cu, fwd_kernel, 256, 0);
    if (per_cu > 2) per_cu = 2;
    if (per_cu < 1) per_cu = 1;
    grid_blocks = cus * per_cu;
  }
  hipMemsetAsync(P.bar, 0, 16384, stream);
  P.phase_begin = 0; P.phase_end = NPHASE;
  void* args[] = {&P};
  hipError_t e = hipLaunchCooperativeKernel((void*)fwd_kernel, dim3(grid_blocks), dim3(256), args, 0, stream);
  if (e != hipSuccess) fprintf(stderr, "cooperative launch failed: %s (grid %d)\n", hipGetErrorString(e), grid_blocks);
#endif
}
```

```cpp
#include <hip/hip_runtime.h>
#include <hip/hip_cooperative_groups.h>
#include <stdint.h>
#include <cstdio>
namespace cg = cooperative_groups;

#ifndef PHMASK
#define PHMASK 0xFFF
#endif
#ifndef USE_BIG
#define USE_BIG 1
#endif
#ifndef PROBE
#define PROBE 0
#endif
#ifndef REPMASK
#define REPMASK 0
#endif
#ifndef MULTI_LAUNCH
#define MULTI_LAUNCH 0
#endif

typedef unsigned short bf16_t;
typedef _Float16 f16_t;
typedef __attribute__((ext_vector_type(8))) short bf16x8;
typedef __attribute__((ext_vector_type(4))) float f32x4;
typedef __attribute__((ext_vector_type(4))) unsigned u32x4;

#define DM 1024
#define NTOK 17408
#define NPR 16384
#define TP 8192
#define NC 32
#define CL 256
#define NBH 32
#define ALPHA_F 1.41421356237f
#define SMEM_BYTES (61 * 1024)
#define NPHASE 12

#define OUT_Y 0
#define OUT_WKV_P 17825792
#define OUT_SH_P 17956864
#define OUT_WK_P 17958912
#define OUT_WV_P 18024448
#define OUT_WKV_S 18089984
#define OUT_SH_S 26478592
#define OUT_WK_S 26609664
#define OUT_WV_S 30803968

struct Params {
  const float *x_prompt, *x_sample, *state_wkv, *state_shift, *cache_k, *cache_v, *ln_g, *ln_b;
  const float *mu, *w_in, *w0, *w1, *w2, *a0, *a1, *a2, *k_k, *k_a, *r_k, *gn_g, *gn_b, *w_out;
  const float *att_w_in, *att_sinks, *att_w_out;
  float* out;
  unsigned* bar;
  bf16_t *WtIn0, *W2t, *A2t, *WtOut0, *WtIn1, *WtOut1;
  bf16_t *XB, *XXB;
  bf16_t *Rb, *Kb, *Vb, *Gb;
  bf16_t *H1, *H2, *MU16;
  float* INVN;
  int phase_begin, phase_end;
};

typedef __bf16 hbf2 __attribute__((ext_vector_type(2)));
typedef float f32x2_ __attribute__((ext_vector_type(2)));
__device__ __forceinline__ unsigned pack2(float a, float b) {
  const f32x2_ v = {a, b};
  return __builtin_bit_cast(unsigned, __builtin_convertvector(v, hbf2));
}
__device__ __forceinline__ bf16_t f2bf(float f) { return (bf16_t)(pack2(f, 0.f) & 0xffffu); }
__device__ __forceinline__ float bf2f(bf16_t h) { return __uint_as_float(((unsigned)h) << 16); }
__device__ __forceinline__ float wave_sum(float x) {
#pragma unroll
  for (int o = 32; o >= 1; o >>= 1) x += __shfl_xor(x, o);
  return x;
}
__device__ __forceinline__ float wave_max(float x) {
#pragma unroll
  for (int o = 32; o >= 1; o >>= 1) x = fmaxf(x, __shfl_xor(x, o));
  return x;
}
__device__ __forceinline__ float quad_sum(float x) {
  x += __builtin_bit_cast(float, __builtin_amdgcn_update_dpp(0, __builtin_bit_cast(int, x), 0xB1, 0xF, 0xF, true));
  x += __builtin_bit_cast(float, __builtin_amdgcn_update_dpp(0, __builtin_bit_cast(int, x), 0x4E, 0xF, 0xF, true));
  return x;
}
__device__ __forceinline__ float sigmoidf_(float x) { return __builtin_amdgcn_rcpf(1.f + __expf(-x)); }
__device__ __forceinline__ const float* xin_row(const Params& P, int m) {
  return (m < NPR) ? (P.x_prompt + (size_t)m * DM) : (P.x_sample + (size_t)(m - NPR) * DM);
}

#define XB_TMO      128
#define XB_XCNT(j)  (256  + 64 * (j))
#define XB_XSUB(j)  (1280 + 64 * (j))
#define XB_XGEN(j)  (2304 + 64 * (j))
#define XB_TOP      3328
#define XB_TOPGEN   3392
#define XCD_BAR_WORDS 3456
#define XB_SPIN_CAP (1u << 22)
#define LAS __attribute__((address_space(3)))
__device__ __forceinline__ unsigned xb_ld(unsigned* p) { return __hip_atomic_load(p, __ATOMIC_RELAXED, __HIP_MEMORY_SCOPE_AGENT); }
__device__ __forceinline__ unsigned xb_add(unsigned* p, unsigned v) { return __hip_atomic_fetch_add(p, v, __ATOMIC_RELAXED, __HIP_MEMORY_SCOPE_AGENT); }
__device__ __forceinline__ unsigned xb_xcc_id() { return (unsigned)__builtin_amdgcn_s_getreg((3 << 11) | 20) & 0xFu; }
#define XB_SPIN(cond, bar) do { unsigned _sp = 0; while (cond) { __builtin_amdgcn_s_sleep(1); \
    if ((++_sp & 255u) == 0u) { if (xb_ld(&(bar)[XB_TMO])) break; if (_sp > XB_SPIN_CAP) { atomicAdd(&(bar)[XB_TMO], 1u); break; } } } } while (0)
struct XcdBarrier { unsigned* bar; unsigned x; volatile LAS unsigned* st; };
__device__ __forceinline__ XcdBarrier xcd_barrier_post(unsigned* bar, volatile LAS unsigned* st) {
  XcdBarrier b; b.bar = bar; b.x = xb_xcc_id(); b.st = st;
  if (threadIdx.x == 0) (void)xb_add(&bar[XB_XCNT(b.x)], 1u);
  return b;
}
__device__ __forceinline__ void xcd_barrier_complete(unsigned* bar, unsigned x, unsigned& nloc, unsigned& nx) {
  const unsigned G = gridDim.x * gridDim.y * gridDim.z;
  unsigned sum, cnt, mine, sp = 0u;
  for (;;) {
    sum = 0u; cnt = 0u; mine = 0u;
#pragma unroll
    for (unsigned j = 0; j < 16; ++j) { const unsigned c = xb_ld(&bar[XB_XCNT(j)]); sum += c; cnt += (c > 0u) ? 1u : 0u; mine = (j == x) ? c : mine; }
    if (sum == G) break;
    __builtin_amdgcn_s_sleep(1);
    if ((++sp & 255u) == 0u) { if (xb_ld(&bar[XB_TMO])) break; if (sp > XB_SPIN_CAP) { atomicAdd(&bar[XB_TMO], 1u); break; } }
  }
  nloc = mine > 0u ? mine : 1u; nx = cnt > 0u ? cnt : 1u;
}
__device__ __forceinline__ void xcd_barrier(const XcdBarrier& b) {
  asm volatile("s_waitcnt vmcnt(0)" ::: "memory");
  __syncthreads();
  if (threadIdx.x == 0) {
    unsigned* bar = b.bar;
    __builtin_amdgcn_s_waitcnt(0);
    unsigned nloc = b.st[0], nx = b.st[1];
    if (nloc == 0u) { xcd_barrier_complete(bar, b.x, nloc, nx); b.st[0] = nloc; b.st[1] = nx; }
    const unsigned old = xb_add(&bar[XB_XSUB(b.x)], 1u);
    const unsigned gen = old / nloc;
    if (old + 1u == (gen + 1u) * nloc) {
      __builtin_amdgcn_fence(__ATOMIC_RELEASE, "agent");
      asm volatile("s_waitcnt vmcnt(0)" ::: "memory");
      const unsigned og = xb_add(&bar[XB_TOP], 1u);
      const unsigned tg = og / nx;
      if (og + 1u == (tg + 1u) * nx) xb_add(&bar[XB_TOPGEN], 1u);
      else XB_SPIN(xb_ld(&bar[XB_TOPGEN]) == tg, bar);
      __builtin_amdgcn_fence(__ATOMIC_ACQUIRE, "agent");
      xb_add(&bar[XB_XGEN(b.x)], 1u);
      asm volatile("s_waitcnt vmcnt(0)" ::: "memory");
    } else {
      XB_SPIN(xb_ld(&bar[XB_XGEN(b.x)]) == gen, bar);
      __builtin_amdgcn_fence(__ATOMIC_ACQUIRE, "agent");
      asm volatile("s_waitcnt vmcnt(0)" ::: "memory");
    }
  }
  __syncthreads();
}

__device__ __forceinline__ unsigned short f2h_bits(float f) { const _Float16 h = (_Float16)f; return __builtin_bit_cast(unsigned short, h); }
__device__ __forceinline__ unsigned pack2h(float a, float b) { return (unsigned)f2h_bits(a) | ((unsigned)f2h_bits(b) << 16); }
__device__ __forceinline__ void transpose_tile(const float* __restrict__ src, int ld, int k0, int n0, bf16_t* __restrict__ dst, int ldd, float* tile, bool half = false) {
  const int t = threadIdx.x;
  {
    const int n = t & 63, kq = t >> 6;
#pragma unroll 4
    for (int i = 0; i < 16; i++) { const int k = i * 4 + kq; tile[k * 65 + n] = src[(size_t)(k0 + k) * ld + n0 + n]; }
  }
  __syncthreads();
  {
    const int k = t & 63, nq = t >> 6;
#pragma unroll 4
    for (int i = 0; i < 16; i++) { const int n2 = i * 4 + nq; const float v_ = tile[k * 65 + n2]; dst[(size_t)(n0 + n2) * ldd + k0 + k] = half ? f2h_bits(v_) : f2bf(v_); }
  }
  __syncthreads();
}

__device__ __forceinline__ void late_weight_prep(const Params& P, unsigned char* smem, int first, int stride) {
  float* tile = (float*)smem;
  for (int id = 1088 + first; id < 2240; id += stride) {
    if (id < 1344) { const int r = id - 1088; transpose_tile(P.w_out, DM, (r >> 4) * 64, (r & 15) * 64, P.WtOut0, DM, tile); }
    else if (id < 1984) { const int r = id - 1344; transpose_tile(P.att_w_in, 2560, (r / 40) * 64, (r % 40) * 64, P.WtIn1, DM, tile); }
    else { const int r = id - 1984; transpose_tile(P.att_w_out, DM, (r >> 4) * 64, (r & 15) * 64, P.WtOut1, DM, tile); }
  }
}
__device__ __forceinline__ void phase_prep(const Params& P, unsigned char* smem, int bid, int nb) {
  float* tile = (float*)smem;
  const int t = threadIdx.x;
  const int NITEMS = 2242 + 4352 + 130;
  for (int id = bid; id < NITEMS; id += nb) {
    if (id < 1024) { const int p = id >> 8, r = id & 255; transpose_tile(P.w_in + (size_t)p * DM * DM, DM, (r >> 4) * 64, (r & 15) * 64, P.WtIn0 + (size_t)p * DM * DM, DM, tile, true); }
    else if (id < 1040) transpose_tile(P.w1, 64, (id - 1024) * 64, 0, P.WtIn0 + (size_t)4096 * DM, DM, tile, true);
    else if (id < 1056) transpose_tile(P.a1, 64, (id - 1040) * 64, 0, P.WtIn0 + (size_t)4224 * DM, DM, tile, true);
    else if (id < 1072) transpose_tile(P.w2, DM, 0, (id - 1056) * 64, P.W2t, 64, tile);
    else if (id < 1088) transpose_tile(P.a2, DM, 0, (id - 1072) * 64, P.A2t, 64, tile);
    else if (id < 2240) { }
    else if (id < 2242) {
      uint4* z = (uint4*)(P.WtIn0 + (size_t)(id == 2240 ? 4160 : 4288) * DM);
      for (int i = t; i < 8192; i += 256) z[i] = make_uint4(0, 0, 0, 0);
      if (id == 2240) for (int i = t; i < 6 * DM; i += 256) P.MU16[i] = f2h_bits(P.mu[i]);
    } else if (id < 2242 + 4352) {
      const int it = id - 2242;
#pragma unroll
      for (int q = 0; q < 4; q++) {
        const int m = it * 4 + q;
        const float4 x = ((const float4*)xin_row(P, m))[t];
        float4 pv = make_float4(0.f, 0.f, 0.f, 0.f);
        if (m < NPR) { if ((m & (TP - 1)) != 0) pv = ((const float4*)xin_row(P, m - 1))[t]; }
        else { const int ms = m - NPR; if ((ms & 7) != 0) pv = ((const float4*)xin_row(P, m - 1))[t]; else pv = ((const float4*)(P.state_shift + (size_t)(ms >> 3) * DM))[t]; }
        uint2 xb, xxb;
        xb.x = pack2h(x.x, x.y); xb.y = pack2h(x.z, x.w);
        xxb.x = pack2h(pv.x - x.x, pv.y - x.y); xxb.y = pack2h(pv.z - x.z, pv.w - x.w);
        ((uint2*)(P.XB + (size_t)m * DM))[t] = xb;
        ((uint2*)(P.XXB + (size_t)m * DM))[t] = xxb;
      }
    } else {
      const int r = id - (2242 + 4352);
      if (r < 2) ((float4*)(P.out + OUT_SH_P + (size_t)r * DM))[t] = ((const float4*)(P.x_prompt + ((size_t)r * TP + TP - 1) * DM))[t];
      else { const int b = r - 2; ((float4*)(P.out + OUT_SH_S + (size_t)b * DM))[t] = ((const float4*)(P.x_sample + ((size_t)b * 8 + 7) * DM))[t]; }
    }
  }
}

#define LDB 48
typedef _Float16 f16x8 __attribute__((ext_vector_type(8)));
typedef _Float16 f16x2 __attribute__((ext_vector_type(2)));
__device__ __forceinline__ unsigned xs16(unsigned x, unsigned d, unsigned m) {
  const f16x2 r = __builtin_elementwise_fma(__builtin_bit_cast(f16x2, d), __builtin_bit_cast(f16x2, m), __builtin_bit_cast(f16x2, x));
  return __builtin_bit_cast(unsigned, r);
}
template <int MODE>
__device__ __forceinline__ void gemm_tile(const Params& P, unsigned char* smem, int mt, int nt) {
  constexpr int KT = (MODE == 2) ? 1 : 16;
  bf16_t* Asb[2]; bf16_t* Bsb[2];
  Asb[0] = (bf16_t*)smem; Bsb[0] = Asb[0] + 128 * LDB; Asb[1] = Bsb[0] + 128 * LDB; Bsb[1] = Asb[1] + 128 * LDB;
  const int t = threadIdx.x, lane = t & 63, w = t >> 6;
  const int wm = w >> 1, wn = w & 1;
  const int g = lane >> 4, lc = lane & 15;
  const int lr = t >> 2, lc4 = t & 3;
  const int m0 = mt * 128, n0 = nt * 128;

  const bf16_t* Ap; const bf16_t* A2p = nullptr; const bf16_t* mup = nullptr; const bf16_t* Bp; int lda, ldb;
  if (MODE == 1) {
    const int p = (nt < 32) ? (nt >> 3) : (4 + (nt - 32));
    Ap = P.XB; A2p = P.XXB; lda = DM; mup = P.MU16 + (size_t)p * DM;
    Bp = P.WtIn0 + (size_t)((nt < 32) ? n0 : (4096 + (nt - 32) * 128)) * DM; ldb = DM;
  } else if (MODE == 2) {
    Ap = (nt < 8) ? P.H1 : P.H2; lda = 64;
    Bp = ((nt < 8) ? P.W2t : P.A2t) + (size_t)((nt & 7) * 128) * 64; ldb = 64;
  } else if (MODE == 3) { Ap = P.Gb; lda = DM; Bp = P.WtOut0 + (size_t)n0 * DM; ldb = DM; }
  else if (MODE == 4 || MODE == 6) { Ap = P.Rb; lda = DM; Bp = P.WtIn1 + (size_t)n0 * DM; ldb = DM; }
  else { Ap = P.Gb; lda = DM; Bp = P.WtOut1 + (size_t)n0 * DM; ldb = DM; }

  f32x4 acc[4][4];
#pragma unroll
  for (int i = 0; i < 4; i++)
#pragma unroll
    for (int j = 0; j < 4; j++) acc[i][j] = (f32x4){0.f, 0.f, 0.f, 0.f};

  u32x4 ra[2][2][2], rb[2][2][2], ra2[2][2][2], rmu[2][2];
  const unsigned voffA = (unsigned)(lr * lda + lc4 * 8) * 2u;
  const unsigned voffB = (unsigned)(lr * ldb + lc4 * 8) * 2u;
  const char* baseA = (const char*)(Ap + (size_t)m0 * lda);
  const char* baseA2 = (const char*)(A2p + (size_t)m0 * lda);
  const char* baseB = (const char*)Bp;
#define LOADH(S_, kt_, H_) do { if ((kt_) < KT) { \
    _Pragma("unroll") for (int ii_ = 0; ii_ < 2; ii_++) { \
      const size_t uo_ = ((size_t)(64 * ii_) * lda + (size_t)(kt_) * 64 + 32 * (H_)) * 2; \
      const size_t uob_ = ((size_t)(64 * ii_) * ldb + (size_t)(kt_) * 64 + 32 * (H_)) * 2; \
      ra[S_][H_][ii_] = *(const u32x4*)(baseA + uo_ + voffA); \
      if (MODE == 1) ra2[S_][H_][ii_] = *(const u32x4*)(baseA2 + uo_ + voffA); \
      rb[S_][H_][ii_] = *(const u32x4*)(baseB + uob_ + voffB); \
    } \
    if (MODE == 1) rmu[S_][H_] = *(const u32x4*)(mup + (kt_) * 64 + 32 * (H_) + lc4 * 8); \
  } } while (0)
#define STOREH(S_, H_, B_) do { \
    _Pragma("unroll") for (int ii_ = 0; ii_ < 2; ii_++) { \
      const int row_ = lr + 64 * ii_; \
      u32x4 av_ = ra[S_][H_][ii_]; \
      if (MODE == 1) { \
        const u32x4 xv_ = ra[S_][H_][ii_], dv_ = ra2[S_][H_][ii_], mv_ = rmu[S_][H_]; \
        av_ = (u32x4){xs16(xv_.x, dv_.x, mv_.x), xs16(xv_.y, dv_.y, mv_.y), xs16(xv_.z, dv_.z, mv_.z), xs16(xv_.w, dv_.w, mv_.w)}; \
      } \
      *(u32x4*)(Asb[B_] + row_ * LDB + lc4 * 8) = av_; \
      *(u32x4*)(Bsb[B_] + row_ * LDB + lc4 * 8) = rb[S_][H_][ii_]; \
    } \
  } while (0)
#define COMPUTE_SUB(B_) do { if (!(MODE == 6 && PROBE == 3)) { \
    bf16x8 af[4], bfr[4]; \
    _Pragma("unroll") for (int i = 0; i < 4; i++) af[i] = *(const bf16x8*)(Bsb[B_] + (wn * 64 + i * 16 + lc) * LDB + g * 8); \
    _Pragma("unroll") for (int j = 0; j < 4; j++) bfr[j] = *(const bf16x8*)(Asb[B_] + (wm * 64 + j * 16 + lc) * LDB + g * 8); \
    _Pragma("unroll") for (int i = 0; i < 4; i++) \
      _Pragma("unroll") for (int j = 0; j < 4; j++) { \
        if (MODE == 1) acc[i][j] = __builtin_amdgcn_mfma_f32_16x16x32_f16(__builtin_bit_cast(f16x8, af[i]), __builtin_bit_cast(f16x8, bfr[j]), acc[i][j], 0, 0, 0); \
        else acc[i][j] = __builtin_amdgcn_mfma_f32_16x16x32_bf16(af[i], bfr[j], acc[i][j], 0, 0, 0); \
      } \
  } } while (0)
  __syncthreads();
  LOADH(0, 0, 0); LOADH(0, 0, 1); LOADH(1, 1, 0); LOADH(1, 1, 1);
  STOREH(0, 0, 0);
  LOADH(0, 2, 0);
  __syncthreads();
  for (int kt = 0; kt < KT; kt += 2) {
    STOREH(0, 1, 1); LOADH(0, kt + 2, 1);
    COMPUTE_SUB(0);
    if (!(MODE == 6 && PROBE == 5)) __syncthreads();
    if (kt + 1 < KT) { STOREH(1, 0, 0); LOADH(1, kt + 3, 0); }
    COMPUTE_SUB(1);
    __syncthreads();
    if (kt + 1 < KT) {
      STOREH(1, 1, 1); LOADH(1, kt + 3, 1);
      COMPUTE_SUB(0);
      if (!(MODE == 6 && PROBE == 5)) __syncthreads();
      if (kt + 2 < KT) { STOREH(0, 0, 0); LOADH(0, kt + 4, 0); }
      COMPUTE_SUB(1);
      __syncthreads();
    }
  }
  if (MODE == 1 && nt >= 8 && nt < 16) {
    const int hh = (nt & 7) * 2 + wn;
    float kkw[4][4];
#pragma unroll
    for (int i = 0; i < 4; i++) { const float4 kq = *(const float4*)(P.k_k + hh * 64 + i * 16 + 4 * g); kkw[i][0] = kq.x; kkw[i][1] = kq.y; kkw[i][2] = kq.z; kkw[i][3] = kq.w; }
#pragma unroll
    for (int j = 0; j < 4; j++) {
      float ssq = 0.f;
#pragma unroll
      for (int i = 0; i < 4; i++) {
        const unsigned u0 = pack2(acc[i][j][0], acc[i][j][1]), u1 = pack2(acc[i][j][2], acc[i][j][3]);
        const float q0 = __uint_as_float(u0 << 16) * kkw[i][0], q1 = __uint_as_float(u0 & 0xffff0000u) * kkw[i][1];
        const float q2 = __uint_as_float(u1 << 16) * kkw[i][2], q3 = __uint_as_float(u1 & 0xffff0000u) * kkw[i][3];
        ssq = fmaf(q0, q0, ssq); ssq = fmaf(q1, q1, ssq); ssq = fmaf(q2, q2, ssq); ssq = fmaf(q3, q3, ssq);
      }
      ssq += __shfl_xor(ssq, 16); ssq += __shfl_xor(ssq, 32);
      if (g == 0) P.INVN[(size_t)(m0 + wm * 64 + j * 16 + lc) * 16 + hh] = __builtin_amdgcn_rsqf(fmaxf(ssq, 1e-24f));
    }
  }
#pragma unroll
  for (int i = 0; i < 4; i++) {
    const int nl = wn * 64 + i * 16 + 4 * g;
#pragma unroll
    for (int j = 0; j < 4; j++) {
      const int m = m0 + wm * 64 + j * 16 + lc;
      const f32x4 v = acc[i][j];
      if (MODE == 1) {
        if (nt < 32) {
          const int p = nt >> 3, c = (nt & 7) * 128 + nl;
          bf16_t* dst = (p == 0) ? P.Rb : (p == 1) ? P.Kb : (p == 2) ? P.Vb : P.Gb;
          uint2 o; o.x = pack2(v[0], v[1]); o.y = pack2(v[2], v[3]);
          *(uint2*)(dst + (size_t)m * DM + c) = o;
        } else if (nl < 64) {
          uint2 o;
          if (nt == 32) { o.x = pack2(tanhf(v[0]), tanhf(v[1])); o.y = pack2(tanhf(v[2]), tanhf(v[3])); *(uint2*)(P.H1 + (size_t)m * 64 + nl) = o; }
          else { o.x = pack2(v[0], v[1]); o.y = pack2(v[2], v[3]); *(uint2*)(P.H2 + (size_t)m * 64 + nl) = o; }
        }
      } else if (MODE == 2) {
        const int c = (nt & 7) * 128 + nl;
        f16_t o[4];
        if (nt < 8) {
          const float4 w0v = *(const float4*)(P.w0 + c);
          const float ws[4] = {w0v.x, w0v.y, w0v.z, w0v.w};
#pragma unroll
          for (int r = 0; r < 4; r++) o[r] = (f16_t)(sigmoidf_(ws[r] + v[r]) * 0.60653065971f);
          *(uint2*)(((f16_t*)(P.out + OUT_Y)) + (size_t)m * DM + c) = *(uint2*)o;
        } else {
          const float4 a0v = *(const float4*)(P.a0 + c);
          const float as_[4] = {a0v.x, a0v.y, a0v.z, a0v.w};
#pragma unroll
          for (int r = 0; r < 4; r++) o[r] = (f16_t)sigmoidf_(as_[r] + v[r]);
          *(uint2*)(((f16_t*)(P.out + OUT_Y) + (size_t)NTOK * DM) + (size_t)m * DM + c) = *(uint2*)o;
        }
      } else if (MODE == 3 || MODE == 5) {
        const int c = n0 + nl;
        float4 res;
        if (MODE == 3) res = *(const float4*)(xin_row(P, m) + c);
        else { const uint2 rb2 = *(const uint2*)(P.Rb + (size_t)m * DM + c); res = make_float4(__uint_as_float(rb2.x << 16), __uint_as_float(rb2.x & 0xffff0000u), __uint_as_float(rb2.y << 16), __uint_as_float(rb2.y & 0xffff0000u)); }
        float4 o = make_float4(v[0] + ALPHA_F * res.x, v[1] + ALPHA_F * res.y, v[2] + ALPHA_F * res.z, v[3] + ALPHA_F * res.w);
        *(float4*)(P.out + OUT_Y + (size_t)m * DM + c) = o;
      } else if (MODE == 6) {
        uint2 o; o.x = pack2(v[0], v[1]); o.y = pack2(v[2], v[3]);
        *(uint2*)(P.XB + (size_t)(m & 4095) * DM + ((n0 + nl) & 1023)) = o;
      } else if (MODE == 4) {
        uint2 o; o.x = pack2(v[0], v[1]); o.y = pack2(v[2], v[3]);
        if (nt < 8) { *(uint2*)(P.Kb + (size_t)m * DM + n0 + nl) = o; }
        else if (nt >= 12) { *(uint2*)(P.Vb + (size_t)m * DM + (nt - 12) * 128 + nl) = o; }
        else {
          const bool isk = nt < 10;
          const int ck = (nt & 1) * 128 + nl;
          bf16_t* K1 = P.XB; bf16_t* V1 = P.XB + (size_t)NTOK * 256; bf16_t* VT1 = P.XB + (size_t)NTOK * 512;
          *(uint2*)((isk ? K1 : V1) + (size_t)m * 256 + ck) = o;
          const float4 fo = make_float4(v[0], v[1], v[2], v[3]);
          if (m < NPR) {
            const int b = m >> 13, tt = m & (TP - 1);
            if (!isk) {
              const int hk = ck >> 6, d = ck & 63;
              bf16_t* vt = VT1 + ((size_t)((b * 4 + hk) * 64 + d)) * TP + tt;
              vt[0] = f2bf(v[0]); vt[TP] = f2bf(v[1]); vt[2 * TP] = f2bf(v[2]); vt[3 * TP] = f2bf(v[3]);
            }
            if (tt >= TP - 128) *(float4*)(P.out + (isk ? OUT_WK_P : OUT_WV_P) + ((size_t)(b * 128 + tt - (TP - 128))) * 256 + ck) = fo;
          } else {
            const int ms = m - NPR, b = ms >> 3, tt = ms & 7;
            *(float4*)(P.out + (isk ? OUT_WK_S : OUT_WV_S) + ((size_t)(b * 128 + 120 + tt)) * 256 + ck) = fo;
          }
        }
      }
    }
  }
}
#define LDBG 80
template <int MODE>
__device__ __forceinline__ void gemm_tile_big(const Params& P, unsigned char* smem, int mt, int nt) {
  bf16_t* As = (bf16_t*)smem;
  bf16_t* Bs = As + 256 * LDBG;
  const int t = threadIdx.x, lane = t & 63, w = __builtin_amdgcn_readfirstlane((int)(threadIdx.x >> 6));
  const int wm = w >> 1, wn = w & 1;
  const int g = lane >> 4, lc = lane & 15;
  const int lrow = t >> 3, lch = t & 7;
  const int m0 = mt * 256, n0 = nt * 128;
  const bf16_t* Ap = (MODE == 4) ? P.Rb : P.Gb;
  const bf16_t* Bp = ((MODE == 3) ? P.WtOut0 : (MODE == 4) ? P.WtIn1 : P.WtOut1) + (size_t)n0 * DM;
  f32x4 acc[4][8];
#pragma unroll
  for (int i = 0; i < 4; i++)
#pragma unroll
    for (int j = 0; j < 8; j++) acc[i][j] = (f32x4){0.f, 0.f, 0.f, 0.f};
  u32x4 ra[8], rb[4];
  const unsigned voff = (unsigned)(lrow * DM + lch * 8) * 2u;
  const char* baseA = (const char*)(Ap + (size_t)m0 * DM);
  const char* baseB = (const char*)Bp;
#define BIG_LOAD(kt_) do { \
    _Pragma("unroll") for (int i_ = 0; i_ < 8; i_++) ra[i_] = *(const u32x4*)(baseA + ((size_t)(32 * i_) * DM + (size_t)(kt_) * 64) * 2 + voff); \
    _Pragma("unroll") for (int i_ = 0; i_ < 4; i_++) rb[i_] = *(const u32x4*)(baseB + ((size_t)(32 * i_) * DM + (size_t)(kt_) * 64) * 2 + voff); \
  } while (0)
  BIG_LOAD(0);
  for (int kt = 0; kt < 16; kt++) {
    __syncthreads();
#pragma unroll
    for (int i = 0; i < 8; i++) *(u32x4*)(As + (lrow + 32 * i) * LDBG + lch * 8) = ra[i];
#pragma unroll
    for (int i = 0; i < 4; i++) *(u32x4*)(Bs + (lrow + 32 * i) * LDBG + lch * 8) = rb[i];
    __syncthreads();
    if (kt + 1 < 16) BIG_LOAD(kt + 1);
#pragma unroll
    for (int ks = 0; ks < 2; ks++) {
      bf16x8 af[4];
#pragma unroll
      for (int i = 0; i < 4; i++) af[i] = *(const bf16x8*)(Bs + (wn * 64 + i * 16 + lc) * LDBG + ks * 32 + g * 8);
#pragma unroll
      for (int jh = 0; jh < 2; jh++) {
        bf16x8 bfr[4];
#pragma unroll
        for (int j = 0; j < 4; j++) bfr[j] = *(const bf16x8*)(As + (wm * 128 + (jh * 4 + j) * 16 + lc) * LDBG + ks * 32 + g * 8);
#pragma unroll
        for (int i = 0; i < 4; i++)
#pragma unroll
          for (int j = 0; j < 4; j++) acc[i][jh * 4 + j] = __builtin_amdgcn_mfma_f32_16x16x32_bf16(af[i], bfr[j], acc[i][jh * 4 + j], 0, 0, 0);
      }
    }
  }
#pragma unroll
  for (int i = 0; i < 4; i++) {
    const int nl = wn * 64 + i * 16 + 4 * g;
#pragma unroll
    for (int j = 0; j < 8; j++) {
      const int m = m0 + wm * 128 + j * 16 + lc;
      const f32x4 v = acc[i][j];
      if (MODE == 3 || MODE == 5) {
        const int c = n0 + nl;
        float4 res;
        if (MODE == 3) res = *(const float4*)(xin_row(P, m) + c);
        else { const uint2 rb2 = *(const uint2*)(P.Rb + (size_t)m * DM + c); res = make_float4(__uint_as_float(rb2.x << 16), __uint_as_float(rb2.x & 0xffff0000u), __uint_as_float(rb2.y << 16), __uint_as_float(rb2.y & 0xffff0000u)); }
        *(float4*)(P.out + OUT_Y + (size_t)m * DM + c) = make_float4(v[0] + ALPHA_F * res.x, v[1] + ALPHA_F * res.y, v[2] + ALPHA_F * res.z, v[3] + ALPHA_F * res.w);
      } else {
        uint2 o; o.x = pack2(v[0], v[1]); o.y = pack2(v[2], v[3]);
        if (nt < 8) { *(uint2*)(P.Kb + (size_t)m * DM + n0 + nl) = o; }
        else if (nt >= 12) { *(uint2*)(P.Vb + (size_t)m * DM + (nt - 12) * 128 + nl) = o; }
        else {
          const bool isk = nt < 10;
          const int ck = (nt & 1) * 128 + nl;
          bf16_t* K1 = P.XB; bf16_t* V1 = P.XB + (size_t)NTOK * 256; bf16_t* VT1 = P.XB + (size_t)NTOK * 512;
          *(uint2*)((isk ? K1 : V1) + (size_t)m * 256 + ck) = o;
          const float4 fo = make_float4(v[0], v[1], v[2], v[3]);
          if (m < NPR) {
            const int b = m >> 13, tt = m & (TP - 1);
            if (!isk) {
              const int hk = ck >> 6, d = ck & 63;
              bf16_t* vt = VT1 + ((size_t)((b * 4 + hk) * 64 + d)) * TP + tt;
              vt[0] = f2bf(v[0]); vt[TP] = f2bf(v[1]); vt[2 * TP] = f2bf(v[2]); vt[3 * TP] = f2bf(v[3]);
            }
            if (tt >= TP - 128) *(float4*)(P.out + (isk ? OUT_WK_P : OUT_WV_P) + ((size_t)(b * 128 + tt - (TP - 128))) * 256 + ck) = fo;
          } else {
            const int ms = m - NPR, b = ms >> 3, tt = ms & 7;
            *(float4*)(P.out + (isk ? OUT_WK_S : OUT_WV_S) + ((size_t)(b * 128 + 120 + tt)) * 256 + ck) = fo;
          }
        }
      }
    }
  }
}
__device__ __forceinline__ void gemm1_part(const Params& P, unsigned char* smem, int part, int first, int stride) {
  const int nnt = part ? 16 : 18;
  for (int tile = first; tile < 136 * nnt; tile += stride) {
    const int mt = tile % 136, ntl = tile / 136;
    const int nt = part ? ((ntl < 8) ? ntl : (24 + ntl - 8)) : ((ntl < 16) ? (8 + ntl) : (32 + ntl - 16));
    gemm_tile<1>(P, smem, mt, nt);
  }
}
template <int MODE>
__device__ __forceinline__ void gemm_phase(const Params& P, unsigned char* smem, int bid, int nb) {
  constexpr int NT = (MODE == 1) ? 34 : (MODE == 2) ? 16 : (MODE == 4 || MODE == 6) ? 20 : 8;
#if USE_BIG
  if (MODE == 4) {
    for (int tile = bid; tile < 68 * NT; tile += nb) gemm_tile_big<MODE>(P, smem, tile % 68, tile / 68);
    return;
  }
#endif
  const int ntiles = 136 * NT;
  for (int tile = bid; tile < ntiles; tile += nb) gemm_tile<MODE>(P, smem, tile % 136, tile / 136);
}

#define TS 8
#define REC 392
typedef float f32x2 __attribute__((ext_vector_type(2)));
__device__ __forceinline__ f32x2 pkfma(f32x2 a, f32x2 b, f32x2 c) { return __builtin_elementwise_fma(a, b, c); }
#define DPP_ADD(x, ctrl) ((x) + __builtin_bit_cast(float, __builtin_amdgcn_update_dpp(0, __builtin_bit_cast(int, (x)), (ctrl), 0xF, 0xF, true)))
__device__ __forceinline__ float wave_sum_fast(float x) {
  x = DPP_ADD(x, 0xB1); x = DPP_ADD(x, 0x4E); x = DPP_ADD(x, 0x141); x = DPP_ADD(x, 0x140);
  const int xi = __builtin_bit_cast(int, x);
  const float t0 = __builtin_bit_cast(float, __builtin_amdgcn_readlane(xi, 0)), t1 = __builtin_bit_cast(float, __builtin_amdgcn_readlane(xi, 16));
  const float t2 = __builtin_bit_cast(float, __builtin_amdgcn_readlane(xi, 32)), t3 = __builtin_bit_cast(float, __builtin_amdgcn_readlane(xi, 48));
  return (t0 + t1) + (t2 + t3);
}
#define LD8(dst, ptr) do { _Pragma("unroll") for (int j4_ = 0; j4_ < 4; j4_++) { const f32x4 v_ = *(const f32x4*)((ptr) + 4 * j4_); \
    dst[2 * j4_] = (f32x2){v_[0], v_[1]}; dst[2 * j4_ + 1] = (f32x2){v_[2], v_[3]}; } } while (0)

template <int INIT  , bool USEV, bool WRITEY>
__device__ __forceinline__ void scan_unit(const Params& P, float* ws, int lane, int tok0, int nsteps, int h, const float* init_ptr, float* fin) {
  const int rq = lane >> 2, q = lane & 3;
  f32x2 s[4][8];
#pragma unroll
  for (int i = 0; i < 4; i++)
#pragma unroll
    for (int j = 0; j < 8; j++) {
      if (INIT == 1) s[i][j] = (f32x2){((rq + 16 * i) == (16 * q + 2 * j)) ? 1.f : 0.f, ((rq + 16 * i) == (16 * q + 2 * j + 1)) ? 1.f : 0.f};
      else s[i][j] = (f32x2){0.f, 0.f};
    }
  if (INIT == 2) {
#pragma unroll
    for (int i = 0; i < 4; i++) LD8(s[i], init_ptr + (size_t)(rq + 16 * i) * 64 + 16 * q);
  }
  const int c = h * 64 + lane;
  const float kkc = P.k_k[c], kac = P.k_a[c], rkc = P.r_k[c];
  const int crow = h * 64 + rq + 16 * q;
  const float gng = P.gn_g[crow], gnb = P.gn_b[crow];
  const f16_t* EW = ((const f16_t*)(P.out + OUT_Y));
  const f16_t* AA = ((const f16_t*)(P.out + OUT_Y) + (size_t)NTOK * DM);

  bf16_t rk[TS], rv[TS], rr[TS]; f16_t ra_[TS], re_[TS]; float rn_[TS];
#define LOAD_RAW(tb) do { const size_t ub_ = (size_t)(tok0 + (tb)) * DM; \
    const bf16_t* kb_ = P.Kb + ub_; const f16_t* ab_ = AA + ub_; const f16_t* eb_ = EW + ub_; const bf16_t* vb_ = P.Vb + ub_; const bf16_t* rb_ = P.Rb + ub_; \
    _Pragma("unroll") for (int tt_ = 0; tt_ < TS; tt_++) { const unsigned off_ = (unsigned)(tt_ * DM + c); \
    rn_[tt_] = P.INVN[(size_t)(tok0 + (tb) + tt_) * 16 + h]; rk[tt_] = kb_[off_]; ra_[tt_] = ab_[off_]; re_[tt_] = eb_[off_]; if (USEV) rv[tt_] = vb_[off_]; if (WRITEY) rr[tt_] = rb_[off_]; } } while (0)
  LOAD_RAW(0);
  for (int t0 = 0; t0 < nsteps; t0 += TS) {
    {
      float gcum = 1.f;
#pragma unroll
      for (int tt = 0; tt < TS; tt++) {
        const float kraw = bf2f(rk[tt]);
        const float a = (float)ra_[tt];
        const float wd = __expf(-(float)re_[tt]);
        const float kkv = kraw * kkc * rn_[tt];
        const float kf = kraw * (1.f + (a - 1.f) * kac);
        float* rec = ws + tt * REC;
        rec[lane] = kkv * gcum;
        gcum *= wd;
        const float ginv = __builtin_amdgcn_rcpf(gcum);
        rec[128 + lane] = kf * ginv; rec[192 + lane] = kkv * a * ginv;
        if (WRITEY) {
          const float r = bf2f(rr[tt]);
          rec[256 + lane] = r * gcum;
          const float bonus = wave_sum_fast(r * kf * rkc);
          if (lane == 0) rec[384] = bonus;
        }
        if (USEV) rec[320 + lane] = bf2f(rv[tt]);
      }
      ws[TS * REC + lane] = gcum;
    }
    __builtin_amdgcn_wave_barrier();
    asm volatile("s_waitcnt lgkmcnt(0)" ::: "memory");
    if (t0 + TS < nsteps) LOAD_RAW(t0 + TS);
#pragma unroll 1
    for (int tt = 0; tt < TS; tt++) {
      const float* rec = ws + tt * REC;
      f32x2 o2[8], b2[8], kf2[8];
      LD8(o2, rec + 16 * q);
      LD8(b2, rec + 192 + 16 * q);
      if (USEV) LD8(kf2, rec + 128 + 16 * q);
      f32x2 nsa2[4];
      {
        f32x2 acc[4];
#pragma unroll
        for (int i = 0; i < 4; i++) acc[i] = s[i][0] * o2[0];
#pragma unroll
        for (int j = 1; j < 8; j++)
#pragma unroll
          for (int i = 0; i < 4; i++) acc[i] = pkfma(s[i][j], o2[j], acc[i]);
#pragma unroll
        for (int i = 0; i < 4; i++) { const float t = -quad_sum(acc[i][0] + acc[i][1]); nsa2[i] = (f32x2){t, t}; }
      }
      float vv[4];
      if (USEV) {
#pragma unroll
        for (int i = 0; i < 4; i++) vv[i] = rec[320 + rq + 16 * i];
      }
      if (WRITEY) LD8(o2, rec + 256 + 16 * q);
#pragma unroll
      for (int i = 0; i < 4; i++) {
#pragma unroll
        for (int j = 0; j < 8; j++) s[i][j] = pkfma(nsa2[i], b2[j], s[i][j]);
        if (USEV) {
          const f32x2 vv2 = (f32x2){vv[i], vv[i]};
#pragma unroll
          for (int j = 0; j < 8; j++) s[i][j] = pkfma(vv2, kf2[j], s[i][j]);
        }
      }
      if (WRITEY) {
        float y[4];
        {
          f32x2 acc[4];
#pragma unroll
          for (int i = 0; i < 4; i++) acc[i] = s[i][0] * o2[0];
#pragma unroll
          for (int j = 1; j < 8; j++)
#pragma unroll
            for (int i = 0; i < 4; i++) acc[i] = pkfma(s[i][j], o2[j], acc[i]);
#pragma unroll
          for (int i = 0; i < 4; i++) y[i] = quad_sum(acc[i][0] + acc[i][1]);
        }
        const float ysel = (q == 0) ? y[0] : (q == 1) ? y[1] : (q == 2) ? y[2] : y[3];
        const float vsel = (q == 0) ? vv[0] : (q == 1) ? vv[1] : (q == 2) ? vv[2] : vv[3];
        const float mean = wave_sum_fast(ysel) * (1.f / 64.f);
        const float ex2 = wave_sum_fast(ysel * ysel) * (1.f / 64.f);
        const float var = fmaxf(ex2 - mean * mean, 0.f);
        float yo = (ysel - mean) * rsqrtf(var + 64e-5f) * gng + gnb + rec[384] * vsel;
        const size_t off = (size_t)(tok0 + t0 + tt) * DM + crow;
        const float gt = bf2f(P.Gb[off]);
        yo *= gt * sigmoidf_(gt);
        P.Gb[off] = f2bf(yo);
      }
    }
    {
      f32x2 ge[8];
      LD8(ge, ws + TS * REC + 16 * q);
#pragma unroll
      for (int i = 0; i < 4; i++)
#pragma unroll
        for (int j = 0; j < 8; j++) s[i][j] *= ge[j];
    }
    __builtin_amdgcn_wave_barrier();
    asm volatile("s_waitcnt lgkmcnt(0)" ::: "memory");
  }
  if (fin) {
#pragma unroll
    for (int i = 0; i < 4; i++)
#pragma unroll
      for (int j4 = 0; j4 < 4; j4++)
        *(f32x4*)(fin + (size_t)(rq + 16 * i) * 64 + 16 * q + 4 * j4) = (f32x4){s[i][2 * j4][0], s[i][2 * j4][1], s[i][2 * j4 + 1][0], s[i][2 * j4 + 1][1]};
  }
}

__device__ __forceinline__ void phase_scan1(const Params& P, unsigned char* smem, int bid, int nb) {
  const int lane = threadIdx.x & 63, w = __builtin_amdgcn_readfirstlane((int)(threadIdx.x >> 6));
  float* ws = (float*)smem + w * (TS * REC + 64);
  float* Ploc = P.out + OUT_WK_S;
  float* Sloc = P.out + OUT_WV_S;
  const int hb = nb >> 1;
  if (bid >= hb) { gemm1_part(P, smem, 1, bid - hb, nb - hb); return; }
  for (int u = w * hb + bid; u < NBH * (NC - 1) * 2; u += 4 * hb) {
    const int kind = (u ^ (u / (4 * hb))) & 1, rest = u >> 1;
    const int c = rest % (NC - 1), bh = rest / (NC - 1);
    const int tok0 = (bh >> 4) * TP + c * CL, h = bh & 15;
    float* fin = (kind ? Ploc : Sloc) + (size_t)(bh * (NC - 1) + c) * 4096;
    if (kind) scan_unit<1, false, false>(P, ws, lane, tok0, CL, h, nullptr, fin);
    else scan_unit<0, true, false>(P, ws, lane, tok0, CL, h, nullptr, fin);
  }
}
__device__ __forceinline__ void phase_scan2(const Params& P, unsigned char* smem, int bid, int nb) {
  const int lane = threadIdx.x & 63, w = __builtin_amdgcn_readfirstlane((int)(threadIdx.x >> 6));
  float* ws = (float*)smem + w * 256;
  float* Ploc = P.out + OUT_WK_S;
  float* Sloc = P.out + OUT_WV_S;
  for (int item = bid; item < NBH * 4; item += nb) {
    const int bh = item >> 2, row0 = (item & 3) * 16 + w * 4;
    float s[4];
    {
      const float* S0 = Sloc + (size_t)(bh * (NC - 1)) * 4096;
#pragma unroll
      for (int r = 0; r < 4; r++) s[r] = S0[(row0 + r) * 64 + lane];
    }
    for (int c = 1; c < NC - 1; c++) {
      const float* Pc = Ploc + (size_t)(bh * (NC - 1) + c) * 4096;
      float* Sc = Sloc + (size_t)(bh * (NC - 1) + c) * 4096;
      float acc[4];
#pragma unroll
      for (int r = 0; r < 4; r++) { acc[r] = Sc[(row0 + r) * 64 + lane]; ws[r * 64 + lane] = s[r]; }
      __builtin_amdgcn_wave_barrier();
      asm volatile("s_waitcnt lgkmcnt(0)" ::: "memory");
#pragma unroll 1
      for (int hf = 0; hf < 2; hf++) {
        float p[32];
#pragma unroll
        for (int i = 0; i < 32; i++) p[i] = Pc[(hf * 32 + i) * 64 + lane];
#pragma unroll
        for (int r = 0; r < 4; r++) {
#pragma unroll
          for (int i4 = 0; i4 < 8; i4++) {
            const float4 sv = *(const float4*)(ws + r * 64 + hf * 32 + 4 * i4);
            acc[r] = fmaf(sv.x, p[4 * i4], acc[r]); acc[r] = fmaf(sv.y, p[4 * i4 + 1], acc[r]);
            acc[r] = fmaf(sv.z, p[4 * i4 + 2], acc[r]); acc[r] = fmaf(sv.w, p[4 * i4 + 3], acc[r]);
          }
        }
      }
      __builtin_amdgcn_wave_barrier();
      asm volatile("s_waitcnt lgkmcnt(0)" ::: "memory");
#pragma unroll
      for (int r = 0; r < 4; r++) { s[r] = acc[r]; Sc[(row0 + r) * 64 + lane] = acc[r]; }
    }
  }
}
__device__ __forceinline__ void phase_scan3(const Params& P, unsigned char* smem, int bid, int nb) {
  const int lane = threadIdx.x & 63, w = __builtin_amdgcn_readfirstlane((int)(threadIdx.x >> 6));
  float* ws = (float*)smem + w * (TS * REC + 64);
  float* Sloc = P.out + OUT_WV_S;
  const int hb = nb >> 1;
  if (bid < hb) {
    for (int u = w * hb + bid; u < NBH * NC; u += 4 * hb) {
      const int bh = u >> 5, c = u & 31;
      const int tok0 = (bh >> 4) * TP + c * CL, h = bh & 15;
      const float* ip = (c > 0) ? (Sloc + (size_t)(bh * (NC - 1) + c - 1) * 4096) : nullptr;
      float* fin = (c == NC - 1) ? (P.out + OUT_WKV_P + (size_t)bh * 4096) : nullptr;
      if (c > 0) scan_unit<2, true, true>(P, ws, lane, tok0, CL, h, ip, fin);
      else scan_unit<0, true, true>(P, ws, lane, tok0, CL, h, ip, fin);
    }
  } else {
    for (int sb = w * (nb - hb) + (bid - hb); sb < 2048; sb += 4 * (nb - hb))
      scan_unit<2, true, true>(P, ws, lane, NPR + (sb >> 4) * 8, 8, sb & 15, P.state_wkv + (size_t)sb * 4096, P.out + OUT_WKV_S + (size_t)sb * 4096);
    __syncthreads();
    late_weight_prep(P, smem, bid - hb, nb - hb);
  }
}

__device__ __forceinline__ void phase_ln(const Params& P, int layer, int bid, int nb) {
  const int lane = threadIdx.x & 63, w = __builtin_amdgcn_readfirstlane((int)(threadIdx.x >> 6));
  const float* gg = P.ln_g + layer * DM; const float* bb = P.ln_b + layer * DM;
  for (int tok = bid * 4 + w; tok < NTOK; tok += nb * 4) {
    f32x4* row = (f32x4*)(P.out + OUT_Y + (size_t)tok * DM);
    f32x4 v[4];
    float sum = 0.f;
#pragma unroll
    for (int i = 0; i < 4; i++) { v[i] = row[lane + 64 * i]; sum += v[i][0] + v[i][1] + v[i][2] + v[i][3]; }
    const float mean = wave_sum(sum) * (1.f / 1024.f);
    float sq = 0.f;
#pragma unroll
    for (int i = 0; i < 4; i++) { v[i] -= mean; sq += v[i][0] * v[i][0] + v[i][1] * v[i][1] + v[i][2] * v[i][2] + v[i][3] * v[i][3]; }
    const float rs = rsqrtf(wave_sum(sq) * (1.f / 1024.f) + 1e-5f);
#pragma unroll
    for (int i = 0; i < 4; i++) {
      const f32x4 g4 = ((const f32x4*)gg)[lane + 64 * i], b4 = ((const f32x4*)bb)[lane + 64 * i];
      const f32x4 o = v[i] * rs * g4 + b4;
      if (layer != 0) row[lane + 64 * i] = o;
      if (layer == 0) { uint2 ob; ob.x = pack2(o[0], o[1]); ob.y = pack2(o[2], o[3]); ((uint2*)(P.Rb + (size_t)tok * DM))[lane + 64 * i] = ob; }
    }
  }
}

__device__ __forceinline__ void attn_prompt_item(const Params& P, unsigned char* smem, int item) {
  const int qh = item & 1, hk = (item >> 1) & 3, n = (item >> 3) & 63, b = item >> 9;
  bf16_t* Ks = (bf16_t*)smem;
  bf16_t* Vs = Ks + 192 * 72;
  const bf16_t* K1 = P.XB; const bf16_t* VT1 = P.XB + (size_t)NTOK * 512;
  const bf16_t* Q1 = P.Kb; const bf16_t* G1 = P.Vb; bf16_t* AO = P.Gb;
  const int t = threadIdx.x, lane = t & 63, w = t >> 6;
  const int g = lane >> 4, lc = lane & 15;
  const int pos0 = (n - 1) * 128 + 64 * qh;
  __syncthreads();
#pragma unroll
  for (int i = 0; i < 6; i++) {
    const int idx = t + 256 * i; const int row = idx >> 3, ch = idx & 7; const int pos = pos0 + row;
    uint4 v = make_uint4(0, 0, 0, 0);
    if (pos >= 0) v = *(const uint4*)(K1 + ((size_t)(b * TP + pos)) * 256 + hk * 64 + ch * 8);
    *(uint4*)(Ks + row * 72 + ch * 8) = v;
  }
#pragma unroll
  for (int i = 0; i < 6; i++) {
    const int idx = t + 256 * i; const int d = idx / 24, ch = idx % 24; const int pos = pos0 + ch * 8;
    uint4 v = make_uint4(0, 0, 0, 0);
    if (pos >= 0) v = *(const uint4*)(VT1 + ((size_t)((b * 4 + hk) * 64 + d)) * TP + pos);
    *(uint4*)(Vs + d * 200 + ch * 8) = v;
  }
  __syncthreads();
  const int h = hk * 4 + w;
  const float slope = exp2f(-0.5f * (float)(h + 1));
  const float sink = P.att_sinks[h];
  for (int sb = 0; sb < 2; sb++) {
    const int i0 = 64 * qh + 32 * sb;
    const int tokb = b * TP + n * 128 + i0;
    bf16x8 qf[2][2];
#pragma unroll
    for (int nn = 0; nn < 2; nn++)
#pragma unroll
      for (int ks = 0; ks < 2; ks++) qf[nn][ks] = *(const bf16x8*)(Q1 + (size_t)(tokb + 16 * nn + lc) * DM + h * 64 + ks * 32 + g * 8);
    float mrun[2] = {sink, sink}, lrun[2] = {1.f, 1.f};
    f32x4 O[4][2];
#pragma unroll
    for (int dm = 0; dm < 4; dm++) { O[dm][0] = (f32x4){0.f, 0.f, 0.f, 0.f}; O[dm][1] = (f32x4){0.f, 0.f, 0.f, 0.f}; }
    for (int kt = 0; kt < 3; kt++) {
      if (n == 0 && (qh + kt) < 2) continue;
      f32x4 S[4][2];
#pragma unroll
      for (int mm = 0; mm < 4; mm++) { S[mm][0] = (f32x4){0.f, 0.f, 0.f, 0.f}; S[mm][1] = (f32x4){0.f, 0.f, 0.f, 0.f}; }
#pragma unroll
      for (int ks = 0; ks < 2; ks++)
#pragma unroll
        for (int mm = 0; mm < 4; mm++) {
          const bf16x8 kf = *(const bf16x8*)(Ks + (kt * 64 + mm * 16 + lc) * 72 + ks * 32 + g * 8);
          S[mm][0] = __builtin_amdgcn_mfma_f32_16x16x32_bf16(kf, qf[0][ks], S[mm][0], 0, 0, 0);
          S[mm][1] = __builtin_amdgcn_mfma_f32_16x16x32_bf16(kf, qf[1][ks], S[mm][1], 0, 0, 0);
        }
#pragma unroll
      for (int nn = 0; nn < 2; nn++) {
        const int qi = i0 + 16 * nn + lc;
        float mx = mrun[nn];
#pragma unroll
        for (int mm = 0; mm < 4; mm++)
#pragma unroll
          for (int r = 0; r < 4; r++) {
            const int j = 64 * (qh + kt) + 16 * mm + 4 * g + r;
            const int dist = 128 + qi - j;
            const bool live = (dist >= 0) && (dist < 128);
            const float sv = live ? (S[mm][nn][r] * 0.125f - slope * (float)dist) : -1e30f;
            S[mm][nn][r] = sv; mx = fmaxf(mx, sv);
          }
        mx = fmaxf(mx, __shfl_xor(mx, 16)); mx = fmaxf(mx, __shfl_xor(mx, 32));
        const float corr = __expf(mrun[nn] - mx); mrun[nn] = mx;
        float sum = 0.f;
#pragma unroll
        for (int mm = 0; mm < 4; mm++)
#pragma unroll
          for (int r = 0; r < 4; r++) { const float pp = __expf(S[mm][nn][r] - mx); S[mm][nn][r] = pp; sum += pp; }
        sum += __shfl_xor(sum, 16); sum += __shfl_xor(sum, 32);
        lrun[nn] = lrun[nn] * corr + sum;
#pragma unroll
        for (int dm = 0; dm < 4; dm++) { O[dm][nn][0] *= corr; O[dm][nn][1] *= corr; O[dm][nn][2] *= corr; O[dm][nn][3] *= corr; }
      }
#pragma unroll
      for (int k2 = 0; k2 < 2; k2++) {
        bf16x8 pf[2];
#pragma unroll
        for (int nn = 0; nn < 2; nn++) {
          const unsigned u0 = pack2(S[2 * k2][nn][0], S[2 * k2][nn][1]), u1 = pack2(S[2 * k2][nn][2], S[2 * k2][nn][3]);
          const unsigned u2 = pack2(S[2 * k2 + 1][nn][0], S[2 * k2 + 1][nn][1]), u3 = pack2(S[2 * k2 + 1][nn][2], S[2 * k2 + 1][nn][3]);
          const uint4 uu = make_uint4(u0, u1, u2, u3);
          pf[nn] = *(const bf16x8*)&uu;
        }
#pragma unroll
        for (int dm = 0; dm < 4; dm++) {
          const bf16_t* vb = Vs + (dm * 16 + lc) * 200 + kt * 64 + k2 * 32 + 4 * g;
          const uint2 lo = *(const uint2*)vb, hi = *(const uint2*)(vb + 16);
          const uint4 uu = make_uint4(lo.x, lo.y, hi.x, hi.y);
          const bf16x8 vf = *(const bf16x8*)&uu;
          O[dm][0] = __builtin_amdgcn_mfma_f32_16x16x32_bf16(vf, pf[0], O[dm][0], 0, 0, 0);
          O[dm][1] = __builtin_amdgcn_mfma_f32_16x16x32_bf16(vf, pf[1], O[dm][1], 0, 0, 0);
        }
      }
    }
#pragma unroll
    for (int nn = 0; nn < 2; nn++) {
      const float inv = 1.f / lrun[nn];
      const size_t tok = (size_t)(tokb + 16 * nn + lc);
#pragma unroll
      for (int dm = 0; dm < 4; dm++) {
        const int d = dm * 16 + 4 * g;
        const uint2 gv = *(const uint2*)(G1 + tok * DM + h * 64 + d);
        const float g0 = __uint_as_float(gv.x << 16), g1 = __uint_as_float(gv.x & 0xffff0000u);
        const float g2 = __uint_as_float(gv.y << 16), g3 = __uint_as_float(gv.y & 0xffff0000u);
        uint2 o;
        o.x = pack2(O[dm][nn][0] * inv * g0 * sigmoidf_(g0), O[dm][nn][1] * inv * g1 * sigmoidf_(g1));
        o.y = pack2(O[dm][nn][2] * inv * g2 * sigmoidf_(g2), O[dm][nn][3] * inv * g3 * sigmoidf_(g3));
        *(uint2*)(AO + tok * DM + h * 64 + d) = o;
      }
    }
  }
}

__device__ __forceinline__ void attn_sample_item(const Params& P, unsigned char* smem, int item) {
  const int b = item >> 2, hk = item & 3;
  const int t = threadIdx.x, lane = t & 63, w = t >> 6;
  float* kv = (float*)smem;
  float* qs = kv + 136 * 65 + w * 512;
  float* ps = kv + 136 * 65 + 2048 + w * (8 * 136);
  const bf16_t* K1 = P.XB; const bf16_t* V1 = P.XB + (size_t)NTOK * 256;
  const bf16_t* Q1 = P.Kb; const bf16_t* G1 = P.Vb; bf16_t* AO = P.Gb;
  const int h = hk * 4 + w;
  const float slope = exp2f(-0.5f * (float)(h + 1));
  const float sink = P.att_sinks[h];
  const int tok0 = NPR + b * 8;
  __syncthreads();
#pragma unroll 2
  for (int it = 0; it < 8; it++) {
    const int idx = t + 256 * it; const int row = idx >> 4, c4 = idx & 15;
    const size_t so = ((size_t)(b * 128 + row)) * 256 + hk * 64 + c4 * 4;
    const float4 kx = *(const float4*)(P.cache_k + so);
    const float4 vx = *(const float4*)(P.cache_v + so);
    float* kd = kv + row * 65 + c4 * 4;
    kd[0] = kx.x; kd[1] = kx.y; kd[2] = kx.z; kd[3] = kx.w;
    if (row >= 8) {
      const size_t dofs = ((size_t)(b * 128 + row - 8)) * 256 + hk * 64 + c4 * 4;
      *(float4*)(P.out + OUT_WK_S + dofs) = kx;
      *(float4*)(P.out + OUT_WV_S + dofs) = vx;
    }
  }
#pragma unroll
  for (int it = 0; it < 2; it++) {
    const int idx = t + 256 * it; const int r8 = idx >> 6, d = idx & 63;
    kv[(128 + r8) * 65 + d] = bf2f(K1[(size_t)(tok0 + r8) * 256 + hk * 64 + d]);
  }
#pragma unroll
  for (int i = 0; i < 8; i++) qs[i * 64 + lane] = bf2f(Q1[(size_t)(tok0 + i) * DM + h * 64 + lane]);
  __syncthreads();
  float sc[3][8];
#pragma unroll
  for (int ksel = 0; ksel < 3; ksel++) {
    float acc[8];
#pragma unroll
    for (int i = 0; i < 8; i++) acc[i] = 0.f;
    const float* kr = kv + ((ksel < 2) ? (lane + 64 * ksel) : (128 + (lane & 7))) * 65;
#pragma unroll 2
    for (int d4 = 0; d4 < 16; d4++) {
      const float k0 = kr[4 * d4], k1 = kr[4 * d4 + 1], k2 = kr[4 * d4 + 2], k3 = kr[4 * d4 + 3];
#pragma unroll
      for (int i = 0; i < 8; i++) {
        const float4 qv = *(const float4*)(qs + i * 64 + 4 * d4);
        acc[i] = fmaf(qv.x, k0, acc[i]); acc[i] = fmaf(qv.y, k1, acc[i]); acc[i] = fmaf(qv.z, k2, acc[i]); acc[i] = fmaf(qv.w, k3, acc[i]);
      }
    }
#pragma unroll
    for (int i = 0; i < 8; i++) {
      int dist; bool live;
      if (ksel < 2) { const int j = lane + 64 * ksel; dist = 128 + i - j; live = (j > i); }
      else { dist = i - lane; live = (lane <= i); }
      sc[ksel][i] = live ? (acc[i] * 0.125f - slope * (float)dist) : -1e30f;
    }
  }
#pragma unroll
  for (int i = 0; i < 8; i++) {
    float mx = fmaxf(fmaxf(sc[0][i], sc[1][i]), sc[2][i]);
    mx = fmaxf(wave_max(mx), sink);
    const float p0 = __expf(sc[0][i] - mx), p1 = __expf(sc[1][i] - mx), p2 = __expf(sc[2][i] - mx);
    const float den = wave_sum(p0 + p1 + p2) + __expf(sink - mx);
    const float inv = 1.f / den;
    ps[i * 136 + lane] = p0 * inv; ps[i * 136 + 64 + lane] = p1 * inv;
    if (lane < 8) ps[i * 136 + 128 + lane] = p2 * inv;
  }
  __syncthreads();
#pragma unroll 4
  for (int it = 0; it < 8; it++) {
    const int idx = t + 256 * it; const int row = idx >> 4, c4 = idx & 15;
    *(float4*)(kv + row * 64 + c4 * 4) = *(const float4*)(P.cache_v + ((size_t)(b * 128 + row)) * 256 + hk * 64 + c4 * 4);
  }
#pragma unroll
  for (int it = 0; it < 2; it++) {
    const int idx = t + 256 * it; const int r8 = idx >> 6, d = idx & 63;
    kv[(128 + r8) * 64 + d] = bf2f(V1[(size_t)(tok0 + r8) * 256 + hk * 64 + d]);
  }
  __syncthreads();
  float o[8];
#pragma unroll
  for (int i = 0; i < 8; i++) o[i] = 0.f;
#pragma unroll 2
  for (int j0 = 0; j0 < 136; j0 += 4) {
    const float v0 = kv[(j0) * 64 + lane], v1 = kv[(j0 + 1) * 64 + lane], v2 = kv[(j0 + 2) * 64 + lane], v3 = kv[(j0 + 3) * 64 + lane];
#pragma unroll
    for (int i = 0; i < 8; i++) {
      const float4 pa = *(const float4*)(ps + i * 136 + j0);
      o[i] = fmaf(pa.x, v0, o[i]); o[i] = fmaf(pa.y, v1, o[i]); o[i] = fmaf(pa.z, v2, o[i]); o[i] = fmaf(pa.w, v3, o[i]);
    }
  }
#pragma unroll
  for (int i = 0; i < 8; i++) {
    const size_t off = (size_t)(tok0 + i) * DM + h * 64 + lane;
    const float gt = bf2f(G1[off]);
    AO[off] = f2bf(o[i] * gt * sigmoidf_(gt));
  }
}
__device__ __forceinline__ void phase_attn(const Params& P, unsigned char* smem, int bid, int nb) {
#if PROBE == 7
  for (int item = bid; item < 1024; item += nb) attn_prompt_item(P, smem, item);
#elif PROBE == 8
  for (int item = bid; item < 512; item += nb) attn_sample_item(P, smem, item);
#endif
  for (int item = bid; item < 1024 + 512; item += nb) {
    if (item < 1024) attn_prompt_item(P, smem, item);
    else attn_sample_item(P, smem, item - 1024);
  }
}

#if MULTI_LAUNCH
#define PH_BARRIER(ph)
#else
#define PH_BARRIER(ph) do { if ((ph) + 1 < P.phase_end) xcd_barrier(xb); } while (0)
#endif
#define RUN_PH(ph, call) do { if (P.phase_begin <= (ph) && (ph) < P.phase_end) { if ((REPMASK >> (ph)) & 1) { call; PH_BARRIER(ph); } call; PH_BARRIER(ph); } } while (0)

__global__ void __launch_bounds__(256, 2) fwd_kernel(Params P) {
  __shared__ __attribute__((aligned(16))) unsigned char smem[SMEM_BYTES];
  const int bid = blockIdx.x, nb = gridDim.x;
#if !MULTI_LAUNCH
  __shared__ uint4 xb_words;
  if (threadIdx.x == 0) xb_words = make_uint4(0u, 0u, 0u, 0u);
  __syncthreads();
  XcdBarrier xb = xcd_barrier_post(P.bar, (volatile LAS unsigned*)&xb_words);
#endif
#if (PHMASK >> 0) & 1
  RUN_PH(0, phase_prep(P, smem, bid, nb));
#endif
#if (PHMASK >> 1) & 1
  RUN_PH(1, gemm1_part(P, smem, 0, bid, nb));
#endif
#if (PHMASK >> 2) & 1
  RUN_PH(2, gemm_phase<2>(P, smem, bid, nb));
#endif
#if (PHMASK >> 3) & 1
  RUN_PH(3, phase_scan1(P, smem, bid, nb));
#endif
#if (PHMASK >> 4) & 1
  RUN_PH(4, phase_scan2(P, smem, bid, nb));
#endif
#if (PHMASK >> 5) & 1
  RUN_PH(5, phase_scan3(P, smem, bid, nb));
#endif
#if (PHMASK >> 6) & 1
  RUN_PH(6, gemm_phase<3>(P, smem, bid, nb));
#endif
#if (PHMASK >> 7) & 1
  RUN_PH(7, phase_ln(P, 0, bid, nb));
#endif
#if (PHMASK >> 8) & 1
  RUN_PH(8, gemm_phase<4>(P, smem, bid, nb));
#endif
#if (PHMASK >> 9) & 1
  RUN_PH(9, phase_attn(P, smem, bid, nb));
#endif
#if (PHMASK >> 10) & 1
  RUN_PH(10, gemm_phase<5>(P, smem, bid, nb));
#endif
#if (PHMASK >> 11) & 1
  RUN_PH(11, phase_ln(P, 1, bid, nb));
#endif
#if PROBE && PROBE < 7
  xcd_barrier(xb);
  gemm_phase<6>(P, smem, bid, nb);
#endif
#if !MULTI_LAUNCH
  if (P.phase_end > NPHASE) cg::this_grid().sync();
#endif
}

extern "C" void kernel_launch(void* const* d_in, const int* in_sizes, int n_in, void* d_out, int out_size, void* d_ws, size_t ws_size, hipStream_t stream) {
  Params P{};
  P.x_prompt = (const float*)d_in[0]; P.x_sample = (const float*)d_in[1]; P.state_wkv = (const float*)d_in[2]; P.state_shift = (const float*)d_in[3];
  P.cache_k = (const float*)d_in[4]; P.cache_v = (const float*)d_in[5]; P.ln_g = (const float*)d_in[6]; P.ln_b = (const float*)d_in[7];
  P.mu = (const float*)d_in[8]; P.w_in = (const float*)d_in[9]; P.w0 = (const float*)d_in[10]; P.w1 = (const float*)d_in[11]; P.w2 = (const float*)d_in[12];
  P.a0 = (const float*)d_in[13]; P.a1 = (const float*)d_in[14]; P.a2 = (const float*)d_in[15]; P.k_k = (const float*)d_in[16]; P.k_a = (const float*)d_in[17];
  P.r_k = (const float*)d_in[18]; P.gn_g = (const float*)d_in[19]; P.gn_b = (const float*)d_in[20]; P.w_out = (const float*)d_in[21];
  P.att_w_in = (const float*)d_in[22]; P.att_sinks = (const float*)d_in[23]; P.att_w_out = (const float*)d_in[24];
  P.out = (float*)d_out;
  unsigned char* ws = (unsigned char*)d_ws;
  size_t off = 0;
  auto take = [&](size_t bytes) { unsigned char* p = ws + off; off += (bytes + 255) & ~(size_t)255; return p; };
  P.bar = (unsigned*)take(16384);
  P.WtIn0 = (bf16_t*)take((size_t)4352 * DM * 2);
  P.W2t = (bf16_t*)take((size_t)DM * 64 * 2);
  P.A2t = (bf16_t*)take((size_t)DM * 64 * 2);
  P.WtOut0 = (bf16_t*)take((size_t)DM * DM * 2);
  P.WtIn1 = (bf16_t*)take((size_t)2560 * DM * 2);
  P.WtOut1 = (bf16_t*)take((size_t)DM * DM * 2);
  P.XB = (bf16_t*)take((size_t)NTOK * DM * 2);
  P.XXB = (bf16_t*)take((size_t)NTOK * DM * 2);
  P.Rb = (bf16_t*)take((size_t)NTOK * DM * 2);
  P.Kb = (bf16_t*)take((size_t)NTOK * DM * 2);
  P.Vb = (bf16_t*)take((size_t)NTOK * DM * 2);
  P.Gb = (bf16_t*)take((size_t)NTOK * DM * 2);
  P.H1 = (bf16_t*)take((size_t)NTOK * 64 * 2);
  P.H2 = (bf16_t*)take((size_t)NTOK * 64 * 2);
  P.MU16 = (bf16_t*)take((size_t)6 * DM * 2);
  P.INVN = (float*)take((size_t)NTOK * 16 * 4);
  if (off > ws_size) { fprintf(stderr, "workspace too small: need %zu have %zu\n", off, ws_size); return; }
#if MULTI_LAUNCH
  for (int ph = 0; ph < NPHASE; ph++) {
    P.phase_begin = ph; P.phase_end = ph + 1;
    hipLaunchKernelGGL(fwd_kernel, dim3(512), dim3(256), 0, stream, P);
  }
#else
  static int grid_blocks = 0;
  if (!grid_blocks) {
    int dev = 0, cus = 0, per_cu = 0;
    hipGetDevice(&dev);
    hipDeviceGetAttribute(&cus, hipDeviceAttributeMultiprocessorCount, dev);
    hipOccupancyMaxActiveBlocksPerMultiprocessor(&per_cu, fwd_kernel, 256, 0);
    if (per_cu > 2) per_cu = 2;
    if (per_cu < 1) per_cu = 1;
    grid_blocks = cus * per_cu;
  }
  hipMemsetAsync(P.bar, 0, 16384, stream);
  P.phase_begin = 0; P.phase_end = NPHASE;
  void* args[] = {&P};
  hipError_t e = hipLaunchCooperativeKernel((void*)fwd_kernel, dim3(grid_blocks), dim3(256), args, 0, stream);
  if (e != hipSuccess) fprintf(stderr, "cooperative launch failed: %s (grid %d)\n", hipGetErrorString(e), grid_blocks);
#endif
}
```

```cpp
#include <hip/hip_runtime.h>
#include <hip/hip_cooperative_groups.h>
#include <stdint.h>
#include <cstdio>
namespace cg = cooperative_groups;

#ifndef PHMASK
#define PHMASK 0xFFF
#endif
#ifndef USE_BIG
#define USE_BIG 1
#endif
#ifndef PROBE
#define PROBE 0
#endif
#ifndef REPMASK
#define REPMASK 0
#endif
#ifndef MULTI_LAUNCH
#define MULTI_LAUNCH 0
#endif

typedef unsigned short bf16_t;
typedef _Float16 f16_t;
typedef __attribute__((ext_vector_type(8))) short bf16x8;
typedef __attribute__((ext_vector_type(4))) float f32x4;
typedef __attribute__((ext_vector_type(4))) unsigned u32x4;

#define DM 1024
#define NTOK 17408
#define NPR 16384
#define TP 8192
#define NC 32
#define CL 256
#define NBH 32
#define ALPHA_F 1.41421356237f
#define SMEM_BYTES (61 * 1024)
#define NPHASE 12

#define OUT_Y 0
#define OUT_WKV_P 17825792
#define OUT_SH_P 17956864
#define OUT_WK_P 17958912
#define OUT_WV_P 18024448
#define OUT_WKV_S 18089984
#define OUT_SH_S 26478592
#define OUT_WK_S 26609664
#define OUT_WV_S 30803968

struct Params {
  const float *x_prompt, *x_sample, *state_wkv, *state_shift, *cache_k, *cache_v, *ln_g, *ln_b;
  const float *mu, *w_in, *w0, *w1, *w2, *a0, *a1, *a2, *k_k, *k_a, *r_k, *gn_g, *gn_b, *w_out;
  const float *att_w_in, *att_sinks, *att_w_out;
  float* out;
  unsigned* bar;
  bf16_t *WtIn0, *W2t, *A2t, *WtOut0, *WtIn1, *WtOut1;
  bf16_t *XB, *XXB;
  bf16_t *Rb, *Kb, *Vb, *Gb;
  bf16_t *H1, *H2, *MU16;
  float* INVN;
  int phase_begin, phase_end;
};

typedef __bf16 hbf2 __attribute__((ext_vector_type(2)));
typedef float f32x2_ __attribute__((ext_vector_type(2)));
__device__ __forceinline__ unsigned pack2(float a, float b) {
  const f32x2_ v = {a, b};
  return __builtin_bit_cast(unsigned, __builtin_convertvector(v, hbf2));
}
__device__ __forceinline__ bf16_t f2bf(float f) { return (bf16_t)(pack2(f, 0.f) & 0xffffu); }
__device__ __forceinline__ float bf2f(bf16_t h) { return __uint_as_float(((unsigned)h) << 16); }
__device__ __forceinline__ float wave_sum(float x) {
#pragma unroll
  for (int o = 32; o >= 1; o >>= 1) x += __shfl_xor(x, o);
  return x;
}
__device__ __forceinline__ float wave_max(float x) {
#pragma unroll
  for (int o = 32; o >= 1; o >>= 1) x = fmaxf(x, __shfl_xor(x, o));
  return x;
}
__device__ __forceinline__ float quad_sum(float x) {
  x += __builtin_bit_cast(float, __builtin_amdgcn_update_dpp(0, __builtin_bit_cast(int, x), 0xB1, 0xF, 0xF, true));
  x += __builtin_bit_cast(float, __builtin_amdgcn_update_dpp(0, __builtin_bit_cast(int, x), 0x4E, 0xF, 0xF, true));
  return x;
}
__device__ __forceinline__ float sigmoidf_(float x) { return __builtin_amdgcn_rcpf(1.f + __expf(-x)); }
__device__ __forceinline__ const float* xin_row(const Params& P, int m) {
  return (m < NPR) ? (P.x_prompt + (size_t)m * DM) : (P.x_sample + (size_t)(m - NPR) * DM);
}

#define XB_TMO      128
#define XB_XCNT(j)  (256  + 64 * (j))
#define XB_XSUB(j)  (1280 + 64 * (j))
#define XB_XGEN(j)  (2304 + 64 * (j))
#define XB_TOP      3328
#define XB_TOPGEN   3392
#define XCD_BAR_WORDS 3456
#define XB_SPIN_CAP (1u << 22)
#define LAS __attribute__((address_space(3)))
__device__ __forceinline__ unsigned xb_ld(unsigned* p) { return __hip_atomic_load(p, __ATOMIC_RELAXED, __HIP_MEMORY_SCOPE_AGENT); }
__device__ __forceinline__ unsigned xb_add(unsigned* p, unsigned v) { return __hip_atomic_fetch_add(p, v, __ATOMIC_RELAXED, __HIP_MEMORY_SCOPE_AGENT); }
__device__ __forceinline__ unsigned xb_xcc_id() { return (unsigned)__builtin_amdgcn_s_getreg((3 << 11) | 20) & 0xFu; }
#define XB_SPIN(cond, bar) do { unsigned _sp = 0; while (cond) { __builtin_amdgcn_s_sleep(1); \
    if ((++_sp & 255u) == 0u) { if (xb_ld(&(bar)[XB_TMO])) break; if (_sp > XB_SPIN_CAP) { atomicAdd(&(bar)[XB_TMO], 1u); break; } } } } while (0)
struct XcdBarrier { unsigned* bar; unsigned x; volatile LAS unsigned* st; };
__device__ __forceinline__ XcdBarrier xcd_barrier_post(unsigned* bar, volatile LAS unsigned* st) {
  XcdBarrier b; b.bar = bar; b.x = xb_xcc_id(); b.st = st;
  if (threadIdx.x == 0) (void)xb_add(&bar[XB_XCNT(b.x)], 1u);
  return b;
}
__device__ __forceinline__ void xcd_barrier_complete(unsigned* bar, unsigned x, unsigned& nloc, unsigned& nx) {
  const unsigned G = gridDim.x * gridDim.y * gridDim.z;
  unsigned sum, cnt, mine, sp = 0u;
  for (;;) {
    sum = 0u; cnt = 0u; mine = 0u;
#pragma unroll
    for (unsigned j = 0; j < 16; ++j) { const unsigned c = xb_ld(&bar[XB_XCNT(j)]); sum += c; cnt += (c > 0u) ? 1u : 0u; mine = (j == x) ? c : mine; }
    if (sum == G) break;
    __builtin_amdgcn_s_sleep(1);
    if ((++sp & 255u) == 0u) { if (xb_ld(&bar[XB_TMO])) break; if (sp > XB_SPIN_CAP) { atomicAdd(&bar[XB_TMO], 1u); break; } }
  }
  nloc = mine > 0u ? mine : 1u; nx = cnt > 0u ? cnt : 1u;
}
__device__ __forceinline__ void xcd_barrier(const XcdBarrier& b) {
  asm volatile("s_waitcnt vmcnt(0)" ::: "memory");
  __syncthreads();
  if (threadIdx.x == 0) {
    unsigned* bar = b.bar;
    __builtin_amdgcn_s_waitcnt(0);
    unsigned nloc = b.st[0], nx = b.st[1];
    if (nloc == 0u) { xcd_barrier_complete(bar, b.x, nloc, nx); b.st[0] = nloc; b.st[1] = nx; }
    const unsigned old = xb_add(&bar[XB_XSUB(b.x)], 1u);
    const unsigned gen = old / nloc;
    if (old + 1u == (gen + 1u) * nloc) {
      __builtin_amdgcn_fence(__ATOMIC_RELEASE, "agent");
      asm volatile("s_waitcnt vmcnt(0)" ::: "memory");
      const unsigned og = xb_add(&bar[XB_TOP], 1u);
      const unsigned tg = og / nx;
      if (og + 1u == (tg + 1u) * nx) xb_add(&bar[XB_TOPGEN], 1u);
      else XB_SPIN(xb_ld(&bar[XB_TOPGEN]) == tg, bar);
      __builtin_amdgcn_fence(__ATOMIC_ACQUIRE, "agent");
      xb_add(&bar[XB_XGEN(b.x)], 1u);
      asm volatile("s_waitcnt vmcnt(0)" ::: "memory");
    } else {
      XB_SPIN(xb_ld(&bar[XB_XGEN(b.x)]) == gen, bar);
      __builtin_amdgcn_fence(__ATOMIC_ACQUIRE, "agent");
      asm volatile("s_waitcnt vmcnt(0)" ::: "memory");
    }
  }
  __syncthreads();
}

__device__ __forceinline__ unsigned short f2h_bits(float f) { const _Float16 h = (_Float16)f; return __builtin_bit_cast(unsigned short, h); }
__device__ __forceinline__ unsigned pack2h(float a, float b) { return (unsigned)f2h_bits(a) | ((unsigned)f2h_bits(b) << 16); }
__device__ __forceinline__ void transpose_tile(const float* __restrict__ src, int ld, int k0, int n0, bf16_t* __restrict__ dst, int ldd, float* tile, bool half = false) {
  const int t = threadIdx.x;
  {
    const int n = t & 63, kq = t >> 6;
#pragma unroll 4
    for (int i = 0; i < 16; i++) { const int k = i * 4 + kq; tile[k * 65 + n] = src[(size_t)(k0 + k) * ld + n0 + n]; }
  }
  __syncthreads();
  {
    const int k = t & 63, nq = t >> 6;
#pragma unroll 4
    for (int i = 0; i < 16; i++) { const int n2 = i * 4 + nq; const float v_ = tile[k * 65 + n2]; dst[(size_t)(n0 + n2) * ldd + k0 + k] = half ? f2h_bits(v_) : f2bf(v_); }
  }
  __syncthreads();
}

__device__ __forceinline__ void late_weight_prep(const Params& P, unsigned char* smem, int first, int stride) {
  float* tile = (float*)smem;
  for (int id = 1088 + first; id < 2240; id += stride) {
    if (id < 1344) { const int r = id - 1088; transpose_tile(P.w_out, DM, (r >> 4) * 64, (r & 15) * 64, P.WtOut0, DM, tile); }
    else if (id < 1984) { const int r = id - 1344; transpose_tile(P.att_w_in, 2560, (r / 40) * 64, (r % 40) * 64, P.WtIn1, DM, tile); }
    else { const int r = id - 1984; transpose_tile(P.att_w_out, DM, (r >> 4) * 64, (r & 15) * 64, P.WtOut1, DM, tile); }
  }
}
__device__ __forceinline__ void phase_prep(const Params& P, unsigned char* smem, int bid, int nb) {
  float* tile = (float*)smem;
  const int t = threadIdx.x;
  const int NITEMS = 2242 + 4352 + 130;
  for (int id = bid; id < NITEMS; id += nb) {
    if (id < 1024) { const int p = id >> 8, r = id & 255; transpose_tile(P.w_in + (size_t)p * DM * DM, DM, (r >> 4) * 64, (r & 15) * 64, P.WtIn0 + (size_t)p * DM * DM, DM, tile, true); }
    else if (id < 1040) transpose_tile(P.w1, 64, (id - 1024) * 64, 0, P.WtIn0 + (size_t)4096 * DM, DM, tile, true);
    else if (id < 1056) transpose_tile(P.a1, 64, (id - 1040) * 64, 0, P.WtIn0 + (size_t)4224 * DM, DM, tile, true);
    else if (id < 1072) transpose_tile(P.w2, DM, 0, (id - 1056) * 64, P.W2t, 64, tile);
    else if (id < 1088) transpose_tile(P.a2, DM, 0, (id - 1072) * 64, P.A2t, 64, tile);
    else if (id < 2240) { }
    else if (id < 2242) {
      uint4* z = (uint4*)(P.WtIn0 + (size_t)(id == 2240 ? 4160 : 4288) * DM);
      for (int i = t; i < 8192; i += 256) z[i] = make_uint4(0, 0, 0, 0);
      if (id == 2240) for (int i = t; i < 6 * DM; i += 256) P.MU16[i] = f2h_bits(P.mu[i]);
    } else if (id < 2242 + 4352) {
      const int it = id - 2242;
#pragma unroll
      for (int q = 0; q < 4; q++) {
        const int m = it * 4 + q;
        const float4 x = ((const float4*)xin_row(P, m))[t];
        float4 pv = make_float4(0.f, 0.f, 0.f, 0.f);
        if (m < NPR) { if ((m & (TP - 1)) != 0) pv = ((const float4*)xin_row(P, m - 1))[t]; }
        else { const int ms = m - NPR; if ((ms & 7) != 0) pv = ((const float4*)xin_row(P, m - 1))[t]; else pv = ((const float4*)(P.state_shift + (size_t)(ms >> 3) * DM))[t]; }
        uint2 xb, xxb;
        xb.x = pack2h(x.x, x.y); xb.y = pack2h(x.z, x.w);
        xxb.x = pack2h(pv.x - x.x, pv.y - x.y); xxb.y = pack2h(pv.z - x.z, pv.w - x.w);
        ((uint2*)(P.XB + (size_t)m * DM))[t] = xb;
        ((uint2*)(P.XXB + (size_t)m * DM))[t] = xxb;
      }
    } else {
      const int r = id - (2242 + 4352);
      if (r < 2) ((float4*)(P.out + OUT_SH_P + (size_t)r * DM))[t] = ((const float4*)(P.x_prompt + ((size_t)r * TP + TP - 1) * DM))[t];
      else { const int b = r - 2; ((float4*)(P.out + OUT_SH_S + (size_t)b * DM))[t] = ((const float4*)(P.x_sample + ((size_t)b * 8 + 7) * DM))[t]; }
    }
  }
}

#define LDB 48
typedef _Float16 f16x8 __attribute__((ext_vector_type(8)));
typedef _Float16 f16x2 __attribute__((ext_vector_type(2)));
__device__ __forceinline__ unsigned xs16(unsigned x, unsigned d, unsigned m) {
  const f16x2 r = __builtin_elementwise_fma(__builtin_bit_cast(f16x2, d), __builtin_bit_cast(f16x2, m), __builtin_bit_cast(f16x2, x));
  return __builtin_bit_cast(unsigned, r);
}
template <int MODE>
__device__ __forceinline__ void gemm_tile(const Params& P, unsigned char* smem, int mt, int nt) {
  constexpr int KT = (MODE == 2) ? 1 : 16;
  bf16_t* Asb[2]; bf16_t* Bsb[2];
  Asb[0] = (bf16_t*)smem; Bsb[0] = Asb[0] + 128 * LDB; Asb[1] = Bsb[0] + 128 * LDB; Bsb[1] = Asb[1] + 128 * LDB;
  const int t = threadIdx.x, lane = t & 63, w = t >> 6;
  const int wm = w >> 1, wn = w & 1;
  const int g = lane >> 4, lc = lane & 15;
  const int lr = t >> 2, lc4 = t & 3;
  const int m0 = mt * 128, n0 = nt * 128;

  const bf16_t* Ap; const bf16_t* A2p = nullptr; const bf16_t* mup = nullptr; const bf16_t* Bp; int lda, ldb;
  if (MODE == 1) {
    const int p = (nt < 32) ? (nt >> 3) : (4 + (nt - 32));
    Ap = P.XB; A2p = P.XXB; lda = DM; mup = P.MU16 + (size_t)p * DM;
    Bp = P.WtIn0 + (size_t)((nt < 32) ? n0 : (4096 + (nt - 32) * 128)) * DM; ldb = DM;
  } else if (MODE == 2) {
    Ap = (nt < 8) ? P.H1 : P.H2; lda = 64;
    Bp = ((nt < 8) ? P.W2t : P.A2t) + (size_t)((nt & 7) * 128) * 64; ldb = 64;
  } else if (MODE == 3) { Ap = P.Gb; lda = DM; Bp = P.WtOut0 + (size_t)n0 * DM; ldb = DM; }
  else if (MODE == 4 || MODE == 6) { Ap = P.Rb; lda = DM; Bp = P.WtIn1 + (size_t)n0 * DM; ldb = DM; }
  else { Ap = P.Gb; lda = DM; Bp = P.WtOut1 + (size_t)n0 * DM; ldb = DM; }

  f32x4 acc[4][4];
#pragma unroll
  for (int i = 0; i < 4; i++)
#pragma unroll
    for (int j = 0; j < 4; j++) acc[i][j] = (f32x4){0.f, 0.f, 0.f, 0.f};

  u32x4 ra[2][2][2], rb[2][2][2], ra2[2][2][2], rmu[2][2];
  const unsigned voffA = (unsigned)(lr * lda + lc4 * 8) * 2u;
  const unsigned voffB = (unsigned)(lr * ldb + lc4 * 8) * 2u;
  const char* baseA = (const char*)(Ap + (size_t)m0 * lda);
  const char* baseA2 = (const char*)(A2p + (size_t)m0 * lda);
  const char* baseB = (const char*)Bp;
#define LOADH(S_, kt_, H_) do { if ((kt_) < KT) { \
    _Pragma("unroll") for (int ii_ = 0; ii_ < 2; ii_++) { \
      const size_t uo_ = ((size_t)(64 * ii_) * lda + (size_t)(kt_) * 64 + 32 * (H_)) * 2; \
      const size_t uob_ = ((size_t)(64 * ii_) * ldb + (size_t)(kt_) * 64 + 32 * (H_)) * 2; \
      ra[S_][H_][ii_] = *(const u32x4*)(baseA + uo_ + voffA); \
      if (MODE == 1) ra2[S_][H_][ii_] = *(const u32x4*)(baseA2 + uo_ + voffA); \
      rb[S_][H_][ii_] = *(const u32x4*)(baseB + uob_ + voffB); \
    } \
    if (MODE == 1) rmu[S_][H_] = *(const u32x4*)(mup + (kt_) * 64 + 32 * (H_) + lc4 * 8); \
  } } while (0)
#define STOREH(S_, H_, B_) do { \
    _Pragma("unroll") for (int ii_ = 0; ii_ < 2; ii_++) { \
      const int row_ = lr + 64 * ii_; \
      u32x4 av_ = ra[S_][H_][ii_]; \
      if (MODE == 1) { \
        const u32x4 xv_ = ra[S_][H_][ii_], dv_ = ra2[S_][H_][ii_], mv_ = rmu[S_][H_]; \
        av_ = (u32x4){xs16(xv_.x, dv_.x, mv_.x), xs16(xv_.y, dv_.y, mv_.y), xs16(xv_.z, dv_.z, mv_.z), xs16(xv_.w, dv_.w, mv_.w)}; \
      } \
      *(u32x4*)(Asb[B_] + row_ * LDB + lc4 * 8) = av_; \
      *(u32x4*)(Bsb[B_] + row_ * LDB + lc4 * 8) = rb[S_][H_][ii_]; \
    } \
  } while (0)
#define COMPUTE_SUB(B_) do { if (!(MODE == 6 && PROBE == 3)) { \
    bf16x8 af[4], bfr[4]; \
    _Pragma("unroll") for (int i = 0; i < 4; i++) af[i] = *(const bf16x8*)(Bsb[B_] + (wn * 64 + i * 16 + lc) * LDB + g * 8); \
    _Pragma("unroll") for (int j = 0; j < 4; j++) bfr[j] = *(const bf16x8*)(Asb[B_] + (wm * 64 + j * 16 + lc) * LDB + g * 8); \
    _Pragma("unroll") for (int i = 0; i < 4; i++) \
      _Pragma("unroll") for (int j = 0; j < 4; j++) { \
        if (MODE == 1) acc[i][j] = __builtin_amdgcn_mfma_f32_16x16x32_f16(__builtin_bit_cast(f16x8, af[i]), __builtin_bit_cast(f16x8, bfr[j]), acc[i][j], 0, 0, 0); \
        else acc[i][j] = __builtin_amdgcn_mfma_f32_16x16x32_bf16(af[i], bfr[j], acc[i][j], 0, 0, 0); \
      } \
  } } while (0)
  __syncthreads();
  LOADH(0, 0, 0); LOADH(0, 0, 1); LOADH(1, 1, 0); LOADH(1, 1, 1);
  STOREH(0, 0, 0);
  LOADH(0, 2, 0);
  __syncthreads();
  for (int kt = 0; kt < KT; kt += 2) {
    STOREH(0, 1, 1); LOADH(0, kt + 2, 1);
    COMPUTE_SUB(0);
    if (!(MODE == 6 && PROBE == 5)) __syncthreads();
    if (kt + 1 < KT) { STOREH(1, 0, 0); LOADH(1, kt + 3, 0); }
    COMPUTE_SUB(1);
    __syncthreads();
    if (kt + 1 < KT) {
      STOREH(1, 1, 1); LOADH(1, kt + 3, 1);
      COMPUTE_SUB(0);
      if (!(MODE == 6 && PROBE == 5)) __syncthreads();
      if (kt + 2 < KT) { STOREH(0, 0, 0); LOADH(0, kt + 4, 0); }
      COMPUTE_SUB(1);
      __syncthreads();
    }
  }
  if (MODE == 1 && nt >= 8 && nt < 16) {
    const int hh = (nt & 7) * 2 + wn;
    float kkw[4][4];
#pragma unroll
    for (int i = 0; i < 4; i++) { const float4 kq = *(const float4*)(P.k_k + hh * 64 + i * 16 + 4 * g); kkw[i][0] = kq.x; kkw[i][1] = kq.y; kkw[i][2] = kq.z; kkw[i][3] = kq.w; }
#pragma unroll
    for (int j = 0; j < 4; j++) {
      float ssq = 0.f;
#pragma unroll
      for (int i = 0; i < 4; i++) {
        const unsigned u0 = pack2(acc[i][j][0], acc[i][j][1]), u1 = pack2(acc[i][j][2], acc[i][j][3]);
        const float q0 = __uint_as_float(u0 << 16) * kkw[i][0], q1 = __uint_as_float(u0 & 0xffff0000u) * kkw[i][1];
        const float q2 = __uint_as_float(u1 << 16) * kkw[i][2], q3 = __uint_as_float(u1 & 0xffff0000u) * kkw[i][3];
        ssq = fmaf(q0, q0, ssq); ssq = fmaf(q1, q1, ssq); ssq = fmaf(q2, q2, ssq); ssq = fmaf(q3, q3, ssq);
      }
      ssq += __shfl_xor(ssq, 16); ssq += __shfl_xor(ssq, 32);
      if (g == 0) P.INVN[(size_t)(m0 + wm * 64 + j * 16 + lc) * 16 + hh] = __builtin_amdgcn_rsqf(fmaxf(ssq, 1e-24f));
    }
  }
#pragma unroll
  for (int i = 0; i < 4; i++) {
    const int nl = wn * 64 + i * 16 + 4 * g;
#pragma unroll
    for (int j = 0; j < 4; j++) {
      const int m = m0 + wm * 64 + j * 16 + lc;
      const f32x4 v = acc[i][j];
      if (MODE == 1) {
        if (nt < 32) {
          const int p = nt >> 3, c = (nt & 7) * 128 + nl;
          bf16_t* dst = (p == 0) ? P.Rb : (p == 1) ? P.Kb : (p == 2) ? P.Vb : P.Gb;
          uint2 o; o.x = pack2(v[0], v[1]); o.y = pack2(v[2], v[3]);
          *(uint2*)(dst + (size_t)m * DM + c) = o;
        } else if (nl < 64) {
          uint2 o;
          if (nt == 32) { o.x = pack2(tanhf(v[0]), tanhf(v[1])); o.y = pack2(tanhf(v[2]), tanhf(v[3])); *(uint2*)(P.H1 + (size_t)m * 64 + nl) = o; }
          else { o.x = pack2(v[0], v[1]); o.y = pack2(v[2], v[3]); *(uint2*)(P.H2 + (size_t)m * 64 + nl) = o; }
        }
      } else if (MODE == 2) {
        const int c = (nt & 7) * 128 + nl;
        f16_t o[4];
        if (nt < 8) {
          const float4 w0v = *(const float4*)(P.w0 + c);
          const float ws[4] = {w0v.x, w0v.y, w0v.z, w0v.w};
#pragma unroll
          for (int r = 0; r < 4; r++) o[r] = (f16_t)(sigmoidf_(ws[r] + v[r]) * 0.60653065971f);
          *(uint2*)(((f16_t*)(P.out + OUT_Y)) + (size_t)m * DM + c) = *(uint2*)o;
        } else {
          const float4 a0v = *(const float4*)(P.a0 + c);
          const float as_[4] = {a0v.x, a0v.y, a0v.z, a0v.w};
#pragma unroll
          for (int r = 0; r < 4; r++) o[r] = (f16_t)sigmoidf_(as_[r] + v[r]);
          *(uint2*)(((f16_t*)(P.out + OUT_Y) + (size_t)NTOK * DM) + (size_t)m * DM + c) = *(uint2*)o;
        }
      } else if (MODE == 3 || MODE == 5) {
        const int c = n0 + nl;
        float4 res;
        if (MODE == 3) res = *(const float4*)(xin_row(P, m) + c);
        else { const uint2 rb2 = *(const uint2*)(P.Rb + (size_t)m * DM + c); res = make_float4(__uint_as_float(rb2.x << 16), __uint_as_float(rb2.x & 0xffff0000u), __uint_as_float(rb2.y << 16), __uint_as_float(rb2.y & 0xffff0000u)); }
        float4 o = make_float4(v[0] + ALPHA_F * res.x, v[1] + ALPHA_F * res.y, v[2] + ALPHA_F * res.z, v[3] + ALPHA_F * res.w);
        *(float4*)(P.out + OUT_Y + (size_t)m * DM + c) = o;
      } else if (MODE == 6) {
        uint2 o; o.x = pack2(v[0], v[1]); o.y = pack2(v[2], v[3]);
        *(uint2*)(P.XB + (size_t)(m & 4095) * DM + ((n0 + nl) & 1023)) = o;
      } else if (MODE == 4) {
        uint2 o; o.x = pack2(v[0], v[1]); o.y = pack2(v[2], v[3]);
        if (nt < 8) { *(uint2*)(P.Kb + (size_t)m * DM + n0 + nl) = o; }
        else if (nt >= 12) { *(uint2*)(P.Vb + (size_t)m * DM + (nt - 12) * 128 + nl) = o; }
        else {
          const bool isk = nt < 10;
          const int ck = (nt & 1) * 128 + nl;
          bf16_t* K1 = P.XB; bf16_t* V1 = P.XB + (size_t)NTOK * 256; bf16_t* VT1 = P.XB + (size_t)NTOK * 512;
          *(uint2*)((isk ? K1 : V1) + (size_t)m * 256 + ck) = o;
          const float4 fo = make_float4(v[0], v[1], v[2], v[3]);
          if (m < NPR) {
            const int b = m >> 13, tt = m & (TP - 1);
            if (!isk) {
              const int hk = ck >> 6, d = ck & 63;
              bf16_t* vt = VT1 + ((size_t)((b * 4 + hk) * 64 + d)) * TP + tt;
              vt[0] = f2bf(v[0]); vt[TP] = f2bf(v[1]); vt[2 * TP] = f2bf(v[2]); vt[3 * TP] = f2bf(v[3]);
            }
            if (tt >= TP - 128) *(float4*)(P.out + (isk ? OUT_WK_P : OUT_WV_P) + ((size_t)(b * 128 + tt - (TP - 128))) * 256 + ck) = fo;
          } else {
            const int ms = m - NPR, b = ms >> 3, tt = ms & 7;
            *(float4*)(P.out + (isk ? OUT_WK_S : OUT_WV_S) + ((size_t)(b * 128 + 120 + tt)) * 256 + ck) = fo;
          }
        }
      }
    }
  }
}
#define LDBG 80
template <int MODE>
__device__ __forceinline__ void gemm_tile_big(const Params& P, unsigned char* smem, int mt, int nt) {
  bf16_t* As = (bf16_t*)smem;
  bf16_t* Bs = As + 256 * LDBG;
  const int t = threadIdx.x, lane = t & 63, w = __builtin_amdgcn_readfirstlane((int)(threadIdx.x >> 6));
  const int wm = w >> 1, wn = w & 1;
  const int g = lane >> 4, lc = lane & 15;
  const int lrow = t >> 3, lch = t & 7;
  const int m0 = mt * 256, n0 = nt * 128;
  const bf16_t* Ap = (MODE == 4) ? P.Rb : P.Gb;
  const bf16_t* Bp = ((MODE == 3) ? P.WtOut0 : (MODE == 4) ? P.WtIn1 : P.WtOut1) + (size_t)n0 * DM;
  f32x4 acc[4][8];
#pragma unroll
  for (int i = 0; i < 4; i++)
#pragma unroll
    for (int j = 0; j < 8; j++) acc[i][j] = (f32x4){0.f, 0.f, 0.f, 0.f};
  u32x4 ra[8], rb[4];
  const unsigned voff = (unsigned)(lrow * DM + lch * 8) * 2u;
  const char* baseA = (const char*)(Ap + (size_t)m0 * DM);
  const char* baseB = (const char*)Bp;
#define BIG_LOAD(kt_) do { \
    _Pragma("unroll") for (int i_ = 0; i_ < 8; i_++) ra[i_] = *(const u32x4*)(baseA + ((size_t)(32 * i_) * DM + (size_t)(kt_) * 64) * 2 + voff); \
    _Pragma("unroll") for (int i_ = 0; i_ < 4; i_++) rb[i_] = *(const u32x4*)(baseB + ((size_t)(32 * i_) * DM + (size_t)(kt_) * 64) * 2 + voff); \
  } while (0)
  BIG_LOAD(0);
  for (int kt = 0; kt < 16; kt++) {
    __syncthreads();
#pragma unroll
    for (int i = 0; i < 8; i++) *(u32x4*)(As + (lrow + 32 * i) * LDBG + lch * 8) = ra[i];
#pragma unroll
    for (int i = 0; i < 4; i++) *(u32x4*)(Bs + (lrow + 32 * i) * LDBG + lch * 8) = rb[i];
    __syncthreads();
    if (kt + 1 < 16) BIG_LOAD(kt + 1);
#pragma unroll
    for (int ks = 0; ks < 2; ks++) {
      bf16x8 af[4];
#pragma unroll
      for (int i = 0; i < 4; i++) af[i] = *(const bf16x8*)(Bs + (wn * 64 + i * 16 + lc) * LDBG + ks * 32 + g * 8);
#pragma unroll
      for (int jh = 0; jh < 2; jh++) {
        bf16x8 bfr[4];
#pragma unroll
        for (int j = 0; j < 4; j++) bfr[j] = *(const bf16x8*)(As + (wm * 128 + (jh * 4 + j) * 16 + lc) * LDBG + ks * 32 + g * 8);
#pragma unroll
        for (int i = 0; i < 4; i++)
#pragma unroll
          for (int j = 0; j < 4; j++) acc[i][jh * 4 + j] = __builtin_amdgcn_mfma_f32_16x16x32_bf16(af[i], bfr[j], acc[i][jh * 4 + j], 0, 0, 0);
      }
    }
  }
#pragma unroll
  for (int i = 0; i < 4; i++) {
    const int nl = wn * 64 + i * 16 + 4 * g;
#pragma unroll
    for (int j = 0; j < 8; j++) {
      const int m = m0 + wm * 128 + j * 16 + lc;
      const f32x4 v = acc[i][j];
      if (MODE == 3 || MODE == 5) {
        const int c = n0 + nl;
        float4 res;
        if (MODE == 3) res = *(const float4*)(xin_row(P, m) + c);
        else { const uint2 rb2 = *(const uint2*)(P.Rb + (size_t)m * DM + c); res = make_float4(__uint_as_float(rb2.x << 16), __uint_as_float(rb2.x & 0xffff0000u), __uint_as_float(rb2.y << 16), __uint_as_float(rb2.y & 0xffff0000u)); }
        *(float4*)(P.out + OUT_Y + (size_t)m * DM + c) = make_float4(v[0] + ALPHA_F * res.x, v[1] + ALPHA_F * res.y, v[2] + ALPHA_F * res.z, v[3] + ALPHA_F * res.w);
      } else {
        uint2 o; o.x = pack2(v[0], v[1]); o.y = pack2(v[2], v[3]);
        if (nt < 8) { *(uint2*)(P.Kb + (size_t)m * DM + n0 + nl) = o; }
        else if (nt >= 12) { *(uint2*)(P.Vb + (size_t)m * DM + (nt - 12) * 128 + nl) = o; }
        else {
          const bool isk = nt < 10;
          const int ck = (nt & 1) * 128 + nl;
          bf16_t* K1 = P.XB; bf16_t* V1 = P.XB + (size_t)NTOK * 256; bf16_t* VT1 = P.XB + (size_t)NTOK * 512;
          *(uint2*)((isk ? K1 : V1) + (size_t)m * 256 + ck) = o;
          const float4 fo = make_float4(v[0], v[1], v[2], v[3]);
          if (m < NPR) {
            const int b = m >> 13, tt = m & (TP - 1);
            if (!isk) {
              const int hk = ck >> 6, d = ck & 63;
              bf16_t* vt = VT1 + ((size_t)((b * 4 + hk) * 64 + d)) * TP + tt;
              vt[0] = f2bf(v[0]); vt[TP] = f2bf(v[1]); vt[2 * TP] = f2bf(v[2]); vt[3 * TP] = f2bf(v[3]);
            }
            if (tt >= TP - 128) *(float4*)(P.out + (isk ? OUT_WK_P : OUT_WV_P) + ((size_t)(b * 128 + tt - (TP - 128))) * 256 + ck) = fo;
          } else {
            const int ms = m - NPR, b = ms >> 3, tt = ms & 7;
            *(float4*)(P.out + (isk ? OUT_WK_S : OUT_WV_S) + ((size_t)(b * 128 + 120 + tt)) * 256 + ck) = fo;
          }
        }
      }
    }
  }
}
__device__ __forceinline__ void gemm1_part(const Params& P, unsigned char* smem, int part, int first, int stride) {
  const int nnt = part ? 16 : 18;
  for (int tile = first; tile < 136 * nnt; tile += stride) {
    const int mt = tile % 136, ntl = tile / 136;
    const int nt = part ? ((ntl < 8) ? ntl : (24 + ntl - 8)) : ((ntl < 16) ? (8 + ntl) : (32 + ntl - 16));
    gemm_tile<1>(P, smem, mt, nt);
  }
}
template <int MODE>
__device__ __forceinline__ void gemm_phase(const Params& P, unsigned char* smem, int bid, int nb) {
  constexpr int NT = (MODE == 1) ? 34 : (MODE == 2) ? 16 : (MODE == 4 || MODE == 6) ? 20 : 8;
#if USE_BIG
  if (MODE == 4) {
    for (int tile = bid; tile < 68 * NT; tile += nb) gemm_tile_big<MODE>(P, smem, tile % 68, tile / 68);
    return;
  }
  if (MODE == 3 || MODE == 5) {
    for (int tile = bid; tile < 64 * NT; tile += nb) gemm_tile_big<MODE>(P, smem, tile % 64, tile / 64);
    for (int id = bid; id < 8 * NT; id += nb) gemm_tile<MODE>(P, smem, 128 + (id % 8), id / 8);
    return;
  }
#endif
  const int ntiles = 136 * NT;
  for (int tile = bid; tile < ntiles; tile += nb) gemm_tile<MODE>(P, smem, tile % 136, tile / 136);
}

#define TS 8
#define REC 392
typedef float f32x2 __attribute__((ext_vector_type(2)));
__device__ __forceinline__ f32x2 pkfma(f32x2 a, f32x2 b, f32x2 c) { return __builtin_elementwise_fma(a, b, c); }
#define DPP_ADD(x, ctrl) ((x) + __builtin_bit_cast(float, __builtin_amdgcn_update_dpp(0, __builtin_bit_cast(int, (x)), (ctrl), 0xF, 0xF, true)))
__device__ __forceinline__ float wave_sum_fast(float x) {
  x = DPP_ADD(x, 0xB1); x = DPP_ADD(x, 0x4E); x = DPP_ADD(x, 0x141); x = DPP_ADD(x, 0x140);
  const int xi = __builtin_bit_cast(int, x);
  const float t0 = __builtin_bit_cast(float, __builtin_amdgcn_readlane(xi, 0)), t1 = __builtin_bit_cast(float, __builtin_amdgcn_readlane(xi, 16));
  const float t2 = __builtin_bit_cast(float, __builtin_amdgcn_readlane(xi, 32)), t3 = __builtin_bit_cast(float, __builtin_amdgcn_readlane(xi, 48));
  return (t0 + t1) + (t2 + t3);
}
#define LD8(dst, ptr) do { _Pragma("unroll") for (int j4_ = 0; j4_ < 4; j4_++) { const f32x4 v_ = *(const f32x4*)((ptr) + 4 * j4_); \
    dst[2 * j4_] = (f32x2){v_[0], v_[1]}; dst[2 * j4_ + 1] = (f32x2){v_[2], v_[3]}; } } while (0)

template <int INIT  , bool USEV, bool WRITEY>
__device__ __forceinline__ void scan_unit(const Params& P, float* ws, int lane, int tok0, int nsteps, int h, const float* init_ptr, float* fin) {
  const int rq = lane >> 2, q = lane & 3;
  f32x2 s[4][8];
#pragma unroll
  for (int i = 0; i < 4; i++)
#pragma unroll
    for (int j = 0; j < 8; j++) {
      if (INIT == 1) s[i][j] = (f32x2){((rq + 16 * i) == (16 * q + 2 * j)) ? 1.f : 0.f, ((rq + 16 * i) == (16 * q + 2 * j + 1)) ? 1.f : 0.f};
      else s[i][j] = (f32x2){0.f, 0.f};
    }
  if (INIT == 2) {
#pragma unroll
    for (int i = 0; i < 4; i++) LD8(s[i], init_ptr + (size_t)(rq + 16 * i) * 64 + 16 * q);
  }
  const int c = h * 64 + lane;
  const float kkc = P.k_k[c], kac = P.k_a[c], rkc = P.r_k[c];
  const int crow = h * 64 + rq + 16 * q;
  const float gng = P.gn_g[crow], gnb = P.gn_b[crow];
  const f16_t* EW = ((const f16_t*)(P.out + OUT_Y));
  const f16_t* AA = ((const f16_t*)(P.out + OUT_Y) + (size_t)NTOK * DM);

  bf16_t rk[TS], rv[TS], rr[TS]; f16_t ra_[TS], re_[TS]; float rn_[TS];
#define LOAD_RAW(tb) do { const size_t ub_ = (size_t)(tok0 + (tb)) * DM; \
    const bf16_t* kb_ = P.Kb + ub_; const f16_t* ab_ = AA + ub_; const f16_t* eb_ = EW + ub_; const bf16_t* vb_ = P.Vb + ub_; const bf16_t* rb_ = P.Rb + ub_; \
    _Pragma("unroll") for (int tt_ = 0; tt_ < TS; tt_++) { const unsigned off_ = (unsigned)(tt_ * DM + c); \
    rn_[tt_] = P.INVN[(size_t)(tok0 + (tb) + tt_) * 16 + h]; rk[tt_] = kb_[off_]; ra_[tt_] = ab_[off_]; re_[tt_] = eb_[off_]; if (USEV) rv[tt_] = vb_[off_]; if (WRITEY) rr[tt_] = rb_[off_]; } } while (0)
  LOAD_RAW(0);
  for (int t0 = 0; t0 < nsteps; t0 += TS) {
    {
      float gcum = 1.f;
#pragma unroll
      for (int tt = 0; tt < TS; tt++) {
        const float kraw = bf2f(rk[tt]);
        const float a = (float)ra_[tt];
        const float wd = __expf(-(float)re_[tt]);
        const float kkv = kraw * kkc * rn_[tt];
        const float kf = kraw * (1.f + (a - 1.f) * kac);
        float* rec = ws + tt * REC;
        rec[lane] = kkv * gcum;
        gcum *= wd;
        const float ginv = __builtin_amdgcn_rcpf(gcum);
        rec[128 + lane] = kf * ginv; rec[192 + lane] = kkv * a * ginv;
        if (WRITEY) {
          const float r = bf2f(rr[tt]);
          rec[256 + lane] = r * gcum;
          const float bonus = wave_sum_fast(r * kf * rkc);
          if (lane == 0) rec[384] = bonus;
        }
        if (USEV) rec[320 + lane] = bf2f(rv[tt]);
      }
      ws[TS * REC + lane] = gcum;
    }
    __builtin_amdgcn_wave_barrier();
    asm volatile("s_waitcnt lgkmcnt(0)" ::: "memory");
    if (t0 + TS < nsteps) LOAD_RAW(t0 + TS);
#pragma unroll 1
    for (int tt = 0; tt < TS; tt++) {
      const float* rec = ws + tt * REC;
      f32x2 o2[8], b2[8], kf2[8];
      LD8(o2, rec + 16 * q);
      LD8(b2, rec + 192 + 16 * q);
      if (USEV) LD8(kf2, rec + 128 + 16 * q);
      f32x2 nsa2[4];
      {
        f32x2 acc[4];
#pragma unroll
        for (int i = 0; i < 4; i++) acc[i] = s[i][0] * o2[0];
#pragma unroll
        for (int j = 1; j < 8; j++)
#pragma unroll
          for (int i = 0; i < 4; i++) acc[i] = pkfma(s[i][j], o2[j], acc[i]);
#pragma unroll
        for (int i = 0; i < 4; i++) { const float t = -quad_sum(acc[i][0] + acc[i][1]); nsa2[i] = (f32x2){t, t}; }
      }
      float vv[4];
      if (USEV) {
#pragma unroll
        for (int i = 0; i < 4; i++) vv[i] = rec[320 + rq + 16 * i];
      }
      if (WRITEY) LD8(o2, rec + 256 + 16 * q);
#pragma unroll
      for (int i = 0; i < 4; i++) {
#pragma unroll
        for (int j = 0; j < 8; j++) s[i][j] = pkfma(nsa2[i], b2[j], s[i][j]);
        if (USEV) {
          const f32x2 vv2 = (f32x2){vv[i], vv[i]};
#pragma unroll
          for (int j = 0; j < 8; j++) s[i][j] = pkfma(vv2, kf2[j], s[i][j]);
        }
      }
      if (WRITEY) {
        float y[4];
        {
          f32x2 acc[4];
#pragma unroll
          for (int i = 0; i < 4; i++) acc[i] = s[i][0] * o2[0];
#pragma unroll
          for (int j = 1; j < 8; j++)
#pragma unroll
            for (int i = 0; i < 4; i++) acc[i] = pkfma(s[i][j], o2[j], acc[i]);
#pragma unroll
          for (int i = 0; i < 4; i++) y[i] = quad_sum(acc[i][0] + acc[i][1]);
        }
        const float ysel = (q == 0) ? y[0] : (q == 1) ? y[1] : (q == 2) ? y[2] : y[3];
        const float vsel = (q == 0) ? vv[0] : (q == 1) ? vv[1] : (q == 2) ? vv[2] : vv[3];
        const float mean = wave_sum_fast(ysel) * (1.f / 64.f);
        const float ex2 = wave_sum_fast(ysel * ysel) * (1.f / 64.f);
        const float var = fmaxf(ex2 - mean * mean, 0.f);
        float yo = (ysel - mean) * rsqrtf(var + 64e-5f) * gng + gnb + rec[384] * vsel;
        const size_t off = (size_t)(tok0 + t0 + tt) * DM + crow;
        const float gt = bf2f(P.Gb[off]);
        yo *= gt * sigmoidf_(gt);
        P.Gb[off] = f2bf(yo);
      }
    }
    {
      f32x2 ge[8];
      LD8(ge, ws + TS * REC + 16 * q);
#pragma unroll
      for (int i = 0; i < 4; i++)
#pragma unroll
        for (int j = 0; j < 8; j++) s[i][j] *= ge[j];
    }
    __builtin_amdgcn_wave_barrier();
    asm volatile("s_waitcnt lgkmcnt(0)" ::: "memory");
  }
  if (fin) {
#pragma unroll
    for (int i = 0; i < 4; i++)
#pragma unroll
      for (int j4 = 0; j4 < 4; j4++)
        *(f32x4*)(fin + (size_t)(rq + 16 * i) * 64 + 16 * q + 4 * j4) = (f32x4){s[i][2 * j4][0], s[i][2 * j4][1], s[i][2 * j4 + 1][0], s[i][2 * j4 + 1][1]};
  }
}

__device__ __forceinline__ void phase_scan1(const Params& P, unsigned char* smem, int bid, int nb) {
  const int lane = threadIdx.x & 63, w = __builtin_amdgcn_readfirstlane((int)(threadIdx.x >> 6));
  float* ws = (float*)smem + w * (TS * REC + 64);
  float* Ploc = P.out + OUT_WK_S;
  float* Sloc = P.out + OUT_WV_S;
  const int hb = nb >> 1;
  if (bid >= hb) { gemm1_part(P, smem, 1, bid - hb, nb - hb); return; }
  for (int u = w * hb + bid; u < NBH * (NC - 1) * 2; u += 4 * hb) {
    const int kind = (u ^ (u / (4 * hb))) & 1, rest = u >> 1;
    const int c = rest % (NC - 1), bh = rest / (NC - 1);
    const int tok0 = (bh >> 4) * TP + c * CL, h = bh & 15;
    float* fin = (kind ? Ploc : Sloc) + (size_t)(bh * (NC - 1) + c) * 4096;
    if (kind) scan_unit<1, false, false>(P, ws, lane, tok0, CL, h, nullptr, fin);
    else scan_unit<0, true, false>(P, ws, lane, tok0, CL, h, nullptr, fin);
  }
}
__device__ __forceinline__ void phase_scan2(const Params& P, unsigned char* smem, int bid, int nb) {
  const int lane = threadIdx.x & 63, w = __builtin_amdgcn_readfirstlane((int)(threadIdx.x >> 6));
  float* ws = (float*)smem + w * 256;
  float* Ploc = P.out + OUT_WK_S;
  float* Sloc = P.out + OUT_WV_S;
  for (int item = bid; item < NBH * 4; item += nb) {
    const int bh = item >> 2, row0 = (item & 3) * 16 + w * 4;
    float s[4];
    {
      const float* S0 = Sloc + (size_t)(bh * (NC - 1)) * 4096;
#pragma unroll
      for (int r = 0; r < 4; r++) s[r] = S0[(row0 + r) * 64 + lane];
    }
    for (int c = 1; c < NC - 1; c++) {
      const float* Pc = Ploc + (size_t)(bh * (NC - 1) + c) * 4096;
      float* Sc = Sloc + (size_t)(bh * (NC - 1) + c) * 4096;
      float acc[4];
#pragma unroll
      for (int r = 0; r < 4; r++) { acc[r] = Sc[(row0 + r) * 64 + lane]; ws[r * 64 + lane] = s[r]; }
      __builtin_amdgcn_wave_barrier();
      asm volatile("s_waitcnt lgkmcnt(0)" ::: "memory");
#pragma unroll 1
      for (int hf = 0; hf < 2; hf++) {
        float p[32];
#pragma unroll
        for (int i = 0; i < 32; i++) p[i] = Pc[(hf * 32 + i) * 64 + lane];
#pragma unroll
        for (int r = 0; r < 4; r++) {
#pragma unroll
          for (int i4 = 0; i4 < 8; i4++) {
            const float4 sv = *(const float4*)(ws + r * 64 + hf * 32 + 4 * i4);
            acc[r] = fmaf(sv.x, p[4 * i4], acc[r]); acc[r] = fmaf(sv.y, p[4 * i4 + 1], acc[r]);
            acc[r] = fmaf(sv.z, p[4 * i4 + 2], acc[r]); acc[r] = fmaf(sv.w, p[4 * i4 + 3], acc[r]);
          }
        }
      }
      __builtin_amdgcn_wave_barrier();
      asm volatile("s_waitcnt lgkmcnt(0)" ::: "memory");
#pragma unroll
      for (int r = 0; r < 4; r++) { s[r] = acc[r]; Sc[(row0 + r) * 64 + lane] = acc[r]; }
    }
  }
}
__device__ __forceinline__ void phase_scan3(const Params& P, unsigned char* smem, int bid, int nb) {
  const int lane = threadIdx.x & 63, w = __builtin_amdgcn_readfirstlane((int)(threadIdx.x >> 6));
  float* ws = (float*)smem + w * (TS * REC + 64);
  float* Sloc = P.out + OUT_WV_S;
  const int hb = nb >> 1;
  if (bid < hb) {
    for (int u = w * hb + bid; u < NBH * NC; u += 4 * hb) {
      const int bh = u >> 5, c = u & 31;
      const int tok0 = (bh >> 4) * TP + c * CL, h = bh & 15;
      const float* ip = (c > 0) ? (Sloc + (size_t)(bh * (NC - 1) + c - 1) * 4096) : nullptr;
      float* fin = (c == NC - 1) ? (P.out + OUT_WKV_P + (size_t)bh * 4096) : nullptr;
      if (c > 0) scan_unit<2, true, true>(P, ws, lane, tok0, CL, h, ip, fin);
      else scan_unit<0, true, true>(P, ws, lane, tok0, CL, h, ip, fin);
    }
  } else {
    for (int sb = w * (nb - hb) + (bid - hb); sb < 2048; sb += 4 * (nb - hb))
      scan_unit<2, true, true>(P, ws, lane, NPR + (sb >> 4) * 8, 8, sb & 15, P.state_wkv + (size_t)sb * 4096, P.out + OUT_WKV_S + (size_t)sb * 4096);
    __syncthreads();
    late_weight_prep(P, smem, bid - hb, nb - hb);
  }
}

__device__ __forceinline__ void phase_ln(const Params& P, int layer, int bid, int nb) {
  const int lane = threadIdx.x & 63, w = __builtin_amdgcn_readfirstlane((int)(threadIdx.x >> 6));
  const float* gg = P.ln_g + layer * DM; const float* bb = P.ln_b + layer * DM;
  for (int tok = bid * 4 + w; tok < NTOK; tok += nb * 4) {
    f32x4* row = (f32x4*)(P.out + OUT_Y + (size_t)tok * DM);
    f32x4 v[4];
    float sum = 0.f;
#pragma unroll
    for (int i = 0; i < 4; i++) { v[i] = row[lane + 64 * i]; sum += v[i][0] + v[i][1] + v[i][2] + v[i][3]; }
    const float mean = wave_sum(sum) * (1.f / 1024.f);
    float sq = 0.f;
#pragma unroll
    for (int i = 0; i < 4; i++) { v[i] -= mean; sq += v[i][0] * v[i][0] + v[i][1] * v[i][1] + v[i][2] * v[i][2] + v[i][3] * v[i][3]; }
    const float rs = rsqrtf(wave_sum(sq) * (1.f / 1024.f) + 1e-5f);
#pragma unroll
    for (int i = 0; i < 4; i++) {
      const f32x4 g4 = ((const f32x4*)gg)[lane + 64 * i], b4 = ((const f32x4*)bb)[lane + 64 * i];
      const f32x4 o = v[i] * rs * g4 + b4;
      if (layer != 0) row[lane + 64 * i] = o;
      if (layer == 0) { uint2 ob; ob.x = pack2(o[0], o[1]); ob.y = pack2(o[2], o[3]); ((uint2*)(P.Rb + (size_t)tok * DM))[lane + 64 * i] = ob; }
    }
  }
}

__device__ __forceinline__ void attn_prompt_item(const Params& P, unsigned char* smem, int item) {
  const int qh = item & 1, hk = (item >> 1) & 3, n = (item >> 3) & 63, b = item >> 9;
  bf16_t* Ks = (bf16_t*)smem;
  bf16_t* Vs = Ks + 192 * 72;
  const bf16_t* K1 = P.XB; const bf16_t* VT1 = P.XB + (size_t)NTOK * 512;
  const bf16_t* Q1 = P.Kb; const bf16_t* G1 = P.Vb; bf16_t* AO = P.Gb;
  const int t = threadIdx.x, lane = t & 63, w = t >> 6;
  const int g = lane >> 4, lc = lane & 15;
  const int pos0 = (n - 1) * 128 + 64 * qh;
  __syncthreads();
#pragma unroll
  for (int i = 0; i < 6; i++) {
    const int idx = t + 256 * i; const int row = idx >> 3, ch = idx & 7; const int pos = pos0 + row;
    uint4 v = make_uint4(0, 0, 0, 0);
    if (pos >= 0) v = *(const uint4*)(K1 + ((size_t)(b * TP + pos)) * 256 + hk * 64 + ch * 8);
    *(uint4*)(Ks + row * 72 + ch * 8) = v;
  }
#pragma unroll
  for (int i = 0; i < 6; i++) {
    const int idx = t + 256 * i; const int d = idx / 24, ch = idx % 24; const int pos = pos0 + ch * 8;
    uint4 v = make_uint4(0, 0, 0, 0);
    if (pos >= 0) v = *(const uint4*)(VT1 + ((size_t)((b * 4 + hk) * 64 + d)) * TP + pos);
    *(uint4*)(Vs + d * 200 + ch * 8) = v;
  }
  __syncthreads();
  const int h = hk * 4 + w;
  const float slope = exp2f(-0.5f * (float)(h + 1));
  const float sink = P.att_sinks[h];
  for (int sb = 0; sb < 2; sb++) {
    const int i0 = 64 * qh + 32 * sb;
    const int tokb = b * TP + n * 128 + i0;
    bf16x8 qf[2][2];
#pragma unroll
    for (int nn = 0; nn < 2; nn++)
#pragma unroll
      for (int ks = 0; ks < 2; ks++) qf[nn][ks] = *(const bf16x8*)(Q1 + (size_t)(tokb + 16 * nn + lc) * DM + h * 64 + ks * 32 + g * 8);
    float mrun[2] = {sink, sink}, lrun[2] = {1.f, 1.f};
    f32x4 O[4][2];
#pragma unroll
    for (int dm = 0; dm < 4; dm++) { O[dm][0] = (f32x4){0.f, 0.f, 0.f, 0.f}; O[dm][1] = (f32x4){0.f, 0.f, 0.f, 0.f}; }
    for (int kt = 0; kt < 3; kt++) {
      if (n == 0 && (qh + kt) < 2) continue;
      f32x4 S[4][2];
#pragma unroll
      for (int mm = 0; mm < 4; mm++) { S[mm][0] = (f32x4){0.f, 0.f, 0.f, 0.f}; S[mm][1] = (f32x4){0.f, 0.f, 0.f, 0.f}; }
#pragma unroll
      for (int ks = 0; ks < 2; ks++)
#pragma unroll
        for (int mm = 0; mm < 4; mm++) {
          const bf16x8 kf = *(const bf16x8*)(Ks + (kt * 64 + mm * 16 + lc) * 72 + ks * 32 + g * 8);
          S[mm][0] = __builtin_amdgcn_mfma_f32_16x16x32_bf16(kf, qf[0][ks], S[mm][0], 0, 0, 0);
          S[mm][1] = __builtin_amdgcn_mfma_f32_16x16x32_bf16(kf, qf[1][ks], S[mm][1], 0, 0, 0);
        }
#pragma unroll
      for (int nn = 0; nn < 2; nn++) {
        const int qi = i0 + 16 * nn + lc;
        float mx = mrun[nn];
#pragma unroll
        for (int mm = 0; mm < 4; mm++)
#pragma unroll
          for (int r = 0; r < 4; r++) {
            const int j = 64 * (qh + kt) + 16 * mm + 4 * g + r;
            const int dist = 128 + qi - j;
            const bool live = (dist >= 0) && (dist < 128);
            const float sv = live ? (S[mm][nn][r] * 0.125f - slope * (float)dist) : -1e30f;
            S[mm][nn][r] = sv; mx = fmaxf(mx, sv);
          }
        mx = fmaxf(mx, __shfl_xor(mx, 16)); mx = fmaxf(mx, __shfl_xor(mx, 32));
        const float corr = __expf(mrun[nn] - mx); mrun[nn] = mx;
        float sum = 0.f;
#pragma unroll
        for (int mm = 0; mm < 4; mm++)
#pragma unroll
          for (int r = 0; r < 4; r++) { const float pp = __expf(S[mm][nn][r] - mx); S[mm][nn][r] = pp; sum += pp; }
        sum += __shfl_xor(sum, 16); sum += __shfl_xor(sum, 32);
        lrun[nn] = lrun[nn] * corr + sum;
#pragma unroll
        for (int dm = 0; dm < 4; dm++) { O[dm][nn][0] *= corr; O[dm][nn][1] *= corr; O[dm][nn][2] *= corr; O[dm][nn][3] *= corr; }
      }
#pragma unroll
      for (int k2 = 0; k2 < 2; k2++) {
        bf16x8 pf[2];
#pragma unroll
        for (int nn = 0; nn < 2; nn++) {
          const unsigned u0 = pack2(S[2 * k2][nn][0], S[2 * k2][nn][1]), u1 = pack2(S[2 * k2][nn][2], S[2 * k2][nn][3]);
          const unsigned u2 = pack2(S[2 * k2 + 1][nn][0], S[2 * k2 + 1][nn][1]), u3 = pack2(S[2 * k2 + 1][nn][2], S[2 * k2 + 1][nn][3]);
          const uint4 uu = make_uint4(u0, u1, u2, u3);
          pf[nn] = *(const bf16x8*)&uu;
        }
#pragma unroll
        for (int dm = 0; dm < 4; dm++) {
          const bf16_t* vb = Vs + (dm * 16 + lc) * 200 + kt * 64 + k2 * 32 + 4 * g;
          const uint2 lo = *(const uint2*)vb, hi = *(const uint2*)(vb + 16);
          const uint4 uu = make_uint4(lo.x, lo.y, hi.x, hi.y);
          const bf16x8 vf = *(const bf16x8*)&uu;
          O[dm][0] = __builtin_amdgcn_mfma_f32_16x16x32_bf16(vf, pf[0], O[dm][0], 0, 0, 0);
          O[dm][1] = __builtin_amdgcn_mfma_f32_16x16x32_bf16(vf, pf[1], O[dm][1], 0, 0, 0);
        }
      }
    }
#pragma unroll
    for (int nn = 0; nn < 2; nn++) {
      const float inv = 1.f / lrun[nn];
      const size_t tok = (size_t)(tokb + 16 * nn + lc);
#pragma unroll
      for (int dm = 0; dm < 4; dm++) {
        const int d = dm * 16 + 4 * g;
        const uint2 gv = *(const uint2*)(G1 + tok * DM + h * 64 + d);
        const float g0 = __uint_as_float(gv.x << 16), g1 = __uint_as_float(gv.x & 0xffff0000u);
        const float g2 = __uint_as_float(gv.y << 16), g3 = __uint_as_float(gv.y & 0xffff0000u);
        uint2 o;
        o.x = pack2(O[dm][nn][0] * inv * g0 * sigmoidf_(g0), O[dm][nn][1] * inv * g1 * sigmoidf_(g1));
        o.y = pack2(O[dm][nn][2] * inv * g2 * sigmoidf_(g2), O[dm][nn][3] * inv * g3 * sigmoidf_(g3));
        *(uint2*)(AO + tok * DM + h * 64 + d) = o;
      }
    }
  }
}

__device__ __forceinline__ void attn_sample_item(const Params& P, unsigned char* smem, int item) {
  const int b = item >> 2, hk = item & 3;
  const int t = threadIdx.x, lane = t & 63, w = t >> 6;
  float* kv = (float*)smem;
  float* qs = kv + 136 * 65 + w * 512;
  float* ps = kv + 136 * 65 + 2048 + w * (8 * 136);
  const bf16_t* K1 = P.XB; const bf16_t* V1 = P.XB + (size_t)NTOK * 256;
  const bf16_t* Q1 = P.Kb; const bf16_t* G1 = P.Vb; bf16_t* AO = P.Gb;
  const int h = hk * 4 + w;
  const float slope = exp2f(-0.5f * (float)(h + 1));
  const float sink = P.att_sinks[h];
  const int tok0 = NPR + b * 8;
  __syncthreads();
#pragma unroll 2
  for (int it = 0; it < 8; it++) {
    const int idx = t + 256 * it; const int row = idx >> 4, c4 = idx & 15;
    const size_t so = ((size_t)(b * 128 + row)) * 256 + hk * 64 + c4 * 4;
    const float4 kx = *(const float4*)(P.cache_k + so);
    const float4 vx = *(const float4*)(P.cache_v + so);
    float* kd = kv + row * 65 + c4 * 4;
    kd[0] = kx.x; kd[1] = kx.y; kd[2] = kx.z; kd[3] = kx.w;
    if (row >= 8) {
      const size_t dofs = ((size_t)(b * 128 + row - 8)) * 256 + hk * 64 + c4 * 4;
      *(float4*)(P.out + OUT_WK_S + dofs) = kx;
      *(float4*)(P.out + OUT_WV_S + dofs) = vx;
    }
  }
#pragma unroll
  for (int it = 0; it < 2; it++) {
    const int idx = t + 256 * it; const int r8 = idx >> 6, d = idx & 63;
    kv[(128 + r8) * 65 + d] = bf2f(K1[(size_t)(tok0 + r8) * 256 + hk * 64 + d]);
  }
#pragma unroll
  for (int i = 0; i < 8; i++) qs[i * 64 + lane] = bf2f(Q1[(size_t)(tok0 + i) * DM + h * 64 + lane]);
  __syncthreads();
  float sc[3][8];
#pragma unroll
  for (int ksel = 0; ksel < 3; ksel++) {
    float acc[8];
#pragma unroll
    for (int i = 0; i < 8; i++) acc[i] = 0.f;
    const float* kr = kv + ((ksel < 2) ? (lane + 64 * ksel) : (128 + (lane & 7))) * 65;
#pragma unroll 2
    for (int d4 = 0; d4 < 16; d4++) {
      const float k0 = kr[4 * d4], k1 = kr[4 * d4 + 1], k2 = kr[4 * d4 + 2], k3 = kr[4 * d4 + 3];
#pragma unroll
      for (int i = 0; i < 8; i++) {
        const float4 qv = *(const float4*)(qs + i * 64 + 4 * d4);
        acc[i] = fmaf(qv.x, k0, acc[i]); acc[i] = fmaf(qv.y, k1, acc[i]); acc[i] = fmaf(qv.z, k2, acc[i]); acc[i] = fmaf(qv.w, k3, acc[i]);
      }
    }
#pragma unroll
    for (int i = 0; i < 8; i++) {
      int dist; bool live;
      if (ksel < 2) { const int j = lane + 64 * ksel; dist = 128 + i - j; live = (j > i); }
      else { dist = i - lane; live = (lane <= i); }
      sc[ksel][i] = live ? (acc[i] * 0.125f - slope * (float)dist) : -1e30f;
    }
  }
#pragma unroll
  for (int i = 0; i < 8; i++) {
    float mx = fmaxf(fmaxf(sc[0][i], sc[1][i]), sc[2][i]);
    mx = fmaxf(wave_max(mx), sink);
    const float p0 = __expf(sc[0][i] - mx), p1 = __expf(sc[1][i] - mx), p2 = __expf(sc[2][i] - mx);
    const float den = wave_sum(p0 + p1 + p2) + __expf(sink - mx);
    const float inv = 1.f / den;
    ps[i * 136 + lane] = p0 * inv; ps[i * 136 + 64 + lane] = p1 * inv;
    if (lane < 8) ps[i * 136 + 128 + lane] = p2 * inv;
  }
  __syncthreads();
#pragma unroll 4
  for (int it = 0; it < 8; it++) {
    const int idx = t + 256 * it; const int row = idx >> 4, c4 = idx & 15;
    *(float4*)(kv + row * 64 + c4 * 4) = *(const float4*)(P.cache_v + ((size_t)(b * 128 + row)) * 256 + hk * 64 + c4 * 4);
  }
#pragma unroll
  for (int it = 0; it < 2; it++) {
    const int idx = t + 256 * it; const int r8 = idx >> 6, d = idx & 63;
    kv[(128 + r8) * 64 + d] = bf2f(V1[(size_t)(tok0 + r8) * 256 + hk * 64 + d]);
  }
  __syncthreads();
  float o[8];
#pragma unroll
  for (int i = 0; i < 8; i++) o[i] = 0.f;
#pragma unroll 2
  for (int j0 = 0; j0 < 136; j0 += 4) {
    const float v0 = kv[(j0) * 64 + lane], v1 = kv[(j0 + 1) * 64 + lane], v2 = kv[(j0 + 2) * 64 + lane], v3 = kv[(j0 + 3) * 64 + lane];
#pragma unroll
    for (int i = 0; i < 8; i++) {
      const float4 pa = *(const float4*)(ps + i * 136 + j0);
      o[i] = fmaf(pa.x, v0, o[i]); o[i] = fmaf(pa.y, v1, o[i]); o[i] = fmaf(pa.z, v2, o[i]); o[i] = fmaf(pa.w, v3, o[i]);
    }
  }
#pragma unroll
  for (int i = 0; i < 8; i++) {
    const size_t off = (size_t)(tok0 + i) * DM + h * 64 + lane;
    const float gt = bf2f(G1[off]);
    AO[off] = f2bf(o[i] * gt * sigmoidf_(gt));
  }
}
__device__ __forceinline__ void phase_attn(const Params& P, unsigned char* smem, int bid, int nb) {
#if PROBE == 7
  for (int item = bid; item < 1024; item += nb) attn_prompt_item(P, smem, item);
#elif PROBE == 8
  for (int item = bid; item < 512; item += nb) attn_sample_item(P, smem, item);
#endif
  for (int item = bid; item < 1024 + 512; item += nb) {
    if (item < 1024) attn_prompt_item(P, smem, item);
    else attn_sample_item(P, smem, item - 1024);
  }
}

#if MULTI_LAUNCH
#define PH_BARRIER(ph)
#else
#define PH_BARRIER(ph) do { if ((ph) + 1 < P.phase_end) xcd_barrier(xb); } while (0)
#endif
#define RUN_PH(ph, call) do { if (P.phase_begin <= (ph) && (ph) < P.phase_end) { if ((REPMASK >> (ph)) & 1) { call; PH_BARRIER(ph); } call; PH_BARRIER(ph); } } while (0)

__global__ void __launch_bounds__(256, 2) fwd_kernel(Params P) {
  __shared__ __attribute__((aligned(16))) unsigned char smem[SMEM_BYTES];
  const int bid = blockIdx.x, nb = gridDim.x;
#if !MULTI_LAUNCH
  __shared__ uint4 xb_words;
  if (threadIdx.x == 0) xb_words = make_uint4(0u, 0u, 0u, 0u);
  __syncthreads();
  XcdBarrier xb = xcd_barrier_post(P.bar, (volatile LAS unsigned*)&xb_words);
#endif
#if (PHMASK >> 0) & 1
  RUN_PH(0, phase_prep(P, smem, bid, nb));
#endif
#if (PHMASK >> 1) & 1
  RUN_PH(1, gemm1_part(P, smem, 0, bid, nb));
#endif
#if (PHMASK >> 2) & 1
  RUN_PH(2, gemm_phase<2>(P, smem, bid, nb));
#endif
#if (PHMASK >> 3) & 1
  RUN_PH(3, phase_scan1(P, smem, bid, nb));
#endif
#if (PHMASK >> 4) & 1
  RUN_PH(4, phase_scan2(P, smem, bid, nb));
#endif
#if (PHMASK >> 5) & 1
  RUN_PH(5, phase_scan3(P, smem, bid, nb));
#endif
#if (PHMASK >> 6) & 1
  RUN_PH(6, gemm_phase<3>(P, smem, bid, nb));
#endif
#if (PHMASK >> 7) & 1
  RUN_PH(7, phase_ln(P, 0, bid, nb));
#endif
#if (PHMASK >> 8) & 1
  RUN_PH(8, gemm_phase<4>(P, smem, bid, nb));
#endif
#if (PHMASK >> 9) & 1
  RUN_PH(9, phase_attn(P, smem, bid, nb));
#endif
#if (PHMASK >> 10) & 1
  RUN_PH(10, gemm_phase<5>(P, smem, bid, nb));
#endif
#if (PHMASK >> 11) & 1
  RUN_PH(11, phase_ln(P, 1, bid, nb));
#endif
#if PROBE && PROBE < 7
  xcd_barrier(xb);
  gemm_phase<6>(P, smem, bid, nb);
#endif
#if !MULTI_LAUNCH
  if (P.phase_end > NPHASE) cg::this_grid().sync();
#endif
}

extern "C" void kernel_launch(void* const* d_in, const int* in_sizes, int n_in, void* d_out, int out_size, void* d_ws, size_t ws_size, hipStream_t stream) {
  Params P{};
  P.x_prompt = (const float*)d_in[0]; P.x_sample = (const float*)d_in[1]; P.state_wkv = (const float*)d_in[2]; P.state_shift = (const float*)d_in[3];
  P.cache_k = (const float*)d_in[4]; P.cache_v = (const float*)d_in[5]; P.ln_g = (const float*)d_in[6]; P.ln_b = (const float*)d_in[7];
  P.mu = (const float*)d_in[8]; P.w_in = (const float*)d_in[9]; P.w0 = (const float*)d_in[10]; P.w1 = (const float*)d_in[11]; P.w2 = (const float*)d_in[12];
  P.a0 = (const float*)d_in[13]; P.a1 = (const float*)d_in[14]; P.a2 = (const float*)d_in[15]; P.k_k = (const float*)d_in[16]; P.k_a = (const float*)d_in[17];
  P.r_k = (const float*)d_in[18]; P.gn_g = (const float*)d_in[19]; P.gn_b = (const float*)d_in[20]; P.w_out = (const float*)d_in[21];
  P.att_w_in = (const float*)d_in[22]; P.att_sinks = (const float*)d_in[23]; P.att_w_out = (const float*)d_in[24];
  P.out = (float*)d_out;
  unsigned char* ws = (unsigned char*)d_ws;
  size_t off = 0;
  auto take = [&](size_t bytes) { unsigned char* p = ws + off; off += (bytes + 255) & ~(size_t)255; return p; };
  P.bar = (unsigned*)take(16384);
  P.WtIn0 = (bf16_t*)take((size_t)4352 * DM * 2);
  P.W2t = (bf16_t*)take((size_t)DM * 64 * 2);
  P.A2t = (bf16_t*)take((size_t)DM * 64 * 2);
  P.WtOut0 = (bf16_t*)take((size_t)DM * DM * 2);
  P.WtIn1 = (bf16_t*)take((size_t)2560 * DM * 2);
  P.WtOut1 = (bf16_t*)take((size_t)DM * DM * 2);
  P.XB = (bf16_t*)take((size_t)NTOK * DM * 2);
  P.XXB = (bf16_t*)take((size_t)NTOK * DM * 2);
  P.Rb = (bf16_t*)take((size_t)NTOK * DM * 2);
  P.Kb = (bf16_t*)take((size_t)NTOK * DM * 2);
  P.Vb = (bf16_t*)take((size_t)NTOK * DM * 2);
  P.Gb = (bf16_t*)take((size_t)NTOK * DM * 2);
  P.H1 = (bf16_t*)take((size_t)NTOK * 64 * 2);
  P.H2 = (bf16_t*)take((size_t)NTOK * 64 * 2);
  P.MU16 = (bf16_t*)take((size_t)6 * DM * 2);
  P.INVN = (float*)take((size_t)NTOK * 16 * 4);
  if (off > ws_size) { fprintf(stderr, "workspace too small: need %zu have %zu\n", off, ws_size); return; }
#if MULTI_LAUNCH
  for (int ph = 0; ph < NPHASE; ph++) {
    P.phase_begin = ph; P.phase_end = ph + 1;
    hipLaunchKernelGGL(fwd_kernel, dim3(512), dim3(256), 0, stream, P);
  }
#else
  static int grid_blocks = 0;
  if (!grid_blocks) {
    int dev = 0, cus = 0, per_cu = 0;
    hipGetDevice(&dev);
    hipDeviceGetAttribute(&cus, hipDeviceAttributeMultiprocessorCount, dev);
    hipOccupancyMaxActiveBlocksPerMultiprocessor(&per_cu, fwd_kernel, 256, 0);
    if (per_cu > 2) per_cu = 2;
    if (per_cu < 1) per_cu = 1;
    grid_blocks = cus * per_cu;
  }
  hipMemsetAsync(P.bar, 0, 16384, stream);
  P.phase_begin = 0; P.phase_end = NPHASE;
  void* args[] = {&P};
  hipError_t e = hipLaunchCooperativeKernel((void*)fwd_kernel, dim3(grid_blocks), dim3(256), args, 0, stream);
  if (e != hipSuccess) fprintf(stderr, "cooperative launch failed: %s (grid %d)\n", hipGetErrorString(e), grid_blocks);
#endif
}
```

```cpp
#include <hip/hip_runtime.h>
#include <hip/hip_cooperative_groups.h>
#include <stdint.h>
#include <cstdio>
namespace cg = cooperative_groups;

#ifndef PHMASK
#define PHMASK 0xFFF
#endif
#ifndef USE_BIG
#define USE_BIG 1
#endif
#ifndef PROBE
#define PROBE 0
#endif
#ifndef REPMASK
#define REPMASK 0
#endif
#ifndef MULTI_LAUNCH
#define MULTI_LAUNCH 0
#endif

typedef unsigned short bf16_t;
typedef _Float16 f16_t;
typedef __attribute__((ext_vector_type(8))) short bf16x8;
typedef __attribute__((ext_vector_type(4))) float f32x4;
typedef __attribute__((ext_vector_type(4))) unsigned u32x4;

#define DM 1024
#define NTOK 17408
#define NPR 16384
#define TP 8192
#define NC 32
#define CL 256
#define NBH 32
#define ALPHA_F 1.41421356237f
#define SMEM_BYTES (61 * 1024)
#define NPHASE 12

#define OUT_Y 0
#define OUT_WKV_P 17825792
#define OUT_SH_P 17956864
#define OUT_WK_P 17958912
#define OUT_WV_P 18024448
#define OUT_WKV_S 18089984
#define OUT_SH_S 26478592
#define OUT_WK_S 26609664
#define OUT_WV_S 30803968

struct Params {
  const float *x_prompt, *x_sample, *state_wkv, *state_shift, *cache_k, *cache_v, *ln_g, *ln_b;
  const float *mu, *w_in, *w0, *w1, *w2, *a0, *a1, *a2, *k_k, *k_a, *r_k, *gn_g, *gn_b, *w_out;
  const float *att_w_in, *att_sinks, *att_w_out;
  float* out;
  unsigned* bar;
  bf16_t *WtIn0, *W2t, *A2t, *WtOut0, *WtIn1, *WtOut1;
  bf16_t *XB, *XXB;
  bf16_t *Rb, *Kb, *Vb, *Gb;
  bf16_t *H1, *H2, *MU16;
  float* INVN;
  int phase_begin, phase_end;
};

typedef __bf16 hbf2 __attribute__((ext_vector_type(2)));
typedef float f32x2_ __attribute__((ext_vector_type(2)));
__device__ __forceinline__ unsigned pack2(float a, float b) {
  const f32x2_ v = {a, b};
  return __builtin_bit_cast(unsigned, __builtin_convertvector(v, hbf2));
}
__device__ __forceinline__ bf16_t f2bf(float f) { return (bf16_t)(pack2(f, 0.f) & 0xffffu); }
__device__ __forceinline__ float bf2f(bf16_t h) { return __uint_as_float(((unsigned)h) << 16); }
__device__ __forceinline__ float wave_sum(float x) {
#pragma unroll
  for (int o = 32; o >= 1; o >>= 1) x += __shfl_xor(x, o);
  return x;
}
__device__ __forceinline__ float wave_max(float x) {
#pragma unroll
  for (int o = 32; o >= 1; o >>= 1) x = fmaxf(x, __shfl_xor(x, o));
  return x;
}
__device__ __forceinline__ float quad_sum(float x) {
  x += __builtin_bit_cast(float, __builtin_amdgcn_update_dpp(0, __builtin_bit_cast(int, x), 0xB1, 0xF, 0xF, true));
  x += __builtin_bit_cast(float, __builtin_amdgcn_update_dpp(0, __builtin_bit_cast(int, x), 0x4E, 0xF, 0xF, true));
  return x;
}
__device__ __forceinline__ float sigmoidf_(float x) { return __builtin_amdgcn_rcpf(1.f + __expf(-x)); }
__device__ __forceinline__ const float* xin_row(const Params& P, int m) {
  return (m < NPR) ? (P.x_prompt + (size_t)m * DM) : (P.x_sample + (size_t)(m - NPR) * DM);
}

#define XB_TMO      128
#define XB_XCNT(j)  (256  + 64 * (j))
#define XB_XSUB(j)  (1280 + 64 * (j))
#define XB_XGEN(j)  (2304 + 64 * (j))
#define XB_TOP      3328
#define XB_TOPGEN   3392
#define XCD_BAR_WORDS 3456
#define XB_SPIN_CAP (1u << 22)
#define LAS __attribute__((address_space(3)))
__device__ __forceinline__ unsigned xb_ld(unsigned* p) { return __hip_atomic_load(p, __ATOMIC_RELAXED, __HIP_MEMORY_SCOPE_AGENT); }
__device__ __forceinline__ unsigned xb_add(unsigned* p, unsigned v) { return __hip_atomic_fetch_add(p, v, __ATOMIC_RELAXED, __HIP_MEMORY_SCOPE_AGENT); }
__device__ __forceinline__ unsigned xb_xcc_id() { return (unsigned)__builtin_amdgcn_s_getreg((3 << 11) | 20) & 0xFu; }
#define XB_SPIN(cond, bar) do { unsigned _sp = 0; while (cond) { __builtin_amdgcn_s_sleep(1); \
    if ((++_sp & 255u) == 0u) { if (xb_ld(&(bar)[XB_TMO])) break; if (_sp > XB_SPIN_CAP) { atomicAdd(&(bar)[XB_TMO], 1u); break; } } } } while (0)
struct XcdBarrier { unsigned* bar; unsigned x; volatile LAS unsigned* st; };
__device__ __forceinline__ XcdBarrier xcd_barrier_post(unsigned* bar, volatile LAS unsigned* st) {
  XcdBarrier b; b.bar = bar; b.x = xb_xcc_id(); b.st = st;
  if (threadIdx.x == 0) (void)xb_add(&bar[XB_XCNT(b.x)], 1u);
  return b;
}
__device__ __forceinline__ void xcd_barrier_complete(unsigned* bar, unsigned x, unsigned& nloc, unsigned& nx) {
  const unsigned G = gridDim.x * gridDim.y * gridDim.z;
  unsigned sum, cnt, mine, sp = 0u;
  for (;;) {
    sum = 0u; cnt = 0u; mine = 0u;
#pragma unroll
    for (unsigned j = 0; j < 16; ++j) { const unsigned c = xb_ld(&bar[XB_XCNT(j)]); sum += c; cnt += (c > 0u) ? 1u : 0u; mine = (j == x) ? c : mine; }
    if (sum == G) break;
    __builtin_amdgcn_s_sleep(1);
    if ((++sp & 255u) == 0u) { if (xb_ld(&bar[XB_TMO])) break; if (sp > XB_SPIN_CAP) { atomicAdd(&bar[XB_TMO], 1u); break; } }
  }
  nloc = mine > 0u ? mine : 1u; nx = cnt > 0u ? cnt : 1u;
}
__device__ __forceinline__ void xcd_barrier(const XcdBarrier& b) {
  asm volatile("s_waitcnt vmcnt(0)" ::: "memory");
  __syncthreads();
  if (threadIdx.x == 0) {
    unsigned* bar = b.bar;
    __builtin_amdgcn_s_waitcnt(0);
    unsigned nloc = b.st[0], nx = b.st[1];
    if (nloc == 0u) { xcd_barrier_complete(bar, b.x, nloc, nx); b.st[0] = nloc; b.st[1] = nx; }
    const unsigned old = xb_add(&bar[XB_XSUB(b.x)], 1u);
    const unsigned gen = old / nloc;
    if (old + 1u == (gen + 1u) * nloc) {
      __builtin_amdgcn_fence(__ATOMIC_RELEASE, "agent");
      asm volatile("s_waitcnt vmcnt(0)" ::: "memory");
      const unsigned og = xb_add(&bar[XB_TOP], 1u);
      const unsigned tg = og / nx;
      if (og + 1u == (tg + 1u) * nx) xb_add(&bar[XB_TOPGEN], 1u);
      else XB_SPIN(xb_ld(&bar[XB_TOPGEN]) == tg, bar);
      __builtin_amdgcn_fence(__ATOMIC_ACQUIRE, "agent");
      xb_add(&bar[XB_XGEN(b.x)], 1u);
      asm volatile("s_waitcnt vmcnt(0)" ::: "memory");
    } else {
      XB_SPIN(xb_ld(&bar[XB_XGEN(b.x)]) == gen, bar);
      __builtin_amdgcn_fence(__ATOMIC_ACQUIRE, "agent");
      asm volatile("s_waitcnt vmcnt(0)" ::: "memory");
    }
  }
  __syncthreads();
}

__device__ __forceinline__ unsigned short f2h_bits(float f) { const _Float16 h = (_Float16)f; return __builtin_bit_cast(unsigned short, h); }
__device__ __forceinline__ unsigned pack2h(float a, float b) { return (unsigned)f2h_bits(a) | ((unsigned)f2h_bits(b) << 16); }
__device__ __forceinline__ void transpose_tile(const float* __restrict__ src, int ld, int k0, int n0, bf16_t* __restrict__ dst, int ldd, float* tile, bool half = false) {
  const int t = threadIdx.x;
  {
    const int n = t & 63, kq = t >> 6;
#pragma unroll 4
    for (int i = 0; i < 16; i++) { const int k = i * 4 + kq; tile[k * 65 + n] = src[(size_t)(k0 + k) * ld + n0 + n]; }
  }
  __syncthreads();
  {
    const int k = t & 63, nq = t >> 6;
#pragma unroll 4
    for (int i = 0; i < 16; i++) { const int n2 = i * 4 + nq; const float v_ = tile[k * 65 + n2]; dst[(size_t)(n0 + n2) * ldd + k0 + k] = half ? f2h_bits(v_) : f2bf(v_); }
  }
  __syncthreads();
}

__device__ __forceinline__ void late_weight_prep(const Params& P, unsigned char* smem, int first, int stride) {
  float* tile = (float*)smem;
  for (int id = 1088 + first; id < 2240; id += stride) {
    if (id < 1344) { const int r = id - 1088; transpose_tile(P.w_out, DM, (r >> 4) * 64, (r & 15) * 64, P.WtOut0, DM, tile); }
    else if (id < 1984) { const int r = id - 1344; transpose_tile(P.att_w_in, 2560, (r / 40) * 64, (r % 40) * 64, P.WtIn1, DM, tile); }
    else { const int r = id - 1984; transpose_tile(P.att_w_out, DM, (r >> 4) * 64, (r & 15) * 64, P.WtOut1, DM, tile); }
  }
}
__device__ __forceinline__ void phase_prep(const Params& P, unsigned char* smem, int bid, int nb) {
  float* tile = (float*)smem;
  const int t = threadIdx.x;
  const int NITEMS = 2242 + 4352 + 130;
  for (int id = bid; id < NITEMS; id += nb) {
    if (id < 1024) { const int p = id >> 8, r = id & 255; transpose_tile(P.w_in + (size_t)p * DM * DM, DM, (r >> 4) * 64, (r & 15) * 64, P.WtIn0 + (size_t)p * DM * DM, DM, tile, true); }
    else if (id < 1040) transpose_tile(P.w1, 64, (id - 1024) * 64, 0, P.WtIn0 + (size_t)4096 * DM, DM, tile, true);
    else if (id < 1056) transpose_tile(P.a1, 64, (id - 1040) * 64, 0, P.WtIn0 + (size_t)4224 * DM, DM, tile, true);
    else if (id < 1072) transpose_tile(P.w2, DM, 0, (id - 1056) * 64, P.W2t, 64, tile);
    else if (id < 1088) transpose_tile(P.a2, DM, 0, (id - 1072) * 64, P.A2t, 64, tile);
    else if (id < 2240) { }
    else if (id < 2242) {
      uint4* z = (uint4*)(P.WtIn0 + (size_t)(id == 2240 ? 4160 : 4288) * DM);
      for (int i = t; i < 8192; i += 256) z[i] = make_uint4(0, 0, 0, 0);
      if (id == 2240) for (int i = t; i < 6 * DM; i += 256) P.MU16[i] = f2h_bits(P.mu[i]);
    } else if (id < 2242 + 4352) {
      const int it = id - 2242;
#pragma unroll
      for (int q = 0; q < 4; q++) {
        const int m = it * 4 + q;
        const float4 x = ((const float4*)xin_row(P, m))[t];
        float4 pv = make_float4(0.f, 0.f, 0.f, 0.f);
        if (m < NPR) { if ((m & (TP - 1)) != 0) pv = ((const float4*)xin_row(P, m - 1))[t]; }
        else { const int ms = m - NPR; if ((ms & 7) != 0) pv = ((const float4*)xin_row(P, m - 1))[t]; else pv = ((const float4*)(P.state_shift + (size_t)(ms >> 3) * DM))[t]; }
        uint2 xb, xxb;
        xb.x = pack2h(x.x, x.y); xb.y = pack2h(x.z, x.w);
        xxb.x = pack2h(pv.x - x.x, pv.y - x.y); xxb.y = pack2h(pv.z - x.z, pv.w - x.w);
        ((uint2*)(P.XB + (size_t)m * DM))[t] = xb;
        ((uint2*)(P.XXB + (size_t)m * DM))[t] = xxb;
        if (m < NPR) {
          const float4 m1 = ((const float4*)(P.mu + 1 * DM))[t], m2 = ((const float4*)(P.mu + 2 * DM))[t];
          const float dx = pv.x - x.x, dy = pv.y - x.y, dz = pv.z - x.z, dw = pv.w - x.w;
          uint2 s1, s2;
          s1.x = pack2h(fmaf(dx, m1.x, x.x), fmaf(dy, m1.y, x.y)); s1.y = pack2h(fmaf(dz, m1.z, x.z), fmaf(dw, m1.w, x.w));
          s2.x = pack2h(fmaf(dx, m2.x, x.x), fmaf(dy, m2.y, x.y)); s2.y = pack2h(fmaf(dz, m2.z, x.z), fmaf(dw, m2.w, x.w));
          ((uint2*)(P.Rb + (size_t)m * DM))[t] = s1;
          ((uint2*)(P.Gb + (size_t)m * DM))[t] = s2;
        }
      }
    } else {
      const int r = id - (2242 + 4352);
      if (r < 2) ((float4*)(P.out + OUT_SH_P + (size_t)r * DM))[t] = ((const float4*)(P.x_prompt + ((size_t)r * TP + TP - 1) * DM))[t];
      else { const int b = r - 2; ((float4*)(P.out + OUT_SH_S + (size_t)b * DM))[t] = ((const float4*)(P.x_sample + ((size_t)b * 8 + 7) * DM))[t]; }
    }
  }
}

#define LDB 48
typedef _Float16 f16x8 __attribute__((ext_vector_type(8)));
typedef _Float16 f16x2 __attribute__((ext_vector_type(2)));
__device__ __forceinline__ unsigned xs16(unsigned x, unsigned d, unsigned m) {
  const f16x2 r = __builtin_elementwise_fma(__builtin_bit_cast(f16x2, d), __builtin_bit_cast(f16x2, m), __builtin_bit_cast(f16x2, x));
  return __builtin_bit_cast(unsigned, r);
}
template <int MODE>
__device__ __forceinline__ void gemm_tile(const Params& P, unsigned char* smem, int mt, int nt) {
  constexpr int KT = (MODE == 2) ? 1 : 16;
  bf16_t* Asb[2]; bf16_t* Bsb[2];
  Asb[0] = (bf16_t*)smem; Bsb[0] = Asb[0] + 128 * LDB; Asb[1] = Bsb[0] + 128 * LDB; Bsb[1] = Asb[1] + 128 * LDB;
  const int t = threadIdx.x, lane = t & 63, w = t >> 6;
  const int wm = w >> 1, wn = w & 1;
  const int g = lane >> 4, lc = lane & 15;
  const int lr = t >> 2, lc4 = t & 3;
  const int m0 = mt * 128, n0 = nt * 128;

  const bf16_t* Ap; const bf16_t* A2p = nullptr; const bf16_t* mup = nullptr; const bf16_t* Bp; int lda, ldb;
  if (MODE == 1) {
    const int p = (nt < 32) ? (nt >> 3) : (4 + (nt - 32));
    Ap = P.XB; A2p = P.XXB; lda = DM; mup = P.MU16 + (size_t)p * DM;
    Bp = P.WtIn0 + (size_t)((nt < 32) ? n0 : (4096 + (nt - 32) * 128)) * DM; ldb = DM;
  } else if (MODE == 2) {
    Ap = (nt < 8) ? P.H1 : P.H2; lda = 64;
    Bp = ((nt < 8) ? P.W2t : P.A2t) + (size_t)((nt & 7) * 128) * 64; ldb = 64;
  } else if (MODE == 3) { Ap = P.Gb; lda = DM; Bp = P.WtOut0 + (size_t)n0 * DM; ldb = DM; }
  else if (MODE == 4 || MODE == 6) { Ap = P.Rb; lda = DM; Bp = P.WtIn1 + (size_t)n0 * DM; ldb = DM; }
  else { Ap = P.Gb; lda = DM; Bp = P.WtOut1 + (size_t)n0 * DM; ldb = DM; }

  f32x4 acc[4][4];
#pragma unroll
  for (int i = 0; i < 4; i++)
#pragma unroll
    for (int j = 0; j < 4; j++) acc[i][j] = (f32x4){0.f, 0.f, 0.f, 0.f};

  u32x4 ra[2][2][2], rb[2][2][2], ra2[2][2][2], rmu[2][2];
  const unsigned voffA = (unsigned)(lr * lda + lc4 * 8) * 2u;
  const unsigned voffB = (unsigned)(lr * ldb + lc4 * 8) * 2u;
  const char* baseA = (const char*)(Ap + (size_t)m0 * lda);
  const char* baseA2 = (const char*)(A2p + (size_t)m0 * lda);
  const char* baseB = (const char*)Bp;
#define LOADH(S_, kt_, H_) do { if ((kt_) < KT) { \
    _Pragma("unroll") for (int ii_ = 0; ii_ < 2; ii_++) { \
      const size_t uo_ = ((size_t)(64 * ii_) * lda + (size_t)(kt_) * 64 + 32 * (H_)) * 2; \
      const size_t uob_ = ((size_t)(64 * ii_) * ldb + (size_t)(kt_) * 64 + 32 * (H_)) * 2; \
      ra[S_][H_][ii_] = *(const u32x4*)(baseA + uo_ + voffA); \
      if (MODE == 1) ra2[S_][H_][ii_] = *(const u32x4*)(baseA2 + uo_ + voffA); \
      rb[S_][H_][ii_] = *(const u32x4*)(baseB + uob_ + voffB); \
    } \
    if (MODE == 1) rmu[S_][H_] = *(const u32x4*)(mup + (kt_) * 64 + 32 * (H_) + lc4 * 8); \
  } } while (0)
#define STOREH(S_, H_, B_) do { \
    _Pragma("unroll") for (int ii_ = 0; ii_ < 2; ii_++) { \
      const int row_ = lr + 64 * ii_; \
      u32x4 av_ = ra[S_][H_][ii_]; \
      if (MODE == 1) { \
        const u32x4 xv_ = ra[S_][H_][ii_], dv_ = ra2[S_][H_][ii_], mv_ = rmu[S_][H_]; \
        av_ = (u32x4){xs16(xv_.x, dv_.x, mv_.x), xs16(xv_.y, dv_.y, mv_.y), xs16(xv_.z, dv_.z, mv_.z), xs16(xv_.w, dv_.w, mv_.w)}; \
      } \
      *(u32x4*)(Asb[B_] + row_ * LDB + lc4 * 8) = av_; \
      *(u32x4*)(Bsb[B_] + row_ * LDB + lc4 * 8) = rb[S_][H_][ii_]; \
    } \
  } while (0)
#define COMPUTE_SUB(B_) do { if (!(MODE == 6 && PROBE == 3)) { \
    bf16x8 af[4], bfr[4]; \
    _Pragma("unroll") for (int i = 0; i < 4; i++) af[i] = *(const bf16x8*)(Bsb[B_] + (wn * 64 + i * 16 + lc) * LDB + g * 8); \
    _Pragma("unroll") for (int j = 0; j < 4; j++) bfr[j] = *(const bf16x8*)(Asb[B_] + (wm * 64 + j * 16 + lc) * LDB + g * 8); \
    _Pragma("unroll") for (int i = 0; i < 4; i++) \
      _Pragma("unroll") for (int j = 0; j < 4; j++) { \
        if (MODE == 1) acc[i][j] = __builtin_amdgcn_mfma_f32_16x16x32_f16(__builtin_bit_cast(f16x8, af[i]), __builtin_bit_cast(f16x8, bfr[j]), acc[i][j], 0, 0, 0); \
        else acc[i][j] = __builtin_amdgcn_mfma_f32_16x16x32_bf16(af[i], bfr[j], acc[i][j], 0, 0, 0); \
      } \
  } } while (0)
  __syncthreads();
  LOADH(0, 0, 0); LOADH(0, 0, 1); LOADH(1, 1, 0); LOADH(1, 1, 1);
  STOREH(0, 0, 0);
  LOADH(0, 2, 0);
  __syncthreads();
  for (int kt = 0; kt < KT; kt += 2) {
    STOREH(0, 1, 1); LOADH(0, kt + 2, 1);
    COMPUTE_SUB(0);
    if (!(MODE == 6 && PROBE == 5)) __syncthreads();
    if (kt + 1 < KT) { STOREH(1, 0, 0); LOADH(1, kt + 3, 0); }
    COMPUTE_SUB(1);
    __syncthreads();
    if (kt + 1 < KT) {
      STOREH(1, 1, 1); LOADH(1, kt + 3, 1);
      COMPUTE_SUB(0);
      if (!(MODE == 6 && PROBE == 5)) __syncthreads();
      if (kt + 2 < KT) { STOREH(0, 0, 0); LOADH(0, kt + 4, 0); }
      COMPUTE_SUB(1);
      __syncthreads();
    }
  }
  if (MODE == 1 && nt >= 8 && nt < 16) {
    const int hh = (nt & 7) * 2 + wn;
    float kkw[4][4];
#pragma unroll
    for (int i = 0; i < 4; i++) { const float4 kq = *(const float4*)(P.k_k + hh * 64 + i * 16 + 4 * g); kkw[i][0] = kq.x; kkw[i][1] = kq.y; kkw[i][2] = kq.z; kkw[i][3] = kq.w; }
#pragma unroll
    for (int j = 0; j < 4; j++) {
      float ssq = 0.f;
#pragma unroll
      for (int i = 0; i < 4; i++) {
        const unsigned u0 = pack2(acc[i][j][0], acc[i][j][1]), u1 = pack2(acc[i][j][2], acc[i][j][3]);
        const float q0 = __uint_as_float(u0 << 16) * kkw[i][0], q1 = __uint_as_float(u0 & 0xffff0000u) * kkw[i][1];
        const float q2 = __uint_as_float(u1 << 16) * kkw[i][2], q3 = __uint_as_float(u1 & 0xffff0000u) * kkw[i][3];
        ssq = fmaf(q0, q0, ssq); ssq = fmaf(q1, q1, ssq); ssq = fmaf(q2, q2, ssq); ssq = fmaf(q3, q3, ssq);
      }
      ssq += __shfl_xor(ssq, 16); ssq += __shfl_xor(ssq, 32);
      if (g == 0) P.INVN[(size_t)(m0 + wm * 64 + j * 16 + lc) * 16 + hh] = __builtin_amdgcn_rsqf(fmaxf(ssq, 1e-24f));
    }
  }
#pragma unroll
  for (int i = 0; i < 4; i++) {
    const int nl = wn * 64 + i * 16 + 4 * g;
#pragma unroll
    for (int j = 0; j < 4; j++) {
      const int m = m0 + wm * 64 + j * 16 + lc;
      const f32x4 v = acc[i][j];
      if (MODE == 1) {
        if (nt < 32) {
          const int p = nt >> 3, c = (nt & 7) * 128 + nl;
          bf16_t* dst = (p == 0) ? P.Rb : (p == 1) ? P.Kb : (p == 2) ? P.Vb : P.Gb;
          uint2 o; o.x = pack2(v[0], v[1]); o.y = pack2(v[2], v[3]);
          *(uint2*)(dst + (size_t)m * DM + c) = o;
        } else if (nl < 64) {
          uint2 o;
          if (nt == 32) { o.x = pack2(tanhf(v[0]), tanhf(v[1])); o.y = pack2(tanhf(v[2]), tanhf(v[3])); *(uint2*)(P.H1 + (size_t)m * 64 + nl) = o; }
          else { o.x = pack2(v[0], v[1]); o.y = pack2(v[2], v[3]); *(uint2*)(P.H2 + (size_t)m * 64 + nl) = o; }
        }
      } else if (MODE == 2) {
        const int c = (nt & 7) * 128 + nl;
        f16_t o[4];
        if (nt < 8) {
          const float4 w0v = *(const float4*)(P.w0 + c);
          const float ws[4] = {w0v.x, w0v.y, w0v.z, w0v.w};
#pragma unroll
          for (int r = 0; r < 4; r++) o[r] = (f16_t)(sigmoidf_(ws[r] + v[r]) * 0.60653065971f);
          *(uint2*)(((f16_t*)(P.out + OUT_Y)) + (size_t)m * DM + c) = *(uint2*)o;
        } else {
          const float4 a0v = *(const float4*)(P.a0 + c);
          const float as_[4] = {a0v.x, a0v.y, a0v.z, a0v.w};
#pragma unroll
          for (int r = 0; r < 4; r++) o[r] = (f16_t)sigmoidf_(as_[r] + v[r]);
          *(uint2*)(((f16_t*)(P.out + OUT_Y) + (size_t)NTOK * DM) + (size_t)m * DM + c) = *(uint2*)o;
        }
      } else if (MODE == 3 || MODE == 5) {
        const int c = n0 + nl;
        float4 res;
        if (MODE == 3) res = *(const float4*)(xin_row(P, m) + c);
        else { const uint2 rb2 = *(const uint2*)(P.Rb + (size_t)m * DM + c); res = make_float4(__uint_as_float(rb2.x << 16), __uint_as_float(rb2.x & 0xffff0000u), __uint_as_float(rb2.y << 16), __uint_as_float(rb2.y & 0xffff0000u)); }
        float4 o = make_float4(v[0] + ALPHA_F * res.x, v[1] + ALPHA_F * res.y, v[2] + ALPHA_F * res.z, v[3] + ALPHA_F * res.w);
        *(float4*)(P.out + OUT_Y + (size_t)m * DM + c) = o;
      } else if (MODE == 6) {
        uint2 o; o.x = pack2(v[0], v[1]); o.y = pack2(v[2], v[3]);
        *(uint2*)(P.XB + (size_t)(m & 4095) * DM + ((n0 + nl) & 1023)) = o;
      } else if (MODE == 4) {
        uint2 o; o.x = pack2(v[0], v[1]); o.y = pack2(v[2], v[3]);
        if (nt < 8) { *(uint2*)(P.Kb + (size_t)m * DM + n0 + nl) = o; }
        else if (nt >= 12) { *(uint2*)(P.Vb + (size_t)m * DM + (nt - 12) * 128 + nl) = o; }
        else {
          const bool isk = nt < 10;
          const int ck = (nt & 1) * 128 + nl;
          bf16_t* K1 = P.XB; bf16_t* V1 = P.XB + (size_t)NTOK * 256; bf16_t* VT1 = P.XB + (size_t)NTOK * 512;
          *(uint2*)((isk ? K1 : V1) + (size_t)m * 256 + ck) = o;
          const float4 fo = make_float4(v[0], v[1], v[2], v[3]);
          if (m < NPR) {
            const int b = m >> 13, tt = m & (TP - 1);
            if (!isk) {
              const int hk = ck >> 6, d = ck & 63;
              bf16_t* vt = VT1 + ((size_t)((b * 4 + hk) * 64 + d)) * TP + tt;
              vt[0] = f2bf(v[0]); vt[TP] = f2bf(v[1]); vt[2 * TP] = f2bf(v[2]); vt[3 * TP] = f2bf(v[3]);
            }
            if (tt >= TP - 128) *(float4*)(P.out + (isk ? OUT_WK_P : OUT_WV_P) + ((size_t)(b * 128 + tt - (TP - 128))) * 256 + ck) = fo;
          } else {
            const int ms = m - NPR, b = ms >> 3, tt = ms & 7;
            *(float4*)(P.out + (isk ? OUT_WK_S : OUT_WV_S) + ((size_t)(b * 128 + 120 + tt)) * 256 + ck) = fo;
          }
        }
      }
    }
  }
}
#define LDBG 80
template <int MODE>
__device__ __forceinline__ void gemm_tile_big(const Params& P, unsigned char* smem, int mt, int nt) {
  bf16_t* As = (bf16_t*)smem;
  bf16_t* Bs = As + 256 * LDBG;
  const int t = threadIdx.x, lane = t & 63, w = __builtin_amdgcn_readfirstlane((int)(threadIdx.x >> 6));
  const int wm = w >> 1, wn = w & 1;
  const int g = lane >> 4, lc = lane & 15;
  const int lrow = t >> 3, lch = t & 7;
  const int m0 = mt * 256, n0 = nt * 128;
  const bf16_t* Ap = (MODE == 7) ? ((nt < 16) ? P.Rb : P.Gb) : (MODE == 4) ? P.Rb : P.Gb;
  const bf16_t* Bp = ((MODE == 7) ? P.WtIn0 : (MODE == 3) ? P.WtOut0 : (MODE == 4) ? P.WtIn1 : P.WtOut1) + (size_t)n0 * DM;
  f32x4 acc[4][8];
#pragma unroll
  for (int i = 0; i < 4; i++)
#pragma unroll
    for (int j = 0; j < 8; j++) acc[i][j] = (f32x4){0.f, 0.f, 0.f, 0.f};
  u32x4 ra[8], rb[4];
  const unsigned voff = (unsigned)(lrow * DM + lch * 8) * 2u;
  const char* baseA = (const char*)(Ap + (size_t)m0 * DM);
  const char* baseB = (const char*)Bp;
#define BIG_LOAD(kt_) do { \
    _Pragma("unroll") for (int i_ = 0; i_ < 8; i_++) ra[i_] = *(const u32x4*)(baseA + ((size_t)(32 * i_) * DM + (size_t)(kt_) * 64) * 2 + voff); \
    _Pragma("unroll") for (int i_ = 0; i_ < 4; i_++) rb[i_] = *(const u32x4*)(baseB + ((size_t)(32 * i_) * DM + (size_t)(kt_) * 64) * 2 + voff); \
  } while (0)
  BIG_LOAD(0);
  for (int kt = 0; kt < 16; kt++) {
    __syncthreads();
#pragma unroll
    for (int i = 0; i < 8; i++) *(u32x4*)(As + (lrow + 32 * i) * LDBG + lch * 8) = ra[i];
#pragma unroll
    for (int i = 0; i < 4; i++) *(u32x4*)(Bs + (lrow + 32 * i) * LDBG + lch * 8) = rb[i];
    __syncthreads();
    if (kt + 1 < 16) BIG_LOAD(kt + 1);
#pragma unroll
    for (int ks = 0; ks < 2; ks++) {
      bf16x8 af[4];
#pragma unroll
      for (int i = 0; i < 4; i++) af[i] = *(const bf16x8*)(Bs + (wn * 64 + i * 16 + lc) * LDBG + ks * 32 + g * 8);
#pragma unroll
      for (int jh = 0; jh < 2; jh++) {
        bf16x8 bfr[4];
#pragma unroll
        for (int j = 0; j < 4; j++) bfr[j] = *(const bf16x8*)(As + (wm * 128 + (jh * 4 + j) * 16 + lc) * LDBG + ks * 32 + g * 8);
#pragma unroll
        for (int i = 0; i < 4; i++)
#pragma unroll
          for (int j = 0; j < 4; j++) {
            if (MODE == 7) acc[i][jh * 4 + j] = __builtin_amdgcn_mfma_f32_16x16x32_f16(__builtin_bit_cast(f16x8, af[i]), __builtin_bit_cast(f16x8, bfr[j]), acc[i][jh * 4 + j], 0, 0, 0);
            else acc[i][jh * 4 + j] = __builtin_amdgcn_mfma_f32_16x16x32_bf16(af[i], bfr[j], acc[i][jh * 4 + j], 0, 0, 0);
          }
      }
    }
  }
  float ssq[8];
#pragma unroll
  for (int j = 0; j < 8; j++) ssq[j] = 0.f;
  const int hh7 = (nt & 7) * 2 + wn;
#pragma unroll
  for (int i = 0; i < 4; i++) {
    const int nl = wn * 64 + i * 16 + 4 * g;
#pragma unroll
    for (int j = 0; j < 8; j++) {
      const int m = m0 + wm * 128 + j * 16 + lc;
      const f32x4 v = acc[i][j];
      if (MODE == 7) {
        uint2 o; o.x = pack2(v[0], v[1]); o.y = pack2(v[2], v[3]);
        *(uint2*)(((nt < 16) ? P.Kb : P.Vb) + (size_t)m * DM + (nt & 7) * 128 + nl) = o;
        if (nt < 16) {
          const float4 kq = *(const float4*)(P.k_k + hh7 * 64 + i * 16 + 4 * g);
          const float q0 = __uint_as_float(o.x << 16) * kq.x, q1 = __uint_as_float(o.x & 0xffff0000u) * kq.y;
          const float q2 = __uint_as_float(o.y << 16) * kq.z, q3 = __uint_as_float(o.y & 0xffff0000u) * kq.w;
          ssq[j] = fmaf(q0, q0, ssq[j]); ssq[j] = fmaf(q1, q1, ssq[j]); ssq[j] = fmaf(q2, q2, ssq[j]); ssq[j] = fmaf(q3, q3, ssq[j]);
        }
      } else if (MODE == 3 || MODE == 5) {
        const int c = n0 + nl;
        float4 res;
        if (MODE == 3) res = *(const float4*)(xin_row(P, m) + c);
        else { const uint2 rb2 = *(const uint2*)(P.Rb + (size_t)m * DM + c); res = make_float4(__uint_as_float(rb2.x << 16), __uint_as_float(rb2.x & 0xffff0000u), __uint_as_float(rb2.y << 16), __uint_as_float(rb2.y & 0xffff0000u)); }
        *(float4*)(P.out + OUT_Y + (size_t)m * DM + c) = make_float4(v[0] + ALPHA_F * res.x, v[1] + ALPHA_F * res.y, v[2] + ALPHA_F * res.z, v[3] + ALPHA_F * res.w);
      } else {
        uint2 o; o.x = pack2(v[0], v[1]); o.y = pack2(v[2], v[3]);
        if (nt < 8) { *(uint2*)(P.Kb + (size_t)m * DM + n0 + nl) = o; }
        else if (nt >= 12) { *(uint2*)(P.Vb + (size_t)m * DM + (nt - 12) * 128 + nl) = o; }
        else {
          const bool isk = nt < 10;
          const int ck = (nt & 1) * 128 + nl;
          bf16_t* K1 = P.XB; bf16_t* V1 = P.XB + (size_t)NTOK * 256; bf16_t* VT1 = P.XB + (size_t)NTOK * 512;
          *(uint2*)((isk ? K1 : V1) + (size_t)m * 256 + ck) = o;
          const float4 fo = make_float4(v[0], v[1], v[2], v[3]);
          if (m < NPR) {
            const int b = m >> 13, tt = m & (TP - 1);
            if (!isk) {
              const int hk = ck >> 6, d = ck & 63;
              bf16_t* vt = VT1 + ((size_t)((b * 4 + hk) * 64 + d)) * TP + tt;
              vt[0] = f2bf(v[0]); vt[TP] = f2bf(v[1]); vt[2 * TP] = f2bf(v[2]); vt[3 * TP] = f2bf(v[3]);
            }
            if (tt >= TP - 128) *(float4*)(P.out + (isk ? OUT_WK_P : OUT_WV_P) + ((size_t)(b * 128 + tt - (TP - 128))) * 256 + ck) = fo;
          } else {
            const int ms = m - NPR, b = ms >> 3, tt = ms & 7;
            *(float4*)(P.out + (isk ? OUT_WK_S : OUT_WV_S) + ((size_t)(b * 128 + 120 + tt)) * 256 + ck) = fo;
          }
        }
      }
    }
  }
  if (MODE == 7 && nt < 16) {
#pragma unroll
    for (int j = 0; j < 8; j++) {
      float sj = ssq[j];
      sj += __shfl_xor(sj, 16); sj += __shfl_xor(sj, 32);
      if (g == 0) P.INVN[(size_t)(m0 + wm * 128 + j * 16 + lc) * 16 + hh7] = __builtin_amdgcn_rsqf(fmaxf(sj, 1e-24f));
    }
  }
}
template <int PART>
__device__ __forceinline__ void gemm1_part(const Params& P, unsigned char* smem, int first, int stride) {
  if (PART == 1) {
    for (int tile = first; tile < 136 * 16; tile += stride) {
      const int mt = tile % 136, ntl = tile / 136;
      gemm_tile<1>(P, smem, mt, (ntl < 8) ? ntl : (24 + ntl - 8));
    }
  } else {
    for (int tile = first; tile < 64 * 16; tile += stride) gemm_tile_big<7>(P, smem, tile % 64, 8 + tile / 64);
    for (int id = first; id < 128 + 272; id += stride) {
      int mt, nt;
      if (id < 128) { mt = 128 + (id % 8); nt = 8 + id / 8; }
      else { const int t2 = id - 128; mt = t2 % 136; nt = 32 + t2 / 136; }
      gemm_tile<1>(P, smem, mt, nt);
    }
  }
}
template <int MODE>
__device__ __forceinline__ void gemm_phase(const Params& P, unsigned char* smem, int bid, int nb) {
  constexpr int NT = (MODE == 1) ? 34 : (MODE == 2) ? 16 : (MODE == 4 || MODE == 6) ? 20 : 8;
#if USE_BIG
  if (MODE == 4) {
    for (int tile = bid; tile < 68 * NT; tile += nb) gemm_tile_big<MODE>(P, smem, tile % 68, tile / 68);
    return;
  }
  if (MODE == 3 || MODE == 5) {
    for (int tile = bid; tile < 64 * NT; tile += nb) gemm_tile_big<MODE>(P, smem, tile % 64, tile / 64);
    for (int id = bid; id < 8 * NT; id += nb) gemm_tile<MODE>(P, smem, 128 + (id % 8), id / 8);
    return;
  }
#endif
  const int ntiles = 136 * NT;
  for (int tile = bid; tile < ntiles; tile += nb) gemm_tile<MODE>(P, smem, tile % 136, tile / 136);
}

#define TS 8
#define REC 392
typedef float f32x2 __attribute__((ext_vector_type(2)));
__device__ __forceinline__ f32x2 pkfma(f32x2 a, f32x2 b, f32x2 c) { return __builtin_elementwise_fma(a, b, c); }
#define DPP_ADD(x, ctrl) ((x) + __builtin_bit_cast(float, __builtin_amdgcn_update_dpp(0, __builtin_bit_cast(int, (x)), (ctrl), 0xF, 0xF, true)))
__device__ __forceinline__ float wave_sum_fast(float x) {
  x = DPP_ADD(x, 0xB1); x = DPP_ADD(x, 0x4E); x = DPP_ADD(x, 0x141); x = DPP_ADD(x, 0x140);
  const int xi = __builtin_bit_cast(int, x);
  const float t0 = __builtin_bit_cast(float, __builtin_amdgcn_readlane(xi, 0)), t1 = __builtin_bit_cast(float, __builtin_amdgcn_readlane(xi, 16));
  const float t2 = __builtin_bit_cast(float, __builtin_amdgcn_readlane(xi, 32)), t3 = __builtin_bit_cast(float, __builtin_amdgcn_readlane(xi, 48));
  return (t0 + t1) + (t2 + t3);
}
#define LD8(dst, ptr) do { _Pragma("unroll") for (int j4_ = 0; j4_ < 4; j4_++) { const f32x4 v_ = *(const f32x4*)((ptr) + 4 * j4_); \
    dst[2 * j4_] = (f32x2){v_[0], v_[1]}; dst[2 * j4_ + 1] = (f32x2){v_[2], v_[3]}; } } while (0)

template <int INIT  , bool USEV, bool WRITEY>
__device__ __forceinline__ void scan_unit(const Params& P, float* ws, int lane, int tok0, int nsteps, int h, const float* init_ptr, float* fin) {
  const int rq = lane >> 2, q = lane & 3;
  f32x2 s[4][8];
#pragma unroll
  for (int i = 0; i < 4; i++)
#pragma unroll
    for (int j = 0; j < 8; j++) {
      if (INIT == 1) s[i][j] = (f32x2){((rq + 16 * i) == (16 * q + 2 * j)) ? 1.f : 0.f, ((rq + 16 * i) == (16 * q + 2 * j + 1)) ? 1.f : 0.f};
      else s[i][j] = (f32x2){0.f, 0.f};
    }
  if (INIT == 2) {
#pragma unroll
    for (int i = 0; i < 4; i++) LD8(s[i], init_ptr + (size_t)(rq + 16 * i) * 64 + 16 * q);
  }
  const int c = h * 64 + lane;
  const float kkc = P.k_k[c], kac = P.k_a[c], rkc = P.r_k[c];
  const int crow = h * 64 + rq + 16 * q;
  const float gng = P.gn_g[crow], gnb = P.gn_b[crow];
  const f16_t* EW = ((const f16_t*)(P.out + OUT_Y));
  const f16_t* AA = ((const f16_t*)(P.out + OUT_Y) + (size_t)NTOK * DM);

  bf16_t rk[TS], rv[TS], rr[TS]; f16_t ra_[TS], re_[TS]; float rn_[TS];
#define LOAD_RAW(tb) do { const size_t ub_ = (size_t)(tok0 + (tb)) * DM; \
    const bf16_t* kb_ = P.Kb + ub_; const f16_t* ab_ = AA + ub_; const f16_t* eb_ = EW + ub_; const bf16_t* vb_ = P.Vb + ub_; const bf16_t* rb_ = P.Rb + ub_; \
    _Pragma("unroll") for (int tt_ = 0; tt_ < TS; tt_++) { const unsigned off_ = (unsigned)(tt_ * DM + c); \
    rn_[tt_] = P.INVN[(size_t)(tok0 + (tb) + tt_) * 16 + h]; rk[tt_] = kb_[off_]; ra_[tt_] = ab_[off_]; re_[tt_] = eb_[off_]; if (USEV) rv[tt_] = vb_[off_]; if (WRITEY) rr[tt_] = rb_[off_]; } } while (0)
  LOAD_RAW(0);
  for (int t0 = 0; t0 < nsteps; t0 += TS) {
    {
      float gcum = 1.f;
#pragma unroll
      for (int tt = 0; tt < TS; tt++) {
        const float kraw = bf2f(rk[tt]);
        const float a = (float)ra_[tt];
        const float wd = __expf(-(float)re_[tt]);
        const float kkv = kraw * kkc * rn_[tt];
        const float kf = kraw * (1.f + (a - 1.f) * kac);
        float* rec = ws + tt * REC;
        rec[lane] = kkv * gcum;
        gcum *= wd;
        const float ginv = __builtin_amdgcn_rcpf(gcum);
        rec[128 + lane] = kf * ginv; rec[192 + lane] = kkv * a * ginv;
        if (WRITEY) {
          const float r = bf2f(rr[tt]);
          rec[256 + lane] = r * gcum;
          const float bonus = wave_sum_fast(r * kf * rkc);
          if (lane == 0) rec[384] = bonus;
        }
        if (USEV) rec[320 + lane] = bf2f(rv[tt]);
      }
      ws[TS * REC + lane] = gcum;
    }
    __builtin_amdgcn_wave_barrier();
    asm volatile("s_waitcnt lgkmcnt(0)" ::: "memory");
    if (t0 + TS < nsteps) LOAD_RAW(t0 + TS);
#pragma unroll 1
    for (int tt = 0; tt < TS; tt++) {
      const float* rec = ws + tt * REC;
      f32x2 o2[8], b2[8], kf2[8];
      LD8(o2, rec + 16 * q);
      LD8(b2, rec + 192 + 16 * q);
      if (USEV) LD8(kf2, rec + 128 + 16 * q);
      f32x2 nsa2[4];
      {
        f32x2 acc[4];
#pragma unroll
        for (int i = 0; i < 4; i++) acc[i] = s[i][0] * o2[0];
#pragma unroll
        for (int j = 1; j < 8; j++)
#pragma unroll
          for (int i = 0; i < 4; i++) acc[i] = pkfma(s[i][j], o2[j], acc[i]);
#pragma unroll
        for (int i = 0; i < 4; i++) { const float t = -quad_sum(acc[i][0] + acc[i][1]); nsa2[i] = (f32x2){t, t}; }
      }
      float vv[4];
      if (USEV) {
#pragma unroll
        for (int i = 0; i < 4; i++) vv[i] = rec[320 + rq + 16 * i];
      }
      if (WRITEY) LD8(o2, rec + 256 + 16 * q);
#pragma unroll
      for (int i = 0; i < 4; i++) {
#pragma unroll
        for (int j = 0; j < 8; j++) s[i][j] = pkfma(nsa2[i], b2[j], s[i][j]);
        if (USEV) {
          const f32x2 vv2 = (f32x2){vv[i], vv[i]};
#pragma unroll
          for (int j = 0; j < 8; j++) s[i][j] = pkfma(vv2, kf2[j], s[i][j]);
        }
      }
      if (WRITEY) {
        float y[4];
        {
          f32x2 acc[4];
#pragma unroll
          for (int i = 0; i < 4; i++) acc[i] = s[i][0] * o2[0];
#pragma unroll
          for (int j = 1; j < 8; j++)
#pragma unroll
            for (int i = 0; i < 4; i++) acc[i] = pkfma(s[i][j], o2[j], acc[i]);
#pragma unroll
          for (int i = 0; i < 4; i++) y[i] = quad_sum(acc[i][0] + acc[i][1]);
        }
        const float ysel = (q == 0) ? y[0] : (q == 1) ? y[1] : (q == 2) ? y[2] : y[3];
        const float vsel = (q == 0) ? vv[0] : (q == 1) ? vv[1] : (q == 2) ? vv[2] : vv[3];
        const float mean = wave_sum_fast(ysel) * (1.f / 64.f);
        const float ex2 = wave_sum_fast(ysel * ysel) * (1.f / 64.f);
        const float var = fmaxf(ex2 - mean * mean, 0.f);
        float yo = (ysel - mean) * rsqrtf(var + 64e-5f) * gng + gnb + rec[384] * vsel;
        const size_t off = (size_t)(tok0 + t0 + tt) * DM + crow;
        const float gt = bf2f(P.Gb[off]);
        yo *= gt * sigmoidf_(gt);
        P.Gb[off] = f2bf(yo);
      }
    }
    {
      f32x2 ge[8];
      LD8(ge, ws + TS * REC + 16 * q);
#pragma unroll
      for (int i = 0; i < 4; i++)
#pragma unroll
        for (int j = 0; j < 8; j++) s[i][j] *= ge[j];
    }
    __builtin_amdgcn_wave_barrier();
    asm volatile("s_waitcnt lgkmcnt(0)" ::: "memory");
  }
  if (fin) {
#pragma unroll
    for (int i = 0; i < 4; i++)
#pragma unroll
      for (int j4 = 0; j4 < 4; j4++)
        *(f32x4*)(fin + (size_t)(rq + 16 * i) * 64 + 16 * q + 4 * j4) = (f32x4){s[i][2 * j4][0], s[i][2 * j4][1], s[i][2 * j4 + 1][0], s[i][2 * j4 + 1][1]};
  }
}

__device__ __forceinline__ void phase_scan1(const Params& P, unsigned char* smem, int bid, int nb) {
  const int lane = threadIdx.x & 63, w = __builtin_amdgcn_readfirstlane((int)(threadIdx.x >> 6));
  float* ws = (float*)smem + w * (TS * REC + 64);
  float* Ploc = P.out + OUT_WK_S;
  float* Sloc = P.out + OUT_WV_S;
  const int hb = nb >> 1;
  if (bid >= hb) { gemm1_part<1>(P, smem, bid - hb, nb - hb); return; }
  for (int u = w * hb + bid; u < NBH * (NC - 1) * 2; u += 4 * hb) {
    const int kind = (u ^ (u / (4 * hb))) & 1, rest = u >> 1;
    const int c = rest % (NC - 1), bh = rest / (NC - 1);
    const int tok0 = (bh >> 4) * TP + c * CL, h = bh & 15;
    float* fin = (kind ? Ploc : Sloc) + (size_t)(bh * (NC - 1) + c) * 4096;
    if (kind) scan_unit<1, false, false>(P, ws, lane, tok0, CL, h, nullptr, fin);
    else scan_unit<0, true, false>(P, ws, lane, tok0, CL, h, nullptr, fin);
  }
}
__device__ __forceinline__ void phase_scan2(const Params& P, unsigned char* smem, int bid, int nb) {
  const int lane = threadIdx.x & 63, w = __builtin_amdgcn_readfirstlane((int)(threadIdx.x >> 6));
  float* ws = (float*)smem + w * 256;
  float* Ploc = P.out + OUT_WK_S;
  float* Sloc = P.out + OUT_WV_S;
  for (int item = bid; item < NBH * 4; item += nb) {
    const int bh = item >> 2, row0 = (item & 3) * 16 + w * 4;
    float s[4];
    {
      const float* S0 = Sloc + (size_t)(bh * (NC - 1)) * 4096;
#pragma unroll
      for (int r = 0; r < 4; r++) s[r] = S0[(row0 + r) * 64 + lane];
    }
    for (int c = 1; c < NC - 1; c++) {
      const float* Pc = Ploc + (size_t)(bh * (NC - 1) + c) * 4096;
      float* Sc = Sloc + (size_t)(bh * (NC - 1) + c) * 4096;
      float acc[4];
#pragma unroll
      for (int r = 0; r < 4; r++) { acc[r] = Sc[(row0 + r) * 64 + lane]; ws[r * 64 + lane] = s[r]; }
      __builtin_amdgcn_wave_barrier();
      asm volatile("s_waitcnt lgkmcnt(0)" ::: "memory");
#pragma unroll 1
      for (int hf = 0; hf < 2; hf++) {
        float p[32];
#pragma unroll
        for (int i = 0; i < 32; i++) p[i] = Pc[(hf * 32 + i) * 64 + lane];
#pragma unroll
        for (int r = 0; r < 4; r++) {
#pragma unroll
          for (int i4 = 0; i4 < 8; i4++) {
            const float4 sv = *(const float4*)(ws + r * 64 + hf * 32 + 4 * i4);
            acc[r] = fmaf(sv.x, p[4 * i4], acc[r]); acc[r] = fmaf(sv.y, p[4 * i4 + 1], acc[r]);
            acc[r] = fmaf(sv.z, p[4 * i4 + 2], acc[r]); acc[r] = fmaf(sv.w, p[4 * i4 + 3], acc[r]);
          }
        }
      }
      __builtin_amdgcn_wave_barrier();
      asm volatile("s_waitcnt lgkmcnt(0)" ::: "memory");
#pragma unroll
      for (int r = 0; r < 4; r++) { s[r] = acc[r]; Sc[(row0 + r) * 64 + lane] = acc[r]; }
    }
  }
}
__device__ __forceinline__ void phase_scan3(const Params& P, unsigned char* smem, int bid, int nb) {
  const int lane = threadIdx.x & 63, w = __builtin_amdgcn_readfirstlane((int)(threadIdx.x >> 6));
  float* ws = (float*)smem + w * (TS * REC + 64);
  float* Sloc = P.out + OUT_WV_S;
  const int hb = nb >> 1;
  if (bid < hb) {
    for (int u = w * hb + bid; u < NBH * NC; u += 4 * hb) {
      const int bh = u >> 5, c = u & 31;
      const int tok0 = (bh >> 4) * TP + c * CL, h = bh & 15;
      const float* ip = (c > 0) ? (Sloc + (size_t)(bh * (NC - 1) + c - 1) * 4096) : nullptr;
      float* fin = (c == NC - 1) ? (P.out + OUT_WKV_P + (size_t)bh * 4096) : nullptr;
      if (c > 0) scan_unit<2, true, true>(P, ws, lane, tok0, CL, h, ip, fin);
      else scan_unit<0, true, true>(P, ws, lane, tok0, CL, h, ip, fin);
    }
  } else {
    for (int sb = w * (nb - hb) + (bid - hb); sb < 2048; sb += 4 * (nb - hb))
      scan_unit<2, true, true>(P, ws, lane, NPR + (sb >> 4) * 8, 8, sb & 15, P.state_wkv + (size_t)sb * 4096, P.out + OUT_WKV_S + (size_t)sb * 4096);
    __syncthreads();
    late_weight_prep(P, smem, bid - hb, nb - hb);
  }
}

__device__ __forceinline__ void phase_ln(const Params& P, int layer, int bid, int nb) {
  const int lane = threadIdx.x & 63, w = __builtin_amdgcn_readfirstlane((int)(threadIdx.x >> 6));
  const float* gg = P.ln_g + layer * DM; const float* bb = P.ln_b + layer * DM;
  for (int tok = bid * 4 + w; tok < NTOK; tok += nb * 4) {
    f32x4* row = (f32x4*)(P.out + OUT_Y + (size_t)tok * DM);
    f32x4 v[4];
    float sum = 0.f;
#pragma unroll
    for (int i = 0; i < 4; i++) { v[i] = row[lane + 64 * i]; sum += v[i][0] + v[i][1] + v[i][2] + v[i][3]; }
    const float mean = wave_sum(sum) * (1.f / 1024.f);
    float sq = 0.f;
#pragma unroll
    for (int i = 0; i < 4; i++) { v[i] -= mean; sq += v[i][0] * v[i][0] + v[i][1] * v[i][1] + v[i][2] * v[i][2] + v[i][3] * v[i][3]; }
    const float rs = rsqrtf(wave_sum(sq) * (1.f / 1024.f) + 1e-5f);
#pragma unroll
    for (int i = 0; i < 4; i++) {
      const f32x4 g4 = ((const f32x4*)gg)[lane + 64 * i], b4 = ((const f32x4*)bb)[lane + 64 * i];
      const f32x4 o = v[i] * rs * g4 + b4;
      if (layer != 0) row[lane + 64 * i] = o;
      if (layer == 0) { uint2 ob; ob.x = pack2(o[0], o[1]); ob.y = pack2(o[2], o[3]); ((uint2*)(P.Rb + (size_t)tok * DM))[lane + 64 * i] = ob; }
    }
  }
}

__device__ __forceinline__ void attn_prompt_item(const Params& P, unsigned char* smem, int item) {
  const int qh = item & 1, hk = (item >> 1) & 3, n = (item >> 3) & 63, b = item >> 9;
  bf16_t* Ks = (bf16_t*)smem;
  bf16_t* Vs = Ks + 192 * 72;
  const bf16_t* K1 = P.XB; const bf16_t* VT1 = P.XB + (size_t)NTOK * 512;
  const bf16_t* Q1 = P.Kb; const bf16_t* G1 = P.Vb; bf16_t* AO = P.Gb;
  const int t = threadIdx.x, lane = t & 63, w = t >> 6;
  const int g = lane >> 4, lc = lane & 15;
  const int pos0 = (n - 1) * 128 + 64 * qh;
  __syncthreads();
#pragma unroll
  for (int i = 0; i < 6; i++) {
    const int idx = t + 256 * i; const int row = idx >> 3, ch = idx & 7; const int pos = pos0 + row;
    uint4 v = make_uint4(0, 0, 0, 0);
    if (pos >= 0) v = *(const uint4*)(K1 + ((size_t)(b * TP + pos)) * 256 + hk * 64 + ch * 8);
    *(uint4*)(Ks + row * 72 + ch * 8) = v;
  }
#pragma unroll
  for (int i = 0; i < 6; i++) {
    const int idx = t + 256 * i; const int d = idx / 24, ch = idx % 24; const int pos = pos0 + ch * 8;
    uint4 v = make_uint4(0, 0, 0, 0);
    if (pos >= 0) v = *(const uint4*)(VT1 + ((size_t)((b * 4 + hk) * 64 + d)) * TP + pos);
    *(uint4*)(Vs + d * 200 + ch * 8) = v;
  }
  __syncthreads();
  const int h = hk * 4 + w;
  const float slope = exp2f(-0.5f * (float)(h + 1));
  const float sink = P.att_sinks[h];
  for (int sb = 0; sb < 2; sb++) {
    const int i0 = 64 * qh + 32 * sb;
    const int tokb = b * TP + n * 128 + i0;
    bf16x8 qf[2][2];
#pragma unroll
    for (int nn = 0; nn < 2; nn++)
#pragma unroll
      for (int ks = 0; ks < 2; ks++) qf[nn][ks] = *(const bf16x8*)(Q1 + (size_t)(tokb + 16 * nn + lc) * DM + h * 64 + ks * 32 + g * 8);
    float mrun[2] = {sink, sink}, lrun[2] = {1.f, 1.f};
    f32x4 O[4][2];
#pragma unroll
    for (int dm = 0; dm < 4; dm++) { O[dm][0] = (f32x4){0.f, 0.f, 0.f, 0.f}; O[dm][1] = (f32x4){0.f, 0.f, 0.f, 0.f}; }
    for (int kt = 0; kt < 3; kt++) {
      if (n == 0 && (qh + kt) < 2) continue;
      f32x4 S[4][2];
#pragma unroll
      for (int mm = 0; mm < 4; mm++) { S[mm][0] = (f32x4){0.f, 0.f, 0.f, 0.f}; S[mm][1] = (f32x4){0.f, 0.f, 0.f, 0.f}; }
#pragma unroll
      for (int ks = 0; ks < 2; ks++)
#pragma unroll
        for (int mm = 0; mm < 4; mm++) {
          const bf16x8 kf = *(const bf16x8*)(Ks + (kt * 64 + mm * 16 + lc) * 72 + ks * 32 + g * 8);
          S[mm][0] = __builtin_amdgcn_mfma_f32_16x16x32_bf16(kf, qf[0][ks], S[mm][0], 0, 0, 0);
          S[mm][1] = __builtin_amdgcn_mfma_f32_16x16x32_bf16(kf, qf[1][ks], S[mm][1], 0, 0, 0);
        }
#pragma unroll
      for (int nn = 0; nn < 2; nn++) {
        const int qi = i0 + 16 * nn + lc;
        float mx = mrun[nn];
#pragma unroll
        for (int mm = 0; mm < 4; mm++)
#pragma unroll
          for (int r = 0; r < 4; r++) {
            const int j = 64 * (qh + kt) + 16 * mm + 4 * g + r;
            const int dist = 128 + qi - j;
            const bool live = (dist >= 0) && (dist < 128);
            const float sv = live ? (S[mm][nn][r] * 0.125f - slope * (float)dist) : -1e30f;
            S[mm][nn][r] = sv; mx = fmaxf(mx, sv);
          }
        mx = fmaxf(mx, __shfl_xor(mx, 16)); mx = fmaxf(mx, __shfl_xor(mx, 32));
        const float corr = __expf(mrun[nn] - mx); mrun[nn] = mx;
        float sum = 0.f;
#pragma unroll
        for (int mm = 0; mm < 4; mm++)
#pragma unroll
          for (int r = 0; r < 4; r++) { const float pp = __expf(S[mm][nn][r] - mx); S[mm][nn][r] = pp; sum += pp; }
        sum += __shfl_xor(sum, 16); sum += __shfl_xor(sum, 32);
        lrun[nn] = lrun[nn] * corr + sum;
#pragma unroll
        for (int dm = 0; dm < 4; dm++) { O[dm][nn][0] *= corr; O[dm][nn][1] *= corr; O[dm][nn][2] *= corr; O[dm][nn][3] *= corr; }
      }
#pragma unroll
      for (int k2 = 0; k2 < 2; k2++) {
        bf16x8 pf[2];
#pragma unroll
        for (int nn = 0; nn < 2; nn++) {
          const unsigned u0 = pack2(S[2 * k2][nn][0], S[2 * k2][nn][1]), u1 = pack2(S[2 * k2][nn][2], S[2 * k2][nn][3]);
          const unsigned u2 = pack2(S[2 * k2 + 1][nn][0], S[2 * k2 + 1][nn][1]), u3 = pack2(S[2 * k2 + 1][nn][2], S[2 * k2 + 1][nn][3]);
          const uint4 uu = make_uint4(u0, u1, u2, u3);
          pf[nn] = *(const bf16x8*)&uu;
        }
#pragma unroll
        for (int dm = 0; dm < 4; dm++) {
          const bf16_t* vb = Vs + (dm * 16 + lc) * 200 + kt * 64 + k2 * 32 + 4 * g;
          const uint2 lo = *(const uint2*)vb, hi = *(const uint2*)(vb + 16);
          const uint4 uu = make_uint4(lo.x, lo.y, hi.x, hi.y);
          const bf16x8 vf = *(const bf16x8*)&uu;
          O[dm][0] = __builtin_amdgcn_mfma_f32_16x16x32_bf16(vf, pf[0], O[dm][0], 0, 0, 0);
          O[dm][1] = __builtin_amdgcn_mfma_f32_16x16x32_bf16(vf, pf[1], O[dm][1], 0, 0, 0);
        }
      }
    }
#pragma unroll
    for (int nn = 0; nn < 2; nn++) {
      const float inv = 1.f / lrun[nn];
      const size_t tok = (size_t)(tokb + 16 * nn + lc);
#pragma unroll
      for (int dm = 0; dm < 4; dm++) {
        const int d = dm * 16 + 4 * g;
        const uint2 gv = *(const uint2*)(G1 + tok * DM + h * 64 + d);
        const float g0 = __uint_as_float(gv.x << 16), g1 = __uint_as_float(gv.x & 0xffff0000u);
        const float g2 = __uint_as_float(gv.y << 16), g3 = __uint_as_float(gv.y & 0xffff0000u);
        uint2 o;
        o.x = pack2(O[dm][nn][0] * inv * g0 * sigmoidf_(g0), O[dm][nn][1] * inv * g1 * sigmoidf_(g1));
        o.y = pack2(O[dm][nn][2] * inv * g2 * sigmoidf_(g2), O[dm][nn][3] * inv * g3 * sigmoidf_(g3));
        *(uint2*)(AO + tok * DM + h * 64 + d) = o;
      }
    }
  }
}

__device__ __forceinline__ void attn_sample_item(const Params& P, unsigned char* smem, int item) {
  const int b = item >> 2, hk = item & 3;
  const int t = threadIdx.x, lane = t & 63, w = t >> 6;
  float* kv = (float*)smem;
  float* qs = kv + 136 * 65 + w * 512;
  float* ps = kv + 136 * 65 + 2048 + w * (8 * 136);
  const bf16_t* K1 = P.XB; const bf16_t* V1 = P.XB + (size_t)NTOK * 256;
  const bf16_t* Q1 = P.Kb; const bf16_t* G1 = P.Vb; bf16_t* AO = P.Gb;
  const int h = hk * 4 + w;
  const float slope = exp2f(-0.5f * (float)(h + 1));
  const float sink = P.att_sinks[h];
  const int tok0 = NPR + b * 8;
  __syncthreads();
#pragma unroll 2
  for (int it = 0; it < 8; it++) {
    const int idx = t + 256 * it; const int row = idx >> 4, c4 = idx & 15;
    const size_t so = ((size_t)(b * 128 + row)) * 256 + hk * 64 + c4 * 4;
    const float4 kx = *(const float4*)(P.cache_k + so);
    const float4 vx = *(const float4*)(P.cache_v + so);
    float* kd = kv + row * 65 + c4 * 4;
    kd[0] = kx.x; kd[1] = kx.y; kd[2] = kx.z; kd[3] = kx.w;
    if (row >= 8) {
      const size_t dofs = ((size_t)(b * 128 + row - 8)) * 256 + hk * 64 + c4 * 4;
      *(float4*)(P.out + OUT_WK_S + dofs) = kx;
      *(float4*)(P.out + OUT_WV_S + dofs) = vx;
    }
  }
#pragma unroll
  for (int it = 0; it < 2; it++) {
    const int idx = t + 256 * it; const int r8 = idx >> 6, d = idx & 63;
    kv[(128 + r8) * 65 + d] = bf2f(K1[(size_t)(tok0 + r8) * 256 + hk * 64 + d]);
  }
#pragma unroll
  for (int i = 0; i < 8; i++) qs[i * 64 + lane] = bf2f(Q1[(size_t)(tok0 + i) * DM + h * 64 + lane]);
  __syncthreads();
  float sc[3][8];
#pragma unroll
  for (int ksel = 0; ksel < 3; ksel++) {
    float acc[8];
#pragma unroll
    for (int i = 0; i < 8; i++) acc[i] = 0.f;
    const float* kr = kv + ((ksel < 2) ? (lane + 64 * ksel) : (128 + (lane & 7))) * 65;
#pragma unroll 2
    for (int d4 = 0; d4 < 16; d4++) {
      const float k0 = kr[4 * d4], k1 = kr[4 * d4 + 1], k2 = kr[4 * d4 + 2], k3 = kr[4 * d4 + 3];
#pragma unroll
      for (int i = 0; i < 8; i++) {
        const float4 qv = *(const float4*)(qs + i * 64 + 4 * d4);
        acc[i] = fmaf(qv.x, k0, acc[i]); acc[i] = fmaf(qv.y, k1, acc[i]); acc[i] = fmaf(qv.z, k2, acc[i]); acc[i] = fmaf(qv.w, k3, acc[i]);
      }
    }
#pragma unroll
    for (int i = 0; i < 8; i++) {
      int dist; bool live;
      if (ksel < 2) { const int j = lane + 64 * ksel; dist = 128 + i - j; live = (j > i); }
      else { dist = i - lane; live = (lane <= i); }
      sc[ksel][i] = live ? (acc[i] * 0.125f - slope * (float)dist) : -1e30f;
    }
  }
#pragma unroll
  for (int i = 0; i < 8; i++) {
    float mx = fmaxf(fmaxf(sc[0][i], sc[1][i]), sc[2][i]);
    mx = fmaxf(wave_max(mx), sink);
    const float p0 = __expf(sc[0][i] - mx), p1 = __expf(sc[1][i] - mx), p2 = __expf(sc[2][i] - mx);
    const float den = wave_sum(p0 + p1 + p2) + __expf(sink - mx);
    const float inv = 1.f / den;
    ps[i * 136 + lane] = p0 * inv; ps[i * 136 + 64 + lane] = p1 * inv;
    if (lane < 8) ps[i * 136 + 128 + lane] = p2 * inv;
  }
  __syncthreads();
#pragma unroll 4
  for (int it = 0; it < 8; it++) {
    const int idx = t + 256 * it; const int row = idx >> 4, c4 = idx & 15;
    *(float4*)(kv + row * 64 + c4 * 4) = *(const float4*)(P.cache_v + ((size_t)(b * 128 + row)) * 256 + hk * 64 + c4 * 4);
  }
#pragma unroll
  for (int it = 0; it < 2; it++) {
    const int idx = t + 256 * it; const int r8 = idx >> 6, d = idx & 63;
    kv[(128 + r8) * 64 + d] = bf2f(V1[(size_t)(tok0 + r8) * 256 + hk * 64 + d]);
  }
  __syncthreads();
  float o[8];
#pragma unroll
  for (int i = 0; i < 8; i++) o[i] = 0.f;
#pragma unroll 2
  for (int j0 = 0; j0 < 136; j0 += 4) {
    const float v0 = kv[(j0) * 64 + lane], v1 = kv[(j0 + 1) * 64 + lane], v2 = kv[(j0 + 2) * 64 + lane], v3 = kv[(j0 + 3) * 64 + lane];
#pragma unroll
    for (int i = 0; i < 8; i++) {
      const float4 pa = *(const float4*)(ps + i * 136 + j0);
      o[i] = fmaf(pa.x, v0, o[i]); o[i] = fmaf(pa.y, v1, o[i]); o[i] = fmaf(pa.z, v2, o[i]); o[i] = fmaf(pa.w, v3, o[i]);
    }
  }
#pragma unroll
  for (int i = 0; i < 8; i++) {
    const size_t off = (size_t)(tok0 + i) * DM + h * 64 + lane;
    const float gt = bf2f(G1[off]);
    AO[off] = f2bf(o[i] * gt * sigmoidf_(gt));
  }
}
__device__ __forceinline__ void phase_attn(const Params& P, unsigned char* smem, int bid, int nb) {
#if PROBE == 7
  for (int item = bid; item < 1024; item += nb) attn_prompt_item(P, smem, item);
#elif PROBE == 8
  for (int item = bid; item < 512; item += nb) attn_sample_item(P, smem, item);
#endif
  for (int item = bid; item < 1024 + 512; item += nb) {
    if (item < 1024) attn_prompt_item(P, smem, item);
    else attn_sample_item(P, smem, item - 1024);
  }
}

#if MULTI_LAUNCH
#define PH_BARRIER(ph)
#else
#define PH_BARRIER(ph) do { if ((ph) + 1 < P.phase_end) xcd_barrier(xb); } while (0)
#endif
#define RUN_PH(ph, call) do { if (P.phase_begin <= (ph) && (ph) < P.phase_end) { if ((REPMASK >> (ph)) & 1) { call; PH_BARRIER(ph); } call; PH_BARRIER(ph); } } while (0)

__global__ void __launch_bounds__(256, 2) fwd_kernel(Params P) {
  __shared__ __attribute__((aligned(16))) unsigned char smem[SMEM_BYTES];
  const int bid = blockIdx.x, nb = gridDim.x;
#if !MULTI_LAUNCH
  __shared__ uint4 xb_words;
  if (threadIdx.x == 0) xb_words = make_uint4(0u, 0u, 0u, 0u);
  __syncthreads();
  XcdBarrier xb = xcd_barrier_post(P.bar, (volatile LAS unsigned*)&xb_words);
#endif
#if (PHMASK >> 0) & 1
  RUN_PH(0, phase_prep(P, smem, bid, nb));
#endif
#if (PHMASK >> 1) & 1
  RUN_PH(1, gemm1_part<0>(P, smem, bid, nb));
#endif
#if (PHMASK >> 2) & 1
  RUN_PH(2, gemm_phase<2>(P, smem, bid, nb));
#endif
#if (PHMASK >> 3) & 1
  RUN_PH(3, phase_scan1(P, smem, bid, nb));
#endif
#if (PHMASK >> 4) & 1
  RUN_PH(4, phase_scan2(P, smem, bid, nb));
#endif
#if (PHMASK >> 5) & 1
  RUN_PH(5, phase_scan3(P, smem, bid, nb));
#endif
#if (PHMASK >> 6) & 1
  RUN_PH(6, gemm_phase<3>(P, smem, bid, nb));
#endif
#if (PHMASK >> 7) & 1
  RUN_PH(7, phase_ln(P, 0, bid, nb));
#endif
#if (PHMASK >> 8) & 1
  RUN_PH(8, gemm_phase<4>(P, smem, bid, nb));
#endif
#if (PHMASK >> 9) & 1
  RUN_PH(9, phase_attn(P, smem, bid, nb));
#endif
#if (PHMASK >> 10) & 1
  RUN_PH(10, gemm_phase<5>(P, smem, bid, nb));
#endif
#if (PHMASK >> 11) & 1
  RUN_PH(11, phase_ln(P, 1, bid, nb));
#endif
#if PROBE && PROBE < 7
  xcd_barrier(xb);
  gemm_phase<6>(P, smem, bid, nb);
#endif
#if !MULTI_LAUNCH
  if (P.phase_end > NPHASE) cg::this_grid().sync();
#endif
}

extern "C" void kernel_launch(void* const* d_in, const int* in_sizes, int n_in, void* d_out, int out_size, void* d_ws, size_t ws_size, hipStream_t stream) {
  Params P{};
  P.x_prompt = (const float*)d_in[0]; P.x_sample = (const float*)d_in[1]; P.state_wkv = (const float*)d_in[2]; P.state_shift = (const float*)d_in[3];
  P.cache_k = (const float*)d_in[4]; P.cache_v = (const float*)d_in[5]; P.ln_g = (const float*)d_in[6]; P.ln_b = (const float*)d_in[7];
  P.mu = (const float*)d_in[8]; P.w_in = (const float*)d_in[9]; P.w0 = (const float*)d_in[10]; P.w1 = (const float*)d_in[11]; P.w2 = (const float*)d_in[12];
  P.a0 = (const float*)d_in[13]; P.a1 = (const float*)d_in[14]; P.a2 = (const float*)d_in[15]; P.k_k = (const float*)d_in[16]; P.k_a = (const float*)d_in[17];
  P.r_k = (const float*)d_in[18]; P.gn_g = (const float*)d_in[19]; P.gn_b = (const float*)d_in[20]; P.w_out = (const float*)d_in[21];
  P.att_w_in = (const float*)d_in[22]; P.att_sinks = (const float*)d_in[23]; P.att_w_out = (const float*)d_in[24];
  P.out = (float*)d_out;
  unsigned char* ws = (unsigned char*)d_ws;
  size_t off = 0;
  auto take = [&](size_t bytes) { unsigned char* p = ws + off; off += (bytes + 255) & ~(size_t)255; return p; };
  P.bar = (unsigned*)take(16384);
  P.WtIn0 = (bf16_t*)take((size_t)4352 * DM * 2);
  P.W2t = (bf16_t*)take((size_t)DM * 64 * 2);
  P.A2t = (bf16_t*)take((size_t)DM * 64 * 2);
  P.WtOut0 = (bf16_t*)take((size_t)DM * DM * 2);
  P.WtIn1 = (bf16_t*)take((size_t)2560 * DM * 2);
  P.WtOut1 = (bf16_t*)take((size_t)DM * DM * 2);
  P.XB = (bf16_t*)take((size_t)NTOK * DM * 2);
  P.XXB = (bf16_t*)take((size_t)NTOK * DM * 2);
  P.Rb = (bf16_t*)take((size_t)NTOK * DM * 2);
  P.Kb = (bf16_t*)take((size_t)NTOK * DM * 2);
  P.Vb = (bf16_t*)take((size_t)NTOK * DM * 2);
  P.Gb = (bf16_t*)take((size_t)NTOK * DM * 2);
  P.H1 = (bf16_t*)take((size_t)NTOK * 64 * 2);
  P.H2 = (bf16_t*)take((size_t)NTOK * 64 * 2);
  P.MU16 = (bf16_t*)take((size_t)6 * DM * 2);
  P.INVN = (float*)take((size_t)NTOK * 16 * 4);
  if (off > ws_size) { fprintf(stderr, "workspace too small: need %zu have %zu\n", off, ws_size); return; }
#if MULTI_LAUNCH
  for (int ph = 0; ph < NPHASE; ph++) {
    P.phase_begin = ph; P.phase_end = ph + 1;
    hipLaunchKernelGGL(fwd_kernel, dim3(512), dim3(256), 0, stream, P);
  }
#else
  static int grid_blocks = 0;
  if (!grid_blocks) {
    int dev = 0, cus = 0, per_cu = 0;
    hipGetDevice(&dev);
    hipDeviceGetAttribute(&cus, hipDeviceAttributeMultiprocessorCount, dev);
    hipOccupancyMaxActiveBlocksPerMultiprocessor(&per_cu, fwd_kernel, 256, 0);
    if (per_cu > 2) per_cu = 2;
    if (per_cu < 1) per_cu = 1;
    grid_blocks = cus * per_cu;
  }
  hipMemsetAsync(P.bar, 0, 16384, stream);
  P.phase_begin = 0; P.phase_end = NPHASE;
  void* args[] = {&P};
  hipError_t e = hipLaunchCooperativeKernel((void*)fwd_kernel, dim3(grid_blocks), dim3(256), args, 0, stream);
  if (e != hipSuccess) fprintf(stderr, "cooperative launch failed: %s (grid %d)\n", hipGetErrorString(e), grid_blocks);
#endif
}
```
